# Optimizing an MI355X kernel written in HIP

```python
import math
import jax
import jax.numpy as jnp
from jax import lax
import numpy as np

D_MODEL = 1024
BATCH = 8
SEQ = 4096
DEPTH = 2

GRID_W = 64
CTX_LEN = 256
DA_HEADS = 4
DA_HEAD_DIM = 64
DA_WIDTH = DA_HEADS * 2 * DA_HEAD_DIM
HY_WIDTH = D_MODEL - DA_WIDTH
HY_ORDER = 2
HY_SHORT = 3
HY_EMB = 33
HY_BANDS = (HY_EMB - 1) // 2
HY_FFN = 64
HY_FILTERS = HY_ORDER * 2 * HY_WIDTH
HY_TARGET = 1e-2
HY_MIN_DECAY = math.log(HY_TARGET) / 0.3
HY_MAX_DECAY = math.log(HY_TARGET) / 1.5
IN0_WIDTH = 3 * DA_WIDTH + 3 * HY_WIDTH
CV_WIDTH = D_MODEL
CV_KERNEL = 31
N_GROUPS = 4
EXPERTS_PER_GROUP = 8
N_EXPERTS = N_GROUPS * EXPERTS_PER_GROUP
TOP_K = 2
D_EXPERT = 512
ROPE_THETA = 10000.0
EPS = 1e-6
Q_BLOCK = 128
N_EVEN = (DEPTH + 1) // 2
N_ODD = DEPTH // 2

kernel_name = 'hybrid_diffattn_hyena_conformer_hmoe'

F32 = jnp.float32


def rmsnorm(x, g):
    x32 = x.astype(F32)
    y = x32 * lax.rsqrt(jnp.mean(x32 * x32, axis=-1, keepdims=True) + EPS)
    return (y * g).astype(x.dtype)


def layernorm(x, g, b):
    x32 = x.astype(F32)
    mu = jnp.mean(x32, axis=-1, keepdims=True)
    var = jnp.mean(jnp.square(x32 - mu), axis=-1, keepdims=True)
    return ((x32 - mu) * lax.rsqrt(var + EPS) * g + b).astype(x.dtype)


def adaln(cvec, w, b):
    m = (jax.nn.silu(cvec) @ w + b).reshape((-1, 1, 6 * D_MODEL))
    return jnp.split(m, 6, axis=-1)


def modulate(h, shift, scale):
    return h * (1.0 + scale) + shift


def _heads(t, n_heads):
    bsz, n, _ = t.shape
    return t.reshape(bsz, n, n_heads, -1).transpose(0, 2, 1, 3)


def rope_2d(x):
    n, hd = x.shape[2], x.shape[3]
    rows = n // GRID_W
    row = jnp.repeat(jnp.arange(rows, dtype=F32), GRID_W)
    col = jnp.tile(jnp.arange(GRID_W, dtype=F32), rows)
    half = hd // 2
    inv = ROPE_THETA ** (-jnp.arange(0, half, 2, dtype=F32) / half)
    x32 = x.astype(F32)

    def rot(xp, pos):
        ang = pos[:, None] * inv
        cos, sin = jnp.cos(ang), jnp.sin(ang)
        a, b = jnp.split(xp, 2, axis=-1)
        return jnp.concatenate([a * cos - b * sin, a * sin + b * cos], axis=-1)

    out = jnp.concatenate([rot(x32[..., :half], row), rot(x32[..., half:], col)], axis=-1)
    return out.astype(x.dtype)


def diff_attention(q, k, v, lam, subln_g, lam_init):
    bsz, h2, lq, d = q.shape
    nh = h2 // 2
    nb = lq // Q_BLOCK
    qb = q.reshape(bsz, h2, nb, Q_BLOCK, d).transpose(2, 0, 1, 3, 4)
    scale = d ** -0.5

    def block(qi):
        s = jnp.einsum('bhqd,bhkd->bhqk', qi, k).astype(F32) * scale
        p = jax.nn.softmax(s, axis=-1).reshape(bsz, nh, 2, Q_BLOCK, -1)
        a = p[:, :, 0] - lam * p[:, :, 1]
        o = jnp.einsum('bhqk,bhkv->bhqv', a.astype(v.dtype), v)
        return rmsnorm(o, subln_g) * (1.0 - lam_init)

    o = lax.map(block, qb)
    return o.transpose(1, 0, 3, 2, 4).reshape(bsz, lq, nh * 2 * d)


def depthwise_conv(x, w, b):
    kw, ch = w.shape
    y = lax.conv_general_dilated(x, w[:, None, :].astype(x.dtype), window_strides=(1,),
                                 padding=[((kw - 1) // 2, kw // 2)],
                                 dimension_numbers=('NWC', 'WIO', 'NWC'),
                                 feature_group_count=ch)
    return y + b


def hyena_kernels(n, w1, b1, fr1, w2, b2, fr2, w3, b3):
    t = jnp.linspace(0.0, 1.0, n, dtype=F32)[:, None]
    ang = (2.0 * math.pi / n) * jnp.arange(n, dtype=F32)[:, None] * jnp.linspace(1e-4, HY_BANDS - 1, HY_BANDS, dtype=F32)[None, :]
    z = jnp.concatenate([t, jnp.cos(ang), -jnp.sin(ang)], axis=-1).astype(w1.dtype)
    h = jnp.sin(fr1 * (z @ w1 + b1))
    h = jnp.sin(fr2 * (h @ w2 + b2))
    h = (h @ w3 + b3).astype(F32).reshape(n, HY_ORDER, 2, HY_WIDTH)
    deltas = jnp.abs(jnp.linspace(HY_MIN_DECAY, HY_MAX_DECAY, HY_WIDTH, dtype=F32))
    h = h * jnp.exp(-t[:, :, None, None] * deltas)
    fwd, bwd = h[:, :, 0], h[:, :, 1]
    kc = jnp.concatenate([fwd, jnp.zeros_like(fwd[:1]), bwd[:0:-1]], axis=0)
    return kc / jnp.sum(jnp.abs(kc), axis=0, keepdims=True)


def fft_long_conv(z, kf, bias):
    n = z.shape[1]
    z32 = z.astype(F32)
    y = jnp.fft.irfft(jnp.fft.rfft(z32, n=2 * n, axis=1) * kf, n=2 * n, axis=1)[:, :n]
    return (y + z32 * bias.astype(F32)).astype(z.dtype)


def hyena_mixer(u, short_w, short_b, w1, b1, fr1, w2, b2, fr2, w3, b3, bias):
    n = u.shape[1]
    u = depthwise_conv(u, short_w, short_b)
    v, x1, x2 = jnp.split(u, 3, axis=-1)
    kf = jnp.fft.rfft(hyena_kernels(n, w1, b1, fr1, w2, b2, fr2, w3, b3), axis=0)
    z = x1 * fft_long_conv(v, kf[:, 0], bias[0])
    return x2 * fft_long_conv(z, kf[:, 1], bias[1])


def conformer_conv(h, w1, b1, dw_w, dw_b, ln_g, ln_b, w2, b2):
    a = h @ w1 + b1
    a, g = jnp.split(a, 2, axis=-1)
    a = a * jax.nn.sigmoid(g)
    a = depthwise_conv(a, dw_w, dw_b)
    a = jax.nn.silu(layernorm(a, ln_g, ln_b))
    return a @ w2 + b2


def hier_moe(h, wg, bg, we, be, w_gate, w_up, w_down):
    bsz, n, d = h.shape
    t = h.reshape(-1, d)
    ntok = t.shape[0]
    g_prob = jax.nn.softmax((t @ wg + bg).astype(F32), axis=-1)
    g_w, g_idx = lax.top_k(g_prob, 1)
    e_logits = (t @ we + be).astype(F32).reshape(ntok, N_GROUPS, EXPERTS_PER_GROUP)
    e_logits = e_logits[jnp.arange(ntok), g_idx[:, 0]]
    e_w, e_idx = lax.top_k(jax.nn.softmax(e_logits, axis=-1), TOP_K)
    e_w = e_w / jnp.sum(e_w, axis=-1, keepdims=True)
    wts = g_w * e_w
    gid = g_idx * EXPERTS_PER_GROUP + e_idx
    comb = jnp.sum(jax.nn.one_hot(gid, N_EXPERTS, dtype=F32) * wts[..., None], axis=1)
    y = jnp.zeros((ntok, d), F32)
    for e in range(N_EXPERTS):
        he = jax.nn.silu(t @ w_gate[e]) * (t @ w_up[e])
        y = y + comb[:, e:e + 1] * (he @ w_down[e]).astype(F32)
    return y.astype(h.dtype).reshape(bsz, n, d)


def setup_inputs(seed: int = 0) -> dict:
    key = jax.random.key(seed)
    ks = iter(jax.random.split(key, 48))

    def nrm(shape, scale):
        return jax.random.normal(next(ks), shape, jnp.float32) * scale

    def gain(shape, s=0.02):
        return 1.0 + nrm(shape, s)

    D = D_MODEL
    C3 = 3 * HY_WIDTH
    DO = DA_WIDTH + HY_WIDTH
    return dict(
        x=nrm((BATCH, SEQ, D), 1.0),
        c=nrm((BATCH, D), 1.0),
        ctx=nrm((BATCH, CTX_LEN, D), 1.0),
        c_ctx=nrm((D,), 1.0),
        ada_w=nrm((DEPTH, D, 6 * D), 0.5 * D ** -0.5),
        ada_b=nrm((DEPTH, 6 * D), 0.01),
        norm1_g=gain((DEPTH, D)),
        norm2_g=gain((DEPTH, D)),
        final_g=gain((D,)),
        w_in0=nrm((N_EVEN, D, IN0_WIDTH), D ** -0.5),
        w_out0=nrm((N_EVEN, DO, D), DO ** -0.5),
        lam_q1=nrm((N_EVEN, DA_HEAD_DIM), 0.1),
        lam_k1=nrm((N_EVEN, DA_HEAD_DIM), 0.1),
        lam_q2=nrm((N_EVEN, DA_HEAD_DIM), 0.1),
        lam_k2=nrm((N_EVEN, DA_HEAD_DIM), 0.1),
        subln_g=gain((N_EVEN, 2 * DA_HEAD_DIM)),
        hy_short_w=nrm((N_EVEN, HY_SHORT, C3), HY_SHORT ** -0.5),
        hy_short_b=nrm((N_EVEN, C3), 0.01),
        hy_w1=nrm((N_EVEN, HY_EMB, HY_FFN), HY_EMB ** -0.5),
        hy_b1=nrm((N_EVEN, HY_FFN), 0.1),
        hy_fr1=gain((N_EVEN, HY_FFN), 0.1),
        hy_w2=nrm((N_EVEN, HY_FFN, HY_FFN), HY_FFN ** -0.5),
        hy_b2=nrm((N_EVEN, HY_FFN), 0.1),
        hy_fr2=gain((N_EVEN, HY_FFN), 0.1),
        hy_w3=nrm((N_EVEN, HY_FFN, HY_FILTERS), HY_FFN ** -0.5),
        hy_b3=nrm((N_EVEN, HY_FILTERS), 0.01),
        hy_bias=nrm((N_EVEN, HY_ORDER, HY_WIDTH), 0.5),
        cv_w1=nrm((N_ODD, D, 2 * CV_WIDTH), D ** -0.5),
        cv_b1=nrm((N_ODD, 2 * CV_WIDTH), 0.01),
        cv_dw_w=nrm((N_ODD, CV_KERNEL, CV_WIDTH), CV_KERNEL ** -0.5),
        cv_dw_b=nrm((N_ODD, CV_WIDTH), 0.01),
        cv_ln_g=gain((N_ODD, CV_WIDTH)),
        cv_ln_b=nrm((N_ODD, CV_WIDTH), 0.01),
        cv_w2=nrm((N_ODD, CV_WIDTH, D), CV_WIDTH ** -0.5),
        cv_b2=nrm((N_ODD, D), 0.01),
        moe_wg=nrm((DEPTH, D, N_GROUPS), D ** -0.5),
        moe_bg=nrm((DEPTH, N_GROUPS), 0.01),
        moe_we=nrm((DEPTH, D, N_EXPERTS), D ** -0.5),
        moe_be=nrm((DEPTH, N_EXPERTS), 0.01),
        moe_w_gate=nrm((DEPTH, N_EXPERTS, D, D_EXPERT), D ** -0.5),
        moe_w_up=nrm((DEPTH, N_EXPERTS, D, D_EXPERT), D ** -0.5),
        moe_w_down=nrm((DEPTH, N_EXPERTS, D_EXPERT, D), D_EXPERT ** -0.5),
    )


def reference(x, c, ctx, c_ctx, ada_w, ada_b, norm1_g, norm2_g, final_g,
              w_in0, w_out0, lam_q1, lam_k1, lam_q2, lam_k2, subln_g,
              hy_short_w, hy_short_b, hy_w1, hy_b1, hy_fr1, hy_w2, hy_b2, hy_fr2, hy_w3, hy_b3, hy_bias,
              cv_w1, cv_b1, cv_dw_w, cv_dw_b, cv_ln_g, cv_ln_b, cv_w2, cv_b2,
              moe_wg, moe_bg, moe_we, moe_be, moe_w_gate, moe_w_up, moe_w_down):
    ctx_s = ctx
    H2 = 2 * DA_HEADS
    for i in range(DEPTH):
        j = i // 2
        ctx_live = any(m % 2 == 0 for m in range(i + 1, DEPTH))
        sh1, sc1, g1, sh2, sc2, g2 = adaln(c, ada_w[i], ada_b[i])
        if i % 2 == 0 or ctx_live:
            csh1, csc1, cg1, csh2, csc2, cg2 = adaln(c_ctx, ada_w[i], ada_b[i])
        hx = modulate(rmsnorm(x, norm1_g[i]), sh1, sc1)
        if i % 2 == 0:
            w_in = w_in0[j]
            hy = (hy_short_w[j], hy_short_b[j], hy_w1[j], hy_b1[j], hy_fr1[j], hy_w2[j], hy_b2[j],
                  hy_fr2[j], hy_w3[j], hy_b3[j], hy_bias[j])
            lam_init = 0.8 - 0.6 * math.exp(-0.3 * i)
            lam = (jnp.exp(jnp.sum(lam_q1[j] * lam_k1[j]).astype(F32))
                   - jnp.exp(jnp.sum(lam_q2[j] * lam_k2[j]).astype(F32)) + lam_init)
            hc = modulate(rmsnorm(ctx_s, norm1_g[i]), csh1, csc1)
            if ctx_live:
                pc = hc @ w_in
                pc_kv = pc[..., DA_WIDTH:3 * DA_WIDTH]
            else:
                pc_kv = hc @ w_in[:, DA_WIDTH:3 * DA_WIDTH]
            kc = _heads(pc_kv[..., :DA_WIDTH], H2)
            vc = _heads(pc_kv[..., DA_WIDTH:], DA_HEADS)
            px = hx @ w_in
            q = rope_2d(_heads(px[..., :DA_WIDTH], H2))
            k = rope_2d(_heads(px[..., DA_WIDTH:2 * DA_WIDTH], H2))
            v = _heads(px[..., 2 * DA_WIDTH:3 * DA_WIDTH], DA_HEADS)
            o_a = diff_attention(q, jnp.concatenate([kc, k], axis=2), jnp.concatenate([vc, v], axis=2),
                                 lam, subln_g[j], lam_init)
            o_b = hyena_mixer(px[..., 3 * DA_WIDTH:], *hy)
            x_new = x + g1 * (jnp.concatenate([o_a, o_b], axis=-1) @ w_out0[j])
            if ctx_live:
                qc = _heads(pc[..., :DA_WIDTH], H2)
                oc_a = diff_attention(qc, kc, vc, lam, subln_g[j], lam_init)
                oc_b = hyena_mixer(pc[..., 3 * DA_WIDTH:], *hy)
                ctx_s = ctx_s + cg1 * (jnp.concatenate([oc_a, oc_b], axis=-1) @ w_out0[j])
            x = x_new
        else:
            cv = (cv_w1[j], cv_b1[j], cv_dw_w[j], cv_dw_b[j], cv_ln_g[j], cv_ln_b[j], cv_w2[j], cv_b2[j])
            x = x + g1 * conformer_conv(hx, *cv)
            if ctx_live:
                hc = modulate(rmsnorm(ctx_s, norm1_g[i]), csh1, csc1)
                ctx_s = ctx_s + cg1 * conformer_conv(hc, *cv)
        moe_p = (moe_wg[i], moe_bg[i], moe_we[i], moe_be[i], moe_w_gate[i], moe_w_up[i], moe_w_down[i])
        x = x + g2 * hier_moe(modulate(rmsnorm(x, norm2_g[i]), sh2, sc2), *moe_p)
        if ctx_live:
            ctx_s = ctx_s + cg2 * hier_moe(modulate(rmsnorm(ctx_s, norm2_g[i]), csh2, csc2), *moe_p)
    return rmsnorm(x, final_g)
```

```cpp
#define MK_PER_PHASE 0
#include <hip/hip_runtime.h>
#include <stdint.h>
#include <math.h>

#define LAS __attribute__((address_space(3)))
#define GAS __attribute__((address_space(1)))
typedef unsigned short bf16_t;
typedef short bf16x8 __attribute__((ext_vector_type(8)));
typedef short s16x4 __attribute__((ext_vector_type(4)));
typedef float f32x2 __attribute__((ext_vector_type(2)));
typedef float f32x4 __attribute__((ext_vector_type(4)));
typedef float f32x16 __attribute__((ext_vector_type(16)));
typedef unsigned u32x2 __attribute__((ext_vector_type(2)));
typedef unsigned u32x4 __attribute__((ext_vector_type(4)));

constexpr int DM = 1024, NB = 8, SEQ = 4096, NTOK = NB * SEQ, CTXL = 256, LKV = CTXL + SEQ;
constexpr int NEXP = 32, DEXP = 512, SLOT_ROWS = 73728;
constexpr float EPS = 1e-6f;
constexpr float QSCALE = 0.125f * 1.4426950408889634f;

constexpr size_t MiB = 1u << 20;
constexpr size_t WS_CTL = 0, CTL_ZERO_BYTES = 1 * MiB;
constexpr size_t WS_MOD = 1 * MiB;
constexpr size_t WS_TAB = 2 * MiB;
constexpr size_t WS_TOK = 3 * MiB;
constexpr size_t WS_LIST = 4 * MiB;
constexpr size_t WS_LOGIT = 8 * MiB;
constexpr size_t WS_KRAW = 16 * MiB;
constexpr size_t WS_WR = 48 * MiB;
constexpr size_t WS_WQKVH = 50 * MiB;
constexpr size_t WS_WO = 56 * MiB;
constexpr size_t WS_WC1 = 58 * MiB;
constexpr size_t WS_WC2 = 62 * MiB;
constexpr size_t WS_WMOE = 64 * MiB;
constexpr size_t WS_BUF0 = 256 * MiB;
constexpr size_t WS_Q = 320 * MiB;
constexpr size_t WS_K = 352 * MiB;
constexpr size_t WS_V = 386 * MiB;
constexpr size_t WS_UT = 420 * MiB;
constexpr size_t WS_OBT = 516 * MiB;
constexpr size_t WS_H = 320 * MiB;
constexpr size_t WS_Y = 392 * MiB;
constexpr size_t WS_GLU = 320 * MiB;
constexpr size_t WS_END = 548 * MiB;

constexpr int CW_TMO = 0;
constexpr int CW_BAR = 4096;
constexpr int CW_CNT = 8192;
constexpr int TB_ROPE_C = 0, TB_ROPE_S = 1024, TB_T4096 = 2048  , TB_T8A = 2560  , TB_T8B = 2688  , TB_LAM = 2816;

constexpr int RING_BYTES = 131072;
constexpr int MISC_OFF = 144384;
constexpr int LDS_BYTES = 147456;
constexpr int NWAVES = 8, NTHREADS = 512;

#define RLX_AGENT __ATOMIC_RELAXED, __HIP_MEMORY_SCOPE_AGENT
#define LDS_WAIT() asm volatile("s_waitcnt lgkmcnt(0)" ::: "memory")
#define VM_WAIT() asm volatile("s_waitcnt vmcnt(0)" ::: "memory")

__device__ __forceinline__ unsigned cvt_pk_bf16(float lo, float hi) { unsigned r; asm volatile("v_cvt_pk_bf16_f32 %0, %1, %2" : "=v"(r) : "v"(lo), "v"(hi)); return r; }
__device__ __forceinline__ float bf2f(bf16_t v) { return __uint_as_float((unsigned)v << 16); }
__device__ __forceinline__ float bflo(unsigned v) { return __uint_as_float(v << 16); }
__device__ __forceinline__ float bfhi(unsigned v) { return __uint_as_float(v & 0xffff0000u); }
__device__ __forceinline__ float wave_sum(float v) {
#pragma unroll
    for (int o = 1; o < 64; o <<= 1) v += __shfl_xor(v, o);
    return v;
}
__device__ __forceinline__ float silu_f(float v) { return v / (1.0f + __expf(-v)); }
__device__ __forceinline__ float sigmoid_f(float v) { return 1.0f / (1.0f + __expf(-v)); }

#define XB_TMO      128
#define XB_XCNT(j)  (256  + 64 * (j))
#define XB_XSUB(j)  (1280 + 64 * (j))
#define XB_XGEN(j)  (2304 + 64 * (j))
#define XB_TOP      3328
#define XB_TOPGEN   3392
#define XCD_BAR_WORDS 3456
#define XB_SPIN_CAP (1u << 20)

__device__ __forceinline__ unsigned xb_ld(unsigned* p)              { return __hip_atomic_load(p, __ATOMIC_RELAXED, __HIP_MEMORY_SCOPE_AGENT); }
__device__ __forceinline__ unsigned xb_add(unsigned* p, unsigned v) { return __hip_atomic_fetch_add(p, v, __ATOMIC_RELAXED, __HIP_MEMORY_SCOPE_AGENT); }
__device__ __forceinline__ unsigned xb_xcc_id() { return (unsigned)__builtin_amdgcn_s_getreg((3 << 11) | 20) & 0xFu; }
#define XB_SPIN(cond, bar) do { unsigned _sp = 0; while (cond) { __builtin_amdgcn_s_sleep(1); \
    if ((++_sp & 255u) == 0u) { if (xb_ld(&(bar)[XB_TMO])) break; if (_sp > XB_SPIN_CAP) { atomicAdd(&(bar)[XB_TMO], 1u); break; } } } } while (0)

struct XcdBarrier { unsigned* bar; unsigned x; volatile LAS unsigned* st; };

__device__ __forceinline__ XcdBarrier xcd_barrier_post(unsigned* bar, volatile LAS unsigned* st, bool leader  ) {
    XcdBarrier b; b.bar = bar; b.x = xb_xcc_id(); b.st = st;
    if (leader) (void)xb_add(&bar[XB_XCNT(b.x)], 1u);
    return b;
}
__device__ __forceinline__ void xcd_barrier_complete(unsigned* bar, unsigned x, unsigned& nloc, unsigned& nx) {
    const unsigned G = gridDim.x * gridDim.y * gridDim.z;
    unsigned sum, cnt, mine, sp = 0u;
    for (;;) {
        sum = 0u; cnt = 0u; mine = 0u;
#pragma unroll
        for (unsigned j = 0; j < 16; ++j) { const unsigned c = xb_ld(&bar[XB_XCNT(j)]); sum += c; cnt += (c > 0u) ? 1u : 0u; mine = (j == x) ? c : mine; }
        if (sum == G) break;
        __builtin_amdgcn_s_sleep(1);
        if ((++sp & 255u) == 0u) { if (xb_ld(&bar[XB_TMO])) break; if (sp > XB_SPIN_CAP) { atomicAdd(&bar[XB_TMO], 1u); break; } }
    }
    nloc = mine > 0u ? mine : 1u; nx = cnt > 0u ? cnt : 1u;
}
__device__ __forceinline__ void xcd_barrier(const XcdBarrier& b, bool leader  ) {
    asm volatile("s_waitcnt vmcnt(0)" ::: "memory");
    __syncthreads();
    if (leader) {
        unsigned* bar = b.bar;
        __builtin_amdgcn_s_waitcnt(0);
        unsigned nloc = b.st[0], nx = b.st[1];
        if (nloc == 0u) { xcd_barrier_complete(bar, b.x, nloc, nx); b.st[0] = nloc; b.st[1] = nx; }
        const unsigned old = xb_add(&bar[XB_XSUB(b.x)], 1u);
        const unsigned gen = old / nloc;
        if (old + 1u == (gen + 1u) * nloc) {
            __builtin_amdgcn_fence(__ATOMIC_RELEASE, "agent");
            asm volatile("s_waitcnt vmcnt(0)" ::: "memory");
            const unsigned og = xb_add(&bar[XB_TOP], 1u);
            const unsigned tg = og / nx;
            if (og + 1u == (tg + 1u) * nx) xb_add(&bar[XB_TOPGEN], 1u);
            else XB_SPIN(xb_ld(&bar[XB_TOPGEN]) == tg, bar);
            __builtin_amdgcn_fence(__ATOMIC_ACQUIRE, "agent");
            xb_add(&bar[XB_XGEN(b.x)], 1u);
            asm volatile("s_waitcnt vmcnt(0)" ::: "memory");
        } else {
            XB_SPIN(xb_ld(&bar[XB_XGEN(b.x)]) == gen, bar);
            __builtin_amdgcn_fence(__ATOMIC_ACQUIRE, "agent");
            asm volatile("s_waitcnt vmcnt(0)" ::: "memory");
        }
    }
    __syncthreads();
}
namespace pg8 {
constexpr int BM = 256, BK = 64, HALF = 128, HTB = HALF * BK * 2, STAGE_BYTES = 8 * HTB, NXCD = 8, WGM = 8;

__host__ __device__ __forceinline__ int lds_byte(int r, int c) { const int st = (r >> 4) * 2 + (c >> 5), rr = r & 15, cc = c & 31, ob = rr * 64 + cc * 2; return st * 1024 + (ob ^ (((ob >> 9) & 1) << 5)); }
__host__ __device__ __forceinline__ void stage_rc(int b, int& R, int& C) { const int st = b / 1024, sb = b % 1024, swz = sb ^ (((sb >> 9) & 1) << 5); R = (st >> 1) * 16 + swz / 64; C = (st & 1) * 32 + (swz % 64) / 2; }
__host__ __device__ __forceinline__ int perm32(int rho) { const int n = rho >> 4, i = rho & 15; return 8 * (i >> 2) + 4 * n + (i & 3); }

struct Unit { int pm, pn; const char* a; const char* b; int aux; };

struct StaticOrder {
    static constexpr bool GATHER = false;
    int nM, nN, nwg, G, c; const char* A; const char* Bt; size_t tstep;
    __device__ void init(const void* A_, const void* Bt_, int M, int N, int K, int G_, int c_) { A = (const char*)A_; Bt = (const char*)Bt_; nM = M / BM; nN = N / BM; nwg = nM * nN; G = G_; c = c_; tstep = (size_t)BM * K * 2; }
    __device__ bool next(int i, Unit& u) const {
        const long L = (long)i * G + c; if (L >= nwg) return false;
        int wgid = (int)L; { const int q = nwg / NXCD, r = nwg % NXCD, xcd = wgid % NXCD, off = wgid / NXCD; wgid = (xcd < r ? xcd * (q + 1) : r * (q + 1) + (xcd - r) * q) + off; }
        const int nig = WGM * nN, gid = wgid / nig, fm = gid * WGM, gsz = (nM - fm) < WGM ? (nM - fm) : WGM;
        u.pm = fm + ((wgid % nig) % gsz); u.pn = (wgid % nig) / gsz; u.a = A + (size_t)u.pm * tstep; u.b = Bt + (size_t)u.pn * tstep; u.aux = 0; return true;
    }
    __device__ __forceinline__ void gather(const Unit&, int, int, unsigned (&)[2][2]) const {}
};

template <class Epi, class Sched>
__device__ __forceinline__ void gemm_phase(LAS unsigned char* lds, int tid, const int K, const Sched& S, const Epi& E) {
    asm volatile("" : "+v"(tid));
    const int wid = __builtin_amdgcn_readfirstlane(tid >> 6), lane = tid & 63, wr = wid >> 2, wc = wid & 3, fr = lane & 15, fq = lane >> 4;
    const int nt = K / BK;
    const size_t kstep = (size_t)(BK * 2);
    const size_t hstep = (size_t)HALF * K * 2;
    int Rr[2], Cc[2];
    unsigned voffB[2];
#pragma unroll
    for (int i = 0; i < 2; ++i) { int R, C; stage_rc(tid * 16 + i * 8192, R, C); Rr[i] = R; Cc[i] = C; const int Rb = Epi::PERM ? ((R & ~31) + perm32(R & 31)) : R; voffB[i] = (unsigned)(Rb * K + C) * 2u; }
    unsigned vAc[2][2], vAn[2][2];
#pragma unroll
    for (int h = 0; h < 2; ++h)
#pragma unroll
        for (int i = 0; i < 2; ++i) { vAc[h][i] = (unsigned)((h * HALF + Rr[i]) * K + Cc[i]) * 2u; vAn[h][i] = vAc[h][i]; }
    const unsigned ldsw = (unsigned)wid * 1024u;
    const int aoff = lds_byte(wr * 64 + fr, fq * 8), boff = lds_byte(wc * 32 + fr, fq * 8);
#define PG8_SA(b, h) (((b) * 2 + (h)) * HTB)
#define PG8_SB(b, h) ((4 + (b) * 2 + (h)) * HTB)
#define PG8_STAGE_B(bufoff, gbase) do { _Pragma("unroll") for (int _i = 0; _i < 2; ++_i) \
        __builtin_amdgcn_global_load_lds((const unsigned*)((const char*)(gbase) + voffB[_i]), (LAS unsigned*)(lds + (bufoff) + ldsw + _i * 8192), 16, 0, 0); } while (0)
#define PG8_STAGE_A(bufoff, gbase, V, h) do { _Pragma("unroll") for (int _i = 0; _i < 2; ++_i) \
        __builtin_amdgcn_global_load_lds((const unsigned*)((const char*)(gbase) + (V)[h][_i]), (LAS unsigned*)(lds + (bufoff) + ldsw + _i * 8192), 16, 0, 0); } while (0)
#define PG8_LDA(dst, b, h) do { _Pragma("unroll") for (int m = 0; m < 4; ++m) _Pragma("unroll") for (int k = 0; k < 2; ++k) dst[m][k] = *(const LAS bf16x8*)(lds + PG8_SA(b, h) + aoff + m * 2048 + k * 1024); } while (0)
#define PG8_LDB(dst, b, h) do { _Pragma("unroll") for (int n = 0; n < 2; ++n) _Pragma("unroll") for (int k = 0; k < 2; ++k) dst[n][k] = *(const LAS bf16x8*)(lds + PG8_SB(b, h) + boff + n * 2048 + k * 1024); } while (0)
#define PG8_MMA(ai, bj, At, Bt) do { __builtin_amdgcn_s_setprio(1); _Pragma("unroll") for (int m = 0; m < 4; ++m) _Pragma("unroll") for (int n = 0; n < 2; ++n) _Pragma("unroll") for (int k = 0; k < 2; ++k) \
        acc[ai][bj][m][n] = __builtin_amdgcn_mfma_f32_16x16x32_bf16(Bt[n][k], At[m][k], acc[ai][bj][m][n], 0, 0, 0); __builtin_amdgcn_s_setprio(0); } while (0)
#define PG8_WAIT_V(n) asm volatile("s_waitcnt vmcnt(" #n ")" ::: "memory")
#define PG8_WAIT_L(n) asm volatile("s_waitcnt lgkmcnt(" #n ")" ::: "memory")
#define PG8_BAR __builtin_amdgcn_s_barrier()
#define PG8_SCHED __builtin_amdgcn_sched_barrier(0)
    Unit cur, nxt; int ui = 0;
    if (!S.next(0, cur)) return;
    if constexpr (Sched::GATHER) { S.gather(cur, Rr[0], Rr[1], vAc);
#pragma unroll
        for (int h = 0; h < 2; ++h)
#pragma unroll
            for (int i = 0; i < 2; ++i) vAc[h][i] += (unsigned)Cc[i] * 2u; }
    f32x4 acc[2][2][4][2];
#pragma unroll
    for (int a = 0; a < 2; ++a)
#pragma unroll
        for (int b = 0; b < 2; ++b)
#pragma unroll
            for (int m = 0; m < 4; ++m)
#pragma unroll
                for (int n = 0; n < 2; ++n) acc[a][b][m][n] = (f32x4){0.f, 0.f, 0.f, 0.f};
    bf16x8 At[4][2], B0[2][2], B1[2][2];
    const char* cA = cur.a; const char* cB = cur.b;
    PG8_STAGE_B(PG8_SB(0, 0), cB); PG8_STAGE_B(PG8_SB(0, 1), cB + hstep); PG8_STAGE_A(PG8_SA(0, 0), cA, vAc, 0); PG8_STAGE_A(PG8_SA(0, 1), cA, vAc, 1);
    if (wr == 1) PG8_BAR;
    PG8_WAIT_V(2); PG8_BAR;
    PG8_STAGE_B(PG8_SB(1, 0), cB + kstep); PG8_STAGE_A(PG8_SA(1, 0), cA + kstep, vAc, 0); PG8_STAGE_B(PG8_SB(1, 1), cB + hstep + kstep);
    PG8_WAIT_V(6); PG8_BAR;
    for (;;) {
        const bool has_next = S.next(ui + 1, nxt);
        if constexpr (Sched::GATHER) { if (has_next) { S.gather(nxt, Rr[0], Rr[1], vAn);
#pragma unroll
            for (int h = 0; h < 2; ++h)
#pragma unroll
                for (int i = 0; i < 2; ++i) vAn[h][i] += (unsigned)Cc[i] * 2u; } else {
#pragma unroll
            for (int h = 0; h < 2; ++h)
#pragma unroll
                for (int i = 0; i < 2; ++i) vAn[h][i] = vAc[h][i]; } }
        const char* nA = has_next ? nxt.a : cA; const char* nB = has_next ? nxt.b : cB;
        for (int t = 0; t < nt; t += 2) {
            const bool last = (t == nt - 2);
            const char* a1 = cA + (size_t)(t + 1) * kstep;
            const char* a2 = last ? nA : cA + (size_t)(t + 2) * kstep; const char* b2 = last ? nB : cB + (size_t)(t + 2) * kstep;
            const char* a3 = a2 + kstep; const char* b3 = b2 + kstep;
            unsigned v2[2][2];
#pragma unroll
            for (int h = 0; h < 2; ++h)
#pragma unroll
                for (int i = 0; i < 2; ++i) v2[h][i] = (Sched::GATHER && last) ? vAn[h][i] : vAc[h][i];
            PG8_LDB(B0, 0, 0); PG8_LDB(B1, 0, 1); PG8_SCHED; PG8_LDA(At, 0, 0); PG8_STAGE_A(PG8_SA(1, 1), a1, vAc, 1);
            PG8_WAIT_V(8); PG8_WAIT_L(0); PG8_BAR; PG8_MMA(0, 0, At, B0); PG8_MMA(0, 1, At, B1); PG8_BAR; PG8_SCHED;
            PG8_LDA(At, 0, 1); PG8_STAGE_B(PG8_SB(0, 0), b2); PG8_STAGE_B(PG8_SB(0, 1), b2 + hstep); PG8_STAGE_A(PG8_SA(0, 0), a2, v2, 0);
            PG8_WAIT_V(8); PG8_WAIT_L(0); PG8_BAR; PG8_MMA(1, 0, At, B0); PG8_MMA(1, 1, At, B1); PG8_BAR; PG8_SCHED;
            PG8_LDB(B0, 1, 0); PG8_LDB(B1, 1, 1); PG8_SCHED; PG8_LDA(At, 1, 0); PG8_STAGE_A(PG8_SA(0, 1), a2, v2, 1);
            PG8_WAIT_V(8); PG8_WAIT_L(0); PG8_BAR; PG8_MMA(0, 0, At, B0); PG8_MMA(0, 1, At, B1); PG8_BAR; PG8_SCHED;
            PG8_LDA(At, 1, 1); PG8_STAGE_B(PG8_SB(1, 0), b3); PG8_STAGE_B(PG8_SB(1, 1), b3 + hstep); PG8_STAGE_A(PG8_SA(1, 0), a3, v2, 0);
            PG8_WAIT_V(8); PG8_WAIT_L(0); PG8_BAR; PG8_MMA(1, 0, At, B0); PG8_MMA(1, 1, At, B1); PG8_BAR; PG8_SCHED;
        }
        if (wr == 0) PG8_BAR;
        E(acc, cur, wr, wc, fr, fq);
        if (!has_next) break;
#pragma unroll
        for (int a = 0; a < 2; ++a)
#pragma unroll
            for (int b = 0; b < 2; ++b)
#pragma unroll
                for (int m = 0; m < 4; ++m)
#pragma unroll
                    for (int n = 0; n < 2; ++n) acc[a][b][m][n] = (f32x4){0.f, 0.f, 0.f, 0.f};
        cur = nxt; cA = nA; cB = nB; ++ui;
#pragma unroll
        for (int h = 0; h < 2; ++h)
#pragma unroll
            for (int i = 0; i < 2; ++i) vAc[h][i] = vAn[h][i];
        if (wr == 1) PG8_BAR;
    }
    PG8_WAIT_V(0);
    PG8_BAR;
#undef PG8_SA
#undef PG8_SB
#undef PG8_STAGE_A
#undef PG8_STAGE_B
#undef PG8_LDA
#undef PG8_LDB
#undef PG8_MMA
#undef PG8_WAIT_V
#undef PG8_WAIT_L
#undef PG8_BAR
#undef PG8_SCHED
}
}
namespace pg8 {

struct EpiBf16 {
    static constexpr bool PERM = true;
    bf16_t* O; size_t ldc;
    __device__ __forceinline__ void operator()(const f32x4 (&acc)[2][2][4][2], const Unit& u, int wr, int wc, int fr, int fq) const {
        const size_t row0 = (size_t)u.pm * BM + wr * 64 + fr; const int col0 = u.pn * BM + wc * 32 + 8 * fq;
#pragma unroll
        for (int ai = 0; ai < 2; ++ai)
#pragma unroll
            for (int m = 0; m < 4; ++m) { bf16_t* rowp = O + (row0 + ai * HALF + m * 16) * ldc + col0;
#pragma unroll
                for (int bj = 0; bj < 2; ++bj) { const f32x4 v0 = acc[ai][bj][m][0], v1 = acc[ai][bj][m][1];
                    u32x4 w; w.x = cvt_pk_bf16(v0[0], v0[1]); w.y = cvt_pk_bf16(v0[2], v0[3]); w.z = cvt_pk_bf16(v1[0], v1[1]); w.w = cvt_pk_bf16(v1[2], v1[3]);
                    *(u32x4*)(rowp + bj * HALF) = w; } }
    }
};

struct EpiQKV {
    static constexpr bool PERM = false;
    bf16_t* Q; bf16_t* Kb; bf16_t* Vb; const float* ropec; const float* ropes;
    __device__ __forceinline__ void operator()(const f32x4 (&acc)[2][2][4][2], const Unit& u, int wr, int wc, int fr, int fq) const {
        const int sec = u.pn >> 1;
        const int bt = u.pm >> 4, t0 = (u.pm & 15) * BM;
        bf16_t* base; size_t rowb; float sc = 1.f;
        if (sec == 0) { base = Q; rowb = (size_t)u.pm * BM; sc = QSCALE; }
        else { base = (sec == 1) ? Kb : Vb; rowb = (size_t)bt * LKV + CTXL + t0; }
        const int colt = (u.pn & 1) * BM + wc * 32 + 4 * fq;
        const bool rope = sec < 2; const bool colpos = (wc & 1) != 0;
#pragma unroll
        for (int ai = 0; ai < 2; ++ai)
#pragma unroll
            for (int m = 0; m < 4; ++m) {
                const int rl = ai * HALF + wr * 64 + m * 16 + fr; const int t = t0 + rl;
                const int pos = colpos ? (t & 63) : (t >> 6);
                f32x4 cs = (f32x4){1.f, 1.f, 1.f, 1.f}, sn = (f32x4){0.f, 0.f, 0.f, 0.f};
                if (rope) { cs = *(const f32x4*)(ropec + pos * 16 + 4 * fq); sn = *(const f32x4*)(ropes + pos * 16 + 4 * fq); }
                bf16_t* rowp = base + (rowb + rl) * 512 + colt;
#pragma unroll
                for (int bj = 0; bj < 2; ++bj) {
                    const f32x4 a = acc[ai][bj][m][0], b = acc[ai][bj][m][1];
                    f32x4 oa, ob;
                    if (rope) { oa = (a * cs - b * sn) * sc; ob = (a * sn + b * cs) * sc; } else { oa = a; ob = b; }
                    u32x2 w0, w1; w0.x = cvt_pk_bf16(oa[0], oa[1]); w0.y = cvt_pk_bf16(oa[2], oa[3]); w1.x = cvt_pk_bf16(ob[0], ob[1]); w1.y = cvt_pk_bf16(ob[2], ob[3]);
                    *(u32x2*)(rowp + bj * HALF) = w0; *(u32x2*)(rowp + bj * HALF + 16) = w1; }
            }
    }
};

struct EpiCtxKV {
    static constexpr bool PERM = true;
    bf16_t* Kb; bf16_t* Vb;
    __device__ __forceinline__ void operator()(const f32x4 (&acc)[2][2][4][2], const Unit& u, int wr, int wc, int fr, int fq) const {
        bf16_t* base = (u.pn < 2) ? Kb : Vb; const size_t rowb = (size_t)u.pm * LKV; const int col0 = (u.pn & 1) * BM + wc * 32 + 8 * fq;
#pragma unroll
        for (int ai = 0; ai < 2; ++ai)
#pragma unroll
            for (int m = 0; m < 4; ++m) { bf16_t* rowp = base + (rowb + ai * HALF + wr * 64 + m * 16 + fr) * 512 + col0;
#pragma unroll
                for (int bj = 0; bj < 2; ++bj) { const f32x4 v0 = acc[ai][bj][m][0], v1 = acc[ai][bj][m][1];
                    u32x4 w; w.x = cvt_pk_bf16(v0[0], v0[1]); w.y = cvt_pk_bf16(v0[2], v0[3]); w.z = cvt_pk_bf16(v1[0], v1[1]); w.w = cvt_pk_bf16(v1[2], v1[3]);
                    *(u32x4*)(rowp + bj * HALF) = w; } }
    }
};

struct EpiResid {
    static constexpr bool PERM = false;
    const float* xin; float* out; const float* gate;   const float* bias;
    __device__ __forceinline__ void operator()(const f32x4 (&acc)[2][2][4][2], const Unit& u, int wr, int wc, int fr, int fq) const {
        const int bt = u.pm >> 4; const int col0 = u.pn * BM + wc * 32 + 4 * fq;
        f32x4 gv[2][2], bv[2][2];
#pragma unroll
        for (int bj = 0; bj < 2; ++bj)
#pragma unroll
            for (int n = 0; n < 2; ++n) { gv[bj][n] = *(const f32x4*)(gate + (size_t)bt * 6144 + col0 + bj * HALF + n * 16);
                bv[bj][n] = bias ? *(const f32x4*)(bias + col0 + bj * HALF + n * 16) : (f32x4){0.f, 0.f, 0.f, 0.f}; }
#pragma unroll
        for (int ai = 0; ai < 2; ++ai)
#pragma unroll
            for (int m = 0; m < 4; ++m) { const size_t off = ((size_t)u.pm * BM + ai * HALF + wr * 64 + m * 16 + fr) * DM + col0;
#pragma unroll
                for (int bj = 0; bj < 2; ++bj)
#pragma unroll
                    for (int n = 0; n < 2; ++n) { const f32x4 xi = *(const f32x4*)(xin + off + bj * HALF + n * 16);
                        *(f32x4*)(out + off + bj * HALF + n * 16) = xi + gv[bj][n] * (acc[ai][bj][m][n] + bv[bj][n]); } }
    }
};

template <int MODE> struct EpiGated {
    static constexpr bool PERM = true;
    bf16_t* O; size_t ldo; const float* ba; const float* bg;
    __device__ __forceinline__ void operator()(const f32x4 (&acc)[2][2][4][2], const Unit& u, int wr, int wc, int fr, int fq) const {
        const size_t row0 = (size_t)u.pm * BM + wr * 64 + fr; const int col0 = u.pn * 128 + wc * 16 + 4 * fq;
#pragma unroll
        for (int bj = 0; bj < 2; ++bj) {
            f32x4 b0 = (f32x4){0.f, 0.f, 0.f, 0.f}, b1 = b0;
            if (MODE == 1) { b0 = *(const f32x4*)(ba + col0 + bj * 64); b1 = *(const f32x4*)(bg + col0 + bj * 64); }
#pragma unroll
            for (int ai = 0; ai < 2; ++ai)
#pragma unroll
                for (int m = 0; m < 4; ++m) { bf16_t* rowp = O + (row0 + ai * HALF + m * 16) * ldo + col0;
                    const f32x4 a = acc[ai][bj][m][0] + b0, g = acc[ai][bj][m][1] + b1; f32x4 o;
#pragma unroll
                    for (int j = 0; j < 4; ++j) o[j] = (MODE == 0) ? silu_f(a[j]) * g[j] : a[j] * sigmoid_f(g[j]);
                    u32x2 w; w.x = cvt_pk_bf16(o[0], o[1]); w.y = cvt_pk_bf16(o[2], o[3]);
                    *(u32x2*)(rowp + bj * 64) = w; }
        }
    }
};

struct EpiLogits {
    static constexpr bool PERM = false;
    float* O;
    __device__ __forceinline__ void operator()(const f32x4 (&acc)[2][2][4][2], const Unit& u, int wr, int wc, int fr, int fq) const {
        if (wc >= 2) return;
#pragma unroll
        for (int ai = 0; ai < 2; ++ai)
#pragma unroll
            for (int m = 0; m < 4; ++m) { float* rowp = O + ((size_t)u.pm * BM + ai * HALF + wr * 64 + m * 16 + fr) * 64 + wc * 32 + 4 * fq;
#pragma unroll
                for (int n = 0; n < 2; ++n) *(f32x4*)(rowp + n * 16) = acc[ai][0][m][n]; }
    }
};
}
enum { I_X = 0, I_C, I_CTX, I_CCTX, I_ADAW, I_ADAB, I_N1G, I_N2G, I_FING, I_WIN0, I_WOUT0, I_LQ1, I_LK1, I_LQ2, I_LK2, I_SUBLN,
       I_HYSW, I_HYSB, I_HYW1, I_HYB1, I_HYFR1, I_HYW2, I_HYB2, I_HYFR2, I_HYW3, I_HYB3, I_HYBIAS,
       I_CVW1, I_CVB1, I_CVDWW, I_CVDWB, I_CVLNG, I_CVLNB, I_CVW2, I_CVB2, I_MWG, I_MBG, I_MWE, I_MBE, I_MGATE, I_MUP, I_MDOWN, N_IN };

struct Args { const float* in[N_IN]; float* out; unsigned char* ws; int ph_lo, ph_hi; };

struct Frame {
    LAS unsigned char* lds;
    int tid, lane, wave, G, bid;
    const float* const* in; float* out; unsigned char* ws;
};

struct RowMap { int mode, half, which0; __device__ __forceinline__ int operator()(int s) const { if (mode == 0) return s; const int w = which0 + s / half, sp = s % half; return 8 * (sp >> 2) + 4 * w + (sp & 3); } };
__device__ __forceinline__ void p0_transpose_item(const float* W, int K, int N, bf16_t* WT, const RowMap rm, LAS float* scr, int item, int lane) {
    const int nblk = N / 32, kb = item / nblk, nb = item % nblk, k0 = 64 * kb, n0 = 32 * nb;
#pragma unroll 8
    for (int i = 0; i < 32; ++i) { const int kk = 2 * i + (lane >> 5); scr[kk * 33 + (lane & 31)] = W[(size_t)(k0 + kk) * N + n0 + (lane & 31)]; }
    LDS_WAIT(); asm volatile("" ::: "memory");
    const int c = lane & 7;
#pragma unroll
    for (int j = 0; j < 4; ++j) { const int n = (lane >> 3) + 8 * j; const LAS float* s = scr + (8 * c) * 33 + n;
        u32x4 o; o.x = cvt_pk_bf16(s[0 * 33], s[1 * 33]); o.y = cvt_pk_bf16(s[2 * 33], s[3 * 33]); o.z = cvt_pk_bf16(s[4 * 33], s[5 * 33]); o.w = cvt_pk_bf16(s[6 * 33], s[7 * 33]);
        *(u32x4*)(WT + (size_t)rm(n0 + n) * K + k0 + 8 * c) = o; }
    LDS_WAIT(); asm volatile("" ::: "memory");
}

__device__ __forceinline__ void p0_convert_weights(Frame& F) {
    LAS float* scr = (LAS float*)(F.lds + F.wave * 16384);
    const int gw = F.bid * NWAVES + F.wave, NGW = F.G * NWAVES;
    constexpr int I_IN = 16 * 96, I_OUT = 16 * 32, I_C1 = 16 * 64, I_C2 = 16 * 32, I_MOE = 64 * 768;
    constexpr int NITEMS = I_IN + I_OUT + I_C1 + I_C2 + I_MOE;
    for (int it = gw; it < NITEMS; it += NGW) {
        int r = it;
        if (r < I_IN) { p0_transpose_item(F.in[I_WIN0], 1024, 3072, (bf16_t*)(F.ws + WS_WQKVH), RowMap{0, 1, 0}, scr, r, F.lane); continue; } r -= I_IN;
        if (r < I_OUT) { p0_transpose_item(F.in[I_WOUT0], 1024, 1024, (bf16_t*)(F.ws + WS_WO), RowMap{0, 1, 0}, scr, r, F.lane); continue; } r -= I_OUT;
        if (r < I_C1) { p0_transpose_item(F.in[I_CVW1], 1024, 2048, (bf16_t*)(F.ws + WS_WC1), RowMap{1, 1024, 0}, scr, r, F.lane); continue; } r -= I_C1;
        if (r < I_C2) { p0_transpose_item(F.in[I_CVW2], 1024, 1024, (bf16_t*)(F.ws + WS_WC2), RowMap{0, 1, 0}, scr, r, F.lane); continue; } r -= I_C2;
        const int le = r / 768, q = r % 768; unsigned char* wb = F.ws + WS_WMOE + (size_t)le * 3 * MiB;
        if (q < 256) p0_transpose_item(F.in[I_MGATE] + (size_t)le * 1024 * 512, 1024, 512, (bf16_t*)wb, RowMap{1, 512, 0}, scr, q, F.lane);
        else if (q < 512) p0_transpose_item(F.in[I_MUP] + (size_t)le * 1024 * 512, 1024, 512, (bf16_t*)wb, RowMap{1, 512, 1}, scr, q - 256, F.lane);
        else p0_transpose_item(F.in[I_MDOWN] + (size_t)le * 512 * 1024, 512, 1024, (bf16_t*)(wb + 2 * MiB), RowMap{0, 1, 0}, scr, q - 512, F.lane);
    }
    bf16_t* wr = (bf16_t*)(F.ws + WS_WR);
    for (int idx = F.bid * NTHREADS + F.tid; idx < 2 * 256 * 1024; idx += F.G * NTHREADS) {
        const int l = idx >> 18, n = (idx >> 10) & 255, k = idx & 1023; float v = 0.f;
        if (n < 4) v = F.in[I_MWG][((size_t)l * 1024 + k) * 4 + n]; else if (n < 36) v = F.in[I_MWE][((size_t)l * 1024 + k) * 32 + (n - 4)];
        wr[idx] = (bf16_t)(cvt_pk_bf16(v, 0.f) & 0xffffu);
    }
}

__device__ __forceinline__ void p0_adaln_task(Frame& F, int task) {
    const int layer = task / 96, n0 = (task % 96) * 64;
    LAS float* sc = (LAS float*)F.lds;
    LAS float* red = (LAS float*)(F.lds + 36864);
    for (int i = F.tid; i < 9 * 1024; i += NTHREADS) { const int r = i >> 10, k = i & 1023; const float v = (r < 8) ? F.in[I_C][r * 1024 + k] : F.in[I_CCTX][k]; sc[i] = silu_f(v); }
    __syncthreads();
    const int col = F.tid & 63, ks = F.tid >> 6;
    const float* W = F.in[I_ADAW] + (size_t)layer * 1024 * 6144 + n0 + col;
    float acc[9];
#pragma unroll
    for (int r = 0; r < 9; ++r) acc[r] = 0.f;
#pragma unroll 8
    for (int k = ks * 128; k < ks * 128 + 128; ++k) { const float w = W[(size_t)k * 6144];
#pragma unroll
        for (int r = 0; r < 9; ++r) acc[r] += sc[r * 1024 + k] * w; }
#pragma unroll
    for (int r = 0; r < 9; ++r) red[(ks * 9 + r) * 64 + col] = acc[r];
    __syncthreads();
    float* mod = (float*)(F.ws + WS_MOD) + (size_t)layer * 9 * 6144;
    for (int i = F.tid; i < 9 * 64; i += NTHREADS) { const int r = i >> 6, c2 = i & 63; float s = F.in[I_ADAB][layer * 6144 + n0 + c2];
#pragma unroll
        for (int k8 = 0; k8 < 8; ++k8) s += red[(k8 * 9 + r) * 64 + c2];
        mod[(size_t)r * 6144 + n0 + c2] = s; }
    __syncthreads();
}

constexpr float HY_MIN_DECAY = -15.350567286626973f, HY_MAX_DECAY = -3.0701134573253945f;
__device__ __forceinline__ void p0_hyfilter_task(Frame& F, int pb) {
    const int t0 = pb * 32;
    LAS float* z = (LAS float*)F.lds;
    LAS float* h1 = z + 32 * 33;
    LAS float* h2 = h1 + 32 * 64;
    for (int i = F.tid; i < 32 * 33; i += NTHREADS) { const int p = i / 33, e = i % 33; const int t = t0 + p; float v;
        if (e == 0) v = (float)t / 4095.0f;
        else { const int bi = (e - 1) & 15; const float band = 1e-4f + (float)bi * ((15.0f - 1e-4f) / 15.0f); const float ang = (6.283185307179586f / 4096.0f) * (float)t * band; v = (e <= 16) ? cosf(ang) : -sinf(ang); }
        z[i] = v; }
    __syncthreads();
    for (int i = F.tid; i < 32 * 64; i += NTHREADS) { const int p = i >> 6, j = i & 63; float s = F.in[I_HYB1][j];
        for (int e = 0; e < 33; ++e) s += z[p * 33 + e] * F.in[I_HYW1][e * 64 + j];
        h1[i] = sinf(F.in[I_HYFR1][j] * s); }
    __syncthreads();
    for (int i = F.tid; i < 32 * 64; i += NTHREADS) { const int p = i >> 6, j = i & 63; float s = F.in[I_HYB2][j];
        for (int e = 0; e < 64; ++e) s += h1[p * 64 + e] * F.in[I_HYW2][e * 64 + j];
        h2[i] = sinf(F.in[I_HYFR2][j] * s); }
    __syncthreads();
    const int c0 = 4 * F.tid;
    f32x4 acc[32];
    const f32x4 b3 = *(const f32x4*)(F.in[I_HYB3] + c0);
#pragma unroll
    for (int p = 0; p < 32; ++p) acc[p] = b3;
    for (int j4 = 0; j4 < 16; ++j4) {
        f32x4 w[4];
#pragma unroll
        for (int jj = 0; jj < 4; ++jj) w[jj] = *(const f32x4*)(F.in[I_HYW3] + (size_t)(4 * j4 + jj) * 2048 + c0);
#pragma unroll
        for (int p = 0; p < 32; ++p) { const f32x4 hv = *(const LAS f32x4*)(h2 + p * 64 + 4 * j4);
            acc[p] += w[0] * hv[0] + w[1] * hv[1] + w[2] * hv[2] + w[3] * hv[3]; }
    }
    float* kraw = (float*)(F.ws + WS_KRAW);
#pragma unroll
    for (int cc = 0; cc < 4; ++cc) { const int col = c0 + cc, ch = col & 511;
        const float delta = fabsf(HY_MIN_DECAY + (float)ch * ((HY_MAX_DECAY - HY_MIN_DECAY) / 511.0f));
        float* dst = kraw + (size_t)col * 4096 + t0;
#pragma unroll
        for (int p4 = 0; p4 < 8; ++p4) { f32x4 o;
#pragma unroll
            for (int q = 0; q < 4; ++q) { const int p = 4 * p4 + q; const float tn = (float)(t0 + p) / 4095.0f; o[q] = acc[p][cc] * __expf(-tn * delta); }
            *(f32x4*)(dst + 4 * p4) = o; } }
    __syncthreads();
}

__device__ __forceinline__ void p0_tables_task(Frame& F) {
    float* tab = (float*)(F.ws + WS_TAB);
    for (int i = F.tid; i < 1024; i += NTHREADS) { const int pos = i >> 4, fi = i & 15; const float inv = powf(10000.0f, -(float)fi / 16.0f); const float ang = (float)pos * inv;
        tab[TB_ROPE_C + i] = cosf(ang); tab[TB_ROPE_S + i] = sinf(ang); }
    for (int i = F.tid; i < 256; i += NTHREADS) { float s, c; sincospif(2.0f * (float)i / 4096.0f, &s, &c); tab[TB_T4096 + 2 * i] = c; tab[TB_T4096 + 2 * i + 1] = -s; }
    for (int i = F.tid; i < 64; i += NTHREADS) { float s, c; sincospif(2.0f * (float)i / 8192.0f, &s, &c); tab[TB_T8A + 2 * i] = c; tab[TB_T8A + 2 * i + 1] = -s;
        sincospif(2.0f * (float)(64 * i) / 8192.0f, &s, &c); tab[TB_T8B + 2 * i] = c; tab[TB_T8B + 2 * i + 1] = -s; }
    if (F.tid < 64) { const float a = wave_sum(F.in[I_LQ1][F.lane] * F.in[I_LK1][F.lane]), b = wave_sum(F.in[I_LQ2][F.lane] * F.in[I_LK2][F.lane]);
        if (F.lane == 0) tab[TB_LAM] = expf(a) - expf(b) + 0.2f; }
}

__device__ __forceinline__ void p0_block_tasks(Frame& F) {
    for (int task = F.bid; task < 192 + 128 + 1; task += F.G) {
        if (task < 192) p0_adaln_task(F, task);
        else if (task < 320) p0_hyfilter_task(F, task - 192);
        else p0_tables_task(F);
    }
    __syncthreads();
}

__device__ __forceinline__ void rms_mod_store(const f32x4 (&v)[4], const float* g, const float* sh, const float* sc, bf16_t* orow, float* frow, int lane) {
    float s = 0.f;
#pragma unroll
    for (int j = 0; j < 4; ++j) s += (v[j].x * v[j].x + v[j].y * v[j].y) + (v[j].z * v[j].z + v[j].w * v[j].w);
    const float rstd = 1.0f / sqrtf(wave_sum(s) * (1.0f / 1024.0f) + EPS);
#pragma unroll
    for (int j = 0; j < 4; ++j) { const int c = 4 * lane + 256 * j; f32x4 y = v[j] * rstd * *(const f32x4*)(g + c);
        if (sc) y = y * (*(const f32x4*)(sc + c) + 1.0f) + *(const f32x4*)(sh + c);
        if (orow) { u32x2 w; w.x = cvt_pk_bf16(y[0], y[1]); w.y = cvt_pk_bf16(y[2], y[3]); *(u32x2*)(orow + c) = w; }
        if (frow) *(f32x4*)(frow + c) = y; }
}

__device__ __forceinline__ void p1_norm_in(Frame& F) {
    const int gw = F.bid * NWAVES + F.wave, NGW = F.G * NWAVES;
    const float* mod = (const float*)(F.ws + WS_MOD);
    for (int r = gw; r < NTOK + NB * CTXL; r += NGW) {
        const bool isx = r < NTOK; const int rr = isx ? r : r - NTOK; const int b = isx ? (rr >> 12) : 8;
        const float* xrow = (isx ? F.in[I_X] : F.in[I_CTX]) + (size_t)rr * DM;
        bf16_t* orow = (bf16_t*)(F.ws + (isx ? WS_BUF0 : WS_OBT)) + (size_t)rr * DM;
        f32x4 v[4];
#pragma unroll
        for (int j = 0; j < 4; ++j) v[j] = *(const f32x4*)(xrow + 4 * F.lane + 256 * j);
        rms_mod_store(v, F.in[I_N1G], mod + (size_t)b * 6144 + 0, mod + (size_t)b * 6144 + 1024, orow, nullptr, F.lane);
    }
}

__device__ __forceinline__ void moe_norm(Frame& F, int layer) {
    const int gw = F.bid * NWAVES + F.wave, NGW = F.G * NWAVES;
    const float* mod = (const float*)(F.ws + WS_MOD) + (size_t)layer * 9 * 6144;
    for (int r = gw; r < NTOK; r += NGW) {
        const int b = r >> 12; const float* xrow = F.out + (size_t)r * DM;
        f32x4 v[4];
#pragma unroll
        for (int j = 0; j < 4; ++j) v[j] = *(const f32x4*)(xrow + 4 * F.lane + 256 * j);
        rms_mod_store(v, F.in[I_N2G] + layer * DM, mod + (size_t)b * 6144 + 3 * 1024, mod + (size_t)b * 6144 + 4 * 1024, (bf16_t*)(F.ws + WS_BUF0) + (size_t)r * DM, nullptr, F.lane);
    }
}

__device__ __forceinline__ void moe_route(Frame& F, int layer) {
    LAS int* lcnt = (LAS int*)F.lds; LAS int* lbase = lcnt + 32;
    unsigned* gcnt = (unsigned*)(F.ws + WS_CTL) + CW_CNT + layer * 32 * 64;
    const float* logit = (const float*)(F.ws + WS_LOGIT);
    int* list = (int*)(F.ws + WS_LIST);
    int* tinfo = (int*)(F.ws + WS_TOK); float* tw = (float*)(F.ws + WS_TOK + 512 * 1024);
    for (int blk = F.bid; blk < 64; blk += F.G) {
        if (F.tid < 32) lcnt[F.tid] = 0;
        __syncthreads();
        const int tok = blk * 512 + F.tid;
        float lg[36];
#pragma unroll
        for (int q = 0; q < 9; ++q) { const f32x4 t = *(const f32x4*)(logit + (size_t)tok * 64 + 4 * q); lg[4 * q] = t[0]; lg[4 * q + 1] = t[1]; lg[4 * q + 2] = t[2]; lg[4 * q + 3] = t[3]; }
        int g = 0; float gm = -1e30f, gl[4];
#pragma unroll
        for (int i = 0; i < 4; ++i) { gl[i] = lg[i] + F.in[I_MBG][layer * 4 + i]; if (gl[i] > gm) { gm = gl[i]; g = i; } }
        float gs = 0.f;
#pragma unroll
        for (int i = 0; i < 4; ++i) gs += __expf(gl[i] - gm);
        const float gw = 1.0f / gs;
        float el[8];
#pragma unroll
        for (int i = 0; i < 8; ++i) { float v = 0.f;
#pragma unroll
            for (int gg = 0; gg < 4; ++gg) v = (g == gg) ? lg[4 + 8 * gg + i] + F.in[I_MBE][layer * 32 + 8 * gg + i] : v;
            el[i] = v; }
        int i1 = 0; float m1 = -1e30f;
#pragma unroll
        for (int i = 0; i < 8; ++i) if (el[i] > m1) { m1 = el[i]; i1 = i; }
        int i2 = 0; float m2 = -1e30f;
#pragma unroll
        for (int i = 0; i < 8; ++i) if (i != i1 && el[i] > m2) { m2 = el[i]; i2 = i; }
        const float e2 = __expf(m2 - m1), w1 = gw / (1.0f + e2), w2 = gw * e2 / (1.0f + e2);
        const int x1 = g * 8 + i1, x2 = g * 8 + i2;
        const int p1 = __hip_atomic_fetch_add(&lcnt[x1], 1, __ATOMIC_RELAXED, __HIP_MEMORY_SCOPE_WORKGROUP), p2 = __hip_atomic_fetch_add(&lcnt[x2], 1, __ATOMIC_RELAXED, __HIP_MEMORY_SCOPE_WORKGROUP);
        __syncthreads();
        if (F.tid < 32) lbase[F.tid] = (int)__hip_atomic_fetch_add(gcnt + F.tid * 64, (unsigned)lcnt[F.tid], RLX_AGENT);
        __syncthreads();
        const int q1 = lbase[x1] + p1, q2 = lbase[x2] + p2;
        list[x1 * 32768 + q1] = tok; list[x2 * 32768 + q2] = tok;
        *(int4*)(tinfo + 4 * (size_t)tok) = make_int4(x1, q1, x2, q2);
        *(float2*)(tw + 2 * (size_t)tok) = make_float2(w1, w2);
        __syncthreads();
    }
}

__device__ __forceinline__ void moe_prefix(Frame& F, int layer, LAS int* pref) {
    const unsigned* gcnt = (const unsigned*)(F.ws + WS_CTL) + CW_CNT + layer * 32 * 64;
    if (F.tid == 0) { int s = 0; for (int e = 0; e < 32; ++e) { const int c = (int)gcnt[e * 64]; pref[e] = s; pref[40 + e] = c; s += (c + 255) >> 8; } pref[32] = s; }
    __syncthreads();
}

template <int MODE> __device__ __forceinline__ void moe_combine(Frame& F, int layer, LAS int* pref) {
    const int gw = F.bid * NWAVES + F.wave, NGW = F.G * NWAVES;
    const float* mod = (const float*)(F.ws + WS_MOD) + (size_t)layer * 9 * 6144;
    const float* modn = (const float*)(F.ws + WS_MOD) + (size_t)1 * 9 * 6144;
    const int* tinfo = (const int*)(F.ws + WS_TOK); const float* tw = (const float*)(F.ws + WS_TOK + 512 * 1024);
    const bf16_t* Y = (const bf16_t*)(F.ws + WS_Y);
    for (int r = gw; r < NTOK; r += NGW) {
        const int b = r >> 12; float* xrow = F.out + (size_t)r * DM;
        const int4 ti = *(const int4*)(tinfo + 4 * (size_t)r); const float2 ww = *(const float2*)(tw + 2 * (size_t)r);
        const size_t s1 = (size_t)pref[ti.x] * 256 + ti.y, s2 = (size_t)pref[ti.z] * 256 + ti.w;
        const float* g2 = mod + (size_t)b * 6144 + 5 * 1024;
        f32x4 v[4];
#pragma unroll
        for (int j = 0; j < 4; ++j) { const int c = 4 * F.lane + 256 * j; const f32x4 xv = *(const f32x4*)(xrow + c);
            const u32x2 a = *(const u32x2*)(Y + s1 * DM + c), bq = *(const u32x2*)(Y + s2 * DM + c);
            f32x4 ya = (f32x4){bflo(a.x), bfhi(a.x), bflo(a.y), bfhi(a.y)}, yb = (f32x4){bflo(bq.x), bfhi(bq.x), bflo(bq.y), bfhi(bq.y)};
            v[j] = xv + *(const f32x4*)(g2 + c) * (ya * ww.x + yb * ww.y); }
        if (MODE == 0) {
#pragma unroll
            for (int j = 0; j < 4; ++j) *(f32x4*)(xrow + 4 * F.lane + 256 * j) = v[j];
            rms_mod_store(v, F.in[I_N1G] + DM, modn + (size_t)b * 6144 + 0, modn + (size_t)b * 6144 + 1024, (bf16_t*)(F.ws + WS_BUF0) + (size_t)r * DM, nullptr, F.lane);
        } else {
            rms_mod_store(v, F.in[I_FING], nullptr, nullptr, nullptr, xrow, F.lane);
        }
    }
}

__device__ __forceinline__ void transpose_ob(Frame& F) {
    LAS bf16_t* scr = (LAS bf16_t*)(F.lds + F.wave * 16384);
    const int gw = F.bid * NWAVES + F.wave, NGW = F.G * NWAVES;
    const bf16_t* src = (const bf16_t*)(F.ws + WS_OBT); bf16_t* dst = (bf16_t*)(F.ws + WS_BUF0);
    for (int it = gw; it < 8 * 512; it += NGW) {
        const int cb = it & 7, tb = it >> 3; const int c0 = cb * 64, t0 = tb * 64;
        for (int i = 0; i < 64; ++i) scr[i * 66 + F.lane] = src[(size_t)(c0 + i) * NTOK + t0 + F.lane];
        LDS_WAIT(); asm volatile("" ::: "memory");
        for (int i = 0; i < 64; ++i) dst[(size_t)(t0 + i) * DM + 512 + c0 + F.lane] = scr[F.lane * 66 + i];
        LDS_WAIT(); asm volatile("" ::: "memory");
    }
}

template <int SS> __device__ __forceinline__ void conv_step(f32x2 (&acc)[32], const f32x2 (&w)[31], const f32x2 bias, const unsigned rawv) {
    const f32x2 xin = (f32x2){bflo(rawv), bfhi(rawv)};
    acc[SS] = bias;
#pragma unroll
    for (int k = 0; k < 31; ++k) acc[(SS - k) & 31] += w[k] * xin;
}
__device__ __forceinline__ void conv_ln_rows(Frame& F, LAS float* tile, bf16_t* Obase  ) {
#pragma unroll 1
    for (int q = 0; q < 4; ++q) { const int rr = F.wave * 4 + q;
        f32x4 v[4]; float sm = 0.f;
#pragma unroll
        for (int j = 0; j < 4; ++j) { v[j] = *(const LAS f32x4*)(tile + rr * 1024 + 4 * F.lane + 256 * j); sm += (v[j].x + v[j].y) + (v[j].z + v[j].w); }
        const float mean = wave_sum(sm) * (1.0f / 1024.0f); float s2 = 0.f;
#pragma unroll
        for (int j = 0; j < 4; ++j) { v[j] = v[j] - mean; s2 += (v[j].x * v[j].x + v[j].y * v[j].y) + (v[j].z * v[j].z + v[j].w * v[j].w); }
        const float rstd = 1.0f / sqrtf(wave_sum(s2) * (1.0f / 1024.0f) + EPS);
        bf16_t* orow = Obase + (size_t)rr * DM;
#pragma unroll
        for (int j = 0; j < 4; ++j) { const int c = 4 * F.lane + 256 * j; f32x4 y = v[j] * rstd * *(const f32x4*)(F.in[I_CVLNG] + c) + *(const f32x4*)(F.in[I_CVLNB] + c);
#pragma unroll
            for (int e = 0; e < 4; ++e) y[e] = silu_f(y[e]);
            u32x2 pk; pk.x = cvt_pk_bf16(y[0], y[1]); pk.y = cvt_pk_bf16(y[2], y[3]); *(u32x2*)(orow + c) = pk; } }
}
__device__ __forceinline__ void conv_ln_phase(Frame& F) {
    LAS float* tile = (LAS float*)F.lds;
    const bf16_t* A = (const bf16_t*)(F.ws + WS_GLU); bf16_t* O = (bf16_t*)(F.ws + WS_BUF0);
    const int ch = 2 * F.tid;
    f32x2 w[31];
#pragma unroll
    for (int k = 0; k < 31; ++k) w[k] = *(const f32x2*)(F.in[I_CVDWW] + k * 1024 + ch);
    const f32x2 bias = *(const f32x2*)(F.in[I_CVDWB] + ch);
    for (int blk = F.bid; blk < 256; blk += F.G) {
        const int b = blk >> 5, t0 = (blk & 31) * 128;
        const bf16_t* Ab = A + (size_t)b * SEQ * DM + ch;
        f32x2 acc[32];
#pragma unroll
        for (int i = 0; i < 32; ++i) acc[i] = (f32x2){0.f, 0.f};
#pragma unroll 1
        for (int s0 = 0; s0 < 160; s0 += 32) {
            unsigned raw[32];
#pragma unroll
            for (int ss = 0; ss < 32; ++ss) { const int s = s0 + ss, t = t0 - 15 + s; raw[ss] = (s < 158 && t >= 0 && t < SEQ) ? *(const unsigned*)(Ab + (size_t)t * DM) : 0u; }
#define CV_STEP(SS) { conv_step<SS>(acc, w, bias, raw[SS]); const int o = s0 + SS - 30; \
                if (o >= 0 && o < 128) *(LAS f32x2*)(tile + ((SS + 2) & 31) * 1024 + ch) = acc[(SS + 2) & 31]; \
                if (SS == 29 && o >= 0 && o < 128) { __syncthreads(); conv_ln_rows(F, tile, O + ((size_t)b * SEQ + t0 + (o - 31)) * DM); __syncthreads(); } }
            CV_STEP(0) CV_STEP(1) CV_STEP(2) CV_STEP(3) CV_STEP(4) CV_STEP(5) CV_STEP(6) CV_STEP(7) CV_STEP(8) CV_STEP(9) CV_STEP(10) CV_STEP(11) CV_STEP(12) CV_STEP(13) CV_STEP(14) CV_STEP(15)
            CV_STEP(16) CV_STEP(17) CV_STEP(18) CV_STEP(19) CV_STEP(20) CV_STEP(21) CV_STEP(22) CV_STEP(23) CV_STEP(24) CV_STEP(25) CV_STEP(26) CV_STEP(27) CV_STEP(28) CV_STEP(29) CV_STEP(30) CV_STEP(31)
#undef CV_STEP
        }
    }
}
namespace att {
constexpr int KT = 64, NTILE = LKV / KT, ST_BYTES = 24576;
typedef short v4i16_t __attribute__((ext_vector_type(4)));

__device__ __forceinline__ f32x16 mfma32(bf16x8 a, bf16x8 b, f32x16 c) { return __builtin_amdgcn_mfma_f32_32x32x16_bf16(a, b, c, 0, 0, 0); }

__device__ __forceinline__ void attn_phase(Frame& F) {
    LAS unsigned char* lds = F.lds;
    const int l = F.lane, w = F.wave, tid = F.tid, r32 = l & 31, hi = l >> 5;
    const bf16_t* Qb = (const bf16_t*)(F.ws + WS_Q); const bf16_t* Kb = (const bf16_t*)(F.ws + WS_K); const bf16_t* Vb = (const bf16_t*)(F.ws + WS_V);
    bf16_t* Ob = (bf16_t*)(F.ws + WS_BUF0);
    const float lam = ((const float*)(F.ws + WS_TAB))[TB_LAM];
    const unsigned kbase_ = (unsigned)(r32 * 128), kx_ = (unsigned)((r32 >> 1) & 7);
    unsigned vbase_, vq4_;
    { const int g = l >> 4, i = l & 15, q4 = i >> 2, p4 = i & 3; const int row = 4 * (g >> 1) + q4;
      const int lowch = (2 * (g & 1) + (p4 >> 1)) ^ ((row >> 2) & 3);
      vbase_ = (unsigned)(8192 + row * 256 + (lowch << 4) + 8 * (p4 & 1)); vq4_ = (unsigned)q4; }
#define ATT_ISSUE(st, kv0) do { const size_t _ro = (size_t)(kv0) * 1024; int t_ = tid; asm volatile("" : "+v"(t_)); \
        const int krow = t_ >> 3; const unsigned ksrc = (unsigned)(krow * 1024 + (((t_ & 7) ^ ((krow >> 1) & 7)) << 4)); unsigned vsrc[2]; \
        _Pragma("unroll") for (int i_ = 0; i_ < 2; ++i_) { const int p = t_ + 512 * i_, vrow = p >> 4; vsrc[i_] = (unsigned)(vrow * 1024 + (((p & 15) ^ (((vrow & 3) << 2) | ((vrow >> 2) & 3))) << 4)); } \
        __builtin_amdgcn_global_load_lds((const unsigned*)(Kg + _ro + ksrc), (LAS unsigned*)(lds + (st) * ST_BYTES + w * 1024), 16, 0, 0); \
        __builtin_amdgcn_global_load_lds((const unsigned*)(Vg + _ro + vsrc[0]), (LAS unsigned*)(lds + (st) * ST_BYTES + 8192 + w * 1024), 16, 0, 0); \
        __builtin_amdgcn_global_load_lds((const unsigned*)(Vg + _ro + vsrc[1]), (LAS unsigned*)(lds + (st) * ST_BYTES + 16384 + w * 1024), 16, 0, 0); } while (0)

    for (int it = 0;; ++it) {
        int grp, qb;
        if (F.G == 256) { const int x = F.bid & 7, j = F.bid >> 3; if (it >= 2) break; grp = x * 4 + it * 2 + (j >> 4); qb = j & 15; }
        else { const int un = it * F.G + F.bid; if (un >= 512) break; grp = un >> 4; qb = un & 15; }
        const int b = grp >> 2, hp = grp & 3;
        const bf16_t* Qg = Qb + ((size_t)b * SEQ + qb * 256 + w * 32 + r32) * 512;
        const char* Vg = (const char*)(Vb + (size_t)b * LKV * 512 + hp * 128);
        f32x16 o1[4];
#pragma unroll 1
        for (int s = 0; s < 2; ++s) {
            const char* Kg = (const char*)(Kb + (size_t)b * LKV * 512 + (2 * hp + s) * 64);
            bf16x8 qf[4];
#pragma unroll
            for (int ds = 0; ds < 4; ++ds) qf[ds] = *(const bf16x8*)(Qg + (2 * hp + s) * 64 + ds * 16 + hi * 8);
            f32x16 O[4];
#pragma unroll
            for (int d = 0; d < 4; ++d)
#pragma unroll
                for (int r = 0; r < 16; ++r) O[d][r] = 0.f;
            float m = -1e30f, lsum = 0.f;
            __syncthreads();
            ATT_ISSUE(0, 0);
#pragma unroll 1
            for (int j = 0; j < NTILE; ++j) {
                VM_WAIT(); __syncthreads();
                if (j + 1 < NTILE) ATT_ISSUE((j + 1) & 1, (j + 1) * KT);
                const LAS unsigned char* Ks = lds + (j & 1) * ST_BYTES;
                unsigned kbase = kbase_, kx = kx_, vbase = vbase_, vq4 = vq4_; asm volatile("" : "+v"(kbase), "+v"(kx), "+v"(vbase), "+v"(vq4));
                f32x16 p0, p1;
#pragma unroll
                for (int r = 0; r < 16; ++r) { p0[r] = 0.f; p1[r] = 0.f; }
#pragma unroll
                for (int ds = 0; ds < 4; ++ds) { const unsigned ka = kbase + ((((unsigned)(2 * ds + hi)) ^ kx) << 4); const bf16x8 k0 = *(const LAS bf16x8*)(Ks + ka), k1 = *(const LAS bf16x8*)(Ks + ka + 4096);
                    p0 = mfma32(k0, qf[ds], p0); p1 = mfma32(k1, qf[ds], p1); }
                float mx = fmaxf(p0[0], p1[0]);
#pragma unroll
                for (int r = 1; r < 16; ++r) mx = fmaxf(mx, fmaxf(p0[r], p1[r]));
                mx = fmaxf(mx, __shfl_xor(mx, 32));
                if (!__all(mx - m <= 8.0f)) { const float mn = fmaxf(m, mx), alpha = __builtin_amdgcn_exp2f(m - mn);
#pragma unroll
                    for (int d = 0; d < 4; ++d) O[d] = O[d] * alpha;
                    lsum *= alpha; m = mn; }
                float rs = 0.f;
#pragma unroll
                for (int r = 0; r < 16; ++r) { p0[r] = __builtin_amdgcn_exp2f(p0[r] - m); p1[r] = __builtin_amdgcn_exp2f(p1[r] - m); rs += p0[r] + p1[r]; }
                lsum += rs;
                bf16x8 pb[4];
#pragma unroll
                for (int q = 0; q < 2; ++q) { u32x4 a, c;
                    a.x = cvt_pk_bf16(p0[8 * q + 0], p0[8 * q + 1]); a.y = cvt_pk_bf16(p0[8 * q + 2], p0[8 * q + 3]); a.z = cvt_pk_bf16(p0[8 * q + 4], p0[8 * q + 5]); a.w = cvt_pk_bf16(p0[8 * q + 6], p0[8 * q + 7]);
                    c.x = cvt_pk_bf16(p1[8 * q + 0], p1[8 * q + 1]); c.y = cvt_pk_bf16(p1[8 * q + 2], p1[8 * q + 3]); c.z = cvt_pk_bf16(p1[8 * q + 4], p1[8 * q + 5]); c.w = cvt_pk_bf16(p1[8 * q + 6], p1[8 * q + 7]);
                    pb[q] = __builtin_bit_cast(bf16x8, a); pb[2 + q] = __builtin_bit_cast(bf16x8, c); }
#pragma unroll
                for (int d = 0; d < 4; ++d) {
                    const unsigned va0 = vbase + ((((unsigned)d) ^ vq4) << 6), va1 = (va0 ^ 32u) + 2048u;
#pragma unroll
                    for (int kv = 0; kv < 4; ++kv) {
                        const v4i16_t lo = __builtin_amdgcn_ds_read_tr16_b64_v4i16((LAS v4i16_t*)(Ks + va0 + kv * 4096));
                        const v4i16_t hh = __builtin_amdgcn_ds_read_tr16_b64_v4i16((LAS v4i16_t*)(Ks + va1 + kv * 4096));
                        const bf16x8 vf = (bf16x8){lo[0], lo[1], lo[2], lo[3], hh[0], hh[1], hh[2], hh[3]};
                        O[d] = mfma32(vf, pb[kv], O[d]); } }
            }
            const float lt = lsum + __shfl_xor(lsum, 32);
            if (s == 0) { const float inv = 1.0f / lt;
#pragma unroll
                for (int d = 0; d < 4; ++d) o1[d] = O[d] * inv; }
            else { const float inv = lam / lt; float ss = 0.f;
#pragma unroll
                for (int d = 0; d < 4; ++d) { o1[d] = o1[d] - O[d] * inv;
#pragma unroll
                    for (int r = 0; r < 16; ++r) ss += o1[d][r] * o1[d][r]; }
                ss += __shfl_xor(ss, 32);
                const float rn = 0.8f / sqrtf(ss * (1.0f / 128.0f) + EPS);
                bf16_t* orow = Ob + ((size_t)b * SEQ + qb * 256 + w * 32 + r32) * DM + hp * 128 + 4 * hi;
#pragma unroll
                for (int d = 0; d < 4; ++d)
#pragma unroll
                    for (int q = 0; q < 4; ++q) { const f32x4 g4 = *(const f32x4*)(F.in[I_SUBLN] + 32 * d + 8 * q + 4 * hi);
                        u32x2 pk; pk.x = cvt_pk_bf16(o1[d][4 * q] * rn * g4[0], o1[d][4 * q + 1] * rn * g4[1]); pk.y = cvt_pk_bf16(o1[d][4 * q + 2] * rn * g4[2], o1[d][4 * q + 3] * rn * g4[3]);
                        *(u32x2*)(orow + 32 * d + 8 * q) = pk; }
            }
        }
    }
#undef ATT_ISSUE
}
}
namespace hy {
constexpr int FBUF = 4352 * 8;
constexpr int KOFF = 2 * FBUF;
constexpr int KLEN = 2192;
constexpr int RED_OFF = KOFF + 4 * KLEN * 8;
__device__ __forceinline__ int pad(int i) { return i + (i >> 4); }
__device__ __forceinline__ float sgpr_f(float v) { return __int_as_float(__builtin_amdgcn_readfirstlane(__float_as_int(v))); }
__device__ __forceinline__ void cmul(float& xr, float& xi, float wr, float wi) { const float t = xr * wr - xi * wi; xi = xr * wi + xi * wr; xr = t; }

__device__ __forceinline__ void dft4(float& ar, float& ai, float& br, float& bi, float& cr, float& ci, float& dr, float& di) {
    const float s0r = ar + cr, s0i = ai + ci, d0r = ar - cr, d0i = ai - ci;
    const float s1r = br + dr, s1i = bi + di, d1r = br - dr, d1i = bi - di;
    ar = s0r + s1r; ai = s0i + s1i; cr = s0r - s1r; ci = s0i - s1i;
    br = d0r + d1i; bi = d0i - d1r; dr = d0r - d1i; di = d0i + d1r;
}
__device__ __forceinline__ void dft16(float (&xr)[16], float (&xi)[16]) {
    constexpr float C1 = 0.9238795325112867f, S1 = 0.3826834323650898f, R = 0.7071067811865476f;
#pragma unroll
    for (int b = 0; b < 4; ++b) dft4(xr[b], xi[b], xr[4 + b], xi[4 + b], xr[8 + b], xi[8 + b], xr[12 + b], xi[12 + b]);
    cmul(xr[5], xi[5], C1, -S1); cmul(xr[6], xi[6], R, -R); cmul(xr[7], xi[7], S1, -C1);
    cmul(xr[9], xi[9], R, -R); { const float t = xr[10]; xr[10] = xi[10]; xi[10] = -t; } cmul(xr[11], xi[11], -R, -R);
    cmul(xr[13], xi[13], S1, -C1); cmul(xr[14], xi[14], -R, -R); cmul(xr[15], xi[15], -C1, S1);
#pragma unroll
    for (int c = 0; c < 4; ++c) dft4(xr[4 * c], xi[4 * c], xr[4 * c + 1], xi[4 * c + 1], xr[4 * c + 2], xi[4 * c + 2], xr[4 * c + 3], xi[4 * c + 3]);
    float yr[16], yi[16];
#pragma unroll
    for (int k = 0; k < 16; ++k) { yr[k] = xr[4 * (k & 3) + (k >> 2)]; yi[k] = xi[4 * (k & 3) + (k >> 2)]; }
#pragma unroll
    for (int k = 0; k < 16; ++k) { xr[k] = yr[k]; xi[k] = yi[k]; }
}
__device__ __forceinline__ void twiddle_pow(float (&xr)[16], float (&xi)[16], float wr, float wi) {
    float pr[16], pi[16]; pr[1] = wr; pi[1] = wi;
#pragma unroll
    for (int n = 2; n < 16; ++n) { const int a = n >> 1, b = n - a; pr[n] = pr[a] * pr[b] - pi[a] * pi[b]; pi[n] = pr[a] * pi[b] + pi[a] * pr[b]; }
#pragma unroll
    for (int n = 1; n < 16; ++n) cmul(xr[n], xi[n], pr[n], pi[n]);
}
__device__ __forceinline__ void fft4096(float (&xr)[16], float (&xi)[16], LAS f32x2* buf, int uw, int u, const f32x2* T4096) {
    dft16(xr, xi);
#pragma unroll
    for (int k = 0; k < 16; ++k) buf[pad(256 * k + uw)] = (f32x2){xr[k], xi[k]};
    __syncthreads();
    { const int k0 = u >> 4, n0 = u & 15;
#pragma unroll
      for (int n = 0; n < 16; ++n) { const f32x2 v = buf[pad(256 * k0 + 16 * n + n0)]; xr[n] = v.x; xi[n] = v.y; }
      const f32x2 w = T4096[16 * k0];
      twiddle_pow(xr, xi, w.x, w.y);
      dft16(xr, xi);
#pragma unroll
      for (int k = 0; k < 16; ++k) buf[pad(256 * k0 + 16 * k + n0)] = (f32x2){xr[k], xi[k]}; }
    __syncthreads();
    { const int k0 = u >> 4, k1 = u & 15;
#pragma unroll
      for (int n = 0; n < 16; ++n) { const f32x2 v = buf[pad(256 * k0 + 16 * k1 + n)]; xr[n] = v.x; xi[n] = v.y; }
      const f32x2 w = T4096[k0 + 16 * k1];
      twiddle_pow(xr, xi, w.x, w.y);
      dft16(xr, xi); }
}
__device__ __forceinline__ void twiddle_w8192(float (&xr)[16], float (&xi)[16], float br, float bi, bool conj) {
    constexpr float C = 0.9807852804032304f, S = 0.1950903220161283f;
    float wr = br, wi = conj ? -bi : bi; const float sr = C, si = conj ? S : -S;
#pragma unroll
    for (int n = 0; n < 16; ++n) { cmul(xr[n], xi[n], wr, wi); cmul(wr, wi, sr, si); }
}
__device__ __forceinline__ void sconv8(const bf16_t* row, int t0, const float* swp  , const float* sbp, float (&out)[8]) {
    const float w0 = sgpr_f(swp[0]), w1 = sgpr_f(swp[1536]), w2 = sgpr_f(swp[3072]), b = sgpr_f(*sbp);
    const u32x4 raw = *(const u32x4*)(row + t0);
    const float left = t0 > 0 ? bf2f(row[t0 - 1]) : 0.f, right = t0 + 8 < SEQ ? bf2f(row[t0 + 8]) : 0.f;
    float x[10]; x[0] = left; x[9] = right;
    x[1] = bflo(raw.x); x[2] = bfhi(raw.x); x[3] = bflo(raw.y); x[4] = bfhi(raw.y); x[5] = bflo(raw.z); x[6] = bfhi(raw.z); x[7] = bflo(raw.w); x[8] = bfhi(raw.w);
#pragma unroll
    for (int i = 0; i < 8; ++i) out[i] = b + w0 * x[i] + w1 * x[i + 1] + w2 * x[i + 2];
}

__device__ __forceinline__ void hyena_phase(Frame& F) {
    LAS f32x2* FB0 = (LAS f32x2*)F.lds; LAS f32x2* FB1 = (LAS f32x2*)(F.lds + FBUF);
    LAS f32x2* KH = (LAS f32x2*)(F.lds + KOFF);
    LAS float* red = (LAS float*)(F.lds + RED_OFF);
    const int tid = F.tid, half = tid >> 8, u_ = tid & 255, u1_ = (u_ >> 4) + 16 * (u_ & 15);
    LAS f32x2* myF = half ? FB1 : FB0;
    const float* tab = (const float*)(F.ws + WS_TAB);
    const f32x2* T4096 = (const f32x2*)(tab + TB_T4096); const f32x2* T8A = (const f32x2*)(tab + TB_T8A); const f32x2* T8B = (const f32x2*)(tab + TB_T8B);
#define HY_W8192(dst, idx) f32x2 dst; { const f32x2 a_ = T8A[(idx) & 63], b_ = T8B[(idx) >> 6]; dst = (f32x2){a_.x * b_.x - a_.y * b_.y, a_.x * b_.y + a_.y * b_.x}; }
    const float* kraw = (const float*)(F.ws + WS_KRAW);
    const bf16_t* UT = (const bf16_t*)(F.ws + WS_UT); bf16_t* OBT = (bf16_t*)(F.ws + WS_OBT);
    const int j0 = 8 * tid;
    for (int c = F.bid; c < 512; c += F.G) {
        const float* swp = F.in[I_HYSW] + c; const float* sbp = F.in[I_HYSB] + c;
        const float bias0 = sgpr_f(F.in[I_HYBIAS][c]), bias1 = sgpr_f(F.in[I_HYBIAS][512 + c]);
        __syncthreads();
        { float an[2];
#pragma unroll
          for (int o = 0; o < 2; ++o) { const float* fw = kraw + (size_t)(1024 * o + c) * 4096; const float* bw = kraw + (size_t)(1024 * o + 512 + c) * 4096;
              float f[8], g[8];
              { const f32x4 fa = *(const f32x4*)(fw + j0), fb = *(const f32x4*)(fw + j0 + 4);
                const f32x4 ga = *(const f32x4*)(bw + 4088 - j0), gb = *(const f32x4*)(bw + 4092 - j0);
                const float g0 = tid > 0 ? bw[4096 - j0] : 0.f;
                f[0] = fa[0]; f[1] = fa[1]; f[2] = fa[2]; f[3] = fa[3]; f[4] = fb[0]; f[5] = fb[1]; f[6] = fb[2]; f[7] = fb[3];
                g[0] = g0; g[1] = gb[3]; g[2] = gb[2]; g[3] = gb[1]; g[4] = gb[0]; g[5] = ga[3]; g[6] = ga[2]; g[7] = ga[1]; }
              float a = 0.f;
#pragma unroll
              for (int i = 0; i < 8; ++i) { a += fabsf(f[i]) + fabsf(g[i]);
                  ((LAS float*)(FB0 + pad(j0 + i)))[o] = f[i] + g[i]; ((LAS float*)(FB1 + pad(j0 + i)))[o] = f[i] - g[i]; }
              an[o] = wave_sum(a);
              asm volatile("" ::: "memory"); }
          if (F.lane == 0) { red[F.wave] = an[0]; red[8 + F.wave] = an[1]; } }
        __syncthreads();
        float nrm0 = 0.f, nrm1 = 0.f;
#pragma unroll
        for (int i = 0; i < 8; ++i) { nrm0 += red[i]; nrm1 += red[8 + i]; }
        const float sc0 = 1.0f / (nrm0 * 8192.0f), sc1 = 1.0f / (nrm1 * 8192.0f);
        float xr[16], xi[16];
        { int u = u_, u1 = u1_; asm volatile("" : "+v"(u), "+v"(u1));
#pragma unroll
        for (int n = 0; n < 16; ++n) { const f32x2 v = myF[pad(256 * n + u)]; xr[n] = v.x; xi[n] = v.y; }
        __syncthreads();
        if (half) { HY_W8192(wu, u); twiddle_w8192(xr, xi, wu.x, wu.y, false); }
        fft4096(xr, xi, myF, u, u, T4096);
        __syncthreads();
#pragma unroll
        for (int k = 0; k < 16; ++k) myF[pad(256 * k + u1)] = (f32x2){xr[k], xi[k]}; }
        __syncthreads();
        for (int kk = tid; kk < 2049; kk += 512) {
            { const f32x2 A = FB0[pad(kk)]; f32x2 B = FB0[pad((4096 - kk) & 4095)]; B.y = -B.y;
              KH[0 * KLEN + pad(kk)] = (f32x2){(A.x + B.x) * 0.5f * sc0, (A.y + B.y) * 0.5f * sc0};
              KH[2 * KLEN + pad(kk)] = (f32x2){(A.y - B.y) * 0.5f * sc1, -(A.x - B.x) * 0.5f * sc1}; }
            if (kk < 2048) { const f32x2 A = FB1[pad(kk)]; f32x2 B = FB1[pad(4095 - kk)]; B.y = -B.y;
              KH[1 * KLEN + pad(kk)] = (f32x2){(A.x + B.x) * 0.5f * sc0, (A.y + B.y) * 0.5f * sc0};
              KH[3 * KLEN + pad(kk)] = (f32x2){(A.y - B.y) * 0.5f * sc1, -(A.x - B.x) * 0.5f * sc1}; }
        }
        __syncthreads();
#pragma unroll 1
        for (int bp = 0; bp < 4; ++bp) {
            const size_t rb = (size_t)(2 * bp) * SEQ;
            const bf16_t* vr0 = UT + (size_t)c * NTOK + rb; const bf16_t* x1r0 = UT + (size_t)(512 + c) * NTOK + rb; const bf16_t* x2r0 = UT + (size_t)(1024 + c) * NTOK + rb;
            float zr[8], zi[8];
            { float vre[8], vim[8];
              sconv8(vr0, j0, swp, sbp, vre); sconv8(vr0 + SEQ, j0, swp, sbp, vim);
#pragma unroll
              for (int i = 0; i < 8; ++i) FB0[pad(j0 + i)] = (f32x2){vre[i], vim[i]}; }
            __syncthreads();
#pragma unroll 1
            for (int ord = 0; ord < 2; ++ord) {
                int u = u_, u1 = u1_; asm volatile("" : "+v"(u), "+v"(u1));
#pragma unroll
                for (int n = 0; n < 16; ++n) { const f32x2 v = FB0[pad(256 * n + u)]; xr[n] = v.x; xi[n] = v.y; }
                __syncthreads();
                if (half) { HY_W8192(wu, u); twiddle_w8192(xr, xi, wu.x, wu.y, false); }
                fft4096(xr, xi, myF, u, u, T4096);
                { const LAS f32x2* Kp = KH + (2 * ord + half) * KLEN; const int lim = half ? 2047 : 2048, top = half ? 4095 : 4096;
#pragma unroll
                  for (int n = 0; n < 16; ++n) { const int k = 256 * n + u1; const bool mir = k > lim; f32x2 kv = Kp[pad(mir ? top - k : k)]; if (mir) kv.y = -kv.y;
                      const float yr = xr[n] * kv.x - xi[n] * kv.y, yi = xr[n] * kv.y + xi[n] * kv.x; xr[n] = yi; xi[n] = yr; } }
                __syncthreads();
                fft4096(xr, xi, myF, u1, u, T4096);
#pragma unroll
                for (int n = 0; n < 16; ++n) { const float t = xr[n]; xr[n] = xi[n]; xi[n] = t; }
                if (half) { HY_W8192(wu1, u1); twiddle_w8192(xr, xi, wu1.x, wu1.y, true); }
                __syncthreads();
#pragma unroll
                for (int k = 0; k < 16; ++k) myF[pad(256 * k + u1)] = (f32x2){xr[k], xi[k]};
                __syncthreads();
                if (ord == 0) {
                    { float a0[8], vre[8];
                      sconv8(x1r0, j0, swp + 512, sbp + 512, a0); sconv8(vr0, j0, swp, sbp, vre);
#pragma unroll
                      for (int i = 0; i < 8; ++i) { const f32x2 e = FB0[pad(j0 + i)], o = FB1[pad(j0 + i)]; zr[i] = a0[i] * (e.x + o.x + bias0 * vre[i]); } }
                    { float a1[8], vim[8];
                      sconv8(x1r0 + SEQ, j0, swp + 512, sbp + 512, a1); sconv8(vr0 + SEQ, j0, swp, sbp, vim);
#pragma unroll
                      for (int i = 0; i < 8; ++i) { const f32x2 e = FB0[pad(j0 + i)], o = FB1[pad(j0 + i)]; zi[i] = a1[i] * (e.y + o.y + bias0 * vim[i]); } }
                    __syncthreads();
#pragma unroll
                    for (int i = 0; i < 8; ++i) FB0[pad(j0 + i)] = (f32x2){zr[i], zi[i]};
                    __syncthreads();
                } else {
                    float a0[8], a1[8], r0[8], r1[8];
                    sconv8(x2r0, j0, swp + 1024, sbp + 1024, a0); sconv8(x2r0 + SEQ, j0, swp + 1024, sbp + 1024, a1);
#pragma unroll
                    for (int i = 0; i < 8; ++i) { const f32x2 e = FB0[pad(j0 + i)], o = FB1[pad(j0 + i)];
                        r0[i] = a0[i] * (e.x + o.x + bias1 * zr[i]); r1[i] = a1[i] * (e.y + o.y + bias1 * zi[i]); }
                    u32x4 p0, p1;
                    p0.x = cvt_pk_bf16(r0[0], r0[1]); p0.y = cvt_pk_bf16(r0[2], r0[3]); p0.z = cvt_pk_bf16(r0[4], r0[5]); p0.w = cvt_pk_bf16(r0[6], r0[7]);
                    p1.x = cvt_pk_bf16(r1[0], r1[1]); p1.y = cvt_pk_bf16(r1[2], r1[3]); p1.z = cvt_pk_bf16(r1[4], r1[5]); p1.w = cvt_pk_bf16(r1[6], r1[7]);
                    *(u32x4*)(OBT + (size_t)c * NTOK + rb + j0) = p0; *(u32x4*)(OBT + (size_t)c * NTOK + rb + SEQ + j0) = p1;
                    __syncthreads();
                }
            }
        }
    }
}
#undef HY_W8192
}
template <bool GATH> struct MoeOrder {
    static constexpr bool GATHER = GATH;
    const LAS int* pref;
    int total, G, c, ncol, K;
    const char* A; const char* W; size_t wtile; const int* list;
    __device__ bool next(int i, pg8::Unit& u) const {
        const long L = (long)i * G + c; if (L >= total) return false;
        int id = (int)L; { const int q = total / 8, r = total % 8, xcd = id % 8, off = id / 8; id = (xcd < r ? xcd * (q + 1) : r * (q + 1) + (xcd - r) * q) + off; }
        const int rt = id / ncol, pn = id % ncol;
        int e = 0; while (e < 31 && pref[e + 1] <= rt) ++e;
        u.pm = rt; u.pn = pn; u.aux = e;
        u.a = GATH ? A : A + (size_t)rt * 256 * K * 2; u.b = W + (size_t)e * 3 * MiB + (size_t)pn * wtile;
        return true;
    }
    __device__ __forceinline__ void gather(const pg8::Unit& u, int R0, int R1, unsigned (&v)[2][2]) const {
        const int e = u.aux, j = u.pm - pref[e], cnt = pref[40 + e];
#pragma unroll
        for (int h = 0; h < 2; ++h)
#pragma unroll
            for (int i = 0; i < 2; ++i) { int r = j * 256 + h * 128 + (i ? R1 : R0); r = r < cnt ? r : 0; v[h][i] = (unsigned)list[e * 32768 + r] * (unsigned)(K * 2); }
    }
};

#ifndef MK_PER_PHASE
#define MK_PER_PHASE 0
#endif
constexpr int N_PHASES = 21;

__global__ void __launch_bounds__(NTHREADS, 2) fwd_kernel(Args args) {
    extern __shared__ __attribute__((aligned(16))) unsigned char lds_[];
    const int wave0_ = __builtin_amdgcn_readfirstlane((int)threadIdx.x >> 6);
#define MKFRAME(F) Frame F; { int t_ = wave0_ * 64 + (int)__builtin_amdgcn_mbcnt_hi(~0u, __builtin_amdgcn_mbcnt_lo(~0u, 0u)); asm volatile("" : "+v"(t_)); F.lds = (LAS unsigned char*)lds_; F.tid = t_; F.lane = t_ & 63; F.wave = __builtin_amdgcn_readfirstlane(t_ >> 6); \
        F.G = gridDim.x; F.bid = blockIdx.x; F.in = args.in; F.out = args.out; F.ws = args.ws; }
    volatile LAS unsigned* MISC = (volatile LAS unsigned*)((LAS unsigned char*)lds_ + MISC_OFF);
    LAS int* pref = (LAS int*)((LAS unsigned char*)lds_ + MISC_OFF + 64);
    if (threadIdx.x < 128) MISC[threadIdx.x] = 0u;
    __syncthreads();
    unsigned* ctl = (unsigned*)(args.ws + WS_CTL);
    const int lo = args.ph_lo, hi = args.ph_hi;
    XcdBarrier bar; bar.bar = ctl + CW_BAR; bar.x = 0; bar.st = MISC;
    if (hi - lo > 1) bar = xcd_barrier_post(ctl + CW_BAR, MISC, threadIdx.x == 0);
#ifndef PH_MASK
#define PH_MASK 0xFFFFFFFFu
#endif
#define IN(k) (((PH_MASK >> ((k) > 14 ? (k) - 9 : (k))) & 1u) && lo <= (k) && (k) < hi)
#define SEAM(k) do { if (IN(k) && IN((k) + 1)) xcd_barrier(bar, wave0_ == 0 && __builtin_amdgcn_mbcnt_hi(~0u, __builtin_amdgcn_mbcnt_lo(~0u, 0u)) == 0u); } while (0)
#define WSP (args.ws)
#define mod0 ((const float*)(args.ws + WS_MOD))
#define mod1 (mod0 + 9 * 6144)
#define tab ((const float*)(args.ws + WS_TAB))

    if (IN(0)) { MKFRAME(F); p0_convert_weights(F); __syncthreads(); p0_block_tasks(F); }
    SEAM(0);
    if (IN(1)) { MKFRAME(F); p1_norm_in(F); }
    SEAM(1);
    if (IN(2)) { MKFRAME(F);
        { pg8::StaticOrder S; S.init(WSP + WS_BUF0, WSP + WS_WQKVH, NTOK, 1536, 1024, F.G, F.bid);
          pg8::EpiQKV E{(bf16_t*)(WSP + WS_Q), (bf16_t*)(WSP + WS_K), (bf16_t*)(WSP + WS_V), tab + TB_ROPE_C, tab + TB_ROPE_S};
          pg8::gemm_phase(F.lds, F.tid, 1024, S, E); }
        { pg8::StaticOrder S; S.init(WSP + WS_WQKVH + (size_t)1536 * 1024 * 2, WSP + WS_BUF0, 1536, NTOK, 1024, F.G, F.bid);
          pg8::EpiBf16 E{(bf16_t*)(WSP + WS_UT), (size_t)NTOK};
          pg8::gemm_phase(F.lds, F.tid, 1024, S, E); }
        { pg8::StaticOrder S; S.init(WSP + WS_OBT, WSP + WS_WQKVH + (size_t)512 * 1024 * 2, NB * CTXL, 1024, 1024, F.G, F.bid);
          pg8::EpiCtxKV E{(bf16_t*)(WSP + WS_K), (bf16_t*)(WSP + WS_V)};
          pg8::gemm_phase(F.lds, F.tid, 1024, S, E); }
    }
    SEAM(2);
    if (IN(3)) {
#ifndef NO_ATTN
        { MKFRAME(F); att::attn_phase(F); } __syncthreads();
#else
        { MKFRAME(F); bf16_t* o = (bf16_t*)(F.ws + WS_BUF0); for (size_t i = (size_t)F.bid * NTHREADS + F.tid; i < (size_t)NTOK * 64; i += (size_t)F.G * NTHREADS) { const size_t r = i >> 6, c8 = i & 63; *(u32x4*)(o + r * DM + c8 * 8) = (u32x4){0u, 0u, 0u, 0u}; } }
#endif
#ifndef NO_HYENA
        { MKFRAME(F); hy::hyena_phase(F); }
#else
        { MKFRAME(F); bf16_t* o = (bf16_t*)(F.ws + WS_OBT); for (size_t i = (size_t)F.bid * NTHREADS + F.tid; i < (size_t)512 * NTOK / 8; i += (size_t)F.G * NTHREADS) *(u32x4*)(o + i * 8) = (u32x4){0u, 0u, 0u, 0u}; }
#endif
    }
    SEAM(3);
    if (IN(4)) { MKFRAME(F); transpose_ob(F); }
    SEAM(4);
    if (IN(5)) { MKFRAME(F);
        pg8::StaticOrder S; S.init(WSP + WS_BUF0, WSP + WS_WO, NTOK, 1024, 1024, F.G, F.bid);
        pg8::EpiResid E{F.in[I_X], F.out, mod0 + 2 * 1024, nullptr};
        pg8::gemm_phase(F.lds, F.tid, 1024, S, E);
    }
    SEAM(5);
#pragma unroll 1
    for (int layer = 0; layer < 2; ++layer) {
        const int pb = layer == 0 ? 6 : 15;
        if (layer == 1) {
            if (IN(12)) { MKFRAME(F);
                pg8::StaticOrder S; S.init(WSP + WS_BUF0, WSP + WS_WC1, NTOK, 2048, 1024, F.G, F.bid);
                pg8::EpiGated<1> E{(bf16_t*)(WSP + WS_GLU), (size_t)1024, F.in[I_CVB1], F.in[I_CVB1] + 1024};
                pg8::gemm_phase(F.lds, F.tid, 1024, S, E);
            }
            SEAM(12);
            if (IN(13)) { MKFRAME(F); conv_ln_phase(F); }
            SEAM(13);
            if (IN(14)) { MKFRAME(F);
                pg8::StaticOrder S; S.init(WSP + WS_BUF0, WSP + WS_WC2, NTOK, 1024, 1024, F.G, F.bid);
                pg8::EpiResid E{F.out, F.out, mod1 + 2 * 1024, F.in[I_CVB2]};
                pg8::gemm_phase(F.lds, F.tid, 1024, S, E);
            }
            SEAM(14);
        }
        if (IN(pb + 0)) { MKFRAME(F); moe_norm(F, layer); }
        SEAM(pb + 0);
        if (IN(pb + 1)) { MKFRAME(F);
            pg8::StaticOrder S; S.init(WSP + WS_BUF0, WSP + WS_WR + (size_t)layer * 256 * 1024 * 2, NTOK, 256, 1024, F.G, F.bid);
            pg8::EpiLogits E{(float*)(WSP + WS_LOGIT)};
            pg8::gemm_phase(F.lds, F.tid, 1024, S, E);
        }
        SEAM(pb + 1);
        if (IN(pb + 2)) { MKFRAME(F); moe_route(F, layer); }
        SEAM(pb + 2);
        if (IN(pb + 3)) { MKFRAME(F);
            moe_prefix(F, layer, pref);
            MoeOrder<true> S; S.pref = pref; S.total = pref[32] * 4; S.G = F.G; S.c = F.bid; S.ncol = 4; S.K = 1024;
            S.A = (const char*)(WSP + WS_BUF0); S.W = (const char*)(WSP + WS_WMOE + (size_t)layer * 32 * 3 * MiB); S.wtile = (size_t)256 * 1024 * 2; S.list = (const int*)(WSP + WS_LIST);
            pg8::EpiGated<0> E{(bf16_t*)(WSP + WS_H), (size_t)512, nullptr, nullptr};
            pg8::gemm_phase(F.lds, F.tid, 1024, S, E);
        }
        SEAM(pb + 3);
        if (IN(pb + 4)) { MKFRAME(F);
            moe_prefix(F, layer, pref);
            MoeOrder<false> S; S.pref = pref; S.total = pref[32] * 4; S.G = F.G; S.c = F.bid; S.ncol = 4; S.K = 512;
            S.A = (const char*)(WSP + WS_H); S.W = (const char*)(WSP + WS_WMOE + (size_t)layer * 32 * 3 * MiB + 2 * MiB); S.wtile = (size_t)256 * 512 * 2; S.list = nullptr;
            pg8::EpiBf16 E{(bf16_t*)(WSP + WS_Y), (size_t)1024};
            pg8::gemm_phase(F.lds, F.tid, 512, S, E);
        }
        SEAM(pb + 4);
        if (IN(pb + 5)) {
            MKFRAME(F); moe_prefix(F, layer, pref);
            if (layer == 0) moe_combine<0>(F, layer, pref); else moe_combine<1>(F, layer, pref);
        }
        if (layer == 0) SEAM(pb + 5);
    }
#undef IN
#undef SEAM
#undef WSP
#undef mod0
#undef mod1
#undef tab
#undef MKFRAME
}

extern "C" void kernel_launch(void* const* d_in, const int* in_sizes, int n_in, void* d_out, int out_size, void* d_ws, size_t ws_size, hipStream_t stream) {
    static int grid = 0;
    if (grid == 0) {
        if (n_in != N_IN || out_size != NTOK * DM || ws_size < WS_END) { grid = -1; return; }
        int dev = 0, cus = 0, per_cu = 0;
        if (hipGetDevice(&dev) != hipSuccess || hipDeviceGetAttribute(&cus, hipDeviceAttributeMultiprocessorCount, dev) != hipSuccess) { grid = -1; return; }
        if (hipFuncSetAttribute((const void*)fwd_kernel, hipFuncAttributeMaxDynamicSharedMemorySize, LDS_BYTES) != hipSuccess) { grid = -1; return; }
        (void)hipOccupancyMaxActiveBlocksPerMultiprocessor(&per_cu, (const void*)fwd_kernel, NTHREADS, LDS_BYTES);
        (void)hipGetLastError();
        grid = cus;
    }
    if (grid < 0) return;
    (void)hipMemsetAsync((char*)d_ws + WS_CTL, 0, CTL_ZERO_BYTES, stream);
    Args a{};
    for (int i = 0; i < N_IN; ++i) a.in[i] = (const float*)d_in[i];
    a.out = (float*)d_out; a.ws = (unsigned char*)d_ws;
#if MK_PER_PHASE
    for (int p = 0; p < N_PHASES; ++p) { a.ph_lo = p; a.ph_hi = p + 1; hipLaunchKernelGGL(fwd_kernel, dim3(grid), dim3(NTHREADS), LDS_BYTES, stream, a); }
#else
    a.ph_lo = 0; a.ph_hi = N_PHASES;
    hipLaunchKernelGGL(fwd_kernel, dim3(grid), dim3(NTHREADS), LDS_BYTES, stream, a);
#endif
}
```

```cpp
#define CONF_FP8 0
#include <hip/hip_runtime.h>
#include <stdint.h>
#include <math.h>

#define LAS __attribute__((address_space(3)))
#define GAS __attribute__((address_space(1)))
typedef unsigned short bf16_t;
typedef short bf16x8 __attribute__((ext_vector_type(8)));
typedef short s16x4 __attribute__((ext_vector_type(4)));
typedef float f32x2 __attribute__((ext_vector_type(2)));
typedef float f32x4 __attribute__((ext_vector_type(4)));
typedef float f32x16 __attribute__((ext_vector_type(16)));
typedef unsigned u32x2 __attribute__((ext_vector_type(2)));
typedef unsigned u32x4 __attribute__((ext_vector_type(4)));

constexpr int DM = 1024, NB = 8, SEQ = 4096, NTOK = NB * SEQ, CTXL = 256, LKV = CTXL + SEQ;
constexpr int NEXP = 32, DEXP = 512, SLOT_ROWS = 73728;
constexpr float EPS = 1e-6f;
constexpr float QSCALE = 0.125f * 1.4426950408889634f;

constexpr size_t MiB = 1u << 20;
constexpr size_t WS_CTL = 0, CTL_ZERO_BYTES = 1 * MiB;
constexpr size_t WS_MOD = 1 * MiB;
constexpr size_t WS_TAB = 2 * MiB;
constexpr size_t WS_TOK = 3 * MiB;
constexpr size_t WS_LIST = 4 * MiB;
constexpr size_t WS_LOGIT = 8 * MiB;
constexpr size_t WS_KRAW = 16 * MiB;
constexpr size_t WS_WR = 48 * MiB;
constexpr size_t WS_WQKVH = 50 * MiB;
constexpr size_t WS_WO = 56 * MiB;
constexpr size_t WS_WC1 = 58 * MiB;
constexpr size_t WS_WC2 = 62 * MiB;
constexpr size_t WS_WMOE = 64 * MiB;
constexpr size_t WS_BUF0 = 256 * MiB;
constexpr size_t WS_Q = 320 * MiB;
constexpr size_t WS_K = 352 * MiB;
constexpr size_t WS_V = 386 * MiB;
constexpr size_t WS_UT = 420 * MiB;
constexpr size_t WS_OBT = 516 * MiB;
constexpr size_t WS_X = 320 * MiB;
constexpr size_t WS_H = 448 * MiB;
constexpr size_t WS_Y1 = 520 * MiB;
constexpr size_t WS_GLU = 448 * MiB;
constexpr size_t WS_END = 585 * MiB;

constexpr int CW_TMO = 0;
constexpr int CW_BAR = 4096;
constexpr int CW_Q0 = 2048;
constexpr int CW_CNT = 8192;
constexpr int TB_ROPE_C = 0, TB_ROPE_S = 1024, TB_T4096 = 2048  , TB_T8A = 2560  , TB_T8B = 2688  , TB_LAM = 2816;

constexpr int RING_BYTES = 131072;
constexpr int MISC_OFF = 144384;
constexpr int LDS_BYTES = 147456;
constexpr int NWAVES = 8, NTHREADS = 512;

#define RLX_AGENT __ATOMIC_RELAXED, __HIP_MEMORY_SCOPE_AGENT
#define LDS_WAIT() asm volatile("s_waitcnt lgkmcnt(0)" ::: "memory")
#define VM_WAIT() asm volatile("s_waitcnt vmcnt(0)" ::: "memory")

__device__ __forceinline__ unsigned cvt_pk_bf16(float lo, float hi) { unsigned r; asm volatile("v_cvt_pk_bf16_f32 %0, %1, %2" : "=v"(r) : "v"(lo), "v"(hi)); return r; }
__device__ __forceinline__ float bf2f(bf16_t v) { return __uint_as_float((unsigned)v << 16); }
__device__ __forceinline__ float bflo(unsigned v) { return __uint_as_float(v << 16); }
__device__ __forceinline__ float bfhi(unsigned v) { return __uint_as_float(v & 0xffff0000u); }
__device__ __forceinline__ float wave_sum(float v) {
#pragma unroll
    for (int o = 1; o < 64; o <<= 1) v += __shfl_xor(v, o);
    return v;
}
__device__ __forceinline__ float sigmoid_f(float v) { return __builtin_amdgcn_rcpf(1.0f + __builtin_amdgcn_exp2f(-1.4426950408889634f * v)); }
__device__ __forceinline__ float silu_f(float v) { return v * sigmoid_f(v); }

#define XB_TMO      128
#define XB_XCNT(j)  (256  + 64 * (j))
#define XB_XSUB(j)  (1280 + 64 * (j))
#define XB_XGEN(j)  (2304 + 64 * (j))
#define XB_TOP      3328
#define XB_TOPGEN   3392
#define XCD_BAR_WORDS 3456
#define XB_SPIN_CAP (1u << 20)

__device__ __forceinline__ unsigned xb_ld(unsigned* p)              { return __hip_atomic_load(p, __ATOMIC_RELAXED, __HIP_MEMORY_SCOPE_AGENT); }
__device__ __forceinline__ unsigned xb_add(unsigned* p, unsigned v) { return __hip_atomic_fetch_add(p, v, __ATOMIC_RELAXED, __HIP_MEMORY_SCOPE_AGENT); }
__device__ __forceinline__ unsigned xb_xcc_id() { return (unsigned)__builtin_amdgcn_s_getreg((3 << 11) | 20) & 0xFu; }
#define XB_SPIN(cond, bar) do { unsigned _sp = 0; while (cond) { __builtin_amdgcn_s_sleep(1); \
    if ((++_sp & 255u) == 0u) { if (xb_ld(&(bar)[XB_TMO])) break; if (_sp > XB_SPIN_CAP) { atomicAdd(&(bar)[XB_TMO], 1u); break; } } } } while (0)

struct XcdBarrier { unsigned* bar; unsigned x; volatile LAS unsigned* st; };

__device__ __forceinline__ XcdBarrier xcd_barrier_post(unsigned* bar, volatile LAS unsigned* st, bool leader  ) {
    XcdBarrier b; b.bar = bar; b.x = xb_xcc_id(); b.st = st;
    if (leader) (void)xb_add(&bar[XB_XCNT(b.x)], 1u);
    return b;
}
__device__ __forceinline__ void xcd_barrier_complete(unsigned* bar, unsigned x, unsigned& nloc, unsigned& nx) {
    const unsigned G = gridDim.x * gridDim.y * gridDim.z;
    unsigned sum, cnt, mine, sp = 0u;
    for (;;) {
        sum = 0u; cnt = 0u; mine = 0u;
#pragma unroll
        for (unsigned j = 0; j < 16; ++j) { const unsigned c = xb_ld(&bar[XB_XCNT(j)]); sum += c; cnt += (c > 0u) ? 1u : 0u; mine = (j == x) ? c : mine; }
        if (sum == G) break;
        __builtin_amdgcn_s_sleep(1);
        if ((++sp & 255u) == 0u) { if (xb_ld(&bar[XB_TMO])) break; if (sp > XB_SPIN_CAP) { atomicAdd(&bar[XB_TMO], 1u); break; } }
    }
    nloc = mine > 0u ? mine : 1u; nx = cnt > 0u ? cnt : 1u;
}
__device__ __forceinline__ void xcd_barrier(const XcdBarrier& b, bool leader  ) {
    asm volatile("s_waitcnt vmcnt(0)" ::: "memory");
    __syncthreads();
    if (leader) {
        unsigned* bar = b.bar;
        __builtin_amdgcn_s_waitcnt(0);
        unsigned nloc = b.st[0], nx = b.st[1];
        if (nloc == 0u) { xcd_barrier_complete(bar, b.x, nloc, nx); b.st[0] = nloc; b.st[1] = nx; }
        const unsigned old = xb_add(&bar[XB_XSUB(b.x)], 1u);
        const unsigned gen = old / nloc;
        if (old + 1u == (gen + 1u) * nloc) {
            __builtin_amdgcn_fence(__ATOMIC_RELEASE, "agent");
            asm volatile("s_waitcnt vmcnt(0)" ::: "memory");
            const unsigned og = xb_add(&bar[XB_TOP], 1u);
            const unsigned tg = og / nx;
            if (og + 1u == (tg + 1u) * nx) xb_add(&bar[XB_TOPGEN], 1u);
            else XB_SPIN(xb_ld(&bar[XB_TOPGEN]) == tg, bar);
            __builtin_amdgcn_fence(__ATOMIC_ACQUIRE, "agent");
            xb_add(&bar[XB_XGEN(b.x)], 1u);
            asm volatile("s_waitcnt vmcnt(0)" ::: "memory");
        } else {
            XB_SPIN(xb_ld(&bar[XB_XGEN(b.x)]) == gen, bar);
            __builtin_amdgcn_fence(__ATOMIC_ACQUIRE, "agent");
            asm volatile("s_waitcnt vmcnt(0)" ::: "memory");
        }
    }
    __syncthreads();
}
namespace pg8 {
constexpr int BM = 256, BK = 64, HALF = 128, HTB = HALF * BK * 2, STAGE_BYTES = 8 * HTB, NXCD = 8, WGM = 8;

__host__ __device__ __forceinline__ int lds_byte(int r, int c) { const int st = (r >> 4) * 2 + (c >> 5), rr = r & 15, cc = c & 31, ob = rr * 64 + cc * 2; return st * 1024 + (ob ^ (((ob >> 9) & 1) << 5)); }
__host__ __device__ __forceinline__ void stage_rc(int b, int& R, int& C) { const int st = b / 1024, sb = b % 1024, swz = sb ^ (((sb >> 9) & 1) << 5); R = (st >> 1) * 16 + swz / 64; C = (st & 1) * 32 + (swz % 64) / 2; }
__host__ __device__ __forceinline__ int perm32(int rho) { const int n = rho >> 4, i = rho & 15; return 8 * (i >> 2) + 4 * n + (i & 3); }

struct Unit { int pm, pn; const char* a; const char* b; int aux; };

struct StaticOrder {
    static constexpr bool GATHER = false;
    int nM, nN, nwg, G, c; const char* A; const char* Bt; size_t tstep;
    __device__ void init(const void* A_, const void* Bt_, int M, int N, int K, int G_, int c_) { A = (const char*)A_; Bt = (const char*)Bt_; nM = M / BM; nN = N / BM; nwg = nM * nN; G = G_; c = c_; tstep = (size_t)BM * K * 2; }
    __device__ bool next(int i, Unit& u) const {
        const long L = (long)i * G + c; if (L >= nwg) return false;
        int wgid = (int)L; { const int q = nwg / NXCD, r = nwg % NXCD, xcd = wgid % NXCD, off = wgid / NXCD; wgid = (xcd < r ? xcd * (q + 1) : r * (q + 1) + (xcd - r) * q) + off; }
        const int nig = WGM * nN, gid = wgid / nig, fm = gid * WGM, gsz = (nM - fm) < WGM ? (nM - fm) : WGM;
        u.pm = fm + ((wgid % nig) % gsz); u.pn = (wgid % nig) / gsz; u.a = A + (size_t)u.pm * tstep; u.b = Bt + (size_t)u.pn * tstep; u.aux = 0; return true;
    }
    __device__ __forceinline__ void gather(const Unit&, int, int, unsigned (&)[2][2]) const {}
};

template <class Epi, class Sched, bool FP8 = false, int SCA = 127, int SCB = 127>
__device__ __forceinline__ void gemm_phase(LAS unsigned char* lds, int tid, const int K, const Sched& S, const Epi& E) {
    asm volatile("" : "+v"(tid));
    const int wid = __builtin_amdgcn_readfirstlane(tid >> 6), lane = tid & 63, wr = wid >> 2, wc = wid & 3, fr = lane & 15, fq = lane >> 4;
    const int nt = K / BK;
    const size_t kstep = (size_t)(BK * 2);
    const size_t hstep = (size_t)HALF * K * 2;
    int Rr[2], Cc[2];
    unsigned voffB[2];
#pragma unroll
    for (int i = 0; i < 2; ++i) { int R, C; stage_rc(tid * 16 + i * 8192, R, C); Rr[i] = R; Cc[i] = C; const int Rb = Epi::PERM ? ((R & ~31) + perm32(R & 31)) : R; voffB[i] = (unsigned)(Rb * K + C) * 2u; }
    unsigned vAc[2][2], vAn[2][2];
#pragma unroll
    for (int h = 0; h < 2; ++h)
#pragma unroll
        for (int i = 0; i < 2; ++i) { vAc[h][i] = (unsigned)((h * HALF + Rr[i]) * K + Cc[i]) * 2u; vAn[h][i] = vAc[h][i]; }
    const unsigned ldsw = (unsigned)wid * 1024u;
    const int aoff = lds_byte(wr * 64 + fr, fq * 8), boff = lds_byte(wc * 32 + fr, fq * 8);
#define PG8_SA(b, h) (((b) * 2 + (h)) * HTB)
#define PG8_SB(b, h) ((4 + (b) * 2 + (h)) * HTB)
#define PG8_STAGE_B(bufoff, gbase) do { _Pragma("unroll") for (int _i = 0; _i < 2; ++_i) \
        __builtin_amdgcn_global_load_lds((const unsigned*)((const char*)(gbase) + voffB[_i]), (LAS unsigned*)(lds + (bufoff) + ldsw + _i * 8192), 16, 0, 0); } while (0)
#define PG8_STAGE_A(bufoff, gbase, V, h) do { _Pragma("unroll") for (int _i = 0; _i < 2; ++_i) \
        __builtin_amdgcn_global_load_lds((const unsigned*)((const char*)(gbase) + (V)[h][_i]), (LAS unsigned*)(lds + (bufoff) + ldsw + _i * 8192), 16, 0, 0); } while (0)
#define PG8_LDA(dst, b, h) do { _Pragma("unroll") for (int m = 0; m < 4; ++m) { if constexpr (FP8) { const i32x4_ x0_ = *(const LAS i32x4_*)(lds + PG8_SA(b, h) + aoff + m * 2048), x1_ = *(const LAS i32x4_*)(lds + PG8_SA(b, h) + aoff + m * 2048 + 1024); \
            dst##8[m] = __builtin_shufflevector(x0_, x1_, 0, 1, 2, 3, 4, 5, 6, 7); } else { _Pragma("unroll") for (int k = 0; k < 2; ++k) dst[m][k] = *(const LAS bf16x8*)(lds + PG8_SA(b, h) + aoff + m * 2048 + k * 1024); } } } while (0)
#define PG8_LDB(dst, b, h) do { _Pragma("unroll") for (int n = 0; n < 2; ++n) { if constexpr (FP8) { const i32x4_ x0_ = *(const LAS i32x4_*)(lds + PG8_SB(b, h) + boff + n * 2048), x1_ = *(const LAS i32x4_*)(lds + PG8_SB(b, h) + boff + n * 2048 + 1024); \
            dst##8[n] = __builtin_shufflevector(x0_, x1_, 0, 1, 2, 3, 4, 5, 6, 7); } else { _Pragma("unroll") for (int k = 0; k < 2; ++k) dst[n][k] = *(const LAS bf16x8*)(lds + PG8_SB(b, h) + boff + n * 2048 + k * 1024); } } } while (0)
#define PG8_MMA(ai, bj, At, Bt) do { __builtin_amdgcn_s_setprio(1); _Pragma("unroll") for (int m = 0; m < 4; ++m) _Pragma("unroll") for (int n = 0; n < 2; ++n) { \
        if constexpr (FP8) asm volatile("v_mfma_scale_f32_16x16x128_f8f6f4 %0, %1, %2, %0, %3, %4 op_sel_hi:[0,0,0]" : "+v"(acc[ai][bj][m][n]) : "v"(Bt##8[n]), "v"(At##8[m]), "v"(sca_), "v"(scb_)); \
        else { _Pragma("unroll") for (int k = 0; k < 2; ++k) acc[ai][bj][m][n] = __builtin_amdgcn_mfma_f32_16x16x32_bf16(Bt[n][k], At[m][k], acc[ai][bj][m][n], 0, 0, 0); } } \
        __builtin_amdgcn_s_setprio(0); } while (0)
#define PG8_WAIT_V(n) asm volatile("s_waitcnt vmcnt(" #n ")" ::: "memory")
#define PG8_WAIT_L(n) asm volatile("s_waitcnt lgkmcnt(" #n ")" ::: "memory")
#define PG8_BAR __builtin_amdgcn_s_barrier()
#define PG8_SCHED __builtin_amdgcn_sched_barrier(0)
    Unit cur, nxt; int ui = 0;
    if (!S.next(0, cur)) return;
    if constexpr (Sched::GATHER) { S.gather(cur, Rr[0], Rr[1], vAc);
#pragma unroll
        for (int h = 0; h < 2; ++h)
#pragma unroll
            for (int i = 0; i < 2; ++i) vAc[h][i] += (unsigned)Cc[i] * 2u; }
    f32x4 acc[2][2][4][2];
#pragma unroll
    for (int a = 0; a < 2; ++a)
#pragma unroll
        for (int b = 0; b < 2; ++b)
#pragma unroll
            for (int m = 0; m < 4; ++m)
#pragma unroll
                for (int n = 0; n < 2; ++n) acc[a][b][m][n] = (f32x4){0.f, 0.f, 0.f, 0.f};
    typedef int i32x4_ __attribute__((ext_vector_type(4))); typedef int i32x8_ __attribute__((ext_vector_type(8)));
    bf16x8 At[4][2], B0[2][2], B1[2][2];
    i32x8_ At8[4], B08[2], B18[2]; const int sca_ = SCA * 0x01010101, scb_ = SCB * 0x01010101;
    const char* cA = cur.a; const char* cB = cur.b;
    PG8_STAGE_B(PG8_SB(0, 0), cB); PG8_STAGE_B(PG8_SB(0, 1), cB + hstep); PG8_STAGE_A(PG8_SA(0, 0), cA, vAc, 0); PG8_STAGE_A(PG8_SA(0, 1), cA, vAc, 1);
    if (wr == 1) PG8_BAR;
    PG8_WAIT_V(2); PG8_BAR;
    PG8_STAGE_B(PG8_SB(1, 0), cB + kstep); PG8_STAGE_A(PG8_SA(1, 0), cA + kstep, vAc, 0); PG8_STAGE_B(PG8_SB(1, 1), cB + hstep + kstep);
    PG8_WAIT_V(6); PG8_BAR;
    for (;;) {
        const bool has_next = S.next(ui + 1, nxt);
        if constexpr (Sched::GATHER) { if (has_next) { S.gather(nxt, Rr[0], Rr[1], vAn);
#pragma unroll
            for (int h = 0; h < 2; ++h)
#pragma unroll
                for (int i = 0; i < 2; ++i) vAn[h][i] += (unsigned)Cc[i] * 2u; } else {
#pragma unroll
            for (int h = 0; h < 2; ++h)
#pragma unroll
                for (int i = 0; i < 2; ++i) vAn[h][i] = vAc[h][i]; } }
        const char* nA = has_next ? nxt.a : cA; const char* nB = has_next ? nxt.b : cB;
        for (int t = 0; t < nt; t += 2) {
            const bool last = (t == nt - 2);
            const char* a1 = cA + (size_t)(t + 1) * kstep;
            const char* a2 = last ? nA : cA + (size_t)(t + 2) * kstep; const char* b2 = last ? nB : cB + (size_t)(t + 2) * kstep;
            const char* a3 = a2 + kstep; const char* b3 = b2 + kstep;
            unsigned v2[2][2];
#pragma unroll
            for (int h = 0; h < 2; ++h)
#pragma unroll
                for (int i = 0; i < 2; ++i) v2[h][i] = (Sched::GATHER && last) ? vAn[h][i] : vAc[h][i];
            PG8_LDB(B0, 0, 0); PG8_LDB(B1, 0, 1); PG8_SCHED; PG8_LDA(At, 0, 0); PG8_STAGE_A(PG8_SA(1, 1), a1, vAc, 1);
            PG8_WAIT_V(8); PG8_WAIT_L(0); PG8_BAR; PG8_MMA(0, 0, At, B0); PG8_MMA(0, 1, At, B1); PG8_BAR; PG8_SCHED;
            PG8_LDA(At, 0, 1); PG8_STAGE_B(PG8_SB(0, 0), b2); PG8_STAGE_B(PG8_SB(0, 1), b2 + hstep); PG8_STAGE_A(PG8_SA(0, 0), a2, v2, 0);
            PG8_WAIT_V(8); PG8_WAIT_L(0); PG8_BAR; PG8_MMA(1, 0, At, B0); PG8_MMA(1, 1, At, B1); PG8_BAR; PG8_SCHED;
            PG8_LDB(B0, 1, 0); PG8_LDB(B1, 1, 1); PG8_SCHED; PG8_LDA(At, 1, 0); PG8_STAGE_A(PG8_SA(0, 1), a2, v2, 1);
            PG8_WAIT_V(8); PG8_WAIT_L(0); PG8_BAR; PG8_MMA(0, 0, At, B0); PG8_MMA(0, 1, At, B1); PG8_BAR; PG8_SCHED;
            PG8_LDA(At, 1, 1); PG8_STAGE_B(PG8_SB(1, 0), b3); PG8_STAGE_B(PG8_SB(1, 1), b3 + hstep); PG8_STAGE_A(PG8_SA(1, 0), a3, v2, 0);
            PG8_WAIT_V(8); PG8_WAIT_L(0); PG8_BAR; PG8_MMA(1, 0, At, B0); PG8_MMA(1, 1, At, B1); PG8_BAR; PG8_SCHED;
        }
        if (wr == 0) PG8_BAR;
        if constexpr (FP8) { asm volatile("s_nop 15\n\ts_nop 15" ::: "memory"); }
        E(acc, cur, wr, wc, fr, fq);
        if (!has_next) break;
#pragma unroll
        for (int a = 0; a < 2; ++a)
#pragma unroll
            for (int b = 0; b < 2; ++b)
#pragma unroll
                for (int m = 0; m < 4; ++m)
#pragma unroll
                    for (int n = 0; n < 2; ++n) acc[a][b][m][n] = (f32x4){0.f, 0.f, 0.f, 0.f};
        cur = nxt; cA = nA; cB = nB; ++ui;
#pragma unroll
        for (int h = 0; h < 2; ++h)
#pragma unroll
            for (int i = 0; i < 2; ++i) vAc[h][i] = vAn[h][i];
        if (wr == 1) PG8_BAR;
    }
    PG8_WAIT_V(0);
    PG8_BAR;
#undef PG8_SA
#undef PG8_SB
#undef PG8_STAGE_A
#undef PG8_STAGE_B
#undef PG8_LDA
#undef PG8_LDB
#undef PG8_MMA
#undef PG8_WAIT_V
#undef PG8_WAIT_L
#undef PG8_BAR
#undef PG8_SCHED
}
}
namespace pg8 {

struct EpiBf16 {
    static constexpr bool PERM = true;
    bf16_t* O; size_t ldc;
    __device__ __forceinline__ void operator()(const f32x4 (&acc)[2][2][4][2], const Unit& u, int wr, int wc, int fr, int fq) const {
        const size_t row0 = (size_t)u.pm * BM + wr * 64 + fr; const int col0 = u.pn * BM + wc * 32 + 8 * fq;
#pragma unroll
        for (int ai = 0; ai < 2; ++ai)
#pragma unroll
            for (int m = 0; m < 4; ++m) { bf16_t* rowp = O + (row0 + ai * HALF + m * 16) * ldc + col0;
#pragma unroll
                for (int bj = 0; bj < 2; ++bj) { const f32x4 v0 = acc[ai][bj][m][0], v1 = acc[ai][bj][m][1];
                    u32x4 w; w.x = cvt_pk_bf16(v0[0], v0[1]); w.y = cvt_pk_bf16(v0[2], v0[3]); w.z = cvt_pk_bf16(v1[0], v1[1]); w.w = cvt_pk_bf16(v1[2], v1[3]);
                    *(u32x4*)(rowp + bj * HALF) = w; } }
    }
};

struct EpiQKV {
    static constexpr bool PERM = false;
    bf16_t* Q; bf16_t* Kb; bf16_t* Vb; const float* ropec; const float* ropes;
    __device__ __forceinline__ void operator()(const f32x4 (&acc)[2][2][4][2], const Unit& u, int wr, int wc, int fr, int fq) const {
        const int sec = u.pn >> 1;
        const int bt = u.pm >> 4, t0 = (u.pm & 15) * BM;
        bf16_t* base; size_t rowb; float sc = 1.f;
        if (sec == 0) { base = Q; rowb = (size_t)u.pm * BM; sc = QSCALE; }
        else { base = (sec == 1) ? Kb : Vb; rowb = (size_t)bt * LKV + CTXL + t0; }
        const int colt = (u.pn & 1) * BM + wc * 32 + 4 * fq;
        const bool rope = sec < 2; const bool colpos = (wc & 1) != 0;
#pragma unroll
        for (int ai = 0; ai < 2; ++ai)
#pragma unroll
            for (int m = 0; m < 4; ++m) {
                const int rl = ai * HALF + wr * 64 + m * 16 + fr; const int t = t0 + rl;
                const int pos = colpos ? (t & 63) : (t >> 6);
                f32x4 cs = (f32x4){1.f, 1.f, 1.f, 1.f}, sn = (f32x4){0.f, 0.f, 0.f, 0.f};
                if (rope) { cs = *(const f32x4*)(ropec + pos * 16 + 4 * fq); sn = *(const f32x4*)(ropes + pos * 16 + 4 * fq); }
                bf16_t* rowp = base + (rowb + rl) * 512 + colt;
#pragma unroll
                for (int bj = 0; bj < 2; ++bj) {
                    const f32x4 a = acc[ai][bj][m][0], b = acc[ai][bj][m][1];
                    f32x4 oa, ob;
                    if (rope) { oa = (a * cs - b * sn) * sc; ob = (a * sn + b * cs) * sc; } else { oa = a; ob = b; }
                    u32x2 w0, w1; w0.x = cvt_pk_bf16(oa[0], oa[1]); w0.y = cvt_pk_bf16(oa[2], oa[3]); w1.x = cvt_pk_bf16(ob[0], ob[1]); w1.y = cvt_pk_bf16(ob[2], ob[3]);
                    *(u32x2*)(rowp + bj * HALF) = w0; *(u32x2*)(rowp + bj * HALF + 16) = w1; }
            }
    }
};

struct EpiCtxKV {
    static constexpr bool PERM = true;
    bf16_t* Kb; bf16_t* Vb;
    __device__ __forceinline__ void operator()(const f32x4 (&acc)[2][2][4][2], const Unit& u, int wr, int wc, int fr, int fq) const {
        bf16_t* base = (u.pn < 2) ? Kb : Vb; const size_t rowb = (size_t)u.pm * LKV; const int col0 = (u.pn & 1) * BM + wc * 32 + 8 * fq;
#pragma unroll
        for (int ai = 0; ai < 2; ++ai)
#pragma unroll
            for (int m = 0; m < 4; ++m) { bf16_t* rowp = base + (rowb + ai * HALF + wr * 64 + m * 16 + fr) * 512 + col0;
#pragma unroll
                for (int bj = 0; bj < 2; ++bj) { const f32x4 v0 = acc[ai][bj][m][0], v1 = acc[ai][bj][m][1];
                    u32x4 w; w.x = cvt_pk_bf16(v0[0], v0[1]); w.y = cvt_pk_bf16(v0[2], v0[3]); w.z = cvt_pk_bf16(v1[0], v1[1]); w.w = cvt_pk_bf16(v1[2], v1[3]);
                    *(u32x4*)(rowp + bj * HALF) = w; } }
    }
};

template <bool XF32> struct EpiResid {
    static constexpr bool PERM = true;
    const void* xin; bf16_t* out; const float* gate;   const float* bias;
    __device__ __forceinline__ void operator()(const f32x4 (&acc)[2][2][4][2], const Unit& u, int wr, int wc, int fr, int fq) const {
        const int bt = u.pm >> 4; const int col0 = u.pn * BM + wc * 32 + 8 * fq;
#pragma unroll
        for (int bj = 0; bj < 2; ++bj) {
            f32x4 gv[2], bv[2];
#pragma unroll
            for (int n = 0; n < 2; ++n) { gv[n] = *(const f32x4*)(gate + (size_t)bt * 6144 + col0 + bj * HALF + 4 * n);
                bv[n] = bias ? *(const f32x4*)(bias + col0 + bj * HALF + 4 * n) : (f32x4){0.f, 0.f, 0.f, 0.f}; }
#pragma unroll
            for (int ai = 0; ai < 2; ++ai)
#pragma unroll
                for (int m = 0; m < 4; ++m) { const size_t off = ((size_t)u.pm * BM + ai * HALF + wr * 64 + m * 16 + fr) * DM + col0 + bj * HALF;
                    f32x4 x0, x1;
                    if (XF32) { x0 = *(const f32x4*)((const float*)xin + off); x1 = *(const f32x4*)((const float*)xin + off + 4); }
                    else { const u32x4 r = *(const u32x4*)((const bf16_t*)xin + off); x0 = (f32x4){bflo(r.x), bfhi(r.x), bflo(r.y), bfhi(r.y)}; x1 = (f32x4){bflo(r.z), bfhi(r.z), bflo(r.w), bfhi(r.w)}; }
                    const f32x4 y0 = x0 + gv[0] * (acc[ai][bj][m][0] + bv[0]), y1 = x1 + gv[1] * (acc[ai][bj][m][1] + bv[1]);
                    u32x4 w; w.x = cvt_pk_bf16(y0[0], y0[1]); w.y = cvt_pk_bf16(y0[2], y0[3]); w.z = cvt_pk_bf16(y1[0], y1[1]); w.w = cvt_pk_bf16(y1[2], y1[3]);
                    *(u32x4*)(out + off) = w; }
        }
    }
};

template <int MODE> struct EpiGated {
    static constexpr bool PERM = true;
    bf16_t* O; size_t ldo; const float* ba; const float* bg;
    __device__ __forceinline__ void operator()(const f32x4 (&acc)[2][2][4][2], const Unit& u, int wr, int wc, int fr, int fq) const {
        const size_t row0 = (size_t)u.pm * BM + wr * 64 + fr; const int col0 = u.pn * 128 + wc * 32 + 8 * fq;
        f32x4 b0[2], b1[2];
#pragma unroll
        for (int bj = 0; bj < 2; ++bj) { b0[bj] = (f32x4){0.f, 0.f, 0.f, 0.f}; b1[bj] = b0[bj]; if (MODE == 1) { b0[bj] = *(const f32x4*)(ba + col0 + 4 * bj); b1[bj] = *(const f32x4*)(bg + col0 + 4 * bj); } }
#pragma unroll
        for (int ai = 0; ai < 2; ++ai)
#pragma unroll
            for (int m = 0; m < 4; ++m) { f32x4 o[2];
#pragma unroll
                for (int bj = 0; bj < 2; ++bj) { const f32x4 a = acc[ai][bj][m][0] + b0[bj], g = acc[ai][bj][m][1] + b1[bj];
#pragma unroll
                    for (int j = 0; j < 4; ++j) o[bj][j] = (MODE == 1) ? a[j] * sigmoid_f(g[j]) : silu_f(a[j]) * g[j]; }
                if (MODE == 2) { unsigned char* rowp = (unsigned char*)O + (row0 + ai * HALF + m * 16) * ldo + col0;
                    int p0 = 0, p1 = 0; p0 = __builtin_amdgcn_cvt_pk_fp8_f32(o[0][0], o[0][1], p0, false); p0 = __builtin_amdgcn_cvt_pk_fp8_f32(o[0][2], o[0][3], p0, true);
                    p1 = __builtin_amdgcn_cvt_pk_fp8_f32(o[1][0], o[1][1], p1, false); p1 = __builtin_amdgcn_cvt_pk_fp8_f32(o[1][2], o[1][3], p1, true);
                    *(u32x2*)rowp = (u32x2){(unsigned)p0, (unsigned)p1}; }
                else { bf16_t* rowp = O + (row0 + ai * HALF + m * 16) * ldo + col0;
                    u32x4 w; w.x = cvt_pk_bf16(o[0][0], o[0][1]); w.y = cvt_pk_bf16(o[0][2], o[0][3]); w.z = cvt_pk_bf16(o[1][0], o[1][1]); w.w = cvt_pk_bf16(o[1][2], o[1][3]);
                    *(u32x4*)rowp = w; } }
    }
};

struct EpiScatter {
    static constexpr bool PERM = true;
    bf16_t* Y0; bf16_t* Y1; const int* list; const LAS int* pref;
    __device__ __forceinline__ void operator()(const f32x4 (&acc)[2][2][4][2], const Unit& u, int wr, int wc, int fr, int fq) const {
        const int e = u.aux, j = u.pm - pref[e], cnt = pref[40 + e]; const int col0 = u.pn * BM + wc * 32 + 8 * fq;
#pragma unroll
        for (int ai = 0; ai < 2; ++ai)
#pragma unroll
            for (int m = 0; m < 4; ++m) { const int r = j * 256 + ai * HALF + wr * 64 + m * 16 + fr;
                bf16_t* rowp = Y1 + (size_t)NTOK * DM + col0;
                if (r < cnt) { const int ent = list[e * 32768 + r]; rowp = ((ent & 1) ? Y1 : Y0) + (size_t)(ent >> 1) * DM + col0; }
#pragma unroll
                for (int bj = 0; bj < 2; ++bj) { const f32x4 v0 = acc[ai][bj][m][0], v1 = acc[ai][bj][m][1];
                    u32x4 w; w.x = cvt_pk_bf16(v0[0], v0[1]); w.y = cvt_pk_bf16(v0[2], v0[3]); w.z = cvt_pk_bf16(v1[0], v1[1]); w.w = cvt_pk_bf16(v1[2], v1[3]);
                    *(u32x4*)(rowp + bj * HALF) = w; } }
    }
};

struct EpiLogits {
    static constexpr bool PERM = false;
    float* O;
    __device__ __forceinline__ void operator()(const f32x4 (&acc)[2][2][4][2], const Unit& u, int wr, int wc, int fr, int fq) const {
        if (wc >= 2) return;
#pragma unroll
        for (int ai = 0; ai < 2; ++ai)
#pragma unroll
            for (int m = 0; m < 4; ++m) { float* rowp = O + ((size_t)u.pm * BM + ai * HALF + wr * 64 + m * 16 + fr) * 64 + wc * 32 + 4 * fq;
#pragma unroll
                for (int n = 0; n < 2; ++n) *(f32x4*)(rowp + n * 16) = acc[ai][0][m][n]; }
    }
};
}
enum { I_X = 0, I_C, I_CTX, I_CCTX, I_ADAW, I_ADAB, I_N1G, I_N2G, I_FING, I_WIN0, I_WOUT0, I_LQ1, I_LK1, I_LQ2, I_LK2, I_SUBLN,
       I_HYSW, I_HYSB, I_HYW1, I_HYB1, I_HYFR1, I_HYW2, I_HYB2, I_HYFR2, I_HYW3, I_HYB3, I_HYBIAS,
       I_CVW1, I_CVB1, I_CVDWW, I_CVDWB, I_CVLNG, I_CVLNB, I_CVW2, I_CVB2, I_MWG, I_MBG, I_MWE, I_MBE, I_MGATE, I_MUP, I_MDOWN, N_IN };

struct Args { const float* in[N_IN]; float* out; unsigned char* ws; int ph_lo, ph_hi; };

struct Frame {
    LAS unsigned char* lds;
    int tid, lane, wave, G, bid;
    const float* const* in; float* out; unsigned char* ws;
};

struct RowMap { int mode, half, which0;
    __device__ __forceinline__ int operator()(int s) const { if (mode == 0) return s; const int w = which0 + s / half, h = s % half, t = h & 127;
        return 256 * (h >> 7) + 128 * ((t >> 2) & 1) + 32 * (t >> 5) + 8 * ((t >> 3) & 3) + 4 * w + (t & 3); } };
#ifndef CONF_FP8
#define CONF_FP8 1
#endif
struct P0Item { const float* W; bf16_t* WT; int K, N, k0, n0; RowMap rm; int fp8; };
constexpr int P0_I_IN = 16 * 6, P0_I_OUT = 16 * 2, P0_I_C1 = 16 * 4, P0_I_C2 = 16 * 2, P0_I_MOE = 64 * 48;
constexpr int P0_NITEMS = P0_I_IN + P0_I_OUT + P0_I_C1 + P0_I_C2 + P0_I_MOE;
__device__ __forceinline__ P0Item p0_item(Frame& F, int it) {
    P0Item I; int r = it; I.fp8 = 0;
    if (r < P0_I_IN) { I.W = F.in[I_WIN0]; I.WT = (bf16_t*)(F.ws + WS_WQKVH); I.K = 1024; I.N = 3072; I.rm = RowMap{0, 1, 0}; }
    else if ((r -= P0_I_IN) < P0_I_OUT) { I.W = F.in[I_WOUT0]; I.WT = (bf16_t*)(F.ws + WS_WO); I.K = 1024; I.N = 1024; I.rm = RowMap{0, 1, 0}; }
    else if ((r -= P0_I_OUT) < P0_I_C1) { I.W = F.in[I_CVW1]; I.WT = (bf16_t*)(F.ws + WS_WC1); I.K = 1024; I.N = 2048; I.rm = RowMap{1, 1024, 0}; I.fp8 = CONF_FP8; }
    else if ((r -= P0_I_C1) < P0_I_C2) { I.W = F.in[I_CVW2]; I.WT = (bf16_t*)(F.ws + WS_WC2); I.K = 1024; I.N = 1024; I.rm = RowMap{0, 1, 0}; I.fp8 = CONF_FP8; }
    else { r -= P0_I_C2; const int le = r / 48, q = r % 48; unsigned char* wb = F.ws + WS_WMOE + (size_t)le * 3 * MiB;
        I.fp8 = 1;
        if (q < 16) { I.W = F.in[I_MGATE] + (size_t)le * 1024 * 512; I.WT = (bf16_t*)wb; I.K = 1024; I.N = 512; I.rm = RowMap{1, 512, 0}; r = q; }
        else if (q < 32) { I.W = F.in[I_MUP] + (size_t)le * 1024 * 512; I.WT = (bf16_t*)wb; I.K = 1024; I.N = 512; I.rm = RowMap{1, 512, 1}; r = q - 16; }
        else { I.W = F.in[I_MDOWN] + (size_t)le * 512 * 1024; I.WT = (bf16_t*)(wb + 2 * MiB); I.K = 512; I.N = 1024; I.rm = RowMap{0, 1, 0}; r = q - 32; } }
    const int nblk = I.N / 512; I.k0 = 64 * (r / nblk); I.n0 = 512 * (r % nblk); return I;
}
__device__ __forceinline__ void p0_item_load(const P0Item& I, int tid, f32x4 (&v)[16]) {
#pragma unroll
    for (int i = 0; i < 16; ++i) v[i] = *(const f32x4*)(I.W + (size_t)(I.k0 + 4 * i + (tid >> 7)) * I.N + I.n0 + 4 * (tid & 127));
}
__device__ __forceinline__ void p0_item_to_lds(LAS float* scr, int tid, const f32x4 (&v)[16]) {
#pragma unroll
    for (int i = 0; i < 16; ++i) { LAS float* d = scr + (4 * i + (tid >> 7)) * 513 + 4 * (tid & 127); d[0] = v[i][0]; d[1] = v[i][1]; d[2] = v[i][2]; d[3] = v[i][3]; }
}
__device__ __forceinline__ void p0_item_store(const P0Item& I, const LAS float* scr, int tid) {
    if (I.fp8) {
#pragma unroll
        for (int j = 0; j < 4; ++j) { const int q = tid + 512 * j, n = q >> 2, c = q & 3; const LAS float* s = scr + (16 * c) * 513 + n; int w[4];
#pragma unroll
            for (int d = 0; d < 4; ++d) { int p = 0; p = __builtin_amdgcn_cvt_pk_fp8_f32(32.f * s[(4 * d) * 513], 32.f * s[(4 * d + 1) * 513], p, false);
                p = __builtin_amdgcn_cvt_pk_fp8_f32(32.f * s[(4 * d + 2) * 513], 32.f * s[(4 * d + 3) * 513], p, true); w[d] = p; }
            *(u32x4*)((unsigned char*)I.WT + (size_t)I.rm(I.n0 + n) * I.K + I.k0 + 16 * c) = (u32x4){(unsigned)w[0], (unsigned)w[1], (unsigned)w[2], (unsigned)w[3]}; }
        return; }
#pragma unroll
    for (int j = 0; j < 8; ++j) { const int q = tid + 512 * j, n = q >> 3, c = q & 7; const LAS float* s = scr + (8 * c) * 513 + n;
        u32x4 o; o.x = cvt_pk_bf16(s[0 * 513], s[1 * 513]); o.y = cvt_pk_bf16(s[2 * 513], s[3 * 513]); o.z = cvt_pk_bf16(s[4 * 513], s[5 * 513]); o.w = cvt_pk_bf16(s[6 * 513], s[7 * 513]);
        *(u32x4*)(I.WT + (size_t)I.rm(I.n0 + n) * I.K + I.k0 + 8 * c) = o; }
}
__device__ __forceinline__ void p0_router_weights(Frame& F) {
    bf16_t* wr = (bf16_t*)(F.ws + WS_WR);
    for (int idx = F.bid * NTHREADS + F.tid; idx < 2 * 256 * 1024; idx += F.G * NTHREADS) {
        const int l = idx >> 18, n = (idx >> 10) & 255, k = idx & 1023; float v = 0.f;
        if (n < 4) v = F.in[I_MWG][((size_t)l * 1024 + k) * 4 + n]; else if (n < 36) v = F.in[I_MWE][((size_t)l * 1024 + k) * 32 + (n - 4)];
        wr[idx] = (bf16_t)(cvt_pk_bf16(v, 0.f) & 0xffffu);
    }
}

__device__ __forceinline__ void p0_adaln_task(Frame& F, int task) {
    const int layer = task / 24, n0 = (task % 24) * 256;
    LAS float* sc = (LAS float*)F.lds;
    LAS f32x4* red = (LAS f32x4*)(F.lds + 36864);
    for (int i = F.tid; i < 9 * 1024; i += NTHREADS) { const int r = i >> 10, k = i & 1023; const float v = (r < 8) ? F.in[I_C][r * 1024 + k] : F.in[I_CCTX][k]; sc[i] = silu_f(v); }
    __syncthreads();
    const int cq = F.tid & 63, ks = F.tid >> 6;
    const float* W = F.in[I_ADAW] + (size_t)layer * 1024 * 6144 + n0 + 4 * cq;
    f32x4 acc[9];
#pragma unroll
    for (int r = 0; r < 9; ++r) acc[r] = (f32x4){0.f, 0.f, 0.f, 0.f};
#pragma unroll 16
    for (int k = ks * 128; k < ks * 128 + 128; ++k) { const f32x4 w = *(const f32x4*)(W + (size_t)k * 6144);
#pragma unroll
        for (int r = 0; r < 9; ++r) acc[r] += w * sc[r * 1024 + k]; }
#pragma unroll
    for (int r = 0; r < 9; ++r) red[(ks * 9 + r) * 64 + cq] = acc[r];
    __syncthreads();
    float* mod = (float*)(F.ws + WS_MOD) + (size_t)layer * 9 * 6144;
    for (int i = F.tid; i < 9 * 64; i += NTHREADS) { const int r = i >> 6, c2 = i & 63; f32x4 s = *(const f32x4*)(F.in[I_ADAB] + layer * 6144 + n0 + 4 * c2);
#pragma unroll
        for (int k8 = 0; k8 < 8; ++k8) s += red[(k8 * 9 + r) * 64 + c2];
        *(f32x4*)(mod + (size_t)r * 6144 + n0 + 4 * c2) = s; }
    __syncthreads();
}

constexpr float HY_MIN_DECAY = -15.350567286626973f, HY_MAX_DECAY = -3.0701134573253945f;
__device__ __forceinline__ void p0_hyfilter_task(Frame& F, int pb) {
    const int t0 = pb * 32;
    LAS float* z = (LAS float*)F.lds;
    LAS float* h1 = z + 32 * 33;
    LAS float* h2 = h1 + 32 * 64;
    for (int i = F.tid; i < 32 * 33; i += NTHREADS) { const int p = i / 33, e = i % 33; const int t = t0 + p; float v;
        if (e == 0) v = (float)t / 4095.0f;
        else { const int bi = (e - 1) & 15; const float band = 1e-4f + (float)bi * ((15.0f - 1e-4f) / 15.0f); const float ang = (6.283185307179586f / 4096.0f) * (float)t * band; v = (e <= 16) ? cosf(ang) : -sinf(ang); }
        z[i] = v; }
    __syncthreads();
    for (int i = F.tid; i < 32 * 64; i += NTHREADS) { const int p = i >> 6, j = i & 63; float s = F.in[I_HYB1][j];
        for (int e = 0; e < 33; ++e) s += z[p * 33 + e] * F.in[I_HYW1][e * 64 + j];
        h1[i] = sinf(F.in[I_HYFR1][j] * s); }
    __syncthreads();
    for (int i = F.tid; i < 32 * 64; i += NTHREADS) { const int p = i >> 6, j = i & 63; float s = F.in[I_HYB2][j];
        for (int e = 0; e < 64; ++e) s += h1[p * 64 + e] * F.in[I_HYW2][e * 64 + j];
        h2[i] = sinf(F.in[I_HYFR2][j] * s); }
    __syncthreads();
    const int c0 = 4 * F.tid;
    float* kraw = (float*)(F.ws + WS_KRAW);
    const f32x4 b3 = *(const f32x4*)(F.in[I_HYB3] + c0);
#pragma unroll 1
    for (int ph = 0; ph < 2; ++ph) {
        f32x4 acc[16];
#pragma unroll
        for (int p = 0; p < 16; ++p) acc[p] = b3;
        for (int j4 = 0; j4 < 16; ++j4) {
            f32x4 w[4];
#pragma unroll
            for (int jj = 0; jj < 4; ++jj) w[jj] = *(const f32x4*)(F.in[I_HYW3] + (size_t)(4 * j4 + jj) * 2048 + c0);
#pragma unroll
            for (int p = 0; p < 16; ++p) { const f32x4 hv = *(const LAS f32x4*)(h2 + (16 * ph + p) * 64 + 4 * j4);
                acc[p] += w[0] * hv[0] + w[1] * hv[1] + w[2] * hv[2] + w[3] * hv[3]; }
        }
#pragma unroll
        for (int cc = 0; cc < 4; ++cc) { const int col = c0 + cc, ch = col & 511;
            const float delta = fabsf(HY_MIN_DECAY + (float)ch * ((HY_MAX_DECAY - HY_MIN_DECAY) / 511.0f));
            float* dst = kraw + (size_t)col * 4096 + t0 + 16 * ph;
#pragma unroll
            for (int p4 = 0; p4 < 4; ++p4) { f32x4 o;
#pragma unroll
                for (int q = 0; q < 4; ++q) { const int p = 4 * p4 + q; const float tn = (float)(t0 + 16 * ph + p) / 4095.0f; o[q] = acc[p][cc] * __expf(-tn * delta); }
                *(f32x4*)(dst + 4 * p4) = o; } }
    }
    __syncthreads();
}

__device__ __forceinline__ void p0_tables_task(Frame& F) {
    float* tab = (float*)(F.ws + WS_TAB);
    for (int i = F.tid; i < 1024; i += NTHREADS) { const int pos = i >> 4, fi = i & 15; const float inv = powf(10000.0f, -(float)fi / 16.0f); const float ang = (float)pos * inv;
        tab[TB_ROPE_C + i] = cosf(ang); tab[TB_ROPE_S + i] = sinf(ang); }
    for (int i = F.tid; i < 256; i += NTHREADS) { float s, c; sincospif(2.0f * (float)i / 4096.0f, &s, &c); tab[TB_T4096 + 2 * i] = c; tab[TB_T4096 + 2 * i + 1] = -s; }
    for (int i = F.tid; i < 64; i += NTHREADS) { float s, c; sincospif(2.0f * (float)i / 8192.0f, &s, &c); tab[TB_T8A + 2 * i] = c; tab[TB_T8A + 2 * i + 1] = -s;
        sincospif(2.0f * (float)(64 * i) / 8192.0f, &s, &c); tab[TB_T8B + 2 * i] = c; tab[TB_T8B + 2 * i + 1] = -s; }
    if (F.tid < 64) { const float a = wave_sum(F.in[I_LQ1][F.lane] * F.in[I_LK1][F.lane]), b = wave_sum(F.in[I_LQ2][F.lane] * F.in[I_LK2][F.lane]);
        if (F.lane == 0) tab[TB_LAM] = expf(a) - expf(b) + 0.2f; }
}

__device__ __forceinline__ void p0_prologue(Frame& F, unsigned* ctr, volatile LAS unsigned* slot) {
    p0_router_weights(F);
#pragma unroll 1
    for (int t = F.bid; t < 48 + 128; t += F.G) { if (t < 48) p0_adaln_task(F, t); else p0_hyfilter_task(F, t - 48); }
    if (F.bid == 0) p0_tables_task(F);
    __syncthreads();
    LAS float* scr = (LAS float*)F.lds;
    if (F.tid == 0) slot[0] = __hip_atomic_fetch_add(ctr, 1u, RLX_AGENT);
    __syncthreads();
    int cur = (int)slot[0];
    f32x4 v[16];
    if (cur < P0_NITEMS) { const P0Item I = p0_item(F, cur); p0_item_load(I, F.tid, v); }
    while (cur < P0_NITEMS) {
        __syncthreads();
        p0_item_to_lds(scr, F.tid, v);
        if (F.tid == 0) slot[0] = __hip_atomic_fetch_add(ctr, 1u, RLX_AGENT);
        __syncthreads();
        const int nxt = (int)slot[0];
        if (nxt < P0_NITEMS) { const P0Item J = p0_item(F, nxt); p0_item_load(J, F.tid, v); }
        { const P0Item I = p0_item(F, cur); p0_item_store(I, scr, F.tid); }
        cur = nxt;
    }
    __syncthreads();
}

__device__ __forceinline__ void bf8_to_f32(const u32x4 r, f32x4& a, f32x4& b) { a = (f32x4){bflo(r.x), bfhi(r.x), bflo(r.y), bfhi(r.y)}; b = (f32x4){bflo(r.z), bfhi(r.z), bflo(r.w), bfhi(r.w)}; }
__device__ __forceinline__ void rms_mod_store(const f32x4 (&v)[4], const float* g, const float* sh, const float* sc, bf16_t* orow, float* frow, int lane) {
    float s = 0.f;
#pragma unroll
    for (int j = 0; j < 4; ++j) s += (v[j].x * v[j].x + v[j].y * v[j].y) + (v[j].z * v[j].z + v[j].w * v[j].w);
    const float rstd = 1.0f / sqrtf(wave_sum(s) * (1.0f / 1024.0f) + EPS);
#pragma unroll
    for (int h = 0; h < 2; ++h) { const int c = 8 * lane + 512 * h; f32x4 y0 = v[2 * h] * rstd * *(const f32x4*)(g + c), y1 = v[2 * h + 1] * rstd * *(const f32x4*)(g + c + 4);
        if (sc) { y0 = y0 * (*(const f32x4*)(sc + c) + 1.0f) + *(const f32x4*)(sh + c); y1 = y1 * (*(const f32x4*)(sc + c + 4) + 1.0f) + *(const f32x4*)(sh + c + 4); }
        if (orow) { u32x4 w; w.x = cvt_pk_bf16(y0[0], y0[1]); w.y = cvt_pk_bf16(y0[2], y0[3]); w.z = cvt_pk_bf16(y1[0], y1[1]); w.w = cvt_pk_bf16(y1[2], y1[3]); *(u32x4*)(orow + c) = w; }
        if (frow) { *(f32x4*)(frow + c) = y0; *(f32x4*)(frow + c + 4) = y1; } }
}

__device__ __forceinline__ void p1_norm_in(Frame& F) {
    const int gw = F.bid * NWAVES + F.wave, NGW = F.G * NWAVES;
    const float* mod = (const float*)(F.ws + WS_MOD);
#pragma unroll 1
    for (int r0 = gw; r0 < NTOK + NB * CTXL; r0 += 4 * NGW) {
        f32x4 v[4][4];
#pragma unroll
        for (int q = 0; q < 4; ++q) { const int r = r0 + q * NGW; if (r < NTOK + NB * CTXL) { const bool isx = r < NTOK; const int rr = isx ? r : r - NTOK;
            const float* xrow = (isx ? F.in[I_X] : F.in[I_CTX]) + (size_t)rr * DM;
#pragma unroll
            for (int j = 0; j < 4; ++j) v[q][j] = *(const f32x4*)(xrow + 8 * F.lane + 512 * (j >> 1) + 4 * (j & 1)); } }
#pragma unroll
        for (int q = 0; q < 4; ++q) { const int r = r0 + q * NGW; if (r < NTOK + NB * CTXL) { const bool isx = r < NTOK; const int rr = isx ? r : r - NTOK; const int b = isx ? (rr >> 12) : 8;
            bf16_t* orow = (bf16_t*)(F.ws + (isx ? WS_BUF0 : WS_OBT)) + (size_t)rr * DM;
            rms_mod_store(v[q], F.in[I_N1G], mod + (size_t)b * 6144 + 0, mod + (size_t)b * 6144 + 1024, orow, nullptr, F.lane); } }
    }
}

constexpr int MF_PITCH = 2064;
constexpr int MF_TILE = 0, MF_RED = 32 * MF_PITCH, MF_SEL = MF_RED + 8 * 32 * 65 * 4, MF_CNT = MF_SEL + 128 * 32;
__device__ __forceinline__ void moe_front(Frame& F, int layer) {
    LAS unsigned char* lds = F.lds;
    LAS float* red = (LAS float*)(lds + MF_RED);
    LAS int* lcnt = (LAS int*)(lds + MF_CNT); LAS int* lbase = lcnt + 32;
    const float* mod = (const float*)(F.ws + WS_MOD) + (size_t)layer * 9 * 6144;
    unsigned* gcnt = (unsigned*)(F.ws + WS_CTL) + CW_CNT + layer * 32 * 64;
    int* list = (int*)(F.ws + WS_LIST);
    int* tinfo = (int*)(F.ws + WS_TOK); float* tw = (float*)(F.ws + WS_TOK + 512 * 1024);
    const int l = F.lane, w = F.wave, r32 = l & 31, hi = l >> 5;
    bf16x8 wb[2][8];
    { const bf16_t* wr = (const bf16_t*)(F.ws + WS_WR) + (size_t)layer * 256 * 1024;
#pragma unroll
      for (int nb = 0; nb < 2; ++nb)
#pragma unroll
          for (int s = 0; s < 8; ++s) wb[nb][s] = *(const bf16x8*)(wr + (size_t)(32 * nb + r32) * 1024 + 128 * w + 16 * s + 8 * hi); }
    for (int blk = F.bid; blk < NTOK / 128; blk += F.G) {
        if (F.tid < 32) lcnt[F.tid] = 0;
        __syncthreads();
#pragma unroll 1
        for (int sg = 0; sg < 4; ++sg) {
            const int tok0 = blk * 128 + sg * 32;
            { f32x4 v[4][4];
#pragma unroll
              for (int q = 0; q < 4; ++q) { const bf16_t* xrow = (const bf16_t*)(F.ws + WS_X) + (size_t)(tok0 + 4 * w + q) * DM;
#pragma unroll
                  for (int h = 0; h < 2; ++h) { const u32x4 t = *(const u32x4*)(xrow + 8 * l + 512 * h); bf8_to_f32(t, v[q][2 * h], v[q][2 * h + 1]); } }
              const int b = tok0 >> 12;
              const float* g = F.in[I_N2G] + layer * DM; const float* sh = mod + (size_t)b * 6144 + 3 * 1024; const float* sc = mod + (size_t)b * 6144 + 4 * 1024;
#pragma unroll
              for (int q = 0; q < 4; ++q) { const int rl = 4 * w + q, r = tok0 + rl; float ssq = 0.f;
#pragma unroll
                  for (int j = 0; j < 4; ++j) ssq += (v[q][j].x * v[q][j].x + v[q][j].y * v[q][j].y) + (v[q][j].z * v[q][j].z + v[q][j].w * v[q][j].w);
                  const float rstd = 1.0f / sqrtf(wave_sum(ssq) * (1.0f / 1024.0f) + EPS);
                  unsigned char* orow = F.ws + WS_BUF0 + (size_t)r * DM;
#pragma unroll
                  for (int h = 0; h < 2; ++h) { const int c = 8 * l + 512 * h;
                      const f32x4 y0 = v[q][2 * h] * rstd * *(const f32x4*)(g + c) * (*(const f32x4*)(sc + c) + 1.0f) + *(const f32x4*)(sh + c);
                      const f32x4 y1 = v[q][2 * h + 1] * rstd * *(const f32x4*)(g + c + 4) * (*(const f32x4*)(sc + c + 4) + 1.0f) + *(const f32x4*)(sh + c + 4);
                      u32x4 pk; pk.x = cvt_pk_bf16(y0[0], y0[1]); pk.y = cvt_pk_bf16(y0[2], y0[3]); pk.z = cvt_pk_bf16(y1[0], y1[1]); pk.w = cvt_pk_bf16(y1[2], y1[3]);
                      *(LAS u32x4*)(lds + MF_TILE + rl * MF_PITCH + c * 2) = pk;
                      int p0 = 0, p1 = 0; p0 = __builtin_amdgcn_cvt_pk_fp8_f32(y0[0], y0[1], p0, false); p0 = __builtin_amdgcn_cvt_pk_fp8_f32(y0[2], y0[3], p0, true);
                      p1 = __builtin_amdgcn_cvt_pk_fp8_f32(y1[0], y1[1], p1, false); p1 = __builtin_amdgcn_cvt_pk_fp8_f32(y1[2], y1[3], p1, true);
                      *(u32x2*)(orow + c) = (u32x2){(unsigned)p0, (unsigned)p1}; } } }
            __syncthreads();
            { f32x16 d0, d1;
#pragma unroll
              for (int r = 0; r < 16; ++r) { d0[r] = 0.f; d1[r] = 0.f; }
#pragma unroll
              for (int s = 0; s < 8; ++s) { const bf16x8 a = *(const LAS bf16x8*)(lds + MF_TILE + r32 * MF_PITCH + (128 * w + 16 * s + 8 * hi) * 2);
                  d0 = __builtin_amdgcn_mfma_f32_32x32x16_bf16(a, wb[0][s], d0, 0, 0, 0); d1 = __builtin_amdgcn_mfma_f32_32x32x16_bf16(a, wb[1][s], d1, 0, 0, 0); }
#pragma unroll
              for (int r = 0; r < 16; ++r) { const int t = (r & 3) + 8 * (r >> 2) + 4 * hi; red[(w * 32 + t) * 65 + r32] = d0[r]; red[(w * 32 + t) * 65 + 32 + r32] = d1[r]; } }
            __syncthreads();
            if (F.tid < 32) { const int t = F.tid;
                int g = 0; float gm = -1e30f, gl[4];
#pragma unroll
                for (int i = 0; i < 4; ++i) { float sum = F.in[I_MBG][layer * 4 + i];
#pragma unroll
                    for (int ww = 0; ww < 8; ++ww) sum += red[(ww * 32 + t) * 65 + i];
                    gl[i] = sum; if (sum > gm) { gm = sum; g = i; } }
                float gs = 0.f;
#pragma unroll
                for (int i = 0; i < 4; ++i) gs += __expf(gl[i] - gm);
                const float gw = 1.0f / gs;
                float el[8];
#pragma unroll
                for (int i = 0; i < 8; ++i) { float sum = F.in[I_MBE][layer * 32 + 8 * g + i];
#pragma unroll
                    for (int ww = 0; ww < 8; ++ww) sum += red[(ww * 32 + t) * 65 + 4 + 8 * g + i];
                    el[i] = sum; }
                int i1 = 0; float m1 = -1e30f;
#pragma unroll
                for (int i = 0; i < 8; ++i) if (el[i] > m1) { m1 = el[i]; i1 = i; }
                int i2 = 0; float m2 = -1e30f;
#pragma unroll
                for (int i = 0; i < 8; ++i) if (i != i1 && el[i] > m2) { m2 = el[i]; i2 = i; }
                const float e2 = __expf(m2 - m1), w1 = gw / (1.0f + e2), w2 = gw * e2 / (1.0f + e2);
                const int x1 = g * 8 + i1, x2 = g * 8 + i2;
                const int p1 = __hip_atomic_fetch_add(&lcnt[x1], 1, __ATOMIC_RELAXED, __HIP_MEMORY_SCOPE_WORKGROUP), p2 = __hip_atomic_fetch_add(&lcnt[x2], 1, __ATOMIC_RELAXED, __HIP_MEMORY_SCOPE_WORKGROUP);
                LAS int* sel = (LAS int*)(lds + MF_SEL) + (sg * 32 + t) * 8;
                sel[0] = x1; sel[1] = p1; sel[2] = x2; sel[3] = p2; sel[4] = __float_as_int(w1); sel[5] = __float_as_int(w2); }
            __syncthreads();
        }
        if (F.tid < 32) lbase[F.tid] = (int)__hip_atomic_fetch_add(gcnt + F.tid * 64, (unsigned)lcnt[F.tid], RLX_AGENT);
        __syncthreads();
        if (F.tid < 128) { const LAS int* sel = (const LAS int*)(lds + MF_SEL) + F.tid * 8; const int tok = blk * 128 + F.tid;
            const int x1 = sel[0], x2 = sel[2], q1 = lbase[x1] + sel[1], q2 = lbase[x2] + sel[3];
            list[x1 * 32768 + q1] = 2 * tok; list[x2 * 32768 + q2] = 2 * tok + 1;
            *(int4*)(tinfo + 4 * (size_t)tok) = make_int4(x1, q1, x2, q2);
            *(float2*)(tw + 2 * (size_t)tok) = make_float2(__int_as_float(sel[4]), __int_as_float(sel[5])); }
        __syncthreads();
    }
}

__device__ __forceinline__ void moe_prefix(Frame& F, int layer, LAS int* pref) {
    const unsigned* gcnt = (const unsigned*)(F.ws + WS_CTL) + CW_CNT + layer * 32 * 64;
    if (F.tid == 0) { int s = 0; for (int e = 0; e < 32; ++e) { const int c = (int)gcnt[e * 64]; pref[e] = s; pref[40 + e] = c; s += (c + 255) >> 8; } pref[32] = s; }
    __syncthreads();
}

template <int MODE> __device__ __forceinline__ void moe_combine(Frame& F, int layer) {
    const int gw = F.bid * NWAVES + F.wave, NGW = F.G * NWAVES;
    const float* mod = (const float*)(F.ws + WS_MOD) + (size_t)layer * 9 * 6144;
    const float* modn = (const float*)(F.ws + WS_MOD) + (size_t)1 * 9 * 6144;
    const float* tw = (const float*)(F.ws + WS_TOK + 512 * 1024);
    const bf16_t* Y0 = (const bf16_t*)(F.ws + WS_BUF0); const bf16_t* Y1 = (const bf16_t*)(F.ws + WS_Y1);
    bf16_t* X = (bf16_t*)(F.ws + WS_X);
#pragma unroll 1
    for (int r0 = gw; r0 < NTOK; r0 += 4 * NGW) {
        f32x4 v[4][4];
#pragma unroll
        for (int q = 0; q < 4; ++q) { const int r = r0 + q * NGW; const int b = r >> 12;
            const float2 ww = *(const float2*)(tw + 2 * (size_t)r);
            const float* g2 = mod + (size_t)b * 6144 + 5 * 1024;
#pragma unroll
            for (int h = 0; h < 2; ++h) { const int c = 8 * F.lane + 512 * h;
                const u32x4 xr = *(const u32x4*)(X + (size_t)r * DM + c), ar = *(const u32x4*)(Y0 + (size_t)r * DM + c), br = *(const u32x4*)(Y1 + (size_t)r * DM + c);
                f32x4 x0, x1, a0, a1, b0, b1; bf8_to_f32(xr, x0, x1); bf8_to_f32(ar, a0, a1); bf8_to_f32(br, b0, b1);
                v[q][2 * h] = x0 + *(const f32x4*)(g2 + c) * (a0 * ww.x + b0 * ww.y); v[q][2 * h + 1] = x1 + *(const f32x4*)(g2 + c + 4) * (a1 * ww.x + b1 * ww.y); } }
#pragma unroll
        for (int q = 0; q < 4; ++q) { const int r = r0 + q * NGW; const int b = r >> 12;
            float ssq = 0.f;
#pragma unroll
            for (int j = 0; j < 4; ++j) ssq += (v[q][j].x * v[q][j].x + v[q][j].y * v[q][j].y) + (v[q][j].z * v[q][j].z + v[q][j].w * v[q][j].w);
            const float rstd = 1.0f / sqrtf(wave_sum(ssq) * (1.0f / 1024.0f) + EPS);
            const float* g = (MODE == 0) ? F.in[I_N1G] + DM : F.in[I_FING];
#pragma unroll
            for (int h = 0; h < 2; ++h) { const int c = 8 * F.lane + 512 * h;
                if (MODE == 0) { u32x4 pk; pk.x = cvt_pk_bf16(v[q][2 * h][0], v[q][2 * h][1]); pk.y = cvt_pk_bf16(v[q][2 * h][2], v[q][2 * h][3]); pk.z = cvt_pk_bf16(v[q][2 * h + 1][0], v[q][2 * h + 1][1]); pk.w = cvt_pk_bf16(v[q][2 * h + 1][2], v[q][2 * h + 1][3]);
                    *(u32x4*)(X + (size_t)r * DM + c) = pk; }
                f32x4 y0 = v[q][2 * h] * rstd * *(const f32x4*)(g + c), y1 = v[q][2 * h + 1] * rstd * *(const f32x4*)(g + c + 4);
                if (MODE == 0) { const float* sh = modn + (size_t)b * 6144; const float* sc = sh + 1024;
                    y0 = y0 * (*(const f32x4*)(sc + c) + 1.0f) + *(const f32x4*)(sh + c); y1 = y1 * (*(const f32x4*)(sc + c + 4) + 1.0f) + *(const f32x4*)(sh + c + 4);
                    if (CONF_FP8) { int p0 = 0, p1 = 0; p0 = __builtin_amdgcn_cvt_pk_fp8_f32(y0[0], y0[1], p0, false); p0 = __builtin_amdgcn_cvt_pk_fp8_f32(y0[2], y0[3], p0, true);
                        p1 = __builtin_amdgcn_cvt_pk_fp8_f32(y1[0], y1[1], p1, false); p1 = __builtin_amdgcn_cvt_pk_fp8_f32(y1[2], y1[3], p1, true);
                        *(u32x2*)(F.ws + WS_BUF0 + (size_t)r * DM + c) = (u32x2){(unsigned)p0, (unsigned)p1}; }
                    else { u32x4 pk; pk.x = cvt_pk_bf16(y0[0], y0[1]); pk.y = cvt_pk_bf16(y0[2], y0[3]); pk.z = cvt_pk_bf16(y1[0], y1[1]); pk.w = cvt_pk_bf16(y1[2], y1[3]);
                        *(u32x4*)((bf16_t*)(F.ws + WS_BUF0) + (size_t)r * DM + c) = pk; } }
                else { *(f32x4*)(F.out + (size_t)r * DM + c) = y0; *(f32x4*)(F.out + (size_t)r * DM + c + 4) = y1; } } }
    }
}

__device__ __forceinline__ void transpose_ob(Frame& F) {
    LAS bf16_t* scr = (LAS bf16_t*)(F.lds + F.wave * 16384);
    const int gw = F.bid * NWAVES + F.wave, NGW = F.G * NWAVES;
    const bf16_t* src = (const bf16_t*)(F.ws + WS_OBT); bf16_t* dst = (bf16_t*)(F.ws + WS_BUF0);
    const int r8 = F.lane >> 3, c8 = F.lane & 7;
    for (int it = gw; it < 8 * 512; it += NGW) {
        const int cb = it & 7, tb = it >> 3; const int c0 = cb * 64, t0 = tb * 64;
        u32x4 v[8];
#pragma unroll
        for (int i = 0; i < 8; ++i) v[i] = *(const u32x4*)(src + (size_t)(c0 + r8 + 8 * i) * NTOK + t0 + 8 * c8);
#pragma unroll
        for (int i = 0; i < 8; ++i) *(LAS u32x4*)(scr + (r8 + 8 * i) * 72 + 8 * c8) = v[i];
        LDS_WAIT(); asm volatile("" ::: "memory");
#pragma unroll
        for (int i = 0; i < 8; ++i) { const int t = r8 + 8 * i; unsigned short e[8];
#pragma unroll
            for (int k = 0; k < 8; ++k) e[k] = scr[(8 * c8 + k) * 72 + t];
            u32x4 o; o.x = e[0] | ((unsigned)e[1] << 16); o.y = e[2] | ((unsigned)e[3] << 16); o.z = e[4] | ((unsigned)e[5] << 16); o.w = e[6] | ((unsigned)e[7] << 16);
            *(u32x4*)(dst + (size_t)(t0 + t) * DM + 512 + c0 + 8 * c8) = o; }
        LDS_WAIT(); asm volatile("" ::: "memory");
    }
}

template <int SS> __device__ __forceinline__ void conv_step(f32x2 (&acc)[32], const f32x2 (&w)[31], const f32x2 bias, const unsigned rawv) {
    const f32x2 xin = (f32x2){bflo(rawv), bfhi(rawv)};
    acc[SS] = bias;
#pragma unroll
    for (int k = 0; k < 31; ++k) acc[(SS - k) & 31] += w[k] * xin;
}
constexpr int CV_TILE = 65536;
__device__ __forceinline__ void conv_ln_rows(Frame& F, const LAS bf16_t* tile, bf16_t* Obase  ) {
#pragma unroll 1
    for (int q = 0; q < 4; ++q) { const int rr = F.wave * 4 + q;
        f32x4 v[4]; float sm = 0.f;
#pragma unroll
        for (int h = 0; h < 2; ++h) { const u32x4 t = *(const LAS u32x4*)(tile + rr * 1024 + 8 * F.lane + 512 * h); bf8_to_f32(t, v[2 * h], v[2 * h + 1]); }
#pragma unroll
        for (int j = 0; j < 4; ++j) sm += (v[j].x + v[j].y) + (v[j].z + v[j].w);
        const float mean = wave_sum(sm) * (1.0f / 1024.0f); float s2 = 0.f;
#pragma unroll
        for (int j = 0; j < 4; ++j) { v[j] = v[j] - mean; s2 += (v[j].x * v[j].x + v[j].y * v[j].y) + (v[j].z * v[j].z + v[j].w * v[j].w); }
        const float rstd = 1.0f / sqrtf(wave_sum(s2) * (1.0f / 1024.0f) + EPS);
        bf16_t* orow = Obase + (size_t)rr * (CONF_FP8 ? DM / 2 : DM);
#pragma unroll
        for (int h = 0; h < 2; ++h) { const int c = 8 * F.lane + 512 * h;
            f32x4 y0 = v[2 * h] * rstd * *(const f32x4*)(F.in[I_CVLNG] + c) + *(const f32x4*)(F.in[I_CVLNB] + c), y1 = v[2 * h + 1] * rstd * *(const f32x4*)(F.in[I_CVLNG] + c + 4) + *(const f32x4*)(F.in[I_CVLNB] + c + 4);
#pragma unroll
            for (int e = 0; e < 4; ++e) { y0[e] = silu_f(y0[e]); y1[e] = silu_f(y1[e]); }
            if (CONF_FP8) { int p0 = 0, p1 = 0; p0 = __builtin_amdgcn_cvt_pk_fp8_f32(y0[0], y0[1], p0, false); p0 = __builtin_amdgcn_cvt_pk_fp8_f32(y0[2], y0[3], p0, true);
                p1 = __builtin_amdgcn_cvt_pk_fp8_f32(y1[0], y1[1], p1, false); p1 = __builtin_amdgcn_cvt_pk_fp8_f32(y1[2], y1[3], p1, true); *(u32x2*)((unsigned char*)orow + c) = (u32x2){(unsigned)p0, (unsigned)p1}; }
            else { u32x4 pk; pk.x = cvt_pk_bf16(y0[0], y0[1]); pk.y = cvt_pk_bf16(y0[2], y0[3]); pk.z = cvt_pk_bf16(y1[0], y1[1]); pk.w = cvt_pk_bf16(y1[2], y1[3]); *(u32x4*)(orow + c) = pk; } } }
}
__device__ __forceinline__ void conv_half_issue(Frame& F, const bf16_t* Abatch, int t0, int s1, LAS unsigned char* dst) {
    const char* zrow = (const char*)(F.ws + WS_CTL + 512 * 1024);
#pragma unroll
    for (int i = 0; i < 4; ++i) { const int p = F.tid + 512 * i, row = p >> 7, chn = p & 127; const int t = t0 - 15 + s1 + row;
        const char* src = (t >= 0 && t < SEQ) ? (const char*)(Abatch + (size_t)t * DM) + 16 * chn : zrow + 16 * chn;
        __builtin_amdgcn_global_load_lds((const unsigned*)src, (LAS unsigned*)(dst + i * 8192 + F.wave * 1024), 16, 0, 0); }
}
__device__ __forceinline__ void conv_ln_phase(Frame& F) {
    LAS unsigned char* stA = F.lds; LAS unsigned char* stB = F.lds + 32768; LAS bf16_t* tile = (LAS bf16_t*)(F.lds + CV_TILE);
    const bf16_t* A = (const bf16_t*)(F.ws + WS_GLU); bf16_t* O = (bf16_t*)(F.ws + WS_BUF0);
    const int ch = 2 * F.tid;
    f32x2 w[31];
#pragma unroll
    for (int k = 0; k < 31; ++k) w[k] = *(const f32x2*)(F.in[I_CVDWW] + k * 1024 + ch);
    const f32x2 bias = *(const f32x2*)(F.in[I_CVDWB] + ch);
    for (int blk = F.bid; blk < 256; blk += F.G) {
        const int b = blk >> 5, t0 = (blk & 31) * 128;
        const bf16_t* Ab = A + (size_t)b * SEQ * DM;
        f32x2 acc[32];
#pragma unroll
        for (int i = 0; i < 32; ++i) acc[i] = (f32x2){0.f, 0.f};
        __syncthreads();
        conv_half_issue(F, Ab, t0, 0, stA); conv_half_issue(F, Ab, t0, 16, stB);
#pragma unroll 1
        for (int s0 = 0; s0 < 160; s0 += 32) {
#define CV_STEP(SS) { conv_step<SS>(acc, w, bias, *(const LAS unsigned*)((SS < 16 ? stA : stB) + (SS & 15) * 2048 + 2 * ch)); const int o = s0 + SS - 30; \
                if (o >= 0 && o < 128) { const f32x2 r_ = acc[(SS + 2) & 31]; *(LAS unsigned*)(tile + ((SS + 2) & 31) * 1024 + ch) = cvt_pk_bf16(r_.x, r_.y); } \
                if (SS == 29 && o >= 0 && o < 128) { __syncthreads(); conv_ln_rows(F, tile, O + ((size_t)b * SEQ + t0 + (o - 31)) * (CONF_FP8 ? DM / 2 : DM)); __syncthreads(); } }
            VM_WAIT(); __syncthreads();
            CV_STEP(0) CV_STEP(1) CV_STEP(2) CV_STEP(3) CV_STEP(4) CV_STEP(5) CV_STEP(6) CV_STEP(7) CV_STEP(8) CV_STEP(9) CV_STEP(10) CV_STEP(11) CV_STEP(12) CV_STEP(13) CV_STEP(14) CV_STEP(15)
            __syncthreads();
            if (s0 + 32 < 160) conv_half_issue(F, Ab, t0, s0 + 32, stA);
            CV_STEP(16) CV_STEP(17) CV_STEP(18) CV_STEP(19) CV_STEP(20) CV_STEP(21) CV_STEP(22) CV_STEP(23) CV_STEP(24) CV_STEP(25) CV_STEP(26) CV_STEP(27) CV_STEP(28) CV_STEP(29) CV_STEP(30) CV_STEP(31)
            __syncthreads();
            if (s0 + 32 < 160) conv_half_issue(F, Ab, t0, s0 + 48, stB);
#undef CV_STEP
        }
    }
}
namespace att {
constexpr int KT = 64, NTILE = LKV / KT, ST_BYTES = 24576;
typedef short v4i16_t __attribute__((ext_vector_type(4)));

__device__ __forceinline__ f32x16 mfma32(bf16x8 a, bf16x8 b, f32x16 c) { return __builtin_amdgcn_mfma_f32_32x32x16_bf16(a, b, c, 0, 0, 0); }

__device__ __forceinline__ void attn_phase(Frame& F) {
    LAS unsigned char* lds = F.lds;
    const int l = F.lane, w = F.wave, tid = F.tid, r32 = l & 31, hi = l >> 5;
    const bf16_t* Qb = (const bf16_t*)(F.ws + WS_Q); const bf16_t* Kb = (const bf16_t*)(F.ws + WS_K); const bf16_t* Vb = (const bf16_t*)(F.ws + WS_V);
    bf16_t* Ob = (bf16_t*)(F.ws + WS_BUF0);
    const float lam = ((const float*)(F.ws + WS_TAB))[TB_LAM];
    const unsigned kbase_ = (unsigned)(r32 * 128), kx_ = (unsigned)((r32 >> 1) & 7);
    unsigned vbase_, vq4_;
    { const int g = l >> 4, i = l & 15, q4 = i >> 2, p4 = i & 3; const int row = 4 * (g >> 1) + q4;
      const int lowch = (2 * (g & 1) + (p4 >> 1)) ^ ((row >> 2) & 3);
      vbase_ = (unsigned)(8192 + row * 256 + (lowch << 4) + 8 * (p4 & 1)); vq4_ = (unsigned)q4; }
#define ATT_ISSUE(st, kv0) do { const size_t _ro = (size_t)(kv0) * 1024; int t_ = tid; asm volatile("" : "+v"(t_)); \
        const int krow = t_ >> 3; const unsigned ksrc = (unsigned)(krow * 1024 + (((t_ & 7) ^ ((krow >> 1) & 7)) << 4)); unsigned vsrc[2]; \
        _Pragma("unroll") for (int i_ = 0; i_ < 2; ++i_) { const int p = t_ + 512 * i_, vrow = p >> 4; vsrc[i_] = (unsigned)(vrow * 1024 + (((p & 15) ^ (((vrow & 3) << 2) | ((vrow >> 2) & 3))) << 4)); } \
        __builtin_amdgcn_global_load_lds((const unsigned*)(Kg + _ro + ksrc), (LAS unsigned*)(lds + (st) * ST_BYTES + w * 1024), 16, 0, 0); \
        __builtin_amdgcn_global_load_lds((const unsigned*)(Vg + _ro + vsrc[0]), (LAS unsigned*)(lds + (st) * ST_BYTES + 8192 + w * 1024), 16, 0, 0); \
        __builtin_amdgcn_global_load_lds((const unsigned*)(Vg + _ro + vsrc[1]), (LAS unsigned*)(lds + (st) * ST_BYTES + 16384 + w * 1024), 16, 0, 0); } while (0)

    for (int it = 0;; ++it) {
        int grp, qb;
        if (F.G == 256) { const int x = F.bid & 7, j = F.bid >> 3; if (it >= 2) break; grp = x * 4 + it * 2 + (j >> 4); qb = j & 15; }
        else { const int un = it * F.G + F.bid; if (un >= 512) break; grp = un >> 4; qb = un & 15; }
        const int b = grp >> 2, hp = grp & 3;
        const bf16_t* Qg = Qb + ((size_t)b * SEQ + qb * 256 + w * 32 + r32) * 512;
        const char* Vg = (const char*)(Vb + (size_t)b * LKV * 512 + hp * 128);
        f32x16 o1[4];
#pragma unroll 1
        for (int s = 0; s < 2; ++s) {
            const char* Kg = (const char*)(Kb + (size_t)b * LKV * 512 + (2 * hp + s) * 64);
            bf16x8 qf[4];
#pragma unroll
            for (int ds = 0; ds < 4; ++ds) qf[ds] = *(const bf16x8*)(Qg + (2 * hp + s) * 64 + ds * 16 + hi * 8);
            f32x16 O[4];
#pragma unroll
            for (int d = 0; d < 4; ++d)
#pragma unroll
                for (int r = 0; r < 16; ++r) O[d][r] = 0.f;
            float m = -1e30f, lsum = 0.f;
            __syncthreads();
            ATT_ISSUE(0, 0);
#pragma unroll 1
            for (int j = 0; j < NTILE; ++j) {
                VM_WAIT(); __syncthreads();
                if (j + 1 < NTILE) ATT_ISSUE((j + 1) & 1, (j + 1) * KT);
                const LAS unsigned char* Ks = lds + (j & 1) * ST_BYTES;
                unsigned kbase = kbase_, kx = kx_, vbase = vbase_, vq4 = vq4_; asm volatile("" : "+v"(kbase), "+v"(kx), "+v"(vbase), "+v"(vq4));
                f32x16 p0, p1;
#pragma unroll
                for (int r = 0; r < 16; ++r) { p0[r] = 0.f; p1[r] = 0.f; }
#pragma unroll
                for (int ds = 0; ds < 4; ++ds) { const unsigned ka = kbase + ((((unsigned)(2 * ds + hi)) ^ kx) << 4); const bf16x8 k0 = *(const LAS bf16x8*)(Ks + ka), k1 = *(const LAS bf16x8*)(Ks + ka + 4096);
                    p0 = mfma32(k0, qf[ds], p0); p1 = mfma32(k1, qf[ds], p1); }
                float mx = fmaxf(p0[0], p1[0]);
#pragma unroll
                for (int r = 1; r < 16; ++r) mx = fmaxf(mx, fmaxf(p0[r], p1[r]));
                mx = fmaxf(mx, __shfl_xor(mx, 32));
                if (!__all(mx - m <= 8.0f)) { const float mn = fmaxf(m, mx), alpha = __builtin_amdgcn_exp2f(m - mn);
#pragma unroll
                    for (int d = 0; d < 4; ++d) O[d] = O[d] * alpha;
                    lsum *= alpha; m = mn; }
                float rs = 0.f;
#pragma unroll
                for (int r = 0; r < 16; ++r) { p0[r] = __builtin_amdgcn_exp2f(p0[r] - m); p1[r] = __builtin_amdgcn_exp2f(p1[r] - m); rs += p0[r] + p1[r]; }
                lsum += rs;
                bf16x8 pb[4];
#pragma unroll
                for (int q = 0; q < 2; ++q) { u32x4 a, c;
                    a.x = cvt_pk_bf16(p0[8 * q + 0], p0[8 * q + 1]); a.y = cvt_pk_bf16(p0[8 * q + 2], p0[8 * q + 3]); a.z = cvt_pk_bf16(p0[8 * q + 4], p0[8 * q + 5]); a.w = cvt_pk_bf16(p0[8 * q + 6], p0[8 * q + 7]);
                    c.x = cvt_pk_bf16(p1[8 * q + 0], p1[8 * q + 1]); c.y = cvt_pk_bf16(p1[8 * q + 2], p1[8 * q + 3]); c.z = cvt_pk_bf16(p1[8 * q + 4], p1[8 * q + 5]); c.w = cvt_pk_bf16(p1[8 * q + 6], p1[8 * q + 7]);
                    pb[q] = __builtin_bit_cast(bf16x8, a); pb[2 + q] = __builtin_bit_cast(bf16x8, c); }
#pragma unroll
                for (int d = 0; d < 4; ++d) {
                    const unsigned va0 = vbase + ((((unsigned)d) ^ vq4) << 6), va1 = (va0 ^ 32u) + 2048u;
#pragma unroll
                    for (int kv = 0; kv < 4; ++kv) {
                        const v4i16_t lo = __builtin_amdgcn_ds_read_tr16_b64_v4i16((LAS v4i16_t*)(Ks + va0 + kv * 4096));
                        const v4i16_t hh = __builtin_amdgcn_ds_read_tr16_b64_v4i16((LAS v4i16_t*)(Ks + va1 + kv * 4096));
                        const bf16x8 vf = (bf16x8){lo[0], lo[1], lo[2], lo[3], hh[0], hh[1], hh[2], hh[3]};
                        O[d] = mfma32(vf, pb[kv], O[d]); } }
            }
            const float lt = lsum + __shfl_xor(lsum, 32);
            if (s == 0) { const float inv = 1.0f / lt;
#pragma unroll
                for (int d = 0; d < 4; ++d) o1[d] = O[d] * inv; }
            else { const float inv = lam / lt; float ss = 0.f;
#pragma unroll
                for (int d = 0; d < 4; ++d) { o1[d] = o1[d] - O[d] * inv;
#pragma unroll
                    for (int r = 0; r < 16; ++r) ss += o1[d][r] * o1[d][r]; }
                ss += __shfl_xor(ss, 32);
                const float rn = 0.8f / sqrtf(ss * (1.0f / 128.0f) + EPS);
                bf16_t* orow = Ob + ((size_t)b * SEQ + qb * 256 + w * 32 + r32) * DM + hp * 128 + 4 * hi;
#pragma unroll
                for (int d = 0; d < 4; ++d)
#pragma unroll
                    for (int q = 0; q < 4; ++q) { const f32x4 g4 = *(const f32x4*)(F.in[I_SUBLN] + 32 * d + 8 * q + 4 * hi);
                        u32x2 pk; pk.x = cvt_pk_bf16(o1[d][4 * q] * rn * g4[0], o1[d][4 * q + 1] * rn * g4[1]); pk.y = cvt_pk_bf16(o1[d][4 * q + 2] * rn * g4[2], o1[d][4 * q + 3] * rn * g4[3]);
                        *(u32x2*)(orow + 32 * d + 8 * q) = pk; }
            }
        }
    }
#undef ATT_ISSUE
}
}
namespace hy {
constexpr int FBUF = 4352 * 8;
constexpr int KOFF = 2 * FBUF;
constexpr int KLEN = 2192;
constexpr int RED_OFF = KOFF + 4 * KLEN * 8;
__device__ __forceinline__ int pad(int i) { return i + (i >> 4); }
__device__ __forceinline__ float sgpr_f(float v) { return __int_as_float(__builtin_amdgcn_readfirstlane(__float_as_int(v))); }
typedef f32x2 cx;
#ifndef HY_ASM
#define HY_ASM 3
#endif
#if HY_ASM & 1
__device__ __forceinline__ void c_mul_ip(cx& x, cx w) { cx t;
    asm("v_pk_mul_f32 %1, %0, %2 op_sel_hi:[0,1]\n\tv_pk_fma_f32 %0, %0, %2, %1 op_sel:[1,1,0] op_sel_hi:[1,0,1] neg_lo:[1,0,0]" : "+v"(x), "=&v"(t) : "v"(w)); }
__device__ __forceinline__ cx c_mul(cx x, cx w) { c_mul_ip(x, w); return x; }
__device__ __forceinline__ void c_mul_sw_ip(cx& x, cx w) { cx t;
    asm("v_pk_mul_f32 %1, %0, %2 op_sel:[0,1] op_sel_hi:[0,0]\n\tv_pk_fma_f32 %0, %0, %2, %1 op_sel:[1,0,0] op_sel_hi:[1,1,1] neg_hi:[1,0,0]" : "+v"(x), "=&v"(t) : "v"(w)); }
__device__ __forceinline__ void c_mul_swc_ip(cx& x, cx w) { cx t;
    asm("v_pk_mul_f32 %1, %0, %2 op_sel:[0,1] op_sel_hi:[0,0]\n\tv_pk_fma_f32 %0, %0, %2, %1 op_sel:[1,0,0] op_sel_hi:[1,1,1] neg_lo:[0,0,1]" : "+v"(x), "=&v"(t) : "v"(w)); }
__device__ __forceinline__ void c_mul_k_ip(cx& x, cx w) { cx t;
    asm("v_pk_mul_f32 %1, %0, %2 op_sel_hi:[0,1]\n\tv_pk_fma_f32 %0, %0, %2, %1 op_sel:[1,1,0] op_sel_hi:[1,0,1] neg_lo:[1,0,0]" : "+v"(x), "=&v"(t) : "s"(w)); }
#else
__device__ __forceinline__ cx c_mul(cx x, cx w) { return (cx){x.x, x.x} * w + (cx){-x.y, x.y} * (cx){w.y, w.x}; }
__device__ __forceinline__ void c_mul_ip(cx& x, cx w) { x = c_mul(x, w); }
__device__ __forceinline__ void c_mul_k_ip(cx& x, cx w) { x = c_mul(x, w); }
__device__ __forceinline__ void c_mul_sw_ip(cx& x, cx w) { x = (cx){x.x, x.x} * (cx){w.y, w.x} + (cx){x.y, -x.y} * w; }
__device__ __forceinline__ void c_mul_swc_ip(cx& x, cx w) { c_mul_sw_ip(x, (cx){w.x, -w.y}); }
#endif
#if HY_ASM & 2
__device__ __forceinline__ cx c_mi(cx a, cx b) { cx d; asm("v_pk_add_f32 %0, %1, %2 op_sel:[0,1] op_sel_hi:[1,0] neg_hi:[0,1]" : "=v"(d) : "v"(a), "v"(b)); return d; }
__device__ __forceinline__ cx c_pi(cx a, cx b) { cx d; asm("v_pk_add_f32 %0, %1, %2 op_sel:[0,1] op_sel_hi:[1,0] neg_lo:[0,1]" : "=v"(d) : "v"(a), "v"(b)); return d; }
#else
__device__ __forceinline__ cx c_mi(cx a, cx b) { return a + (cx){b.y, -b.x}; }
__device__ __forceinline__ cx c_pi(cx a, cx b) { return a + (cx){-b.y, b.x}; }
#endif

__device__ __forceinline__ void dft4(cx& a, cx& b, cx& c, cx& d) {
    const cx s0 = a + c, d0 = a - c, s1 = b + d, d1 = b - d;
    a = s0 + s1; c = s0 - s1; b = c_mi(d0, d1); d = c_pi(d0, d1);
}
__device__ __forceinline__ void dft4_rc(cx& a, cx& b, cx& c, cx& d) {
    const cx s0 = c_mi(a, c), d0 = c_pi(a, c), s1 = b + d, d1 = b - d;
    a = s0 + s1; c = s0 - s1; b = c_mi(d0, d1); d = c_pi(d0, d1);
}
__device__ __forceinline__ void dft16(cx (&x)[16]) {
    constexpr float C1 = 0.9238795325112867f, S1 = 0.3826834323650898f, R = 0.7071067811865476f;
#pragma unroll
    for (int b = 0; b < 4; ++b) dft4(x[b], x[4 + b], x[8 + b], x[12 + b]);
    c_mul_k_ip(x[5], (cx){C1, -S1}); c_mul_k_ip(x[6], (cx){R, -R}); c_mul_k_ip(x[7], (cx){S1, -C1});
    c_mul_k_ip(x[9], (cx){R, -R});   c_mul_k_ip(x[11], (cx){-R, -R});
    c_mul_k_ip(x[13], (cx){S1, -C1}); c_mul_k_ip(x[14], (cx){-R, -R}); c_mul_k_ip(x[15], (cx){-C1, S1});
#pragma unroll
    for (int c = 0; c < 4; ++c) { if (c == 2) dft4_rc(x[8], x[9], x[10], x[11]); else dft4(x[4 * c], x[4 * c + 1], x[4 * c + 2], x[4 * c + 3]); }
    cx y[16];
#pragma unroll
    for (int k = 0; k < 16; ++k) y[k] = x[4 * (k & 3) + (k >> 2)];
#pragma unroll
    for (int k = 0; k < 16; ++k) x[k] = y[k];
}
__device__ __forceinline__ void twiddle_pow(cx (&x)[16], cx w) {
    cx p[16]; p[1] = w;
#pragma unroll
    for (int n = 2; n < 16; ++n) { const int a = n >> 1, b = n - a; p[n] = c_mul(p[a], p[b]); }
#pragma unroll
    for (int n = 1; n < 16; ++n) c_mul_ip(x[n], p[n]);
}
__device__ __forceinline__ void fft4096(cx (&x)[16], LAS f32x2* buf, int uw, int u, const cx w2, const cx w3) {
    dft16(x);
    { LAS f32x2* p = buf + pad(uw);
#pragma unroll
      for (int k = 0; k < 16; ++k) p[272 * k] = x[k]; }
    __syncthreads();
    { LAS f32x2* p = buf + 272 * (u >> 4) + (u & 15);
#pragma unroll
      for (int n = 0; n < 16; ++n) x[n] = p[17 * n];
      twiddle_pow(x, w2);
      dft16(x);
#pragma unroll
      for (int k = 0; k < 16; ++k) p[17 * k] = x[k]; }
    __syncthreads();
    { const LAS f32x2* p = buf + 272 * (u >> 4) + 17 * (u & 15);
#pragma unroll
      for (int n = 0; n < 16; ++n) x[n] = p[n];
      twiddle_pow(x, w3);
      dft16(x); }
}
__device__ __forceinline__ void twiddle_w8192(cx (&x)[16], cx base, bool conj) {
    constexpr float C = 0.9807852804032304f, S = 0.1950903220161283f;
    cx w = conj ? (cx){base.x, -base.y} : base; const cx st = (cx){C, conj ? S : -S};
#pragma unroll
    for (int n = 0; n < 16; ++n) { c_mul_ip(x[n], w); c_mul_ip(w, st); }
}
struct SRow { u32x4 raw; bf16_t l, r; };
__device__ __forceinline__ void sconv_load(const bf16_t* row, int t0, SRow& R) {
    R.raw = *(const u32x4*)(row + t0); R.l = row[t0 > 0 ? t0 - 1 : 0]; R.r = row[t0 + 8 < SEQ ? t0 + 8 : SEQ - 1];
}
__device__ __forceinline__ void sconv_apply(const SRow& R, int t0, const f32x4 wb  , float (&out)[8]) {
    float x[10]; x[0] = t0 > 0 ? bf2f(R.l) : 0.f; x[9] = t0 + 8 < SEQ ? bf2f(R.r) : 0.f;
    x[1] = bflo(R.raw.x); x[2] = bfhi(R.raw.x); x[3] = bflo(R.raw.y); x[4] = bfhi(R.raw.y); x[5] = bflo(R.raw.z); x[6] = bfhi(R.raw.z); x[7] = bflo(R.raw.w); x[8] = bfhi(R.raw.w);
#pragma unroll
    for (int i = 0; i < 8; ++i) out[i] = wb[3] + wb[0] * x[i] + wb[1] * x[i + 1] + wb[2] * x[i + 2];
}

__device__ __forceinline__ void hyena_phase(Frame& F) {
    LAS f32x2* FB0 = (LAS f32x2*)F.lds; LAS f32x2* FB1 = (LAS f32x2*)(F.lds + FBUF);
    LAS f32x2* KH = (LAS f32x2*)(F.lds + KOFF);
    LAS float* red = (LAS float*)(F.lds + RED_OFF);
    const int tid = F.tid, half = tid >> 8, u_ = tid & 255, u1_ = (u_ >> 4) + 16 * (u_ & 15);
    LAS f32x2* myF = half ? FB1 : FB0;
    const float* tab = (const float*)(F.ws + WS_TAB);
    const f32x2* T4096 = (const f32x2*)(tab + TB_T4096); const f32x2* T8A = (const f32x2*)(tab + TB_T8A); const f32x2* T8B = (const f32x2*)(tab + TB_T8B);
#define HY_W8192(dst, idx) f32x2 dst; { const f32x2 a_ = T8A[(idx) & 63], b_ = T8B[(idx) >> 6]; dst = (f32x2){a_.x * b_.x - a_.y * b_.y, a_.x * b_.y + a_.y * b_.x}; }
    const cx tw2 = T4096[16 * (u_ >> 4)], tw3 = T4096[(u_ >> 4) + 16 * (u_ & 15)];
    HY_W8192(twu, u_); HY_W8192(twu1, u1_);
    const float* kraw = (const float*)(F.ws + WS_KRAW);
    const bf16_t* UT = (const bf16_t*)(F.ws + WS_UT); bf16_t* OBT = (bf16_t*)(F.ws + WS_OBT);
    const int j0 = 8 * tid, jp = 8 * tid + (tid >> 1);
    for (int c = F.bid; c < 512; c += F.G) {
        f32x4 wS[3];
#pragma unroll
        for (int s3 = 0; s3 < 3; ++s3) { const float* swp = F.in[I_HYSW] + 512 * s3 + c; wS[s3] = (f32x4){sgpr_f(swp[0]), sgpr_f(swp[1536]), sgpr_f(swp[3072]), sgpr_f(F.in[I_HYSB][512 * s3 + c])}; }
        const float bias0 = sgpr_f(F.in[I_HYBIAS][c]), bias1 = sgpr_f(F.in[I_HYBIAS][512 + c]);
        __syncthreads();
        { float an[2];
#pragma unroll
          for (int o = 0; o < 2; ++o) { const float* fw = kraw + (size_t)(1024 * o + c) * 4096; const float* bw = kraw + (size_t)(1024 * o + 512 + c) * 4096;
              float f[8], g[8];
              { const f32x4 fa = *(const f32x4*)(fw + j0), fb = *(const f32x4*)(fw + j0 + 4);
                const f32x4 ga = *(const f32x4*)(bw + 4088 - j0), gb = *(const f32x4*)(bw + 4092 - j0);
                const float g0 = tid > 0 ? bw[4096 - j0] : 0.f;
                f[0] = fa[0]; f[1] = fa[1]; f[2] = fa[2]; f[3] = fa[3]; f[4] = fb[0]; f[5] = fb[1]; f[6] = fb[2]; f[7] = fb[3];
                g[0] = g0; g[1] = gb[3]; g[2] = gb[2]; g[3] = gb[1]; g[4] = gb[0]; g[5] = ga[3]; g[6] = ga[2]; g[7] = ga[1]; }
              float a = 0.f;
#pragma unroll
              for (int i = 0; i < 8; ++i) { a += fabsf(f[i]) + fabsf(g[i]);
                  ((LAS float*)(FB0 + jp + i))[o] = f[i] + g[i]; ((LAS float*)(FB1 + jp + i))[o] = f[i] - g[i]; }
              an[o] = wave_sum(a);
              asm volatile("" ::: "memory"); }
          if (F.lane == 0) { red[F.wave] = an[0]; red[8 + F.wave] = an[1]; } }
        __syncthreads();
        float nrm0 = 0.f, nrm1 = 0.f;
#pragma unroll
        for (int i = 0; i < 8; ++i) { nrm0 += red[i]; nrm1 += red[8 + i]; }
        const float sc0 = 1.0f / (nrm0 * 8192.0f), sc1 = 1.0f / (nrm1 * 8192.0f);
        cx x[16];
        { int u = u_, u1 = u1_; asm volatile("" : "+v"(u), "+v"(u1));
#pragma unroll
        for (int n = 0; n < 16; ++n) x[n] = (myF + pad(u))[272 * n];
        __syncthreads();
        if (half) twiddle_w8192(x, twu, false);
        fft4096(x, myF, u, u, tw2, tw3);
        __syncthreads();
#pragma unroll
        for (int k = 0; k < 16; ++k) (myF + pad(u1))[272 * k] = x[k]; }
        __syncthreads();
        for (int kk = tid; kk < 2049; kk += 512) {
            { const f32x2 A = FB0[pad(kk)]; f32x2 B = FB0[pad((4096 - kk) & 4095)]; B.y = -B.y;
              KH[0 * KLEN + pad(kk)] = (f32x2){(A.x + B.x) * 0.5f * sc0, (A.y + B.y) * 0.5f * sc0};
              KH[2 * KLEN + pad(kk)] = (f32x2){(A.y - B.y) * 0.5f * sc1, -(A.x - B.x) * 0.5f * sc1}; }
            if (kk < 2048) { const f32x2 A = FB1[pad(kk)]; f32x2 B = FB1[pad(4095 - kk)]; B.y = -B.y;
              KH[1 * KLEN + pad(kk)] = (f32x2){(A.x + B.x) * 0.5f * sc0, (A.y + B.y) * 0.5f * sc0};
              KH[3 * KLEN + pad(kk)] = (f32x2){(A.y - B.y) * 0.5f * sc1, -(A.x - B.x) * 0.5f * sc1}; }
        }
        __syncthreads();
        SRow pv0, pv1, pa0, pa1;
        { const bf16_t* vr = UT + (size_t)c * NTOK; sconv_load(vr, j0, pv0); sconv_load(vr + SEQ, j0, pv1); }
#pragma unroll 1
        for (int bp = 0; bp < 4; ++bp) {
            const size_t rb = (size_t)(2 * bp) * SEQ;
            float zr[8], zi[8], vre[8], vim[8];
            sconv_apply(pv0, j0, wS[0], vre); sconv_apply(pv1, j0, wS[0], vim);
#pragma unroll
            for (int i = 0; i < 8; ++i) (FB0 + jp)[i] = (f32x2){vre[i], vim[i]};
            { const bf16_t* x1r = UT + (size_t)(512 + c) * NTOK + rb; sconv_load(x1r, j0, pa0); sconv_load(x1r + SEQ, j0, pa1); }
            __syncthreads();
#pragma unroll 1
            for (int ord = 0; ord < 2; ++ord) {
                int u = u_, u1 = u1_; asm volatile("" : "+v"(u), "+v"(u1));
#pragma unroll
                for (int n = 0; n < 16; ++n) x[n] = (FB0 + pad(u))[272 * n];
                __syncthreads();
                if (half) twiddle_w8192(x, twu, false);
                fft4096(x, myF, u, u, tw2, tw3);
                { const LAS f32x2* Kp = KH + (2 * ord + half) * KLEN;
                  const LAS f32x2* pf = Kp + pad(u1); const LAS f32x2* pm = Kp + pad((half ? 4095 : 4096) - u1);
#pragma unroll
                  for (int n = 0; n < 8; ++n) c_mul_sw_ip(x[n], pf[272 * n]);
                  { const bool mir = half || u1 > 0; f32x2 kv = *(mir ? pm - 272 * 8 : pf + 272 * 8); if (mir) kv.y = -kv.y; c_mul_sw_ip(x[8], kv); }
#pragma unroll
                  for (int n = 9; n < 16; ++n) c_mul_swc_ip(x[n], *(pm - 272 * n)); }
                __syncthreads();
                fft4096(x, myF, u1, u, tw2, tw3);
                if (half) twiddle_w8192(x, twu1, false);
                __syncthreads();
#pragma unroll
                for (int k = 0; k < 16; ++k) (myF + pad(u1))[272 * k] = x[k];
                __syncthreads();
                if (ord == 0) {
                    { float a0[8];
                      sconv_apply(pa0, j0, wS[1], a0);
#pragma unroll
                      for (int i = 0; i < 8; ++i) { const f32x2 e = (FB0 + jp)[i], o = (FB1 + jp)[i]; zr[i] = a0[i] * (e.y + o.y + bias0 * vre[i]); zi[i] = e.x + o.x + bias0 * vim[i]; } }
                    { float a1[8];
                      sconv_apply(pa1, j0, wS[1], a1);
#pragma unroll
                      for (int i = 0; i < 8; ++i) zi[i] *= a1[i]; }
                    { const bf16_t* x2r = UT + (size_t)(1024 + c) * NTOK + rb; sconv_load(x2r, j0, pa0); sconv_load(x2r + SEQ, j0, pa1);
                      const bf16_t* vn = UT + (size_t)c * NTOK + (size_t)(2 * (bp < 3 ? bp + 1 : 3)) * SEQ; sconv_load(vn, j0, pv0); sconv_load(vn + SEQ, j0, pv1); }
                    __syncthreads();
#pragma unroll
                    for (int i = 0; i < 8; ++i) (FB0 + jp)[i] = (f32x2){zr[i], zi[i]};
                    __syncthreads();
                } else {
                    float a0[8], a1[8], r0[8], r1[8];
                    sconv_apply(pa0, j0, wS[2], a0); sconv_apply(pa1, j0, wS[2], a1);
#pragma unroll
                    for (int i = 0; i < 8; ++i) { const f32x2 e = (FB0 + jp)[i], o = (FB1 + jp)[i];
                        r0[i] = a0[i] * (e.y + o.y + bias1 * zr[i]); r1[i] = a1[i] * (e.x + o.x + bias1 * zi[i]); }
                    u32x4 p0, p1;
                    p0.x = cvt_pk_bf16(r0[0], r0[1]); p0.y = cvt_pk_bf16(r0[2], r0[3]); p0.z = cvt_pk_bf16(r0[4], r0[5]); p0.w = cvt_pk_bf16(r0[6], r0[7]);
                    p1.x = cvt_pk_bf16(r1[0], r1[1]); p1.y = cvt_pk_bf16(r1[2], r1[3]); p1.z = cvt_pk_bf16(r1[4], r1[5]); p1.w = cvt_pk_bf16(r1[6], r1[7]);
                    *(u32x4*)(OBT + (size_t)c * NTOK + rb + j0) = p0; *(u32x4*)(OBT + (size_t)c * NTOK + rb + SEQ + j0) = p1;
                    __syncthreads();
                }
            }
        }
    }
}
#undef HY_W8192
}
template <bool GATH> struct MoeOrder {
    static constexpr bool GATHER = GATH;
    const LAS int* pref;
    int total, G, c, ncol, K;
    const char* A; const char* W; size_t wtile; const int* list;
    __device__ bool next(int i, pg8::Unit& u) const {
        const long L = (long)i * G + c; if (L >= total) return false;
        int id = (int)L; { const int q = total / 8, r = total % 8, xcd = id % 8, off = id / 8; id = (xcd < r ? xcd * (q + 1) : r * (q + 1) + (xcd - r) * q) + off; }
        const int rt = id / ncol, pn = id % ncol;
        int e = 0; while (e < 31 && pref[e + 1] <= rt) ++e;
        u.pm = rt; u.pn = pn; u.aux = e;
        u.a = GATH ? A : A + (size_t)rt * 256 * K * 2; u.b = W + (size_t)e * 3 * MiB + (size_t)pn * wtile;
        return true;
    }
    __device__ __forceinline__ void gather(const pg8::Unit& u, int R0, int R1, unsigned (&v)[2][2]) const {
        const int e = u.aux, j = u.pm - pref[e], cnt = pref[40 + e];
#pragma unroll
        for (int h = 0; h < 2; ++h)
#pragma unroll
            for (int i = 0; i < 2; ++i) { int r = j * 256 + h * 128 + (i ? R1 : R0); r = r < cnt ? r : 0; v[h][i] = (unsigned)(list[e * 32768 + r] >> 1) * (unsigned)(K * 2); }
    }
};

#ifndef MK_PER_PHASE
#define MK_PER_PHASE 0
#endif
constexpr int N_PHASES = 17;

__global__ void __launch_bounds__(NTHREADS, 2) fwd_kernel(Args args) {
    extern __shared__ __attribute__((aligned(16))) unsigned char lds_[];
    const int wave0_ = __builtin_amdgcn_readfirstlane((int)threadIdx.x >> 6);
#define MKFRAME(F) Frame F; { int t_ = wave0_ * 64 + (int)__builtin_amdgcn_mbcnt_hi(~0u, __builtin_amdgcn_mbcnt_lo(~0u, 0u)); asm volatile("" : "+v"(t_)); F.lds = (LAS unsigned char*)lds_; F.tid = t_; F.lane = t_ & 63; F.wave = __builtin_amdgcn_readfirstlane(t_ >> 6); \
        F.G = gridDim.x; F.bid = blockIdx.x; F.in = args.in; F.out = args.out; F.ws = args.ws; }
    volatile LAS unsigned* MISC = (volatile LAS unsigned*)((LAS unsigned char*)lds_ + MISC_OFF);
    if (threadIdx.x < 128) MISC[threadIdx.x] = 0u;
    __syncthreads();
    unsigned* ctl = (unsigned*)(args.ws + WS_CTL);
#define lo (args.ph_lo)
#define hi (args.ph_hi)
    if (hi - lo > 1) (void)xcd_barrier_post(ctl + CW_BAR, MISC, threadIdx.x == 0);
#ifndef PH_MASK
#define PH_MASK 0xFFFFFFFFu
#endif
#define IN(k) (lo <= (k) && (k) < hi)
#ifndef DUP_PHASE
#define DUP_PHASE -1
#endif
#define REP(k) _Pragma("unroll") for (int rep_ = 0; rep_ < ((DUP_PHASE) == (k) ? 2 : 1); ++rep_)
#ifdef TPROBE
    const unsigned long long t_start_ = __builtin_amdgcn_s_memrealtime(); unsigned long long t_mark_ = 0ull;
#define TMARK(k) do { if ((k) == (TPROBE)) t_mark_ = __builtin_amdgcn_s_memrealtime() - t_start_; } while (0)
#else
#define TMARK(k) do { } while (0)
#endif
#define SEAM(k) do { if (IN(k) && IN((k) + 1)) { XcdBarrier bar_; bar_.bar = (unsigned*)(args.ws + WS_CTL) + CW_BAR; bar_.x = xb_xcc_id(); bar_.st = (volatile LAS unsigned*)((LAS unsigned char*)lds_ + MISC_OFF); \
        xcd_barrier(bar_, wave0_ == 0 && __builtin_amdgcn_mbcnt_hi(~0u, __builtin_amdgcn_mbcnt_lo(~0u, 0u)) == 0u); } TMARK(k); } while (0)
#define WSP (args.ws)
#define mod0 ((const float*)(args.ws + WS_MOD))
#define mod1 (mod0 + 9 * 6144)
#define tab ((const float*)(args.ws + WS_TAB))

    if (IN(0)) { MKFRAME(F); p0_prologue(F, (unsigned*)(args.ws + WS_CTL) + CW_Q0, (volatile LAS unsigned*)((LAS unsigned char*)lds_ + MISC_OFF) + 4); }
    SEAM(0);
    if (IN(1)) REP(1) { MKFRAME(F); p1_norm_in(F); }
    SEAM(1);
    if (IN(2)) REP(2) { MKFRAME(F);
        { pg8::StaticOrder S; S.init(WSP + WS_BUF0, WSP + WS_WQKVH, NTOK, 1536, 1024, F.G, F.bid);
          pg8::EpiQKV E{(bf16_t*)(WSP + WS_Q), (bf16_t*)(WSP + WS_K), (bf16_t*)(WSP + WS_V), tab + TB_ROPE_C, tab + TB_ROPE_S};
          pg8::gemm_phase(F.lds, F.tid, 1024, S, E); }
        { pg8::StaticOrder S; S.init(WSP + WS_WQKVH + (size_t)1536 * 1024 * 2, WSP + WS_BUF0, 1536, NTOK, 1024, F.G, F.bid);
          pg8::EpiBf16 E{(bf16_t*)(WSP + WS_UT), (size_t)NTOK};
          pg8::gemm_phase(F.lds, F.tid, 1024, S, E); }
        { pg8::StaticOrder S; S.init(WSP + WS_OBT, WSP + WS_WQKVH + (size_t)512 * 1024 * 2, NB * CTXL, 1024, 1024, F.G, F.bid);
          pg8::EpiCtxKV E{(bf16_t*)(WSP + WS_K), (bf16_t*)(WSP + WS_V)};
          pg8::gemm_phase(F.lds, F.tid, 1024, S, E); }
    }
    SEAM(2);
    if (IN(3)) {
#ifndef NO_ATTN
        { MKFRAME(F); att::attn_phase(F); } __syncthreads();
#ifdef DUP_ATTN
        { MKFRAME(F); att::attn_phase(F); } __syncthreads();
#endif
#else
        { MKFRAME(F); bf16_t* o = (bf16_t*)(F.ws + WS_BUF0); for (size_t i = (size_t)F.bid * NTHREADS + F.tid; i < (size_t)NTOK * 64; i += (size_t)F.G * NTHREADS) { const size_t r = i >> 6, c8 = i & 63; *(u32x4*)(o + r * DM + c8 * 8) = (u32x4){0u, 0u, 0u, 0u}; } }
#endif
#ifndef NO_HYENA
        { MKFRAME(F); hy::hyena_phase(F); }
#ifdef DUP_HYENA
        __syncthreads(); { MKFRAME(F); hy::hyena_phase(F); }
#endif
#else
        { MKFRAME(F); bf16_t* o = (bf16_t*)(F.ws + WS_OBT); for (size_t i = (size_t)F.bid * NTHREADS + F.tid; i < (size_t)512 * NTOK / 8; i += (size_t)F.G * NTHREADS) *(u32x4*)(o + i * 8) = (u32x4){0u, 0u, 0u, 0u}; }
#endif
    }
    SEAM(3);
    if (IN(4)) REP(4) { MKFRAME(F); transpose_ob(F); }
    SEAM(4);
    if (IN(5)) REP(5) { MKFRAME(F);
        pg8::StaticOrder S; S.init(WSP + WS_BUF0, WSP + WS_WO, NTOK, 1024, 1024, F.G, F.bid);
        pg8::EpiResid<true> E{F.in[I_X], (bf16_t*)(WSP + WS_X), mod0 + 2 * 1024, nullptr};
        pg8::gemm_phase(F.lds, F.tid, 1024, S, E);
    }
    SEAM(5);
        if (IN(6 + 0)) { MKFRAME(F); moe_front(F, 0); }
        SEAM(6 + 0);
        if (IN(6 + 1)) REP(9) { MKFRAME(F);
            moe_prefix(F, 0, (LAS int*)((LAS unsigned char*)lds_ + MISC_OFF + 64));
            MoeOrder<true> S; LAS int* pref = (LAS int*)((LAS unsigned char*)lds_ + MISC_OFF + 64); S.pref = pref; S.total = pref[32] * 4; S.G = F.G; S.c = F.bid; S.ncol = 4; S.K = 512;
            S.A = (const char*)(WSP + WS_BUF0); S.W = (const char*)(WSP + WS_WMOE + (size_t)0 * 32 * 3 * MiB); S.wtile = (size_t)256 * 512 * 2; S.list = (const int*)(WSP + WS_LIST);
            pg8::EpiGated<2> E{(bf16_t*)(WSP + WS_H), (size_t)512, nullptr, nullptr};
            pg8::gemm_phase<pg8::EpiGated<2>, MoeOrder<true>, true, 127, 122>(F.lds, F.tid, 512, S, E);
        }
        SEAM(6 + 1);
        if (IN(6 + 2)) REP(10) { MKFRAME(F);
            moe_prefix(F, 0, (LAS int*)((LAS unsigned char*)lds_ + MISC_OFF + 64));
            MoeOrder<false> S; LAS int* pref = (LAS int*)((LAS unsigned char*)lds_ + MISC_OFF + 64); S.pref = pref; S.total = pref[32] * 4; S.G = F.G; S.c = F.bid; S.ncol = 4; S.K = 256;
            S.A = (const char*)(WSP + WS_H); S.W = (const char*)(WSP + WS_WMOE + (size_t)0 * 32 * 3 * MiB + 2 * MiB); S.wtile = (size_t)256 * 256 * 2; S.list = nullptr;
            pg8::EpiScatter E{(bf16_t*)(WSP + WS_BUF0), (bf16_t*)(WSP + WS_Y1), (const int*)(WSP + WS_LIST), pref};
            pg8::gemm_phase<pg8::EpiScatter, MoeOrder<false>, true, 127, 122>(F.lds, F.tid, 256, S, E);
        }
        SEAM(6 + 2);
        if (IN(6 + 3)) {
            MKFRAME(F); moe_combine<0>(F, 0);
        }
        SEAM(6 + 3);

            if (IN(10)) REP(12) { MKFRAME(F);
                pg8::StaticOrder S; S.init(WSP + WS_BUF0, WSP + WS_WC1, NTOK, 2048, CONF_FP8 ? 512 : 1024, F.G, F.bid);
                pg8::EpiGated<1> E{(bf16_t*)(WSP + WS_GLU), (size_t)1024, F.in[I_CVB1], F.in[I_CVB1] + 1024};
                pg8::gemm_phase<pg8::EpiGated<1>, pg8::StaticOrder, CONF_FP8 != 0, 127, CONF_FP8 ? 122 : 127>(F.lds, F.tid, CONF_FP8 ? 512 : 1024, S, E);
            }
            SEAM(10);
            if (IN(11)) REP(13) { MKFRAME(F); conv_ln_phase(F); }
            SEAM(11);
            if (IN(12)) { MKFRAME(F);
                pg8::StaticOrder S; S.init(WSP + WS_BUF0, WSP + WS_WC2, NTOK, 1024, CONF_FP8 ? 512 : 1024, F.G, F.bid);
                pg8::EpiResid<false> E{WSP + WS_X, (bf16_t*)(WSP + WS_X), mod1 + 2 * 1024, F.in[I_CVB2]};
                pg8::gemm_phase<pg8::EpiResid<false>, pg8::StaticOrder, CONF_FP8 != 0, 127, CONF_FP8 ? 122 : 127>(F.lds, F.tid, CONF_FP8 ? 512 : 1024, S, E);
            }
            SEAM(12);
        if (IN(13 + 0)) { MKFRAME(F); moe_front(F, 1); }
        SEAM(13 + 0);
        if (IN(13 + 1)) REP(9) { MKFRAME(F);
            moe_prefix(F, 1, (LAS int*)((LAS unsigned char*)lds_ + MISC_OFF + 64));
            MoeOrder<true> S; LAS int* pref = (LAS int*)((LAS unsigned char*)lds_ + MISC_OFF + 64); S.pref = pref; S.total = pref[32] * 4; S.G = F.G; S.c = F.bid; S.ncol = 4; S.K = 512;
            S.A = (const char*)(WSP + WS_BUF0); S.W = (const char*)(WSP + WS_WMOE + (size_t)1 * 32 * 3 * MiB); S.wtile = (size_t)256 * 512 * 2; S.list = (const int*)(WSP + WS_LIST);
            pg8::EpiGated<2> E{(bf16_t*)(WSP + WS_H), (size_t)512, nullptr, nullptr};
            pg8::gemm_phase<pg8::EpiGated<2>, MoeOrder<true>, true, 127, 122>(F.lds, F.tid, 512, S, E);
        }
        SEAM(13 + 1);
        if (IN(13 + 2)) REP(10) { MKFRAME(F);
            moe_prefix(F, 1, (LAS int*)((LAS unsigned char*)lds_ + MISC_OFF + 64));
            MoeOrder<false> S; LAS int* pref = (LAS int*)((LAS unsigned char*)lds_ + MISC_OFF + 64); S.pref = pref; S.total = pref[32] * 4; S.G = F.G; S.c = F.bid; S.ncol = 4; S.K = 256;
            S.A = (const char*)(WSP + WS_H); S.W = (const char*)(WSP + WS_WMOE + (size_t)1 * 32 * 3 * MiB + 2 * MiB); S.wtile = (size_t)256 * 256 * 2; S.list = nullptr;
            pg8::EpiScatter E{(bf16_t*)(WSP + WS_BUF0), (bf16_t*)(WSP + WS_Y1), (const int*)(WSP + WS_LIST), pref};
            pg8::gemm_phase<pg8::EpiScatter, MoeOrder<false>, true, 127, 122>(F.lds, F.tid, 256, S, E);
        }
        SEAM(13 + 2);
        if (IN(13 + 3)) {
            MKFRAME(F); moe_combine<1>(F, 1);
        }

#ifdef TPROBE
    if (blockIdx.x == 0 && threadIdx.x == 0) { const unsigned long long t1 = __builtin_amdgcn_s_memrealtime(); while (__builtin_amdgcn_s_memrealtime() - t1 < 4ull * t_mark_) __builtin_amdgcn_s_sleep(8); }
#endif
#undef IN
#undef SEAM
#undef lo
#undef hi
#undef WSP
#undef mod0
#undef mod1
#undef tab
#undef MKFRAME
}

extern "C" void kernel_launch(void* const* d_in, const int* in_sizes, int n_in, void* d_out, int out_size, void* d_ws, size_t ws_size, hipStream_t stream) {
    static int grid = 0;
    if (grid == 0) {
        if (n_in != N_IN || out_size != NTOK * DM || ws_size < WS_END) { grid = -1; return; }
        int dev = 0, cus = 0, per_cu = 0;
        if (hipGetDevice(&dev) != hipSuccess || hipDeviceGetAttribute(&cus, hipDeviceAttributeMultiprocessorCount, dev) != hipSuccess) { grid = -1; return; }
        if (hipFuncSetAttribute((const void*)fwd_kernel, hipFuncAttributeMaxDynamicSharedMemorySize, LDS_BYTES) != hipSuccess) { grid = -1; return; }
        (void)hipOccupancyMaxActiveBlocksPerMultiprocessor(&per_cu, (const void*)fwd_kernel, NTHREADS, LDS_BYTES);
        (void)hipGetLastError();
        grid = cus;
    }
    if (grid < 0) return;
    (void)hipMemsetAsync((char*)d_ws + WS_CTL, 0, CTL_ZERO_BYTES, stream);
    Args a{};
    for (int i = 0; i < N_IN; ++i) a.in[i] = (const float*)d_in[i];
    a.out = (float*)d_out; a.ws = (unsigned char*)d_ws;
#if MK_PER_PHASE
    for (int p = 0; p < N_PHASES; ++p) { a.ph_lo = p; a.ph_hi = p + 1; hipLaunchKernelGGL(fwd_kernel, dim3(grid), dim3(NTHREADS), LDS_BYTES, stream, a); }
#else
    a.ph_lo = 0; a.ph_hi = N_PHASES;
    hipLaunchKernelGGL(fwd_kernel, dim3(grid), dim3(NTHREADS), LDS_BYTES, stream, a);
#endif
}
```

```cpp
#define CONF_FP8 0
#include <hip/hip_runtime.h>
#include <stdint.h>
#include <math.h>

#define LAS __attribute__((address_space(3)))
#define GAS __attribute__((address_space(1)))
typedef unsigned short bf16_t;
typedef short bf16x8 __attribute__((ext_vector_type(8)));
typedef short s16x4 __attribute__((ext_vector_type(4)));
typedef float f32x2 __attribute__((ext_vector_type(2)));
typedef float f32x4 __attribute__((ext_vector_type(4)));
typedef float f32x16 __attribute__((ext_vector_type(16)));
typedef unsigned u32x2 __attribute__((ext_vector_type(2)));
typedef unsigned u32x4 __attribute__((ext_vector_type(4)));

constexpr int DM = 1024, NB = 8, SEQ = 4096, NTOK = NB * SEQ, CTXL = 256, LKV = CTXL + SEQ;
constexpr int NEXP = 32, DEXP = 512, SLOT_ROWS = 73728;
constexpr float EPS = 1e-6f;
constexpr float QSCALE = 0.125f * 1.4426950408889634f;

constexpr size_t MiB = 1u << 20;
constexpr size_t WS_CTL = 0, CTL_ZERO_BYTES = 1 * MiB;
constexpr size_t WS_MOD = 1 * MiB;
constexpr size_t WS_TAB = 2 * MiB;
constexpr size_t WS_TOK = 3 * MiB;
constexpr size_t WS_LIST = 4 * MiB;
constexpr size_t WS_LOGIT = 8 * MiB;
constexpr size_t WS_KRAW = 16 * MiB;
constexpr size_t WS_WR = 48 * MiB;
constexpr size_t WS_WQKVH = 50 * MiB;
constexpr size_t WS_WO = 56 * MiB;
constexpr size_t WS_WC1 = 58 * MiB;
constexpr size_t WS_WC2 = 62 * MiB;
constexpr size_t WS_WMOE = 64 * MiB;
constexpr size_t WS_BUF0 = 256 * MiB;
constexpr size_t WS_Q = 320 * MiB;
constexpr size_t WS_K = 352 * MiB;
constexpr size_t WS_V = 386 * MiB;
constexpr size_t WS_UT = 420 * MiB;
constexpr size_t WS_OBT = 516 * MiB;
constexpr size_t WS_X = 320 * MiB;
constexpr size_t WS_H = 448 * MiB;
constexpr size_t WS_Y1 = 520 * MiB;
constexpr size_t WS_GLU = 448 * MiB;
constexpr size_t WS_END = 585 * MiB;

constexpr int CW_TMO = 0;
constexpr int CW_BAR = 4096;
constexpr int CW_Q0 = 2048;
constexpr int CW_CNT = 8192;
constexpr int TB_ROPE_C = 0, TB_ROPE_S = 1024, TB_T4096 = 2048  , TB_T8A = 2560  , TB_T8B = 2688  , TB_LAM = 2816;

constexpr int RING_BYTES = 131072;
constexpr int MISC_OFF = 144384;
constexpr int LDS_BYTES = 147456;
constexpr int NWAVES = 8, NTHREADS = 512;

#define RLX_AGENT __ATOMIC_RELAXED, __HIP_MEMORY_SCOPE_AGENT
#define LDS_WAIT() asm volatile("s_waitcnt lgkmcnt(0)" ::: "memory")
#define VM_WAIT() asm volatile("s_waitcnt vmcnt(0)" ::: "memory")

__device__ __forceinline__ unsigned cvt_pk_bf16(float lo, float hi) { unsigned r; asm volatile("v_cvt_pk_bf16_f32 %0, %1, %2" : "=v"(r) : "v"(lo), "v"(hi)); return r; }
__device__ __forceinline__ float bf2f(bf16_t v) { return __uint_as_float((unsigned)v << 16); }
__device__ __forceinline__ float bflo(unsigned v) { return __uint_as_float(v << 16); }
__device__ __forceinline__ float bfhi(unsigned v) { return __uint_as_float(v & 0xffff0000u); }
__device__ __forceinline__ float wave_sum(float v) {
#pragma unroll
    for (int o = 1; o < 64; o <<= 1) v += __shfl_xor(v, o);
    return v;
}
__device__ __forceinline__ float sigmoid_f(float v) { return __builtin_amdgcn_rcpf(1.0f + __builtin_amdgcn_exp2f(-1.4426950408889634f * v)); }
__device__ __forceinline__ float silu_f(float v) { return v * sigmoid_f(v); }

#define XB_TMO      128
#define XB_XCNT(j)  (256  + 64 * (j))
#define XB_XSUB(j)  (1280 + 64 * (j))
#define XB_XGEN(j)  (2304 + 64 * (j))
#define XB_TOP      3328
#define XB_TOPGEN   3392
#define XCD_BAR_WORDS 3456
#define XB_SPIN_CAP (1u << 20)

__device__ __forceinline__ unsigned xb_ld(unsigned* p)              { return __hip_atomic_load(p, __ATOMIC_RELAXED, __HIP_MEMORY_SCOPE_AGENT); }
__device__ __forceinline__ unsigned xb_add(unsigned* p, unsigned v) { return __hip_atomic_fetch_add(p, v, __ATOMIC_RELAXED, __HIP_MEMORY_SCOPE_AGENT); }
__device__ __forceinline__ unsigned xb_xcc_id() { return (unsigned)__builtin_amdgcn_s_getreg((3 << 11) | 20) & 0xFu; }
#define XB_SPIN(cond, bar) do { unsigned _sp = 0; while (cond) { __builtin_amdgcn_s_sleep(1); \
    if ((++_sp & 255u) == 0u) { if (xb_ld(&(bar)[XB_TMO])) break; if (_sp > XB_SPIN_CAP) { atomicAdd(&(bar)[XB_TMO], 1u); break; } } } } while (0)

struct XcdBarrier { unsigned* bar; unsigned x; volatile LAS unsigned* st; };

__device__ __forceinline__ XcdBarrier xcd_barrier_post(unsigned* bar, volatile LAS unsigned* st, bool leader  ) {
    XcdBarrier b; b.bar = bar; b.x = xb_xcc_id(); b.st = st;
    if (leader) (void)xb_add(&bar[XB_XCNT(b.x)], 1u);
    return b;
}
__device__ __forceinline__ void xcd_barrier_complete(unsigned* bar, unsigned x, unsigned& nloc, unsigned& nx) {
    const unsigned G = gridDim.x * gridDim.y * gridDim.z;
    unsigned sum, cnt, mine, sp = 0u;
    for (;;) {
        sum = 0u; cnt = 0u; mine = 0u;
#pragma unroll
        for (unsigned j = 0; j < 16; ++j) { const unsigned c = xb_ld(&bar[XB_XCNT(j)]); sum += c; cnt += (c > 0u) ? 1u : 0u; mine = (j == x) ? c : mine; }
        if (sum == G) break;
        __builtin_amdgcn_s_sleep(1);
        if ((++sp & 255u) == 0u) { if (xb_ld(&bar[XB_TMO])) break; if (sp > XB_SPIN_CAP) { atomicAdd(&bar[XB_TMO], 1u); break; } }
    }
    nloc = mine > 0u ? mine : 1u; nx = cnt > 0u ? cnt : 1u;
}
__device__ __forceinline__ void xcd_barrier(const XcdBarrier& b, bool leader  ) {
    asm volatile("s_waitcnt vmcnt(0)" ::: "memory");
    __syncthreads();
    if (leader) {
        unsigned* bar = b.bar;
        __builtin_amdgcn_s_waitcnt(0);
        unsigned nloc = b.st[0], nx = b.st[1];
        if (nloc == 0u) { xcd_barrier_complete(bar, b.x, nloc, nx); b.st[0] = nloc; b.st[1] = nx; }
        const unsigned old = xb_add(&bar[XB_XSUB(b.x)], 1u);
        const unsigned gen = old / nloc;
        if (old + 1u == (gen + 1u) * nloc) {
            __builtin_amdgcn_fence(__ATOMIC_RELEASE, "agent");
            asm volatile("s_waitcnt vmcnt(0)" ::: "memory");
            const unsigned og = xb_add(&bar[XB_TOP], 1u);
            const unsigned tg = og / nx;
            if (og + 1u == (tg + 1u) * nx) xb_add(&bar[XB_TOPGEN], 1u);
            else XB_SPIN(xb_ld(&bar[XB_TOPGEN]) == tg, bar);
            __builtin_amdgcn_fence(__ATOMIC_ACQUIRE, "agent");
            xb_add(&bar[XB_XGEN(b.x)], 1u);
            asm volatile("s_waitcnt vmcnt(0)" ::: "memory");
        } else {
            XB_SPIN(xb_ld(&bar[XB_XGEN(b.x)]) == gen, bar);
            __builtin_amdgcn_fence(__ATOMIC_ACQUIRE, "agent");
            asm volatile("s_waitcnt vmcnt(0)" ::: "memory");
        }
    }
    __syncthreads();
}
namespace pg8 {
constexpr int BM = 256, BK = 64, HALF = 128, HTB = HALF * BK * 2, STAGE_BYTES = 8 * HTB, NXCD = 8, WGM = 8;

__host__ __device__ __forceinline__ int lds_byte(int r, int c) { const int st = (r >> 4) * 2 + (c >> 5), rr = r & 15, cc = c & 31, ob = rr * 64 + cc * 2; return st * 1024 + (ob ^ (((ob >> 9) & 1) << 5)); }
__host__ __device__ __forceinline__ void stage_rc(int b, int& R, int& C) { const int st = b / 1024, sb = b % 1024, swz = sb ^ (((sb >> 9) & 1) << 5); R = (st >> 1) * 16 + swz / 64; C = (st & 1) * 32 + (swz % 64) / 2; }
__host__ __device__ __forceinline__ int perm32(int rho) { const int n = rho >> 4, i = rho & 15; return 8 * (i >> 2) + 4 * n + (i & 3); }

struct Unit { int pm, pn; const char* a; const char* b; int aux; };

struct StaticOrder {
    static constexpr bool GATHER = false;
    int nM, nN, nwg, G, c; const char* A; const char* Bt; size_t tstep;
    __device__ void init(const void* A_, const void* Bt_, int M, int N, int K, int G_, int c_) { A = (const char*)A_; Bt = (const char*)Bt_; nM = M / BM; nN = N / BM; nwg = nM * nN; G = G_; c = c_; tstep = (size_t)BM * K * 2; }
    __device__ bool next(int i, Unit& u) const {
        const long L = (long)i * G + c; if (L >= nwg) return false;
        int wgid = (int)L; { const int q = nwg / NXCD, r = nwg % NXCD, xcd = wgid % NXCD, off = wgid / NXCD; wgid = (xcd < r ? xcd * (q + 1) : r * (q + 1) + (xcd - r) * q) + off; }
        const int nig = WGM * nN, gid = wgid / nig, fm = gid * WGM, gsz = (nM - fm) < WGM ? (nM - fm) : WGM;
        u.pm = fm + ((wgid % nig) % gsz); u.pn = (wgid % nig) / gsz; u.a = A + (size_t)u.pm * tstep; u.b = Bt + (size_t)u.pn * tstep; u.aux = 0; return true;
    }
    __device__ __forceinline__ void gather(const Unit&, int, int, unsigned (&)[2][2]) const {}
};

template <class Epi, class Sched, bool FP8 = false, int SCA = 127, int SCB = 127>
__device__ __forceinline__ void gemm_phase(LAS unsigned char* lds, int tid, const int K, const Sched& S, const Epi& E) {
    asm volatile("" : "+v"(tid));
    const int wid = __builtin_amdgcn_readfirstlane(tid >> 6), lane = tid & 63, wr = wid >> 2, wc = wid & 3, fr = lane & 15, fq = lane >> 4;
    const int nt = K / BK;
    const size_t kstep = (size_t)(BK * 2);
    const size_t hstep = (size_t)HALF * K * 2;
    int Rr[2], Cc[2];
    unsigned voffB[2];
#pragma unroll
    for (int i = 0; i < 2; ++i) { int R, C; stage_rc(tid * 16 + i * 8192, R, C); Rr[i] = R; Cc[i] = C; const int Rb = Epi::PERM ? ((R & ~31) + perm32(R & 31)) : R; voffB[i] = (unsigned)(Rb * K + C) * 2u; }
    unsigned vAc[2][2], vAn[2][2];
#pragma unroll
    for (int h = 0; h < 2; ++h)
#pragma unroll
        for (int i = 0; i < 2; ++i) { vAc[h][i] = (unsigned)((h * HALF + Rr[i]) * K + Cc[i]) * 2u; vAn[h][i] = vAc[h][i]; }
    const unsigned ldsw = (unsigned)wid * 1024u;
    const int aoff = lds_byte(wr * 64 + fr, fq * 8), boff = lds_byte(wc * 32 + fr, fq * 8);
#define PG8_SA(b, h) (((b) * 2 + (h)) * HTB)
#define PG8_SB(b, h) ((4 + (b) * 2 + (h)) * HTB)
#define PG8_STAGE_B(bufoff, gbase) do { _Pragma("unroll") for (int _i = 0; _i < 2; ++_i) \
        __builtin_amdgcn_global_load_lds((const unsigned*)((const char*)(gbase) + voffB[_i]), (LAS unsigned*)(lds + (bufoff) + ldsw + _i * 8192), 16, 0, 0); } while (0)
#define PG8_STAGE_A(bufoff, gbase, V, h) do { _Pragma("unroll") for (int _i = 0; _i < 2; ++_i) \
        __builtin_amdgcn_global_load_lds((const unsigned*)((const char*)(gbase) + (V)[h][_i]), (LAS unsigned*)(lds + (bufoff) + ldsw + _i * 8192), 16, 0, 0); } while (0)
#define PG8_LDA(dst, b, h) do { _Pragma("unroll") for (int m = 0; m < 4; ++m) { if constexpr (FP8) { const i32x4_ x0_ = *(const LAS i32x4_*)(lds + PG8_SA(b, h) + aoff + m * 2048), x1_ = *(const LAS i32x4_*)(lds + PG8_SA(b, h) + aoff + m * 2048 + 1024); \
            dst##8[m] = __builtin_shufflevector(x0_, x1_, 0, 1, 2, 3, 4, 5, 6, 7); } else { _Pragma("unroll") for (int k = 0; k < 2; ++k) dst[m][k] = *(const LAS bf16x8*)(lds + PG8_SA(b, h) + aoff + m * 2048 + k * 1024); } } } while (0)
#define PG8_LDB(dst, b, h) do { _Pragma("unroll") for (int n = 0; n < 2; ++n) { if constexpr (FP8) { const i32x4_ x0_ = *(const LAS i32x4_*)(lds + PG8_SB(b, h) + boff + n * 2048), x1_ = *(const LAS i32x4_*)(lds + PG8_SB(b, h) + boff + n * 2048 + 1024); \
            dst##8[n] = __builtin_shufflevector(x0_, x1_, 0, 1, 2, 3, 4, 5, 6, 7); } else { _Pragma("unroll") for (int k = 0; k < 2; ++k) dst[n][k] = *(const LAS bf16x8*)(lds + PG8_SB(b, h) + boff + n * 2048 + k * 1024); } } } while (0)
#define PG8_MMA(ai, bj, At, Bt) do { __builtin_amdgcn_s_setprio(1); _Pragma("unroll") for (int m = 0; m < 4; ++m) _Pragma("unroll") for (int n = 0; n < 2; ++n) { \
        if constexpr (FP8) asm volatile("v_mfma_scale_f32_16x16x128_f8f6f4 %0, %1, %2, %0, %3, %4 op_sel_hi:[0,0,0]" : "+v"(acc[ai][bj][m][n]) : "v"(Bt##8[n]), "v"(At##8[m]), "v"(sca_), "v"(scb_)); \
        else { _Pragma("unroll") for (int k = 0; k < 2; ++k) acc[ai][bj][m][n] = __builtin_amdgcn_mfma_f32_16x16x32_bf16(Bt[n][k], At[m][k], acc[ai][bj][m][n], 0, 0, 0); } } \
        __builtin_amdgcn_s_setprio(0); } while (0)
#define PG8_WAIT_V(n) asm volatile("s_waitcnt vmcnt(" #n ")" ::: "memory")
#define PG8_WAIT_L(n) asm volatile("s_waitcnt lgkmcnt(" #n ")" ::: "memory")
#define PG8_BAR __builtin_amdgcn_s_barrier()
#define PG8_SCHED __builtin_amdgcn_sched_barrier(0)
    Unit cur, nxt; int ui = 0;
    if (!S.next(0, cur)) return;
    if constexpr (Sched::GATHER) { S.gather(cur, Rr[0], Rr[1], vAc);
#pragma unroll
        for (int h = 0; h < 2; ++h)
#pragma unroll
            for (int i = 0; i < 2; ++i) vAc[h][i] += (unsigned)Cc[i] * 2u; }
    f32x4 acc[2][2][4][2];
#pragma unroll
    for (int a = 0; a < 2; ++a)
#pragma unroll
        for (int b = 0; b < 2; ++b)
#pragma unroll
            for (int m = 0; m < 4; ++m)
#pragma unroll
                for (int n = 0; n < 2; ++n) acc[a][b][m][n] = (f32x4){0.f, 0.f, 0.f, 0.f};
    typedef int i32x4_ __attribute__((ext_vector_type(4))); typedef int i32x8_ __attribute__((ext_vector_type(8)));
    bf16x8 At[4][2], B0[2][2], B1[2][2];
    i32x8_ At8[4], B08[2], B18[2]; const int sca_ = SCA * 0x01010101, scb_ = SCB * 0x01010101;
    const char* cA = cur.a; const char* cB = cur.b;
    PG8_STAGE_B(PG8_SB(0, 0), cB); PG8_STAGE_B(PG8_SB(0, 1), cB + hstep); PG8_STAGE_A(PG8_SA(0, 0), cA, vAc, 0); PG8_STAGE_A(PG8_SA(0, 1), cA, vAc, 1);
    if (wr == 1) PG8_BAR;
    PG8_WAIT_V(2); PG8_BAR;
    PG8_STAGE_B(PG8_SB(1, 0), cB + kstep); PG8_STAGE_A(PG8_SA(1, 0), cA + kstep, vAc, 0); PG8_STAGE_B(PG8_SB(1, 1), cB + hstep + kstep);
    PG8_WAIT_V(6); PG8_BAR;
    for (;;) {
        const bool has_next = S.next(ui + 1, nxt);
        if constexpr (Sched::GATHER) { if (has_next) { S.gather(nxt, Rr[0], Rr[1], vAn);
#pragma unroll
            for (int h = 0; h < 2; ++h)
#pragma unroll
                for (int i = 0; i < 2; ++i) vAn[h][i] += (unsigned)Cc[i] * 2u; } else {
#pragma unroll
            for (int h = 0; h < 2; ++h)
#pragma unroll
                for (int i = 0; i < 2; ++i) vAn[h][i] = vAc[h][i]; } }
        const char* nA = has_next ? nxt.a : cA; const char* nB = has_next ? nxt.b : cB;
        for (int t = 0; t < nt; t += 2) {
            const bool last = (t == nt - 2);
            const char* a1 = cA + (size_t)(t + 1) * kstep;
            const char* a2 = last ? nA : cA + (size_t)(t + 2) * kstep; const char* b2 = last ? nB : cB + (size_t)(t + 2) * kstep;
            const char* a3 = a2 + kstep; const char* b3 = b2 + kstep;
            unsigned v2[2][2];
#pragma unroll
            for (int h = 0; h < 2; ++h)
#pragma unroll
                for (int i = 0; i < 2; ++i) v2[h][i] = (Sched::GATHER && last) ? vAn[h][i] : vAc[h][i];
            PG8_LDB(B0, 0, 0); PG8_LDB(B1, 0, 1); PG8_SCHED; PG8_LDA(At, 0, 0); PG8_STAGE_A(PG8_SA(1, 1), a1, vAc, 1);
            PG8_WAIT_V(8); PG8_WAIT_L(0); PG8_BAR; PG8_MMA(0, 0, At, B0); PG8_MMA(0, 1, At, B1); PG8_BAR; PG8_SCHED;
            PG8_LDA(At, 0, 1); PG8_STAGE_B(PG8_SB(0, 0), b2); PG8_STAGE_B(PG8_SB(0, 1), b2 + hstep); PG8_STAGE_A(PG8_SA(0, 0), a2, v2, 0);
            PG8_WAIT_V(8); PG8_WAIT_L(0); PG8_BAR; PG8_MMA(1, 0, At, B0); PG8_MMA(1, 1, At, B1); PG8_BAR; PG8_SCHED;
            PG8_LDB(B0, 1, 0); PG8_LDB(B1, 1, 1); PG8_SCHED; PG8_LDA(At, 1, 0); PG8_STAGE_A(PG8_SA(0, 1), a2, v2, 1);
            PG8_WAIT_V(8); PG8_WAIT_L(0); PG8_BAR; PG8_MMA(0, 0, At, B0); PG8_MMA(0, 1, At, B1); PG8_BAR; PG8_SCHED;
            PG8_LDA(At, 1, 1); PG8_STAGE_B(PG8_SB(1, 0), b3); PG8_STAGE_B(PG8_SB(1, 1), b3 + hstep); PG8_STAGE_A(PG8_SA(1, 0), a3, v2, 0);
            PG8_WAIT_V(8); PG8_WAIT_L(0); PG8_BAR; PG8_MMA(1, 0, At, B0); PG8_MMA(1, 1, At, B1); PG8_BAR; PG8_SCHED;
        }
        if (wr == 0) PG8_BAR;
        if constexpr (FP8) { asm volatile("s_nop 15\n\ts_nop 15" ::: "memory"); }
        E(acc, cur, wr, wc, fr, fq);
        if (!has_next) break;
#pragma unroll
        for (int a = 0; a < 2; ++a)
#pragma unroll
            for (int b = 0; b < 2; ++b)
#pragma unroll
                for (int m = 0; m < 4; ++m)
#pragma unroll
                    for (int n = 0; n < 2; ++n) acc[a][b][m][n] = (f32x4){0.f, 0.f, 0.f, 0.f};
        cur = nxt; cA = nA; cB = nB; ++ui;
#pragma unroll
        for (int h = 0; h < 2; ++h)
#pragma unroll
            for (int i = 0; i < 2; ++i) vAc[h][i] = vAn[h][i];
        if (wr == 1) PG8_BAR;
    }
    PG8_WAIT_V(0);
    PG8_BAR;
#undef PG8_SA
#undef PG8_SB
#undef PG8_STAGE_A
#undef PG8_STAGE_B
#undef PG8_LDA
#undef PG8_LDB
#undef PG8_MMA
#undef PG8_WAIT_V
#undef PG8_WAIT_L
#undef PG8_BAR
#undef PG8_SCHED
}
}
namespace pg8 {

struct EpiBf16 {
    static constexpr bool PERM = true;
    bf16_t* O; size_t ldc;
    __device__ __forceinline__ void operator()(const f32x4 (&acc)[2][2][4][2], const Unit& u, int wr, int wc, int fr, int fq) const {
        const size_t row0 = (size_t)u.pm * BM + wr * 64 + fr; const int col0 = u.pn * BM + wc * 32 + 8 * fq;
#pragma unroll
        for (int ai = 0; ai < 2; ++ai)
#pragma unroll
            for (int m = 0; m < 4; ++m) { bf16_t* rowp = O + (row0 + ai * HALF + m * 16) * ldc + col0;
#pragma unroll
                for (int bj = 0; bj < 2; ++bj) { const f32x4 v0 = acc[ai][bj][m][0], v1 = acc[ai][bj][m][1];
                    u32x4 w; w.x = cvt_pk_bf16(v0[0], v0[1]); w.y = cvt_pk_bf16(v0[2], v0[3]); w.z = cvt_pk_bf16(v1[0], v1[1]); w.w = cvt_pk_bf16(v1[2], v1[3]);
                    *(u32x4*)(rowp + bj * HALF) = w; } }
    }
};

struct EpiQKV {
    static constexpr bool PERM = false;
    bf16_t* Q; bf16_t* Kb; bf16_t* Vb; const float* ropec; const float* ropes;
    __device__ __forceinline__ void operator()(const f32x4 (&acc)[2][2][4][2], const Unit& u, int wr, int wc, int fr, int fq) const {
        const int sec = u.pn >> 1;
        const int bt = u.pm >> 4, t0 = (u.pm & 15) * BM;
        bf16_t* base; size_t rowb; float sc = 1.f;
        if (sec == 0) { base = Q; rowb = (size_t)u.pm * BM; sc = QSCALE; }
        else { base = (sec == 1) ? Kb : Vb; rowb = (size_t)bt * LKV + CTXL + t0; }
        const int colt = (u.pn & 1) * BM + wc * 32 + 4 * fq;
        const bool rope = sec < 2; const bool colpos = (wc & 1) != 0;
#pragma unroll
        for (int ai = 0; ai < 2; ++ai)
#pragma unroll
            for (int m = 0; m < 4; ++m) {
                const int rl = ai * HALF + wr * 64 + m * 16 + fr; const int t = t0 + rl;
                const int pos = colpos ? (t & 63) : (t >> 6);
                f32x4 cs = (f32x4){1.f, 1.f, 1.f, 1.f}, sn = (f32x4){0.f, 0.f, 0.f, 0.f};
                if (rope) { cs = *(const f32x4*)(ropec + pos * 16 + 4 * fq); sn = *(const f32x4*)(ropes + pos * 16 + 4 * fq); }
                bf16_t* rowp = base + (rowb + rl) * 512 + colt;
#pragma unroll
                for (int bj = 0; bj < 2; ++bj) {
                    const f32x4 a = acc[ai][bj][m][0], b = acc[ai][bj][m][1];
                    f32x4 oa, ob;
                    if (rope) { oa = (a * cs - b * sn) * sc; ob = (a * sn + b * cs) * sc; } else { oa = a; ob = b; }
                    u32x2 w0, w1; w0.x = cvt_pk_bf16(oa[0], oa[1]); w0.y = cvt_pk_bf16(oa[2], oa[3]); w1.x = cvt_pk_bf16(ob[0], ob[1]); w1.y = cvt_pk_bf16(ob[2], ob[3]);
                    *(u32x2*)(rowp + bj * HALF) = w0; *(u32x2*)(rowp + bj * HALF + 16) = w1; }
            }
    }
};

struct EpiCtxKV {
    static constexpr bool PERM = true;
    bf16_t* Kb; bf16_t* Vb;
    __device__ __forceinline__ void operator()(const f32x4 (&acc)[2][2][4][2], const Unit& u, int wr, int wc, int fr, int fq) const {
        bf16_t* base = (u.pn < 2) ? Kb : Vb; const size_t rowb = (size_t)u.pm * LKV; const int col0 = (u.pn & 1) * BM + wc * 32 + 8 * fq;
#pragma unroll
        for (int ai = 0; ai < 2; ++ai)
#pragma unroll
            for (int m = 0; m < 4; ++m) { bf16_t* rowp = base + (rowb + ai * HALF + wr * 64 + m * 16 + fr) * 512 + col0;
#pragma unroll
                for (int bj = 0; bj < 2; ++bj) { const f32x4 v0 = acc[ai][bj][m][0], v1 = acc[ai][bj][m][1];
                    u32x4 w; w.x = cvt_pk_bf16(v0[0], v0[1]); w.y = cvt_pk_bf16(v0[2], v0[3]); w.z = cvt_pk_bf16(v1[0], v1[1]); w.w = cvt_pk_bf16(v1[2], v1[3]);
                    *(u32x4*)(rowp + bj * HALF) = w; } }
    }
};

template <bool XF32> struct EpiResid {
    static constexpr bool PERM = true;
    const void* xin; bf16_t* out; const float* gate;   const float* bias;
    __device__ __forceinline__ void operator()(const f32x4 (&acc)[2][2][4][2], const Unit& u, int wr, int wc, int fr, int fq) const {
        const int bt = u.pm >> 4; const int col0 = u.pn * BM + wc * 32 + 8 * fq;
#pragma unroll
        for (int bj = 0; bj < 2; ++bj) {
            f32x4 gv[2], bv[2];
#pragma unroll
            for (int n = 0; n < 2; ++n) { gv[n] = *(const f32x4*)(gate + (size_t)bt * 6144 + col0 + bj * HALF + 4 * n);
                bv[n] = bias ? *(const f32x4*)(bias + col0 + bj * HALF + 4 * n) : (f32x4){0.f, 0.f, 0.f, 0.f}; }
#pragma unroll
            for (int ai = 0; ai < 2; ++ai)
#pragma unroll
                for (int m = 0; m < 4; ++m) { const size_t off = ((size_t)u.pm * BM + ai * HALF + wr * 64 + m * 16 + fr) * DM + col0 + bj * HALF;
                    f32x4 x0, x1;
                    if (XF32) { x0 = *(const f32x4*)((const float*)xin + off); x1 = *(const f32x4*)((const float*)xin + off + 4); }
                    else { const u32x4 r = *(const u32x4*)((const bf16_t*)xin + off); x0 = (f32x4){bflo(r.x), bfhi(r.x), bflo(r.y), bfhi(r.y)}; x1 = (f32x4){bflo(r.z), bfhi(r.z), bflo(r.w), bfhi(r.w)}; }
                    const f32x4 y0 = x0 + gv[0] * (acc[ai][bj][m][0] + bv[0]), y1 = x1 + gv[1] * (acc[ai][bj][m][1] + bv[1]);
                    u32x4 w; w.x = cvt_pk_bf16(y0[0], y0[1]); w.y = cvt_pk_bf16(y0[2], y0[3]); w.z = cvt_pk_bf16(y1[0], y1[1]); w.w = cvt_pk_bf16(y1[2], y1[3]);
                    *(u32x4*)(out + off) = w; }
        }
    }
};

template <int MODE> struct EpiGated {
    static constexpr bool PERM = true;
    bf16_t* O; size_t ldo; const float* ba; const float* bg;
    __device__ __forceinline__ void operator()(const f32x4 (&acc)[2][2][4][2], const Unit& u, int wr, int wc, int fr, int fq) const {
        const size_t row0 = (size_t)u.pm * BM + wr * 64 + fr; const int col0 = u.pn * 128 + wc * 32 + 8 * fq;
        f32x4 b0[2], b1[2];
#pragma unroll
        for (int bj = 0; bj < 2; ++bj) { b0[bj] = (f32x4){0.f, 0.f, 0.f, 0.f}; b1[bj] = b0[bj]; if (MODE == 1) { b0[bj] = *(const f32x4*)(ba + col0 + 4 * bj); b1[bj] = *(const f32x4*)(bg + col0 + 4 * bj); } }
#pragma unroll
        for (int ai = 0; ai < 2; ++ai)
#pragma unroll
            for (int m = 0; m < 4; ++m) { f32x4 o[2];
#pragma unroll
                for (int bj = 0; bj < 2; ++bj) { const f32x4 a = acc[ai][bj][m][0] + b0[bj], g = acc[ai][bj][m][1] + b1[bj];
#pragma unroll
                    for (int j = 0; j < 4; ++j) o[bj][j] = (MODE == 1) ? a[j] * sigmoid_f(g[j]) : silu_f(a[j]) * g[j]; }
                if (MODE == 2) { unsigned char* rowp = (unsigned char*)O + (row0 + ai * HALF + m * 16) * ldo + col0;
                    int p0 = 0, p1 = 0; p0 = __builtin_amdgcn_cvt_pk_fp8_f32(o[0][0], o[0][1], p0, false); p0 = __builtin_amdgcn_cvt_pk_fp8_f32(o[0][2], o[0][3], p0, true);
                    p1 = __builtin_amdgcn_cvt_pk_fp8_f32(o[1][0], o[1][1], p1, false); p1 = __builtin_amdgcn_cvt_pk_fp8_f32(o[1][2], o[1][3], p1, true);
                    *(u32x2*)rowp = (u32x2){(unsigned)p0, (unsigned)p1}; }
                else { bf16_t* rowp = O + (row0 + ai * HALF + m * 16) * ldo + col0;
                    u32x4 w; w.x = cvt_pk_bf16(o[0][0], o[0][1]); w.y = cvt_pk_bf16(o[0][2], o[0][3]); w.z = cvt_pk_bf16(o[1][0], o[1][1]); w.w = cvt_pk_bf16(o[1][2], o[1][3]);
                    *(u32x4*)rowp = w; } }
    }
};

struct EpiScatter {
    static constexpr bool PERM = true;
    bf16_t* Y0; bf16_t* Y1; const int* list; const LAS int* pref;
    __device__ __forceinline__ void operator()(const f32x4 (&acc)[2][2][4][2], const Unit& u, int wr, int wc, int fr, int fq) const {
        const int e = u.aux, j = u.pm - pref[e], cnt = pref[40 + e]; const int col0 = u.pn * BM + wc * 32 + 8 * fq;
#pragma unroll
        for (int ai = 0; ai < 2; ++ai)
#pragma unroll
            for (int m = 0; m < 4; ++m) { const int r = j * 256 + ai * HALF + wr * 64 + m * 16 + fr;
                bf16_t* rowp = Y1 + (size_t)NTOK * DM + col0;
                if (r < cnt) { const int ent = list[e * 32768 + r]; rowp = ((ent & 1) ? Y1 : Y0) + (size_t)(ent >> 1) * DM + col0; }
#pragma unroll
                for (int bj = 0; bj < 2; ++bj) { const f32x4 v0 = acc[ai][bj][m][0], v1 = acc[ai][bj][m][1];
                    u32x4 w; w.x = cvt_pk_bf16(v0[0], v0[1]); w.y = cvt_pk_bf16(v0[2], v0[3]); w.z = cvt_pk_bf16(v1[0], v1[1]); w.w = cvt_pk_bf16(v1[2], v1[3]);
                    *(u32x4*)(rowp + bj * HALF) = w; } }
    }
};

struct EpiLogits {
    static constexpr bool PERM = false;
    float* O;
    __device__ __forceinline__ void operator()(const f32x4 (&acc)[2][2][4][2], const Unit& u, int wr, int wc, int fr, int fq) const {
        if (wc >= 2) return;
#pragma unroll
        for (int ai = 0; ai < 2; ++ai)
#pragma unroll
            for (int m = 0; m < 4; ++m) { float* rowp = O + ((size_t)u.pm * BM + ai * HALF + wr * 64 + m * 16 + fr) * 64 + wc * 32 + 4 * fq;
#pragma unroll
                for (int n = 0; n < 2; ++n) *(f32x4*)(rowp + n * 16) = acc[ai][0][m][n]; }
    }
};
}
enum { I_X = 0, I_C, I_CTX, I_CCTX, I_ADAW, I_ADAB, I_N1G, I_N2G, I_FING, I_WIN0, I_WOUT0, I_LQ1, I_LK1, I_LQ2, I_LK2, I_SUBLN,
       I_HYSW, I_HYSB, I_HYW1, I_HYB1, I_HYFR1, I_HYW2, I_HYB2, I_HYFR2, I_HYW3, I_HYB3, I_HYBIAS,
       I_CVW1, I_CVB1, I_CVDWW, I_CVDWB, I_CVLNG, I_CVLNB, I_CVW2, I_CVB2, I_MWG, I_MBG, I_MWE, I_MBE, I_MGATE, I_MUP, I_MDOWN, N_IN };

struct Args { const float* in[N_IN]; float* out; unsigned char* ws; int ph_lo, ph_hi; };

struct Frame {
    LAS unsigned char* lds;
    int tid, lane, wave, G, bid;
    const float* const* in; float* out; unsigned char* ws;
};

struct RowMap { int mode, half, which0;
    __device__ __forceinline__ int operator()(int s) const { if (mode == 0) return s; const int w = which0 + s / half, h = s % half, t = h & 127;
        return 256 * (h >> 7) + 128 * ((t >> 2) & 1) + 32 * (t >> 5) + 8 * ((t >> 3) & 3) + 4 * w + (t & 3); } };
#ifndef CONF_FP8
#define CONF_FP8 1
#endif
struct P0Item { const float* W; bf16_t* WT; int K, N, k0, n0; RowMap rm; int fp8; };
constexpr int P0_I_IN = 16 * 6, P0_I_OUT = 16 * 2, P0_I_C1 = 16 * 4, P0_I_C2 = 16 * 2, P0_I_MOE = 64 * 48;
constexpr int P0_NITEMS = P0_I_IN + P0_I_OUT + P0_I_C1 + P0_I_C2 + P0_I_MOE;
__device__ __forceinline__ P0Item p0_item(Frame& F, int it) {
    P0Item I; int r = it; I.fp8 = 0;
    if (r < P0_I_IN) { I.W = F.in[I_WIN0]; I.WT = (bf16_t*)(F.ws + WS_WQKVH); I.K = 1024; I.N = 3072; I.rm = RowMap{0, 1, 0}; }
    else if ((r -= P0_I_IN) < P0_I_OUT) { I.W = F.in[I_WOUT0]; I.WT = (bf16_t*)(F.ws + WS_WO); I.K = 1024; I.N = 1024; I.rm = RowMap{0, 1, 0}; }
    else if ((r -= P0_I_OUT) < P0_I_C1) { I.W = F.in[I_CVW1]; I.WT = (bf16_t*)(F.ws + WS_WC1); I.K = 1024; I.N = 2048; I.rm = RowMap{1, 1024, 0}; I.fp8 = CONF_FP8; }
    else if ((r -= P0_I_C1) < P0_I_C2) { I.W = F.in[I_CVW2]; I.WT = (bf16_t*)(F.ws + WS_WC2); I.K = 1024; I.N = 1024; I.rm = RowMap{0, 1, 0}; I.fp8 = CONF_FP8; }
    else { r -= P0_I_C2; const int le = r / 48, q = r % 48; unsigned char* wb = F.ws + WS_WMOE + (size_t)le * 3 * MiB;
        I.fp8 = 1;
        if (q < 16) { I.W = F.in[I_MGATE] + (size_t)le * 1024 * 512; I.WT = (bf16_t*)wb; I.K = 1024; I.N = 512; I.rm = RowMap{1, 512, 0}; r = q; }
        else if (q < 32) { I.W = F.in[I_MUP] + (size_t)le * 1024 * 512; I.WT = (bf16_t*)wb; I.K = 1024; I.N = 512; I.rm = RowMap{1, 512, 1}; r = q - 16; }
        else { I.W = F.in[I_MDOWN] + (size_t)le * 512 * 1024; I.WT = (bf16_t*)(wb + 2 * MiB); I.K = 512; I.N = 1024; I.rm = RowMap{0, 1, 0}; r = q - 32; } }
    const int nblk = I.N / 512; I.k0 = 64 * (r / nblk); I.n0 = 512 * (r % nblk); return I;
}
__device__ __forceinline__ void p0_item_load(const P0Item& I, int tid, f32x4 (&v)[16]) {
#pragma unroll
    for (int i = 0; i < 16; ++i) v[i] = *(const f32x4*)(I.W + (size_t)(I.k0 + 4 * i + (tid >> 7)) * I.N + I.n0 + 4 * (tid & 127));
}
__device__ __forceinline__ void p0_item_to_lds(LAS float* scr, int tid, const f32x4 (&v)[16]) {
#pragma unroll
    for (int i = 0; i < 16; ++i) { LAS float* d = scr + (4 * i + (tid >> 7)) * 513 + 4 * (tid & 127); d[0] = v[i][0]; d[1] = v[i][1]; d[2] = v[i][2]; d[3] = v[i][3]; }
}
__device__ __forceinline__ void p0_item_store(const P0Item& I, const LAS float* scr, int tid) {
    if (I.fp8) {
#pragma unroll
        for (int j = 0; j < 4; ++j) { const int q = tid + 512 * j, n = q >> 2, c = q & 3; const LAS float* s = scr + (16 * c) * 513 + n; int w[4];
#pragma unroll
            for (int d = 0; d < 4; ++d) { int p = 0; p = __builtin_amdgcn_cvt_pk_fp8_f32(32.f * s[(4 * d) * 513], 32.f * s[(4 * d + 1) * 513], p, false);
                p = __builtin_amdgcn_cvt_pk_fp8_f32(32.f * s[(4 * d + 2) * 513], 32.f * s[(4 * d + 3) * 513], p, true); w[d] = p; }
            *(u32x4*)((unsigned char*)I.WT + (size_t)I.rm(I.n0 + n) * I.K + I.k0 + 16 * c) = (u32x4){(unsigned)w[0], (unsigned)w[1], (unsigned)w[2], (unsigned)w[3]}; }
        return; }
#pragma unroll
    for (int j = 0; j < 8; ++j) { const int q = tid + 512 * j, n = q >> 3, c = q & 7; const LAS float* s = scr + (8 * c) * 513 + n;
        u32x4 o; o.x = cvt_pk_bf16(s[0 * 513], s[1 * 513]); o.y = cvt_pk_bf16(s[2 * 513], s[3 * 513]); o.z = cvt_pk_bf16(s[4 * 513], s[5 * 513]); o.w = cvt_pk_bf16(s[6 * 513], s[7 * 513]);
        *(u32x4*)(I.WT + (size_t)I.rm(I.n0 + n) * I.K + I.k0 + 8 * c) = o; }
}
__device__ __forceinline__ void p0_router_weights(Frame& F) {
    bf16_t* wr = (bf16_t*)(F.ws + WS_WR);
    for (int idx = F.bid * NTHREADS + F.tid; idx < 2 * 256 * 1024; idx += F.G * NTHREADS) {
        const int l = idx >> 18, n = (idx >> 10) & 255, k = idx & 1023; float v = 0.f;
        if (n < 4) v = F.in[I_MWG][((size_t)l * 1024 + k) * 4 + n]; else if (n < 36) v = F.in[I_MWE][((size_t)l * 1024 + k) * 32 + (n - 4)];
        wr[idx] = (bf16_t)(cvt_pk_bf16(v, 0.f) & 0xffffu);
    }
}

__device__ __forceinline__ void p0_adaln_task(Frame& F, int task) {
    const int layer = task / 24, n0 = (task % 24) * 256;
    LAS float* sc = (LAS float*)F.lds;
    LAS f32x4* red = (LAS f32x4*)(F.lds + 36864);
    for (int i = F.tid; i < 9 * 1024; i += NTHREADS) { const int r = i >> 10, k = i & 1023; const float v = (r < 8) ? F.in[I_C][r * 1024 + k] : F.in[I_CCTX][k]; sc[i] = silu_f(v); }
    __syncthreads();
    const int cq = F.tid & 63, ks = F.tid >> 6;
    const float* W = F.in[I_ADAW] + (size_t)layer * 1024 * 6144 + n0 + 4 * cq;
    f32x4 acc[9];
#pragma unroll
    for (int r = 0; r < 9; ++r) acc[r] = (f32x4){0.f, 0.f, 0.f, 0.f};
#pragma unroll 16
    for (int k = ks * 128; k < ks * 128 + 128; ++k) { const f32x4 w = *(const f32x4*)(W + (size_t)k * 6144);
#pragma unroll
        for (int r = 0; r < 9; ++r) acc[r] += w * sc[r * 1024 + k]; }
#pragma unroll
    for (int r = 0; r < 9; ++r) red[(ks * 9 + r) * 64 + cq] = acc[r];
    __syncthreads();
    float* mod = (float*)(F.ws + WS_MOD) + (size_t)layer * 9 * 6144;
    for (int i = F.tid; i < 9 * 64; i += NTHREADS) { const int r = i >> 6, c2 = i & 63; f32x4 s = *(const f32x4*)(F.in[I_ADAB] + layer * 6144 + n0 + 4 * c2);
#pragma unroll
        for (int k8 = 0; k8 < 8; ++k8) s += red[(k8 * 9 + r) * 64 + c2];
        *(f32x4*)(mod + (size_t)r * 6144 + n0 + 4 * c2) = s; }
    __syncthreads();
}

constexpr float HY_MIN_DECAY = -15.350567286626973f, HY_MAX_DECAY = -3.0701134573253945f;
__device__ __forceinline__ void p0_hyfilter_task(Frame& F, int pb) {
    const int t0 = pb * 32;
    LAS float* z = (LAS float*)F.lds;
    LAS float* h1 = z + 32 * 33;
    LAS float* h2 = h1 + 32 * 64;
    for (int i = F.tid; i < 32 * 33; i += NTHREADS) { const int p = i / 33, e = i % 33; const int t = t0 + p; float v;
        if (e == 0) v = (float)t / 4095.0f;
        else { const int bi = (e - 1) & 15; const float band = 1e-4f + (float)bi * ((15.0f - 1e-4f) / 15.0f); const float ang = (6.283185307179586f / 4096.0f) * (float)t * band; v = (e <= 16) ? cosf(ang) : -sinf(ang); }
        z[i] = v; }
    __syncthreads();
    for (int i = F.tid; i < 32 * 64; i += NTHREADS) { const int p = i >> 6, j = i & 63; float s = F.in[I_HYB1][j];
        for (int e = 0; e < 33; ++e) s += z[p * 33 + e] * F.in[I_HYW1][e * 64 + j];
        h1[i] = sinf(F.in[I_HYFR1][j] * s); }
    __syncthreads();
    for (int i = F.tid; i < 32 * 64; i += NTHREADS) { const int p = i >> 6, j = i & 63; float s = F.in[I_HYB2][j];
        for (int e = 0; e < 64; ++e) s += h1[p * 64 + e] * F.in[I_HYW2][e * 64 + j];
        h2[i] = sinf(F.in[I_HYFR2][j] * s); }
    __syncthreads();
    const int c0 = 4 * F.tid;
    float* kraw = (float*)(F.ws + WS_KRAW);
    const f32x4 b3 = *(const f32x4*)(F.in[I_HYB3] + c0);
#pragma unroll 1
    for (int ph = 0; ph < 2; ++ph) {
        f32x4 acc[16];
#pragma unroll
        for (int p = 0; p < 16; ++p) acc[p] = b3;
        for (int j4 = 0; j4 < 16; ++j4) {
            f32x4 w[4];
#pragma unroll
            for (int jj = 0; jj < 4; ++jj) w[jj] = *(const f32x4*)(F.in[I_HYW3] + (size_t)(4 * j4 + jj) * 2048 + c0);
#pragma unroll
            for (int p = 0; p < 16; ++p) { const f32x4 hv = *(const LAS f32x4*)(h2 + (16 * ph + p) * 64 + 4 * j4);
                acc[p] += w[0] * hv[0] + w[1] * hv[1] + w[2] * hv[2] + w[3] * hv[3]; }
        }
#pragma unroll
        for (int cc = 0; cc < 4; ++cc) { const int col = c0 + cc, ch = col & 511;
            const float delta = fabsf(HY_MIN_DECAY + (float)ch * ((HY_MAX_DECAY - HY_MIN_DECAY) / 511.0f));
            float* dst = kraw + (size_t)col * 4096 + t0 + 16 * ph;
#pragma unroll
            for (int p4 = 0; p4 < 4; ++p4) { f32x4 o;
#pragma unroll
                for (int q = 0; q < 4; ++q) { const int p = 4 * p4 + q; const float tn = (float)(t0 + 16 * ph + p) / 4095.0f; o[q] = acc[p][cc] * __expf(-tn * delta); }
                *(f32x4*)(dst + 4 * p4) = o; } }
    }
    __syncthreads();
}

__device__ __forceinline__ void p0_tables_task(Frame& F) {
    float* tab = (float*)(F.ws + WS_TAB);
    for (int i = F.tid; i < 1024; i += NTHREADS) { const int pos = i >> 4, fi = i & 15; const float inv = powf(10000.0f, -(float)fi / 16.0f); const float ang = (float)pos * inv;
        tab[TB_ROPE_C + i] = cosf(ang); tab[TB_ROPE_S + i] = sinf(ang); }
    for (int i = F.tid; i < 256; i += NTHREADS) { float s, c; sincospif(2.0f * (float)i / 4096.0f, &s, &c); tab[TB_T4096 + 2 * i] = c; tab[TB_T4096 + 2 * i + 1] = -s; }
    for (int i = F.tid; i < 64; i += NTHREADS) { float s, c; sincospif(2.0f * (float)i / 8192.0f, &s, &c); tab[TB_T8A + 2 * i] = c; tab[TB_T8A + 2 * i + 1] = -s;
        sincospif(2.0f * (float)(64 * i) / 8192.0f, &s, &c); tab[TB_T8B + 2 * i] = c; tab[TB_T8B + 2 * i + 1] = -s; }
    if (F.tid < 64) { const float a = wave_sum(F.in[I_LQ1][F.lane] * F.in[I_LK1][F.lane]), b = wave_sum(F.in[I_LQ2][F.lane] * F.in[I_LK2][F.lane]);
        if (F.lane == 0) tab[TB_LAM] = expf(a) - expf(b) + 0.2f; }
}

__device__ __forceinline__ void p0_prologue(Frame& F, unsigned* ctr, volatile LAS unsigned* slot) {
    p0_router_weights(F);
#pragma unroll 1
    for (int t = F.bid; t < 48 + 128; t += F.G) { if (t < 48) p0_adaln_task(F, t); else p0_hyfilter_task(F, t - 48); }
    if (F.bid == 0) p0_tables_task(F);
    __syncthreads();
    LAS float* scr = (LAS float*)F.lds;
    if (F.tid == 0) slot[0] = __hip_atomic_fetch_add(ctr, 1u, RLX_AGENT);
    __syncthreads();
    int cur = (int)slot[0];
    f32x4 v[16];
    if (cur < P0_NITEMS) { const P0Item I = p0_item(F, cur); p0_item_load(I, F.tid, v); }
    while (cur < P0_NITEMS) {
        __syncthreads();
        p0_item_to_lds(scr, F.tid, v);
        if (F.tid == 0) slot[0] = __hip_atomic_fetch_add(ctr, 1u, RLX_AGENT);
        __syncthreads();
        const int nxt = (int)slot[0];
        if (nxt < P0_NITEMS) { const P0Item J = p0_item(F, nxt); p0_item_load(J, F.tid, v); }
        { const P0Item I = p0_item(F, cur); p0_item_store(I, scr, F.tid); }
        cur = nxt;
    }
    __syncthreads();
}

__device__ __forceinline__ void bf8_to_f32(const u32x4 r, f32x4& a, f32x4& b) { a = (f32x4){bflo(r.x), bfhi(r.x), bflo(r.y), bfhi(r.y)}; b = (f32x4){bflo(r.z), bfhi(r.z), bflo(r.w), bfhi(r.w)}; }
__device__ __forceinline__ void rms_mod_store(const f32x4 (&v)[4], const float* g, const float* sh, const float* sc, bf16_t* orow, float* frow, int lane) {
    float s = 0.f;
#pragma unroll
    for (int j = 0; j < 4; ++j) s += (v[j].x * v[j].x + v[j].y * v[j].y) + (v[j].z * v[j].z + v[j].w * v[j].w);
    const float rstd = 1.0f / sqrtf(wave_sum(s) * (1.0f / 1024.0f) + EPS);
#pragma unroll
    for (int h = 0; h < 2; ++h) { const int c = 8 * lane + 512 * h; f32x4 y0 = v[2 * h] * rstd * *(const f32x4*)(g + c), y1 = v[2 * h + 1] * rstd * *(const f32x4*)(g + c + 4);
        if (sc) { y0 = y0 * (*(const f32x4*)(sc + c) + 1.0f) + *(const f32x4*)(sh + c); y1 = y1 * (*(const f32x4*)(sc + c + 4) + 1.0f) + *(const f32x4*)(sh + c + 4); }
        if (orow) { u32x4 w; w.x = cvt_pk_bf16(y0[0], y0[1]); w.y = cvt_pk_bf16(y0[2], y0[3]); w.z = cvt_pk_bf16(y1[0], y1[1]); w.w = cvt_pk_bf16(y1[2], y1[3]); *(u32x4*)(orow + c) = w; }
        if (frow) { *(f32x4*)(frow + c) = y0; *(f32x4*)(frow + c + 4) = y1; } }
}

__device__ __forceinline__ void p1_norm_in(Frame& F) {
    const int gw = F.bid * NWAVES + F.wave, NGW = F.G * NWAVES;
    const float* mod = (const float*)(F.ws + WS_MOD);
#pragma unroll 1
    for (int r0 = gw; r0 < NTOK + NB * CTXL; r0 += 4 * NGW) {
        f32x4 v[4][4];
#pragma unroll
        for (int q = 0; q < 4; ++q) { const int r = r0 + q * NGW; if (r < NTOK + NB * CTXL) { const bool isx = r < NTOK; const int rr = isx ? r : r - NTOK;
            const float* xrow = (isx ? F.in[I_X] : F.in[I_CTX]) + (size_t)rr * DM;
#pragma unroll
            for (int j = 0; j < 4; ++j) v[q][j] = *(const f32x4*)(xrow + 8 * F.lane + 512 * (j >> 1) + 4 * (j & 1)); } }
#pragma unroll
        for (int q = 0; q < 4; ++q) { const int r = r0 + q * NGW; if (r < NTOK + NB * CTXL) { const bool isx = r < NTOK; const int rr = isx ? r : r - NTOK; const int b = isx ? (rr >> 12) : 8;
            bf16_t* orow = (bf16_t*)(F.ws + (isx ? WS_BUF0 : WS_OBT)) + (size_t)rr * DM;
            rms_mod_store(v[q], F.in[I_N1G], mod + (size_t)b * 6144 + 0, mod + (size_t)b * 6144 + 1024, orow, nullptr, F.lane); } }
    }
}

constexpr int MF_PITCH = 2064;
constexpr int MF_TILE = 0, MF_RED = 32 * MF_PITCH, MF_SEL = MF_RED + 8 * 32 * 65 * 4, MF_CNT = MF_SEL + 128 * 32;
__device__ __forceinline__ void moe_front(Frame& F, int layer) {
    LAS unsigned char* lds = F.lds;
    LAS float* red = (LAS float*)(lds + MF_RED);
    LAS int* lcnt = (LAS int*)(lds + MF_CNT); LAS int* lbase = lcnt + 32;
    const float* mod = (const float*)(F.ws + WS_MOD) + (size_t)layer * 9 * 6144;
    unsigned* gcnt = (unsigned*)(F.ws + WS_CTL) + CW_CNT + layer * 32 * 64;
    int* list = (int*)(F.ws + WS_LIST);
    int* tinfo = (int*)(F.ws + WS_TOK); float* tw = (float*)(F.ws + WS_TOK + 512 * 1024);
    const int l = F.lane, w = F.wave, r32 = l & 31, hi = l >> 5;
    bf16x8 wb[2][8];
    { const bf16_t* wr = (const bf16_t*)(F.ws + WS_WR) + (size_t)layer * 256 * 1024;
#pragma unroll
      for (int nb = 0; nb < 2; ++nb)
#pragma unroll
          for (int s = 0; s < 8; ++s) wb[nb][s] = *(const bf16x8*)(wr + (size_t)(32 * nb + r32) * 1024 + 128 * w + 16 * s + 8 * hi); }
    for (int blk = F.bid; blk < NTOK / 128; blk += F.G) {
        if (F.tid < 32) lcnt[F.tid] = 0;
        __syncthreads();
#pragma unroll 1
        for (int sg = 0; sg < 4; ++sg) {
            const int tok0 = blk * 128 + sg * 32;
            { f32x4 v[4][4];
#pragma unroll
              for (int q = 0; q < 4; ++q) { const bf16_t* xrow = (const bf16_t*)(F.ws + WS_X) + (size_t)(tok0 + 4 * w + q) * DM;
#pragma unroll
                  for (int h = 0; h < 2; ++h) { const u32x4 t = *(const u32x4*)(xrow + 8 * l + 512 * h); bf8_to_f32(t, v[q][2 * h], v[q][2 * h + 1]); } }
              const int b = tok0 >> 12;
              const float* g = F.in[I_N2G] + layer * DM; const float* sh = mod + (size_t)b * 6144 + 3 * 1024; const float* sc = mod + (size_t)b * 6144 + 4 * 1024;
#pragma unroll
              for (int q = 0; q < 4; ++q) { const int rl = 4 * w + q, r = tok0 + rl; float ssq = 0.f;
#pragma unroll
                  for (int j = 0; j < 4; ++j) ssq += (v[q][j].x * v[q][j].x + v[q][j].y * v[q][j].y) + (v[q][j].z * v[q][j].z + v[q][j].w * v[q][j].w);
                  const float rstd = 1.0f / sqrtf(wave_sum(ssq) * (1.0f / 1024.0f) + EPS);
                  unsigned char* orow = F.ws + WS_BUF0 + (size_t)r * DM;
#pragma unroll
                  for (int h = 0; h < 2; ++h) { const int c = 8 * l + 512 * h;
                      const f32x4 y0 = v[q][2 * h] * rstd * *(const f32x4*)(g + c) * (*(const f32x4*)(sc + c) + 1.0f) + *(const f32x4*)(sh + c);
                      const f32x4 y1 = v[q][2 * h + 1] * rstd * *(const f32x4*)(g + c + 4) * (*(const f32x4*)(sc + c + 4) + 1.0f) + *(const f32x4*)(sh + c + 4);
                      u32x4 pk; pk.x = cvt_pk_bf16(y0[0], y0[1]); pk.y = cvt_pk_bf16(y0[2], y0[3]); pk.z = cvt_pk_bf16(y1[0], y1[1]); pk.w = cvt_pk_bf16(y1[2], y1[3]);
                      *(LAS u32x4*)(lds + MF_TILE + rl * MF_PITCH + c * 2) = pk;
                      int p0 = 0, p1 = 0; p0 = __builtin_amdgcn_cvt_pk_fp8_f32(y0[0], y0[1], p0, false); p0 = __builtin_amdgcn_cvt_pk_fp8_f32(y0[2], y0[3], p0, true);
                      p1 = __builtin_amdgcn_cvt_pk_fp8_f32(y1[0], y1[1], p1, false); p1 = __builtin_amdgcn_cvt_pk_fp8_f32(y1[2], y1[3], p1, true);
                      *(u32x2*)(orow + c) = (u32x2){(unsigned)p0, (unsigned)p1}; } } }
            __syncthreads();
            { f32x16 d0, d1;
#pragma unroll
              for (int r = 0; r < 16; ++r) { d0[r] = 0.f; d1[r] = 0.f; }
#pragma unroll
              for (int s = 0; s < 8; ++s) { const bf16x8 a = *(const LAS bf16x8*)(lds + MF_TILE + r32 * MF_PITCH + (128 * w + 16 * s + 8 * hi) * 2);
                  d0 = __builtin_amdgcn_mfma_f32_32x32x16_bf16(a, wb[0][s], d0, 0, 0, 0); d1 = __builtin_amdgcn_mfma_f32_32x32x16_bf16(a, wb[1][s], d1, 0, 0, 0); }
#pragma unroll
              for (int r = 0; r < 16; ++r) { const int t = (r & 3) + 8 * (r >> 2) + 4 * hi; red[(w * 32 + t) * 65 + r32] = d0[r]; red[(w * 32 + t) * 65 + 32 + r32] = d1[r]; } }
            __syncthreads();
            if (F.tid < 32) { const int t = F.tid;
                int g = 0; float gm = -1e30f, gl[4];
#pragma unroll
                for (int i = 0; i < 4; ++i) { float sum = F.in[I_MBG][layer * 4 + i];
#pragma unroll
                    for (int ww = 0; ww < 8; ++ww) sum += red[(ww * 32 + t) * 65 + i];
                    gl[i] = sum; if (sum > gm) { gm = sum; g = i; } }
                float gs = 0.f;
#pragma unroll
                for (int i = 0; i < 4; ++i) gs += __expf(gl[i] - gm);
                const float gw = 1.0f / gs;
                float el[8];
#pragma unroll
                for (int i = 0; i < 8; ++i) { float sum = F.in[I_MBE][layer * 32 + 8 * g + i];
#pragma unroll
                    for (int ww = 0; ww < 8; ++ww) sum += red[(ww * 32 + t) * 65 + 4 + 8 * g + i];
                    el[i] = sum; }
                int i1 = 0; float m1 = -1e30f;
#pragma unroll
                for (int i = 0; i < 8; ++i) if (el[i] > m1) { m1 = el[i]; i1 = i; }
                int i2 = 0; float m2 = -1e30f;
#pragma unroll
                for (int i = 0; i < 8; ++i) if (i != i1 && el[i] > m2) { m2 = el[i]; i2 = i; }
                const float e2 = __expf(m2 - m1), w1 = gw / (1.0f + e2), w2 = gw * e2 / (1.0f + e2);
                const int x1 = g * 8 + i1, x2 = g * 8 + i2;
                const int p1 = __hip_atomic_fetch_add(&lcnt[x1], 1, __ATOMIC_RELAXED, __HIP_MEMORY_SCOPE_WORKGROUP), p2 = __hip_atomic_fetch_add(&lcnt[x2], 1, __ATOMIC_RELAXED, __HIP_MEMORY_SCOPE_WORKGROUP);
                LAS int* sel = (LAS int*)(lds + MF_SEL) + (sg * 32 + t) * 8;
                sel[0] = x1; sel[1] = p1; sel[2] = x2; sel[3] = p2; sel[4] = __float_as_int(w1); sel[5] = __float_as_int(w2); }
            __syncthreads();
        }
        if (F.tid < 32) lbase[F.tid] = (int)__hip_atomic_fetch_add(gcnt + F.tid * 64, (unsigned)lcnt[F.tid], RLX_AGENT);
        __syncthreads();
        if (F.tid < 128) { const LAS int* sel = (const LAS int*)(lds + MF_SEL) + F.tid * 8; const int tok = blk * 128 + F.tid;
            const int x1 = sel[0], x2 = sel[2], q1 = lbase[x1] + sel[1], q2 = lbase[x2] + sel[3];
            list[x1 * 32768 + q1] = 2 * tok; list[x2 * 32768 + q2] = 2 * tok + 1;
            *(int4*)(tinfo + 4 * (size_t)tok) = make_int4(x1, q1, x2, q2);
            *(float2*)(tw + 2 * (size_t)tok) = make_float2(__int_as_float(sel[4]), __int_as_float(sel[5])); }
        __syncthreads();
    }
}

__device__ __forceinline__ void moe_prefix(Frame& F, int layer, LAS int* pref) {
    const unsigned* gcnt = (const unsigned*)(F.ws + WS_CTL) + CW_CNT + layer * 32 * 64;
    if (F.tid == 0) { int s = 0; for (int e = 0; e < 32; ++e) { const int c = (int)gcnt[e * 64]; pref[e] = s; pref[40 + e] = c; s += (c + 255) >> 8; } pref[32] = s; }
    __syncthreads();
}

template <int MODE> __device__ __forceinline__ void moe_combine(Frame& F, int layer) {
    const int gw = F.bid * NWAVES + F.wave, NGW = F.G * NWAVES;
    const float* mod = (const float*)(F.ws + WS_MOD) + (size_t)layer * 9 * 6144;
    const float* modn = (const float*)(F.ws + WS_MOD) + (size_t)1 * 9 * 6144;
    const float* tw = (const float*)(F.ws + WS_TOK + 512 * 1024);
    const bf16_t* Y0 = (const bf16_t*)(F.ws + WS_BUF0); const bf16_t* Y1 = (const bf16_t*)(F.ws + WS_Y1);
    bf16_t* X = (bf16_t*)(F.ws + WS_X);
#pragma unroll 1
    for (int r0 = gw; r0 < NTOK; r0 += 4 * NGW) {
        f32x4 v[4][4];
#pragma unroll
        for (int q = 0; q < 4; ++q) { const int r = r0 + q * NGW; const int b = r >> 12;
            const float2 ww = *(const float2*)(tw + 2 * (size_t)r);
            const float* g2 = mod + (size_t)b * 6144 + 5 * 1024;
#pragma unroll
            for (int h = 0; h < 2; ++h) { const int c = 8 * F.lane + 512 * h;
                const u32x4 xr = *(const u32x4*)(X + (size_t)r * DM + c), ar = *(const u32x4*)(Y0 + (size_t)r * DM + c), br = *(const u32x4*)(Y1 + (size_t)r * DM + c);
                f32x4 x0, x1, a0, a1, b0, b1; bf8_to_f32(xr, x0, x1); bf8_to_f32(ar, a0, a1); bf8_to_f32(br, b0, b1);
                v[q][2 * h] = x0 + *(const f32x4*)(g2 + c) * (a0 * ww.x + b0 * ww.y); v[q][2 * h + 1] = x1 + *(const f32x4*)(g2 + c + 4) * (a1 * ww.x + b1 * ww.y); } }
#pragma unroll
        for (int q = 0; q < 4; ++q) { const int r = r0 + q * NGW; const int b = r >> 12;
            float ssq = 0.f;
#pragma unroll
            for (int j = 0; j < 4; ++j) ssq += (v[q][j].x * v[q][j].x + v[q][j].y * v[q][j].y) + (v[q][j].z * v[q][j].z + v[q][j].w * v[q][j].w);
            const float rstd = 1.0f / sqrtf(wave_sum(ssq) * (1.0f / 1024.0f) + EPS);
            const float* g = (MODE == 0) ? F.in[I_N1G] + DM : F.in[I_FING];
#pragma unroll
            for (int h = 0; h < 2; ++h) { const int c = 8 * F.lane + 512 * h;
                if (MODE == 0) { u32x4 pk; pk.x = cvt_pk_bf16(v[q][2 * h][0], v[q][2 * h][1]); pk.y = cvt_pk_bf16(v[q][2 * h][2], v[q][2 * h][3]); pk.z = cvt_pk_bf16(v[q][2 * h + 1][0], v[q][2 * h + 1][1]); pk.w = cvt_pk_bf16(v[q][2 * h + 1][2], v[q][2 * h + 1][3]);
                    *(u32x4*)(X + (size_t)r * DM + c) = pk; }
                f32x4 y0 = v[q][2 * h] * rstd * *(const f32x4*)(g + c), y1 = v[q][2 * h + 1] * rstd * *(const f32x4*)(g + c + 4);
                if (MODE == 0) { const float* sh = modn + (size_t)b * 6144; const float* sc = sh + 1024;
                    y0 = y0 * (*(const f32x4*)(sc + c) + 1.0f) + *(const f32x4*)(sh + c); y1 = y1 * (*(const f32x4*)(sc + c + 4) + 1.0f) + *(const f32x4*)(sh + c + 4);
                    if (CONF_FP8) { int p0 = 0, p1 = 0; p0 = __builtin_amdgcn_cvt_pk_fp8_f32(y0[0], y0[1], p0, false); p0 = __builtin_amdgcn_cvt_pk_fp8_f32(y0[2], y0[3], p0, true);
                        p1 = __builtin_amdgcn_cvt_pk_fp8_f32(y1[0], y1[1], p1, false); p1 = __builtin_amdgcn_cvt_pk_fp8_f32(y1[2], y1[3], p1, true);
                        *(u32x2*)(F.ws + WS_BUF0 + (size_t)r * DM + c) = (u32x2){(unsigned)p0, (unsigned)p1}; }
                    else { u32x4 pk; pk.x = cvt_pk_bf16(y0[0], y0[1]); pk.y = cvt_pk_bf16(y0[2], y0[3]); pk.z = cvt_pk_bf16(y1[0], y1[1]); pk.w = cvt_pk_bf16(y1[2], y1[3]);
                        *(u32x4*)((bf16_t*)(F.ws + WS_BUF0) + (size_t)r * DM + c) = pk; } }
                else { *(f32x4*)(F.out + (size_t)r * DM + c) = y0; *(f32x4*)(F.out + (size_t)r * DM + c + 4) = y1; } } }
    }
}

__device__ __forceinline__ void transpose_ob(Frame& F) {
    LAS bf16_t* scr = (LAS bf16_t*)(F.lds + F.wave * 16384);
    const int gw = F.bid * NWAVES + F.wave, NGW = F.G * NWAVES;
    const bf16_t* src = (const bf16_t*)(F.ws + WS_OBT); bf16_t* dst = (bf16_t*)(F.ws + WS_BUF0);
    const int r8 = F.lane >> 3, c8 = F.lane & 7;
    for (int it = gw; it < 8 * 512; it += NGW) {
        const int cb = it & 7, tb = it >> 3; const int c0 = cb * 64, t0 = tb * 64;
        u32x4 v[8];
#pragma unroll
        for (int i = 0; i < 8; ++i) v[i] = *(const u32x4*)(src + (size_t)(c0 + r8 + 8 * i) * NTOK + t0 + 8 * c8);
#pragma unroll
        for (int i = 0; i < 8; ++i) *(LAS u32x4*)(scr + (r8 + 8 * i) * 72 + 8 * c8) = v[i];
        LDS_WAIT(); asm volatile("" ::: "memory");
#pragma unroll
        for (int i = 0; i < 8; ++i) { const int t = r8 + 8 * i; unsigned short e[8];
#pragma unroll
            for (int k = 0; k < 8; ++k) e[k] = scr[(8 * c8 + k) * 72 + t];
            u32x4 o; o.x = e[0] | ((unsigned)e[1] << 16); o.y = e[2] | ((unsigned)e[3] << 16); o.z = e[4] | ((unsigned)e[5] << 16); o.w = e[6] | ((unsigned)e[7] << 16);
            *(u32x4*)(dst + (size_t)(t0 + t) * DM + 512 + c0 + 8 * c8) = o; }
        LDS_WAIT(); asm volatile("" ::: "memory");
    }
}

template <int SS> __device__ __forceinline__ void conv_step(f32x2 (&acc)[32], const f32x2 (&w)[31], const f32x2 bias, const unsigned rawv) {
    const f32x2 xin = (f32x2){bflo(rawv), bfhi(rawv)};
    acc[SS] = bias;
#pragma unroll
    for (int k = 0; k < 31; ++k) acc[(SS - k) & 31] += w[k] * xin;
}
constexpr int CV_TILE = 65536;
__device__ __forceinline__ void conv_ln_rows(Frame& F, const LAS bf16_t* tile, bf16_t* Obase  ) {
#pragma unroll 1
    for (int q = 0; q < 4; ++q) { const int rr = F.wave * 4 + q;
        f32x4 v[4]; float sm = 0.f;
#pragma unroll
        for (int h = 0; h < 2; ++h) { const u32x4 t = *(const LAS u32x4*)(tile + rr * 1024 + 8 * F.lane + 512 * h); bf8_to_f32(t, v[2 * h], v[2 * h + 1]); }
#pragma unroll
        for (int j = 0; j < 4; ++j) sm += (v[j].x + v[j].y) + (v[j].z + v[j].w);
        const float mean = wave_sum(sm) * (1.0f / 1024.0f); float s2 = 0.f;
#pragma unroll
        for (int j = 0; j < 4; ++j) { v[j] = v[j] - mean; s2 += (v[j].x * v[j].x + v[j].y * v[j].y) + (v[j].z * v[j].z + v[j].w * v[j].w); }
        const float rstd = 1.0f / sqrtf(wave_sum(s2) * (1.0f / 1024.0f) + EPS);
        bf16_t* orow = Obase + (size_t)rr * (CONF_FP8 ? DM / 2 : DM);
#pragma unroll
        for (int h = 0; h < 2; ++h) { const int c = 8 * F.lane + 512 * h;
            f32x4 y0 = v[2 * h] * rstd * *(const f32x4*)(F.in[I_CVLNG] + c) + *(const f32x4*)(F.in[I_CVLNB] + c), y1 = v[2 * h + 1] * rstd * *(const f32x4*)(F.in[I_CVLNG] + c + 4) + *(const f32x4*)(F.in[I_CVLNB] + c + 4);
#pragma unroll
            for (int e = 0; e < 4; ++e) { y0[e] = silu_f(y0[e]); y1[e] = silu_f(y1[e]); }
            if (CONF_FP8) { int p0 = 0, p1 = 0; p0 = __builtin_amdgcn_cvt_pk_fp8_f32(y0[0], y0[1], p0, false); p0 = __builtin_amdgcn_cvt_pk_fp8_f32(y0[2], y0[3], p0, true);
                p1 = __builtin_amdgcn_cvt_pk_fp8_f32(y1[0], y1[1], p1, false); p1 = __builtin_amdgcn_cvt_pk_fp8_f32(y1[2], y1[3], p1, true); *(u32x2*)((unsigned char*)orow + c) = (u32x2){(unsigned)p0, (unsigned)p1}; }
            else { u32x4 pk; pk.x = cvt_pk_bf16(y0[0], y0[1]); pk.y = cvt_pk_bf16(y0[2], y0[3]); pk.z = cvt_pk_bf16(y1[0], y1[1]); pk.w = cvt_pk_bf16(y1[2], y1[3]); *(u32x4*)(orow + c) = pk; } } }
}
__device__ __forceinline__ void conv_half_issue(Frame& F, const bf16_t* Abatch, int t0, int s1, LAS unsigned char* dst) {
    const char* zrow = (const char*)(F.ws + WS_CTL + 512 * 1024);
#pragma unroll
    for (int i = 0; i < 4; ++i) { const int p = F.tid + 512 * i, row = p >> 7, chn = p & 127; const int t = t0 - 15 + s1 + row;
        const char* src = (t >= 0 && t < SEQ) ? (const char*)(Abatch + (size_t)t * DM) + 16 * chn : zrow + 16 * chn;
        __builtin_amdgcn_global_load_lds((const unsigned*)src, (LAS unsigned*)(dst + i * 8192 + F.wave * 1024), 16, 0, 0); }
}
__device__ __forceinline__ void conv_ln_phase(Frame& F) {
    LAS unsigned char* stA = F.lds; LAS unsigned char* stB = F.lds + 32768; LAS bf16_t* tile = (LAS bf16_t*)(F.lds + CV_TILE);
    const bf16_t* A = (const bf16_t*)(F.ws + WS_GLU); bf16_t* O = (bf16_t*)(F.ws + WS_BUF0);
    const int ch = 2 * F.tid;
    f32x2 w[31];
#pragma unroll
    for (int k = 0; k < 31; ++k) w[k] = *(const f32x2*)(F.in[I_CVDWW] + k * 1024 + ch);
    const f32x2 bias = *(const f32x2*)(F.in[I_CVDWB] + ch);
    for (int blk = F.bid; blk < 256; blk += F.G) {
        const int b = blk >> 5, t0 = (blk & 31) * 128;
        const bf16_t* Ab = A + (size_t)b * SEQ * DM;
        f32x2 acc[32];
#pragma unroll
        for (int i = 0; i < 32; ++i) acc[i] = (f32x2){0.f, 0.f};
        __syncthreads();
        conv_half_issue(F, Ab, t0, 0, stA); conv_half_issue(F, Ab, t0, 16, stB);
#pragma unroll 1
        for (int s0 = 0; s0 < 160; s0 += 32) {
#define CV_STEP(SS) { conv_step<SS>(acc, w, bias, *(const LAS unsigned*)((SS < 16 ? stA : stB) + (SS & 15) * 2048 + 2 * ch)); const int o = s0 + SS - 30; \
                if (o >= 0 && o < 128) { const f32x2 r_ = acc[(SS + 2) & 31]; *(LAS unsigned*)(tile + ((SS + 2) & 31) * 1024 + ch) = cvt_pk_bf16(r_.x, r_.y); } \
                if (SS == 29 && o >= 0 && o < 128) { __syncthreads(); conv_ln_rows(F, tile, O + ((size_t)b * SEQ + t0 + (o - 31)) * (CONF_FP8 ? DM / 2 : DM)); __syncthreads(); } }
            VM_WAIT(); __syncthreads();
            CV_STEP(0) CV_STEP(1) CV_STEP(2) CV_STEP(3) CV_STEP(4) CV_STEP(5) CV_STEP(6) CV_STEP(7) CV_STEP(8) CV_STEP(9) CV_STEP(10) CV_STEP(11) CV_STEP(12) CV_STEP(13) CV_STEP(14) CV_STEP(15)
            __syncthreads();
            if (s0 + 32 < 160) conv_half_issue(F, Ab, t0, s0 + 32, stA);
            CV_STEP(16) CV_STEP(17) CV_STEP(18) CV_STEP(19) CV_STEP(20) CV_STEP(21) CV_STEP(22) CV_STEP(23) CV_STEP(24) CV_STEP(25) CV_STEP(26) CV_STEP(27) CV_STEP(28) CV_STEP(29) CV_STEP(30) CV_STEP(31)
            __syncthreads();
            if (s0 + 32 < 160) conv_half_issue(F, Ab, t0, s0 + 48, stB);
#undef CV_STEP
        }
    }
}
namespace att {
constexpr int KT = 64, NTILE = LKV / KT, ST_BYTES = 24576;
typedef short v4i16_t __attribute__((ext_vector_type(4)));

__device__ __forceinline__ f32x16 mfma32(bf16x8 a, bf16x8 b, f32x16 c) { return __builtin_amdgcn_mfma_f32_32x32x16_bf16(a, b, c, 0, 0, 0); }

__device__ __forceinline__ void attn_phase(Frame& F) {
    LAS unsigned char* lds = F.lds;
    const int l = F.lane, w = F.wave, tid = F.tid, r32 = l & 31, hi = l >> 5;
    const bf16_t* Qb = (const bf16_t*)(F.ws + WS_Q); const bf16_t* Kb = (const bf16_t*)(F.ws + WS_K); const bf16_t* Vb = (const bf16_t*)(F.ws + WS_V);
    bf16_t* Ob = (bf16_t*)(F.ws + WS_BUF0);
    const float lam = ((const float*)(F.ws + WS_TAB))[TB_LAM];
    const unsigned kbase_ = (unsigned)(r32 * 128), kx_ = (unsigned)((r32 >> 1) & 7);
    unsigned vbase_, vq4_;
    { const int g = l >> 4, i = l & 15, q4 = i >> 2, p4 = i & 3; const int row = 4 * (g >> 1) + q4;
      const int lowch = (2 * (g & 1) + (p4 >> 1)) ^ ((row >> 2) & 3);
      vbase_ = (unsigned)(8192 + row * 256 + (lowch << 4) + 8 * (p4 & 1)); vq4_ = (unsigned)q4; }
#define ATT_ISSUE(st, kv0) do { const size_t _ro = (size_t)(kv0) * 1024; int t_ = tid; asm volatile("" : "+v"(t_)); \
        const int krow = t_ >> 3; const unsigned ksrc = (unsigned)(krow * 1024 + (((t_ & 7) ^ ((krow >> 1) & 7)) << 4)); unsigned vsrc[2]; \
        _Pragma("unroll") for (int i_ = 0; i_ < 2; ++i_) { const int p = t_ + 512 * i_, vrow = p >> 4; vsrc[i_] = (unsigned)(vrow * 1024 + (((p & 15) ^ (((vrow & 3) << 2) | ((vrow >> 2) & 3))) << 4)); } \
        __builtin_amdgcn_global_load_lds((const unsigned*)(Kg + _ro + ksrc), (LAS unsigned*)(lds + (st) * ST_BYTES + w * 1024), 16, 0, 0); \
        __builtin_amdgcn_global_load_lds((const unsigned*)(Vg + _ro + vsrc[0]), (LAS unsigned*)(lds + (st) * ST_BYTES + 8192 + w * 1024), 16, 0, 0); \
        __builtin_amdgcn_global_load_lds((const unsigned*)(Vg + _ro + vsrc[1]), (LAS unsigned*)(lds + (st) * ST_BYTES + 16384 + w * 1024), 16, 0, 0); } while (0)

    for (int it = 0;; ++it) {
        int grp, qb;
        if (F.G == 256) { const int x = F.bid & 7, j = F.bid >> 3; if (it >= 2) break; grp = x * 4 + it * 2 + (j >> 4); qb = j & 15; }
        else { const int un = it * F.G + F.bid; if (un >= 512) break; grp = un >> 4; qb = un & 15; }
        const int b = grp >> 2, hp = grp & 3;
        const bf16_t* Qg = Qb + ((size_t)b * SEQ + qb * 256 + w * 32 + r32) * 512;
        const char* Vg = (const char*)(Vb + (size_t)b * LKV * 512 + hp * 128);
        f32x16 o1[4];
#pragma unroll 1
        for (int s = 0; s < 2; ++s) {
            const char* Kg = (const char*)(Kb + (size_t)b * LKV * 512 + (2 * hp + s) * 64);
            bf16x8 qf[4];
#pragma unroll
            for (int ds = 0; ds < 4; ++ds) qf[ds] = *(const bf16x8*)(Qg + (2 * hp + s) * 64 + ds * 16 + hi * 8);
            f32x16 O[4];
#pragma unroll
            for (int d = 0; d < 4; ++d)
#pragma unroll
                for (int r = 0; r < 16; ++r) O[d][r] = 0.f;
            float m = 0.f, lsum = 0.f;
            __syncthreads();
            ATT_ISSUE(0, 0);
#pragma unroll 1
            for (int j = 0; j < NTILE; ++j) {
                VM_WAIT(); __syncthreads();
                if (j + 1 < NTILE) ATT_ISSUE((j + 1) & 1, (j + 1) * KT);
                const LAS unsigned char* Ks = lds + (j & 1) * ST_BYTES;
                unsigned kbase = kbase_, kx = kx_, vbase = vbase_, vq4 = vq4_; asm volatile("" : "+v"(kbase), "+v"(kx), "+v"(vbase), "+v"(vq4));
                f32x16 p0, p1;
#pragma unroll
                for (int r = 0; r < 16; ++r) { p0[r] = 0.f; p1[r] = 0.f; }
#pragma unroll
                for (int ds = 0; ds < 4; ++ds) { const unsigned ka = kbase + ((((unsigned)(2 * ds + hi)) ^ kx) << 4); const bf16x8 k0 = *(const LAS bf16x8*)(Ks + ka), k1 = *(const LAS bf16x8*)(Ks + ka + 4096);
                    p0 = mfma32(k0, qf[ds], p0); p1 = mfma32(k1, qf[ds], p1); }
                if (j == 0) { float mx0 = fmaxf(p0[0], p1[0]);
#pragma unroll
                    for (int r = 1; r < 16; ++r) mx0 = fmaxf(mx0, fmaxf(p0[r], p1[r]));
                    m = fmaxf(mx0, __shfl_xor(mx0, 32)); }
                f32x2 e0[8], e1[8];
                { const f32x2 mm = (f32x2){m, m};
#pragma unroll
                  for (int r = 0; r < 8; ++r) { e0[r] = (f32x2){p0[2 * r], p0[2 * r + 1]} - mm; e1[r] = (f32x2){p1[2 * r], p1[2 * r + 1]} - mm; } }
                float mx = fmaxf(fmaxf(e0[0].x, e0[0].y), fmaxf(e1[0].x, e1[0].y));
#pragma unroll
                for (int r = 1; r < 8; ++r) { mx = fmaxf(fmaxf(mx, e0[r].x), e0[r].y); mx = fmaxf(fmaxf(mx, e1[r].x), e1[r].y); }
                mx = fmaxf(mx, __shfl_xor(mx, 32));
                if (!__all(mx <= 8.0f)) { const float dl = fmaxf(mx, 0.f), alpha = __builtin_amdgcn_exp2f(-dl);
#pragma unroll
                    for (int d = 0; d < 4; ++d) O[d] = O[d] * alpha;
                    lsum *= alpha; m += dl; const f32x2 dd = (f32x2){dl, dl};
#pragma unroll
                    for (int r = 0; r < 8; ++r) { e0[r] -= dd; e1[r] -= dd; } }
                { f32x2 acc = (f32x2){0.f, 0.f};
#pragma unroll
                  for (int r = 0; r < 8; ++r) { e0[r] = (f32x2){__builtin_amdgcn_exp2f(e0[r].x), __builtin_amdgcn_exp2f(e0[r].y)}; e1[r] = (f32x2){__builtin_amdgcn_exp2f(e1[r].x), __builtin_amdgcn_exp2f(e1[r].y)};
                      acc += e0[r] + e1[r]; }
                  lsum += acc.x + acc.y; }
                bf16x8 pb[4];
#pragma unroll
                for (int q = 0; q < 2; ++q) { u32x4 a, c;
                    a.x = cvt_pk_bf16(e0[4 * q + 0].x, e0[4 * q + 0].y); a.y = cvt_pk_bf16(e0[4 * q + 1].x, e0[4 * q + 1].y); a.z = cvt_pk_bf16(e0[4 * q + 2].x, e0[4 * q + 2].y); a.w = cvt_pk_bf16(e0[4 * q + 3].x, e0[4 * q + 3].y);
                    c.x = cvt_pk_bf16(e1[4 * q + 0].x, e1[4 * q + 0].y); c.y = cvt_pk_bf16(e1[4 * q + 1].x, e1[4 * q + 1].y); c.z = cvt_pk_bf16(e1[4 * q + 2].x, e1[4 * q + 2].y); c.w = cvt_pk_bf16(e1[4 * q + 3].x, e1[4 * q + 3].y);
                    pb[q] = __builtin_bit_cast(bf16x8, a); pb[2 + q] = __builtin_bit_cast(bf16x8, c); }
#pragma unroll
                for (int d = 0; d < 4; ++d) {
                    const unsigned va0 = vbase + ((((unsigned)d) ^ vq4) << 6), va1 = (va0 ^ 32u) + 2048u;
#pragma unroll
                    for (int kv = 0; kv < 4; ++kv) {
                        const v4i16_t lo = __builtin_amdgcn_ds_read_tr16_b64_v4i16((LAS v4i16_t*)(Ks + va0 + kv * 4096));
                        const v4i16_t hh = __builtin_amdgcn_ds_read_tr16_b64_v4i16((LAS v4i16_t*)(Ks + va1 + kv * 4096));
                        const bf16x8 vf = (bf16x8){lo[0], lo[1], lo[2], lo[3], hh[0], hh[1], hh[2], hh[3]};
                        O[d] = mfma32(vf, pb[kv], O[d]); } }
            }
            const float lt = lsum + __shfl_xor(lsum, 32);
            if (s == 0) { const float inv = 1.0f / lt;
#pragma unroll
                for (int d = 0; d < 4; ++d) o1[d] = O[d] * inv; }
            else { const float inv = lam / lt; float ss = 0.f;
#pragma unroll
                for (int d = 0; d < 4; ++d) { o1[d] = o1[d] - O[d] * inv;
#pragma unroll
                    for (int r = 0; r < 16; ++r) ss += o1[d][r] * o1[d][r]; }
                ss += __shfl_xor(ss, 32);
                const float rn = 0.8f / sqrtf(ss * (1.0f / 128.0f) + EPS);
                bf16_t* orow = Ob + ((size_t)b * SEQ + qb * 256 + w * 32 + r32) * DM + hp * 128 + 4 * hi;
#pragma unroll
                for (int d = 0; d < 4; ++d)
#pragma unroll
                    for (int q = 0; q < 4; ++q) { const f32x4 g4 = *(const f32x4*)(F.in[I_SUBLN] + 32 * d + 8 * q + 4 * hi);
                        u32x2 pk; pk.x = cvt_pk_bf16(o1[d][4 * q] * rn * g4[0], o1[d][4 * q + 1] * rn * g4[1]); pk.y = cvt_pk_bf16(o1[d][4 * q + 2] * rn * g4[2], o1[d][4 * q + 3] * rn * g4[3]);
                        *(u32x2*)(orow + 32 * d + 8 * q) = pk; }
            }
        }
    }
#undef ATT_ISSUE
}
}
namespace hy {
constexpr int FBUF = 4352 * 8;
constexpr int KOFF = 2 * FBUF;
constexpr int KLEN = 2192;
constexpr int RED_OFF = KOFF + 4 * KLEN * 8;
__device__ __forceinline__ int pad(int i) { return i + (i >> 4); }
__device__ __forceinline__ float sgpr_f(float v) { return __int_as_float(__builtin_amdgcn_readfirstlane(__float_as_int(v))); }
typedef f32x2 cx;
#ifndef HY_ASM
#define HY_ASM 3
#endif
#if HY_ASM & 1
__device__ __forceinline__ void c_mul_ip(cx& x, cx w) { cx t;
    asm("v_pk_mul_f32 %1, %0, %2 op_sel_hi:[0,1]\n\tv_pk_fma_f32 %0, %0, %2, %1 op_sel:[1,1,0] op_sel_hi:[1,0,1] neg_lo:[1,0,0]" : "+v"(x), "=&v"(t) : "v"(w)); }
__device__ __forceinline__ cx c_mul(cx x, cx w) { c_mul_ip(x, w); return x; }
__device__ __forceinline__ void c_mul_sw_ip(cx& x, cx w) { cx t;
    asm("v_pk_mul_f32 %1, %0, %2 op_sel:[0,1] op_sel_hi:[0,0]\n\tv_pk_fma_f32 %0, %0, %2, %1 op_sel:[1,0,0] op_sel_hi:[1,1,1] neg_hi:[1,0,0]" : "+v"(x), "=&v"(t) : "v"(w)); }
__device__ __forceinline__ void c_mul_swc_ip(cx& x, cx w) { cx t;
    asm("v_pk_mul_f32 %1, %0, %2 op_sel:[0,1] op_sel_hi:[0,0]\n\tv_pk_fma_f32 %0, %0, %2, %1 op_sel:[1,0,0] op_sel_hi:[1,1,1] neg_lo:[0,0,1]" : "+v"(x), "=&v"(t) : "v"(w)); }
__device__ __forceinline__ void c_mul_k_ip(cx& x, cx w) { cx t;
    asm("v_pk_mul_f32 %1, %0, %2 op_sel_hi:[0,1]\n\tv_pk_fma_f32 %0, %0, %2, %1 op_sel:[1,1,0] op_sel_hi:[1,0,1] neg_lo:[1,0,0]" : "+v"(x), "=&v"(t) : "s"(w)); }
#else
__device__ __forceinline__ cx c_mul(cx x, cx w) { return (cx){x.x, x.x} * w + (cx){-x.y, x.y} * (cx){w.y, w.x}; }
__device__ __forceinline__ void c_mul_ip(cx& x, cx w) { x = c_mul(x, w); }
__device__ __forceinline__ void c_mul_k_ip(cx& x, cx w) { x = c_mul(x, w); }
__device__ __forceinline__ void c_mul_sw_ip(cx& x, cx w) { x = (cx){x.x, x.x} * (cx){w.y, w.x} + (cx){x.y, -x.y} * w; }
__device__ __forceinline__ void c_mul_swc_ip(cx& x, cx w) { c_mul_sw_ip(x, (cx){w.x, -w.y}); }
#endif
#if HY_ASM & 2
__device__ __forceinline__ cx c_mi(cx a, cx b) { cx d; asm("v_pk_add_f32 %0, %1, %2 op_sel:[0,1] op_sel_hi:[1,0] neg_hi:[0,1]" : "=v"(d) : "v"(a), "v"(b)); return d; }
__device__ __forceinline__ cx c_pi(cx a, cx b) { cx d; asm("v_pk_add_f32 %0, %1, %2 op_sel:[0,1] op_sel_hi:[1,0] neg_lo:[0,1]" : "=v"(d) : "v"(a), "v"(b)); return d; }
#else
__device__ __forceinline__ cx c_mi(cx a, cx b) { return a + (cx){b.y, -b.x}; }
__device__ __forceinline__ cx c_pi(cx a, cx b) { return a + (cx){-b.y, b.x}; }
#endif

__device__ __forceinline__ void dft4(cx& a, cx& b, cx& c, cx& d) {
    const cx s0 = a + c, d0 = a - c, s1 = b + d, d1 = b - d;
    a = s0 + s1; c = s0 - s1; b = c_mi(d0, d1); d = c_pi(d0, d1);
}
__device__ __forceinline__ void dft4_rc(cx& a, cx& b, cx& c, cx& d) {
    const cx s0 = c_mi(a, c), d0 = c_pi(a, c), s1 = b + d, d1 = b - d;
    a = s0 + s1; c = s0 - s1; b = c_mi(d0, d1); d = c_pi(d0, d1);
}
__device__ __forceinline__ void dft16(cx (&x)[16]) {
    constexpr float C1 = 0.9238795325112867f, S1 = 0.3826834323650898f, R = 0.7071067811865476f;
#pragma unroll
    for (int b = 0; b < 4; ++b) dft4(x[b], x[4 + b], x[8 + b], x[12 + b]);
    c_mul_k_ip(x[5], (cx){C1, -S1}); c_mul_k_ip(x[6], (cx){R, -R}); c_mul_k_ip(x[7], (cx){S1, -C1});
    c_mul_k_ip(x[9], (cx){R, -R});   c_mul_k_ip(x[11], (cx){-R, -R});
    c_mul_k_ip(x[13], (cx){S1, -C1}); c_mul_k_ip(x[14], (cx){-R, -R}); c_mul_k_ip(x[15], (cx){-C1, S1});
#pragma unroll
    for (int c = 0; c < 4; ++c) { if (c == 2) dft4_rc(x[8], x[9], x[10], x[11]); else dft4(x[4 * c], x[4 * c + 1], x[4 * c + 2], x[4 * c + 3]); }
    cx y[16];
#pragma unroll
    for (int k = 0; k < 16; ++k) y[k] = x[4 * (k & 3) + (k >> 2)];
#pragma unroll
    for (int k = 0; k < 16; ++k) x[k] = y[k];
}
__device__ __forceinline__ void twiddle_pow(cx (&x)[16], cx w) {
    cx p[16]; p[1] = w;
#pragma unroll
    for (int n = 2; n < 16; ++n) { const int a = n >> 1, b = n - a; p[n] = c_mul(p[a], p[b]); }
#pragma unroll
    for (int n = 1; n < 16; ++n) c_mul_ip(x[n], p[n]);
}
__device__ __forceinline__ void fft4096(cx (&x)[16], LAS f32x2* buf, int uw, int u, const cx w2, const cx w3) {
    dft16(x);
    { LAS f32x2* p = buf + pad(uw);
#pragma unroll
      for (int k = 0; k < 16; ++k) p[272 * k] = x[k]; }
    __syncthreads();
    { LAS f32x2* p = buf + 272 * (u >> 4) + (u & 15);
#pragma unroll
      for (int n = 0; n < 16; ++n) x[n] = p[17 * n];
      twiddle_pow(x, w2);
      dft16(x);
#pragma unroll
      for (int k = 0; k < 16; ++k) p[17 * k] = x[k]; }
    __syncthreads();
    { const LAS f32x2* p = buf + 272 * (u >> 4) + 17 * (u & 15);
#pragma unroll
      for (int n = 0; n < 16; ++n) x[n] = p[n];
      twiddle_pow(x, w3);
      dft16(x); }
}
__device__ __forceinline__ void twiddle_w8192(cx (&x)[16], cx base, bool conj) {
    constexpr float C = 0.9807852804032304f, S = 0.1950903220161283f;
    cx w = conj ? (cx){base.x, -base.y} : base; const cx st = (cx){C, conj ? S : -S};
#pragma unroll
    for (int n = 0; n < 16; ++n) { c_mul_ip(x[n], w); c_mul_ip(w, st); }
}
struct SRow { u32x4 raw; bf16_t l, r; };
__device__ __forceinline__ void sconv_load(const bf16_t* row, int t0, SRow& R) {
    R.raw = *(const u32x4*)(row + t0); R.l = row[t0 > 0 ? t0 - 1 : 0]; R.r = row[t0 + 8 < SEQ ? t0 + 8 : SEQ - 1];
}
__device__ __forceinline__ void sconv_apply(const SRow& R, int t0, const f32x4 wb  , float (&out)[8]) {
    float x[10]; x[0] = t0 > 0 ? bf2f(R.l) : 0.f; x[9] = t0 + 8 < SEQ ? bf2f(R.r) : 0.f;
    x[1] = bflo(R.raw.x); x[2] = bfhi(R.raw.x); x[3] = bflo(R.raw.y); x[4] = bfhi(R.raw.y); x[5] = bflo(R.raw.z); x[6] = bfhi(R.raw.z); x[7] = bflo(R.raw.w); x[8] = bfhi(R.raw.w);
#pragma unroll
    for (int i = 0; i < 8; ++i) out[i] = wb[3] + wb[0] * x[i] + wb[1] * x[i + 1] + wb[2] * x[i + 2];
}

__device__ __forceinline__ void hyena_phase(Frame& F) {
    LAS f32x2* FB0 = (LAS f32x2*)F.lds; LAS f32x2* FB1 = (LAS f32x2*)(F.lds + FBUF);
    LAS f32x2* KH = (LAS f32x2*)(F.lds + KOFF);
    LAS float* red = (LAS float*)(F.lds + RED_OFF);
    const int tid = F.tid, half = tid >> 8, u_ = tid & 255, u1_ = (u_ >> 4) + 16 * (u_ & 15);
    LAS f32x2* myF = half ? FB1 : FB0;
    const float* tab = (const float*)(F.ws + WS_TAB);
    const f32x2* T4096 = (const f32x2*)(tab + TB_T4096); const f32x2* T8A = (const f32x2*)(tab + TB_T8A); const f32x2* T8B = (const f32x2*)(tab + TB_T8B);
#define HY_W8192(dst, idx) f32x2 dst; { const f32x2 a_ = T8A[(idx) & 63], b_ = T8B[(idx) >> 6]; dst = (f32x2){a_.x * b_.x - a_.y * b_.y, a_.x * b_.y + a_.y * b_.x}; }
    const cx tw2 = T4096[16 * (u_ >> 4)], tw3 = T4096[(u_ >> 4) + 16 * (u_ & 15)];
    HY_W8192(twu, u_); HY_W8192(twu1, u1_);
    const float* kraw = (const float*)(F.ws + WS_KRAW);
    const bf16_t* UT = (const bf16_t*)(F.ws + WS_UT); bf16_t* OBT = (bf16_t*)(F.ws + WS_OBT);
    const int j0 = 8 * tid, jp = 8 * tid + (tid >> 1);
    for (int c = F.bid; c < 512; c += F.G) {
        f32x4 wS[3];
#pragma unroll
        for (int s3 = 0; s3 < 3; ++s3) { const float* swp = F.in[I_HYSW] + 512 * s3 + c; wS[s3] = (f32x4){sgpr_f(swp[0]), sgpr_f(swp[1536]), sgpr_f(swp[3072]), sgpr_f(F.in[I_HYSB][512 * s3 + c])}; }
        const float bias0 = sgpr_f(F.in[I_HYBIAS][c]), bias1 = sgpr_f(F.in[I_HYBIAS][512 + c]);
        __syncthreads();
        { float an[2];
#pragma unroll
          for (int o = 0; o < 2; ++o) { const float* fw = kraw + (size_t)(1024 * o + c) * 4096; const float* bw = kraw + (size_t)(1024 * o + 512 + c) * 4096;
              float f[8], g[8];
              { const f32x4 fa = *(const f32x4*)(fw + j0), fb = *(const f32x4*)(fw + j0 + 4);
                const f32x4 ga = *(const f32x4*)(bw + 4088 - j0), gb = *(const f32x4*)(bw + 4092 - j0);
                const float g0 = tid > 0 ? bw[4096 - j0] : 0.f;
                f[0] = fa[0]; f[1] = fa[1]; f[2] = fa[2]; f[3] = fa[3]; f[4] = fb[0]; f[5] = fb[1]; f[6] = fb[2]; f[7] = fb[3];
                g[0] = g0; g[1] = gb[3]; g[2] = gb[2]; g[3] = gb[1]; g[4] = gb[0]; g[5] = ga[3]; g[6] = ga[2]; g[7] = ga[1]; }
              float a = 0.f;
#pragma unroll
              for (int i = 0; i < 8; ++i) { a += fabsf(f[i]) + fabsf(g[i]);
                  ((LAS float*)(FB0 + jp + i))[o] = f[i] + g[i]; ((LAS float*)(FB1 + jp + i))[o] = f[i] - g[i]; }
              an[o] = wave_sum(a);
              asm volatile("" ::: "memory"); }
          if (F.lane == 0) { red[F.wave] = an[0]; red[8 + F.wave] = an[1]; } }
        __syncthreads();
        float nrm0 = 0.f, nrm1 = 0.f;
#pragma unroll
        for (int i = 0; i < 8; ++i) { nrm0 += red[i]; nrm1 += red[8 + i]; }
        const float sc0 = 1.0f / (nrm0 * 8192.0f), sc1 = 1.0f / (nrm1 * 8192.0f);
        cx x[16];
        { int u = u_, u1 = u1_; asm volatile("" : "+v"(u), "+v"(u1));
#pragma unroll
        for (int n = 0; n < 16; ++n) x[n] = (myF + pad(u))[272 * n];
        __syncthreads();
        if (half) twiddle_w8192(x, twu, false);
        fft4096(x, myF, u, u, tw2, tw3);
        __syncthreads();
#pragma unroll
        for (int k = 0; k < 16; ++k) (myF + pad(u1))[272 * k] = x[k]; }
        __syncthreads();
        for (int kk = tid; kk < 2049; kk += 512) {
            { const f32x2 A = FB0[pad(kk)]; f32x2 B = FB0[pad((4096 - kk) & 4095)]; B.y = -B.y;
              KH[0 * KLEN + pad(kk)] = (f32x2){(A.x + B.x) * 0.5f * sc0, (A.y + B.y) * 0.5f * sc0};
              KH[2 * KLEN + pad(kk)] = (f32x2){(A.y - B.y) * 0.5f * sc1, -(A.x - B.x) * 0.5f * sc1}; }
            if (kk < 2048) { const f32x2 A = FB1[pad(kk)]; f32x2 B = FB1[pad(4095 - kk)]; B.y = -B.y;
              KH[1 * KLEN + pad(kk)] = (f32x2){(A.x + B.x) * 0.5f * sc0, (A.y + B.y) * 0.5f * sc0};
              KH[3 * KLEN + pad(kk)] = (f32x2){(A.y - B.y) * 0.5f * sc1, -(A.x - B.x) * 0.5f * sc1}; }
        }
        __syncthreads();
        SRow pv0, pv1, pa0, pa1;
        { const bf16_t* vr = UT + (size_t)c * NTOK; sconv_load(vr, j0, pv0); sconv_load(vr + SEQ, j0, pv1); }
#pragma unroll 1
        for (int bp = 0; bp < 4; ++bp) {
            const size_t rb = (size_t)(2 * bp) * SEQ;
            float zr[8], zi[8], vre[8], vim[8];
            sconv_apply(pv0, j0, wS[0], vre); sconv_apply(pv1, j0, wS[0], vim);
#pragma unroll
            for (int i = 0; i < 8; ++i) (FB0 + jp)[i] = (f32x2){vre[i], vim[i]};
            { const bf16_t* x1r = UT + (size_t)(512 + c) * NTOK + rb; sconv_load(x1r, j0, pa0); sconv_load(x1r + SEQ, j0, pa1); }
            __syncthreads();
#pragma unroll 1
            for (int ord = 0; ord < 2; ++ord) {
                int u = u_, u1 = u1_; asm volatile("" : "+v"(u), "+v"(u1));
#pragma unroll
                for (int n = 0; n < 16; ++n) x[n] = (FB0 + pad(u))[272 * n];
                __syncthreads();
                if (half) twiddle_w8192(x, twu, false);
                fft4096(x, myF, u, u, tw2, tw3);
                { const LAS f32x2* Kp = KH + (2 * ord + half) * KLEN;
                  const LAS f32x2* pf = Kp + pad(u1); const LAS f32x2* pm = Kp + pad((half ? 4095 : 4096) - u1);
#pragma unroll
                  for (int n = 0; n < 8; ++n) c_mul_sw_ip(x[n], pf[272 * n]);
                  { const bool mir = half || u1 > 0; f32x2 kv = *(mir ? pm - 272 * 8 : pf + 272 * 8); if (mir) kv.y = -kv.y; c_mul_sw_ip(x[8], kv); }
#pragma unroll
                  for (int n = 9; n < 16; ++n) c_mul_swc_ip(x[n], *(pm - 272 * n)); }
                __syncthreads();
                fft4096(x, myF, u1, u, tw2, tw3);
                if (half) twiddle_w8192(x, twu1, false);
                __syncthreads();
#pragma unroll
                for (int k = 0; k < 16; ++k) (myF + pad(u1))[272 * k] = x[k];
                __syncthreads();
                if (ord == 0) {
                    { float a0[8];
                      sconv_apply(pa0, j0, wS[1], a0);
#pragma unroll
                      for (int i = 0; i < 8; ++i) { const f32x2 e = (FB0 + jp)[i], o = (FB1 + jp)[i]; zr[i] = a0[i] * (e.y + o.y + bias0 * vre[i]); zi[i] = e.x + o.x + bias0 * vim[i]; } }
                    { float a1[8];
                      sconv_apply(pa1, j0, wS[1], a1);
#pragma unroll
                      for (int i = 0; i < 8; ++i) zi[i] *= a1[i]; }
                    { const bf16_t* x2r = UT + (size_t)(1024 + c) * NTOK + rb; sconv_load(x2r, j0, pa0); sconv_load(x2r + SEQ, j0, pa1);
                      const bf16_t* vn = UT + (size_t)c * NTOK + (size_t)(2 * (bp < 3 ? bp + 1 : 3)) * SEQ; sconv_load(vn, j0, pv0); sconv_load(vn + SEQ, j0, pv1); }
                    __syncthreads();
#pragma unroll
                    for (int i = 0; i < 8; ++i) (FB0 + jp)[i] = (f32x2){zr[i], zi[i]};
                    __syncthreads();
                } else {
                    float a0[8], a1[8], r0[8], r1[8];
                    sconv_apply(pa0, j0, wS[2], a0); sconv_apply(pa1, j0, wS[2], a1);
#pragma unroll
                    for (int i = 0; i < 8; ++i) { const f32x2 e = (FB0 + jp)[i], o = (FB1 + jp)[i];
                        r0[i] = a0[i] * (e.y + o.y + bias1 * zr[i]); r1[i] = a1[i] * (e.x + o.x + bias1 * zi[i]); }
                    u32x4 p0, p1;
                    p0.x = cvt_pk_bf16(r0[0], r0[1]); p0.y = cvt_pk_bf16(r0[2], r0[3]); p0.z = cvt_pk_bf16(r0[4], r0[5]); p0.w = cvt_pk_bf16(r0[6], r0[7]);
                    p1.x = cvt_pk_bf16(r1[0], r1[1]); p1.y = cvt_pk_bf16(r1[2], r1[3]); p1.z = cvt_pk_bf16(r1[4], r1[5]); p1.w = cvt_pk_bf16(r1[6], r1[7]);
                    *(u32x4*)(OBT + (size_t)c * NTOK + rb + j0) = p0; *(u32x4*)(OBT + (size_t)c * NTOK + rb + SEQ + j0) = p1;
                    __syncthreads();
                }
            }
        }
    }
}
#undef HY_W8192
}
template <bool GATH> struct MoeOrder {
    static constexpr bool GATHER = GATH;
    const LAS int* pref;
    int total, G, c, ncol, K;
    const char* A; const char* W; size_t wtile; const int* list;
    __device__ bool next(int i, pg8::Unit& u) const {
        const long L = (long)i * G + c; if (L >= total) return false;
        int id = (int)L; { const int q = total / 8, r = total % 8, xcd = id % 8, off = id / 8; id = (xcd < r ? xcd * (q + 1) : r * (q + 1) + (xcd - r) * q) + off; }
        const int rt = id / ncol, pn = id % ncol;
        int e = 0; while (e < 31 && pref[e + 1] <= rt) ++e;
        u.pm = rt; u.pn = pn; u.aux = e;
        u.a = GATH ? A : A + (size_t)rt * 256 * K * 2; u.b = W + (size_t)e * 3 * MiB + (size_t)pn * wtile;
        return true;
    }
    __device__ __forceinline__ void gather(const pg8::Unit& u, int R0, int R1, unsigned (&v)[2][2]) const {
        const int e = u.aux, j = u.pm - pref[e], cnt = pref[40 + e];
#pragma unroll
        for (int h = 0; h < 2; ++h)
#pragma unroll
            for (int i = 0; i < 2; ++i) { int r = j * 256 + h * 128 + (i ? R1 : R0); r = r < cnt ? r : 0; v[h][i] = (unsigned)(list[e * 32768 + r] >> 1) * (unsigned)(K * 2); }
    }
};

#ifndef MK_PER_PHASE
#define MK_PER_PHASE 0
#endif
constexpr int N_PHASES = 17;

__global__ void __launch_bounds__(NTHREADS, 2) fwd_kernel(Args args) {
    extern __shared__ __attribute__((aligned(16))) unsigned char lds_[];
    const int wave0_ = __builtin_amdgcn_readfirstlane((int)threadIdx.x >> 6);
#define MKFRAME(F) Frame F; { int t_ = wave0_ * 64 + (int)__builtin_amdgcn_mbcnt_hi(~0u, __builtin_amdgcn_mbcnt_lo(~0u, 0u)); asm volatile("" : "+v"(t_)); F.lds = (LAS unsigned char*)lds_; F.tid = t_; F.lane = t_ & 63; F.wave = __builtin_amdgcn_readfirstlane(t_ >> 6); \
        F.G = gridDim.x; F.bid = blockIdx.x; F.in = args.in; F.out = args.out; F.ws = args.ws; }
    volatile LAS unsigned* MISC = (volatile LAS unsigned*)((LAS unsigned char*)lds_ + MISC_OFF);
    if (threadIdx.x < 128) MISC[threadIdx.x] = 0u;
    __syncthreads();
    unsigned* ctl = (unsigned*)(args.ws + WS_CTL);
#define lo (args.ph_lo)
#define hi (args.ph_hi)
    if (hi - lo > 1) (void)xcd_barrier_post(ctl + CW_BAR, MISC, threadIdx.x == 0);
#ifndef PH_MASK
#define PH_MASK 0xFFFFFFFFu
#endif
#define IN(k) (lo <= (k) && (k) < hi)
#ifndef DUP_PHASE
#define DUP_PHASE -1
#endif
#define REP(k) _Pragma("unroll") for (int rep_ = 0; rep_ < ((DUP_PHASE) == (k) ? 2 : 1); ++rep_)
#ifdef TPROBE
    const unsigned long long t_start_ = __builtin_amdgcn_s_memrealtime(); unsigned long long t_mark_ = 0ull;
#define TMARK(k) do { if ((k) == (TPROBE)) t_mark_ = __builtin_amdgcn_s_memrealtime() - t_start_; } while (0)
#else
#define TMARK(k) do { } while (0)
#endif
#define SEAM(k) do { if (IN(k) && IN((k) + 1)) { XcdBarrier bar_; bar_.bar = (unsigned*)(args.ws + WS_CTL) + CW_BAR; bar_.x = xb_xcc_id(); bar_.st = (volatile LAS unsigned*)((LAS unsigned char*)lds_ + MISC_OFF); \
        xcd_barrier(bar_, wave0_ == 0 && __builtin_amdgcn_mbcnt_hi(~0u, __builtin_amdgcn_mbcnt_lo(~0u, 0u)) == 0u); } TMARK(k); } while (0)
#define WSP (args.ws)
#define mod0 ((const float*)(args.ws + WS_MOD))
#define mod1 (mod0 + 9 * 6144)
#define tab ((const float*)(args.ws + WS_TAB))

    if (IN(0)) { MKFRAME(F); p0_prologue(F, (unsigned*)(args.ws + WS_CTL) + CW_Q0, (volatile LAS unsigned*)((LAS unsigned char*)lds_ + MISC_OFF) + 4); }
    SEAM(0);
    if (IN(1)) REP(1) { MKFRAME(F); p1_norm_in(F); }
    SEAM(1);
    if (IN(2)) REP(2) { MKFRAME(F);
        { pg8::StaticOrder S; S.init(WSP + WS_BUF0, WSP + WS_WQKVH, NTOK, 1536, 1024, F.G, F.bid);
          pg8::EpiQKV E{(bf16_t*)(WSP + WS_Q), (bf16_t*)(WSP + WS_K), (bf16_t*)(WSP + WS_V), tab + TB_ROPE_C, tab + TB_ROPE_S};
          pg8::gemm_phase(F.lds, F.tid, 1024, S, E); }
        { pg8::StaticOrder S; S.init(WSP + WS_WQKVH + (size_t)1536 * 1024 * 2, WSP + WS_BUF0, 1536, NTOK, 1024, F.G, F.bid);
          pg8::EpiBf16 E{(bf16_t*)(WSP + WS_UT), (size_t)NTOK};
          pg8::gemm_phase(F.lds, F.tid, 1024, S, E); }
        { pg8::StaticOrder S; S.init(WSP + WS_OBT, WSP + WS_WQKVH + (size_t)512 * 1024 * 2, NB * CTXL, 1024, 1024, F.G, F.bid);
          pg8::EpiCtxKV E{(bf16_t*)(WSP + WS_K), (bf16_t*)(WSP + WS_V)};
          pg8::gemm_phase(F.lds, F.tid, 1024, S, E); }
    }
    SEAM(2);
    if (IN(3)) {
#ifndef NO_ATTN
        { MKFRAME(F); att::attn_phase(F); } __syncthreads();
#ifdef DUP_ATTN
        { MKFRAME(F); att::attn_phase(F); } __syncthreads();
#endif
#else
        { MKFRAME(F); bf16_t* o = (bf16_t*)(F.ws + WS_BUF0); for (size_t i = (size_t)F.bid * NTHREADS + F.tid; i < (size_t)NTOK * 64; i += (size_t)F.G * NTHREADS) { const size_t r = i >> 6, c8 = i & 63; *(u32x4*)(o + r * DM + c8 * 8) = (u32x4){0u, 0u, 0u, 0u}; } }
#endif
#ifndef NO_HYENA
        { MKFRAME(F); hy::hyena_phase(F); }
#ifdef DUP_HYENA
        __syncthreads(); { MKFRAME(F); hy::hyena_phase(F); }
#endif
#else
        { MKFRAME(F); bf16_t* o = (bf16_t*)(F.ws + WS_OBT); for (size_t i = (size_t)F.bid * NTHREADS + F.tid; i < (size_t)512 * NTOK / 8; i += (size_t)F.G * NTHREADS) *(u32x4*)(o + i * 8) = (u32x4){0u, 0u, 0u, 0u}; }
#endif
    }
    SEAM(3);
    if (IN(4)) REP(4) { MKFRAME(F); transpose_ob(F); }
    SEAM(4);
    if (IN(5)) REP(5) { MKFRAME(F);
        pg8::StaticOrder S; S.init(WSP + WS_BUF0, WSP + WS_WO, NTOK, 1024, 1024, F.G, F.bid);
        pg8::EpiResid<true> E{F.in[I_X], (bf16_t*)(WSP + WS_X), mod0 + 2 * 1024, nullptr};
        pg8::gemm_phase(F.lds, F.tid, 1024, S, E);
    }
    SEAM(5);
        if (IN(6 + 0)) { MKFRAME(F); moe_front(F, 0); }
        SEAM(6 + 0);
        if (IN(6 + 1)) REP(9) { MKFRAME(F);
            moe_prefix(F, 0, (LAS int*)((LAS unsigned char*)lds_ + MISC_OFF + 64));
            MoeOrder<true> S; LAS int* pref = (LAS int*)((LAS unsigned char*)lds_ + MISC_OFF + 64); S.pref = pref; S.total = pref[32] * 4; S.G = F.G; S.c = F.bid; S.ncol = 4; S.K = 512;
            S.A = (const char*)(WSP + WS_BUF0); S.W = (const char*)(WSP + WS_WMOE + (size_t)0 * 32 * 3 * MiB); S.wtile = (size_t)256 * 512 * 2; S.list = (const int*)(WSP + WS_LIST);
            pg8::EpiGated<2> E{(bf16_t*)(WSP + WS_H), (size_t)512, nullptr, nullptr};
            pg8::gemm_phase<pg8::EpiGated<2>, MoeOrder<true>, true, 127, 122>(F.lds, F.tid, 512, S, E);
        }
        SEAM(6 + 1);
        if (IN(6 + 2)) REP(10) { MKFRAME(F);
            moe_prefix(F, 0, (LAS int*)((LAS unsigned char*)lds_ + MISC_OFF + 64));
            MoeOrder<false> S; LAS int* pref = (LAS int*)((LAS unsigned char*)lds_ + MISC_OFF + 64); S.pref = pref; S.total = pref[32] * 4; S.G = F.G; S.c = F.bid; S.ncol = 4; S.K = 256;
            S.A = (const char*)(WSP + WS_H); S.W = (const char*)(WSP + WS_WMOE + (size_t)0 * 32 * 3 * MiB + 2 * MiB); S.wtile = (size_t)256 * 256 * 2; S.list = nullptr;
            pg8::EpiScatter E{(bf16_t*)(WSP + WS_BUF0), (bf16_t*)(WSP + WS_Y1), (const int*)(WSP + WS_LIST), pref};
            pg8::gemm_phase<pg8::EpiScatter, MoeOrder<false>, true, 127, 122>(F.lds, F.tid, 256, S, E);
        }
        SEAM(6 + 2);
        if (IN(6 + 3)) {
            MKFRAME(F); moe_combine<0>(F, 0);
        }
        SEAM(6 + 3);

            if (IN(10)) REP(12) { MKFRAME(F);
                pg8::StaticOrder S; S.init(WSP + WS_BUF0, WSP + WS_WC1, NTOK, 2048, CONF_FP8 ? 512 : 1024, F.G, F.bid);
                pg8::EpiGated<1> E{(bf16_t*)(WSP + WS_GLU), (size_t)1024, F.in[I_CVB1], F.in[I_CVB1] + 1024};
                pg8::gemm_phase<pg8::EpiGated<1>, pg8::StaticOrder, CONF_FP8 != 0, 127, CONF_FP8 ? 122 : 127>(F.lds, F.tid, CONF_FP8 ? 512 : 1024, S, E);
            }
            SEAM(10);
            if (IN(11)) REP(13) { MKFRAME(F); conv_ln_phase(F); }
            SEAM(11);
            if (IN(12)) { MKFRAME(F);
                pg8::StaticOrder S; S.init(WSP + WS_BUF0, WSP + WS_WC2, NTOK, 1024, CONF_FP8 ? 512 : 1024, F.G, F.bid);
                pg8::EpiResid<false> E{WSP + WS_X, (bf16_t*)(WSP + WS_X), mod1 + 2 * 1024, F.in[I_CVB2]};
                pg8::gemm_phase<pg8::EpiResid<false>, pg8::StaticOrder, CONF_FP8 != 0, 127, CONF_FP8 ? 122 : 127>(F.lds, F.tid, CONF_FP8 ? 512 : 1024, S, E);
            }
            SEAM(12);
        if (IN(13 + 0)) { MKFRAME(F); moe_front(F, 1); }
        SEAM(13 + 0);
        if (IN(13 + 1)) REP(9) { MKFRAME(F);
            moe_prefix(F, 1, (LAS int*)((LAS unsigned char*)lds_ + MISC_OFF + 64));
            MoeOrder<true> S; LAS int* pref = (LAS int*)((LAS unsigned char*)lds_ + MISC_OFF + 64); S.pref = pref; S.total = pref[32] * 4; S.G = F.G; S.c = F.bid; S.ncol = 4; S.K = 512;
            S.A = (const char*)(WSP + WS_BUF0); S.W = (const char*)(WSP + WS_WMOE + (size_t)1 * 32 * 3 * MiB); S.wtile = (size_t)256 * 512 * 2; S.list = (const int*)(WSP + WS_LIST);
            pg8::EpiGated<2> E{(bf16_t*)(WSP + WS_H), (size_t)512, nullptr, nullptr};
            pg8::gemm_phase<pg8::EpiGated<2>, MoeOrder<true>, true, 127, 122>(F.lds, F.tid, 512, S, E);
        }
        SEAM(13 + 1);
        if (IN(13 + 2)) REP(10) { MKFRAME(F);
            moe_prefix(F, 1, (LAS int*)((LAS unsigned char*)lds_ + MISC_OFF + 64));
            MoeOrder<false> S; LAS int* pref = (LAS int*)((LAS unsigned char*)lds_ + MISC_OFF + 64); S.pref = pref; S.total = pref[32] * 4; S.G = F.G; S.c = F.bid; S.ncol = 4; S.K = 256;
            S.A = (const char*)(WSP + WS_H); S.W = (const char*)(WSP + WS_WMOE + (size_t)1 * 32 * 3 * MiB + 2 * MiB); S.wtile = (size_t)256 * 256 * 2; S.list = nullptr;
            pg8::EpiScatter E{(bf16_t*)(WSP + WS_BUF0), (bf16_t*)(WSP + WS_Y1), (const int*)(WSP + WS_LIST), pref};
            pg8::gemm_phase<pg8::EpiScatter, MoeOrder<false>, true, 127, 122>(F.lds, F.tid, 256, S, E);
        }
        SEAM(13 + 2);
        if (IN(13 + 3)) {
            MKFRAME(F); moe_combine<1>(F, 1);
        }

#ifdef TPROBE
    if (blockIdx.x == 0 && threadIdx.x == 0) { const unsigned long long t1 = __builtin_amdgcn_s_memrealtime(); while (__builtin_amdgcn_s_memrealtime() - t1 < 4ull * t_mark_) __builtin_amdgcn_s_sleep(8); }
#endif
#undef IN
#undef SEAM
#undef lo
#undef hi
#undef WSP
#undef mod0
#undef mod1
#undef tab
#undef MKFRAME
}

extern "C" void kernel_launch(void* const* d_in, const int* in_sizes, int n_in, void* d_out, int out_size, void* d_ws, size_t ws_size, hipStream_t stream) {
    static int grid = 0;
    if (grid == 0) {
        if (n_in != N_IN || out_size != NTOK * DM || ws_size < WS_END) { grid = -1; return; }
        int dev = 0, cus = 0, per_cu = 0;
        if (hipGetDevice(&dev) != hipSuccess || hipDeviceGetAttribute(&cus, hipDeviceAttributeMultiprocessorCount, dev) != hipSuccess) { grid = -1; return; }
        if (hipFuncSetAttribute((const void*)fwd_kernel, hipFuncAttributeMaxDynamicSharedMemorySize, LDS_BYTES) != hipSuccess) { grid = -1; return; }
        (void)hipOccupancyMaxActiveBlocksPerMultiprocessor(&per_cu, (const void*)fwd_kernel, NTHREADS, LDS_BYTES);
        (void)hipGetLastError();
        grid = cus;
    }
    if (grid < 0) return;
    (void)hipMemsetAsync((char*)d_ws + WS_CTL, 0, CTL_ZERO_BYTES, stream);
    Args a{};
    for (int i = 0; i < N_IN; ++i) a.in[i] = (const float*)d_in[i];
    a.out = (float*)d_out; a.ws = (unsigned char*)d_ws;
#if MK_PER_PHASE
    for (int p = 0; p < N_PHASES; ++p) { a.ph_lo = p; a.ph_hi = p + 1; hipLaunchKernelGGL(fwd_kernel, dim3(grid), dim3(NTHREADS), LDS_BYTES, stream, a); }
#else
    a.ph_lo = 0; a.ph_hi = N_PHASES;
    hipLaunchKernelGGL(fwd_kernel, dim3(grid), dim3(NTHREADS), LDS_BYTES, stream, a);
#endif
}
```

```cpp
#define CONF_FP8 0
#include <hip/hip_runtime.h>
#include <stdint.h>
#include <math.h>

#define LAS __attribute__((address_space(3)))
#define GAS __attribute__((address_space(1)))
typedef unsigned short bf16_t;
typedef short bf16x8 __attribute__((ext_vector_type(8)));
typedef short s16x4 __attribute__((ext_vector_type(4)));
typedef float f32x2 __attribute__((ext_vector_type(2)));
typedef float f32x4 __attribute__((ext_vector_type(4)));
typedef float f32x16 __attribute__((ext_vector_type(16)));
typedef unsigned u32x2 __attribute__((ext_vector_type(2)));
typedef unsigned u32x4 __attribute__((ext_vector_type(4)));

constexpr int DM = 1024, NB = 8, SEQ = 4096, NTOK = NB * SEQ, CTXL = 256, LKV = CTXL + SEQ;
constexpr int NEXP = 32, DEXP = 512, SLOT_ROWS = 73728;
constexpr float EPS = 1e-6f;
constexpr float QSCALE = 0.125f * 1.4426950408889634f;

constexpr size_t MiB = 1u << 20;
constexpr size_t WS_CTL = 0, CTL_ZERO_BYTES = 1 * MiB;
constexpr size_t WS_MOD = 1 * MiB;
constexpr size_t WS_TAB = 2 * MiB;
constexpr size_t WS_TOK = 3 * MiB;
constexpr size_t WS_LIST = 4 * MiB;
constexpr size_t WS_LOGIT = 8 * MiB;
constexpr size_t WS_KRAW = 16 * MiB;
constexpr size_t WS_WR = 48 * MiB;
constexpr size_t WS_WQKVH = 50 * MiB;
constexpr size_t WS_WO = 56 * MiB;
constexpr size_t WS_WC1 = 58 * MiB;
constexpr size_t WS_WC2 = 62 * MiB;
constexpr size_t WS_WMOE = 64 * MiB;
constexpr size_t WS_BUF0 = 256 * MiB;
constexpr size_t WS_Q = 320 * MiB;
constexpr size_t WS_K = 352 * MiB;
constexpr size_t WS_V = 386 * MiB;
constexpr size_t WS_UT = 420 * MiB;
constexpr size_t WS_OBT = 516 * MiB;
constexpr size_t WS_X = 320 * MiB;
constexpr size_t WS_H = 448 * MiB;
constexpr size_t WS_Y1 = 520 * MiB;
constexpr size_t WS_GLU = 448 * MiB;
constexpr size_t WS_END = 585 * MiB;

constexpr int CW_TMO = 0;
constexpr int CW_BAR = 4096;
constexpr int CW_Q0 = 2048;
constexpr int CW_CNT = 8192;
constexpr int TB_ROPE_C = 0, TB_ROPE_S = 1024, TB_T4096 = 2048  , TB_T8A = 2560  , TB_T8B = 2688  , TB_LAM = 2816;

constexpr int RING_BYTES = 131072;
constexpr int MISC_OFF = 144384;
constexpr int LDS_BYTES = 147456;
constexpr int NWAVES = 8, NTHREADS = 512;

#define RLX_AGENT __ATOMIC_RELAXED, __HIP_MEMORY_SCOPE_AGENT
#define LDS_WAIT() asm volatile("s_waitcnt lgkmcnt(0)" ::: "memory")
#define VM_WAIT() asm volatile("s_waitcnt vmcnt(0)" ::: "memory")

__device__ __forceinline__ unsigned cvt_pk_bf16(float lo, float hi) { unsigned r; asm volatile("v_cvt_pk_bf16_f32 %0, %1, %2" : "=v"(r) : "v"(lo), "v"(hi)); return r; }
__device__ __forceinline__ float bf2f(bf16_t v) { return __uint_as_float((unsigned)v << 16); }
__device__ __forceinline__ float bflo(unsigned v) { return __uint_as_float(v << 16); }
__device__ __forceinline__ float bfhi(unsigned v) { return __uint_as_float(v & 0xffff0000u); }
__device__ __forceinline__ float wave_sum(float v) {
#pragma unroll
    for (int o = 1; o < 64; o <<= 1) v += __shfl_xor(v, o);
    return v;
}
__device__ __forceinline__ float sigmoid_f(float v) { return __builtin_amdgcn_rcpf(1.0f + __builtin_amdgcn_exp2f(-1.4426950408889634f * v)); }
__device__ __forceinline__ float silu_f(float v) { return v * sigmoid_f(v); }

#define XB_TMO      128
#define XB_XCNT(j)  (256  + 64 * (j))
#define XB_XSUB(j)  (1280 + 64 * (j))
#define XB_XGEN(j)  (2304 + 64 * (j))
#define XB_TOP      3328
#define XB_TOPGEN   3392
#define XCD_BAR_WORDS 3456
#define XB_SPIN_CAP (1u << 20)

__device__ __forceinline__ unsigned xb_ld(unsigned* p)              { return __hip_atomic_load(p, __ATOMIC_RELAXED, __HIP_MEMORY_SCOPE_AGENT); }
__device__ __forceinline__ unsigned xb_add(unsigned* p, unsigned v) { return __hip_atomic_fetch_add(p, v, __ATOMIC_RELAXED, __HIP_MEMORY_SCOPE_AGENT); }
__device__ __forceinline__ unsigned xb_xcc_id() { return (unsigned)__builtin_amdgcn_s_getreg((3 << 11) | 20) & 0xFu; }
#define XB_SPIN(cond, bar) do { unsigned _sp = 0; while (cond) { __builtin_amdgcn_s_sleep(1); \
    if ((++_sp & 255u) == 0u) { if (xb_ld(&(bar)[XB_TMO])) break; if (_sp > XB_SPIN_CAP) { atomicAdd(&(bar)[XB_TMO], 1u); break; } } } } while (0)

struct XcdBarrier { unsigned* bar; unsigned x; volatile LAS unsigned* st; };

__device__ __forceinline__ XcdBarrier xcd_barrier_post(unsigned* bar, volatile LAS unsigned* st, bool leader  ) {
    XcdBarrier b; b.bar = bar; b.x = xb_xcc_id(); b.st = st;
    if (leader) (void)xb_add(&bar[XB_XCNT(b.x)], 1u);
    return b;
}
__device__ __forceinline__ void xcd_barrier_complete(unsigned* bar, unsigned x, unsigned& nloc, unsigned& nx) {
    const unsigned G = gridDim.x * gridDim.y * gridDim.z;
    unsigned sum, cnt, mine, sp = 0u;
    for (;;) {
        sum = 0u; cnt = 0u; mine = 0u;
#pragma unroll
        for (unsigned j = 0; j < 16; ++j) { const unsigned c = xb_ld(&bar[XB_XCNT(j)]); sum += c; cnt += (c > 0u) ? 1u : 0u; mine = (j == x) ? c : mine; }
        if (sum == G) break;
        __builtin_amdgcn_s_sleep(1);
        if ((++sp & 255u) == 0u) { if (xb_ld(&bar[XB_TMO])) break; if (sp > XB_SPIN_CAP) { atomicAdd(&bar[XB_TMO], 1u); break; } }
    }
    nloc = mine > 0u ? mine : 1u; nx = cnt > 0u ? cnt : 1u;
}
__device__ __forceinline__ void xcd_barrier(const XcdBarrier& b, bool leader  ) {
    asm volatile("s_waitcnt vmcnt(0)" ::: "memory");
    __syncthreads();
    if (leader) {
        unsigned* bar = b.bar;
        __builtin_amdgcn_s_waitcnt(0);
        unsigned nloc = b.st[0], nx = b.st[1];
        if (nloc == 0u) { xcd_barrier_complete(bar, b.x, nloc, nx); b.st[0] = nloc; b.st[1] = nx; }
        const unsigned old = xb_add(&bar[XB_XSUB(b.x)], 1u);
        const unsigned gen = old / nloc;
        if (old + 1u == (gen + 1u) * nloc) {
            __builtin_amdgcn_fence(__ATOMIC_RELEASE, "agent");
            asm volatile("s_waitcnt vmcnt(0)" ::: "memory");
            const unsigned og = xb_add(&bar[XB_TOP], 1u);
            const unsigned tg = og / nx;
            if (og + 1u == (tg + 1u) * nx) xb_add(&bar[XB_TOPGEN], 1u);
            else XB_SPIN(xb_ld(&bar[XB_TOPGEN]) == tg, bar);
            __builtin_amdgcn_fence(__ATOMIC_ACQUIRE, "agent");
            xb_add(&bar[XB_XGEN(b.x)], 1u);
            asm volatile("s_waitcnt vmcnt(0)" ::: "memory");
        } else {
            XB_SPIN(xb_ld(&bar[XB_XGEN(b.x)]) == gen, bar);
            __builtin_amdgcn_fence(__ATOMIC_ACQUIRE, "agent");
            asm volatile("s_waitcnt vmcnt(0)" ::: "memory");
        }
    }
    __syncthreads();
}
namespace pg8 {
constexpr int BM = 256, BK = 64, HALF = 128, HTB = HALF * BK * 2, STAGE_BYTES = 8 * HTB, NXCD = 8, WGM = 8;

__host__ __device__ __forceinline__ int lds_byte(int r, int c) { const int st = (r >> 4) * 2 + (c >> 5), rr = r & 15, cc = c & 31, ob = rr * 64 + cc * 2; return st * 1024 + (ob ^ (((ob >> 9) & 1) << 5)); }
__host__ __device__ __forceinline__ void stage_rc(int b, int& R, int& C) { const int st = b / 1024, sb = b % 1024, swz = sb ^ (((sb >> 9) & 1) << 5); R = (st >> 1) * 16 + swz / 64; C = (st & 1) * 32 + (swz % 64) / 2; }
__host__ __device__ __forceinline__ int perm32(int rho) { const int n = rho >> 4, i = rho & 15; return 8 * (i >> 2) + 4 * n + (i & 3); }

struct Unit { int pm, pn; const char* a; const char* b; int aux; };

struct StaticOrder {
    static constexpr bool GATHER = false;
    int nM, nN, nwg, G, c; const char* A; const char* Bt; size_t tstep;
    __device__ void init(const void* A_, const void* Bt_, int M, int N, int K, int G_, int c_) { A = (const char*)A_; Bt = (const char*)Bt_; nM = M / BM; nN = N / BM; nwg = nM * nN; G = G_; c = c_; tstep = (size_t)BM * K * 2; }
    __device__ bool next(int i, Unit& u) const {
        const long L = (long)i * G + c; if (L >= nwg) return false;
        int wgid = (int)L; { const int q = nwg / NXCD, r = nwg % NXCD, xcd = wgid % NXCD, off = wgid / NXCD; wgid = (xcd < r ? xcd * (q + 1) : r * (q + 1) + (xcd - r) * q) + off; }
        const int nig = WGM * nN, gid = wgid / nig, fm = gid * WGM, gsz = (nM - fm) < WGM ? (nM - fm) : WGM;
        u.pm = fm + ((wgid % nig) % gsz); u.pn = (wgid % nig) / gsz; u.a = A + (size_t)u.pm * tstep; u.b = Bt + (size_t)u.pn * tstep; u.aux = 0; return true;
    }
    __device__ __forceinline__ void gather(const Unit&, int, int, unsigned (&)[2][2]) const {}
};

template <class Epi, class Sched, bool FP8 = false, int SCA = 127, int SCB = 127>
__device__ __forceinline__ void gemm_phase(LAS unsigned char* lds, int tid, const int K, const Sched& S, const Epi& E) {
    asm volatile("" : "+v"(tid));
    const int wid = __builtin_amdgcn_readfirstlane(tid >> 6), lane = tid & 63, wr = wid >> 2, wc = wid & 3, fr = lane & 15, fq = lane >> 4;
    const int nt = K / BK;
    const size_t kstep = (size_t)(BK * 2);
    const size_t hstep = (size_t)HALF * K * 2;
    int Rr[2], Cc[2];
    unsigned voffB[2];
#pragma unroll
    for (int i = 0; i < 2; ++i) { int R, C; stage_rc(tid * 16 + i * 8192, R, C); Rr[i] = R; Cc[i] = C; const int Rb = Epi::PERM ? ((R & ~31) + perm32(R & 31)) : R; voffB[i] = (unsigned)(Rb * K + C) * 2u; }
    unsigned vAc[2][2], vAn[2][2];
#pragma unroll
    for (int h = 0; h < 2; ++h)
#pragma unroll
        for (int i = 0; i < 2; ++i) { vAc[h][i] = (unsigned)((h * HALF + Rr[i]) * K + Cc[i]) * 2u; vAn[h][i] = vAc[h][i]; }
    const unsigned ldsw = (unsigned)wid * 1024u;
    const int aoff = lds_byte(wr * 64 + fr, fq * 8), boff = lds_byte(wc * 32 + fr, fq * 8);
#define PG8_SA(b, h) (((b) * 2 + (h)) * HTB)
#define PG8_SB(b, h) ((4 + (b) * 2 + (h)) * HTB)
#define PG8_STAGE_B(bufoff, gbase) do { _Pragma("unroll") for (int _i = 0; _i < 2; ++_i) \
        __builtin_amdgcn_global_load_lds((const unsigned*)((const char*)(gbase) + voffB[_i]), (LAS unsigned*)(lds + (bufoff) + ldsw + _i * 8192), 16, 0, 0); } while (0)
#define PG8_STAGE_A(bufoff, gbase, V, h) do { _Pragma("unroll") for (int _i = 0; _i < 2; ++_i) \
        __builtin_amdgcn_global_load_lds((const unsigned*)((const char*)(gbase) + (V)[h][_i]), (LAS unsigned*)(lds + (bufoff) + ldsw + _i * 8192), 16, 0, 0); } while (0)
#define PG8_LDA(dst, b, h) do { _Pragma("unroll") for (int m = 0; m < 4; ++m) { if constexpr (FP8) { const i32x4_ x0_ = *(const LAS i32x4_*)(lds + PG8_SA(b, h) + aoff + m * 2048), x1_ = *(const LAS i32x4_*)(lds + PG8_SA(b, h) + aoff + m * 2048 + 1024); \
            dst##8[m] = __builtin_shufflevector(x0_, x1_, 0, 1, 2, 3, 4, 5, 6, 7); } else { _Pragma("unroll") for (int k = 0; k < 2; ++k) dst[m][k] = *(const LAS bf16x8*)(lds + PG8_SA(b, h) + aoff + m * 2048 + k * 1024); } } } while (0)
#define PG8_LDB(dst, b, h) do { _Pragma("unroll") for (int n = 0; n < 2; ++n) { if constexpr (FP8) { const i32x4_ x0_ = *(const LAS i32x4_*)(lds + PG8_SB(b, h) + boff + n * 2048), x1_ = *(const LAS i32x4_*)(lds + PG8_SB(b, h) + boff + n * 2048 + 1024); \
            dst##8[n] = __builtin_shufflevector(x0_, x1_, 0, 1, 2, 3, 4, 5, 6, 7); } else { _Pragma("unroll") for (int k = 0; k < 2; ++k) dst[n][k] = *(const LAS bf16x8*)(lds + PG8_SB(b, h) + boff + n * 2048 + k * 1024); } } } while (0)
#define PG8_MMA(ai, bj, At, Bt) do { __builtin_amdgcn_s_setprio(1); _Pragma("unroll") for (int m = 0; m < 4; ++m) _Pragma("unroll") for (int n = 0; n < 2; ++n) { \
        if constexpr (FP8) asm volatile("v_mfma_scale_f32_16x16x128_f8f6f4 %0, %1, %2, %0, %3, %4 op_sel_hi:[0,0,0]" : "+v"(acc[ai][bj][m][n]) : "v"(Bt##8[n]), "v"(At##8[m]), "v"(sca_), "v"(scb_)); \
        else { _Pragma("unroll") for (int k = 0; k < 2; ++k) acc[ai][bj][m][n] = __builtin_amdgcn_mfma_f32_16x16x32_bf16(Bt[n][k], At[m][k], acc[ai][bj][m][n], 0, 0, 0); } } \
        __builtin_amdgcn_s_setprio(0); } while (0)
#define PG8_WAIT_V(n) asm volatile("s_waitcnt vmcnt(" #n ")" ::: "memory")
#define PG8_WAIT_L(n) asm volatile("s_waitcnt lgkmcnt(" #n ")" ::: "memory")
#define PG8_BAR __builtin_amdgcn_s_barrier()
#define PG8_SCHED __builtin_amdgcn_sched_barrier(0)
    Unit cur, nxt; int ui = 0;
    if (!S.next(0, cur)) return;
    if constexpr (Sched::GATHER) { S.gather(cur, Rr[0], Rr[1], vAc);
#pragma unroll
        for (int h = 0; h < 2; ++h)
#pragma unroll
            for (int i = 0; i < 2; ++i) vAc[h][i] += (unsigned)Cc[i] * 2u; }
    f32x4 acc[2][2][4][2];
#pragma unroll
    for (int a = 0; a < 2; ++a)
#pragma unroll
        for (int b = 0; b < 2; ++b)
#pragma unroll
            for (int m = 0; m < 4; ++m)
#pragma unroll
                for (int n = 0; n < 2; ++n) acc[a][b][m][n] = (f32x4){0.f, 0.f, 0.f, 0.f};
    typedef int i32x4_ __attribute__((ext_vector_type(4))); typedef int i32x8_ __attribute__((ext_vector_type(8)));
    bf16x8 At[4][2], B0[2][2], B1[2][2];
    i32x8_ At8[4], B08[2], B18[2]; const int sca_ = SCA * 0x01010101, scb_ = SCB * 0x01010101;
    const char* cA = cur.a; const char* cB = cur.b;
    PG8_STAGE_B(PG8_SB(0, 0), cB); PG8_STAGE_B(PG8_SB(0, 1), cB + hstep); PG8_STAGE_A(PG8_SA(0, 0), cA, vAc, 0); PG8_STAGE_A(PG8_SA(0, 1), cA, vAc, 1);
    if (wr == 1) PG8_BAR;
    PG8_WAIT_V(2); PG8_BAR;
    PG8_STAGE_B(PG8_SB(1, 0), cB + kstep); PG8_STAGE_A(PG8_SA(1, 0), cA + kstep, vAc, 0); PG8_STAGE_B(PG8_SB(1, 1), cB + hstep + kstep);
    PG8_WAIT_V(6); PG8_BAR;
    for (;;) {
        const bool has_next = S.next(ui + 1, nxt);
        if constexpr (Sched::GATHER) { if (has_next) { S.gather(nxt, Rr[0], Rr[1], vAn);
#pragma unroll
            for (int h = 0; h < 2; ++h)
#pragma unroll
                for (int i = 0; i < 2; ++i) vAn[h][i] += (unsigned)Cc[i] * 2u; } else {
#pragma unroll
            for (int h = 0; h < 2; ++h)
#pragma unroll
                for (int i = 0; i < 2; ++i) vAn[h][i] = vAc[h][i]; } }
        const char* nA = has_next ? nxt.a : cA; const char* nB = has_next ? nxt.b : cB;
        for (int t = 0; t < nt; t += 2) {
            const bool last = (t == nt - 2);
            const char* a1 = cA + (size_t)(t + 1) * kstep;
            const char* a2 = last ? nA : cA + (size_t)(t + 2) * kstep; const char* b2 = last ? nB : cB + (size_t)(t + 2) * kstep;
            const char* a3 = a2 + kstep; const char* b3 = b2 + kstep;
            unsigned v2[2][2];
#pragma unroll
            for (int h = 0; h < 2; ++h)
#pragma unroll
                for (int i = 0; i < 2; ++i) v2[h][i] = (Sched::GATHER && last) ? vAn[h][i] : vAc[h][i];
            PG8_LDB(B0, 0, 0); PG8_LDB(B1, 0, 1); PG8_SCHED; PG8_LDA(At, 0, 0); PG8_STAGE_A(PG8_SA(1, 1), a1, vAc, 1);
            PG8_WAIT_V(8); PG8_WAIT_L(0); PG8_BAR; PG8_MMA(0, 0, At, B0); PG8_MMA(0, 1, At, B1); PG8_BAR; PG8_SCHED;
            PG8_LDA(At, 0, 1); PG8_STAGE_B(PG8_SB(0, 0), b2); PG8_STAGE_B(PG8_SB(0, 1), b2 + hstep); PG8_STAGE_A(PG8_SA(0, 0), a2, v2, 0);
            PG8_WAIT_V(8); PG8_WAIT_L(0); PG8_BAR; PG8_MMA(1, 0, At, B0); PG8_MMA(1, 1, At, B1); PG8_BAR; PG8_SCHED;
            PG8_LDB(B0, 1, 0); PG8_LDB(B1, 1, 1); PG8_SCHED; PG8_LDA(At, 1, 0); PG8_STAGE_A(PG8_SA(0, 1), a2, v2, 1);
            PG8_WAIT_V(8); PG8_WAIT_L(0); PG8_BAR; PG8_MMA(0, 0, At, B0); PG8_MMA(0, 1, At, B1); PG8_BAR; PG8_SCHED;
            PG8_LDA(At, 1, 1); PG8_STAGE_B(PG8_SB(1, 0), b3); PG8_STAGE_B(PG8_SB(1, 1), b3 + hstep); PG8_STAGE_A(PG8_SA(1, 0), a3, v2, 0);
            PG8_WAIT_V(8); PG8_WAIT_L(0); PG8_BAR; PG8_MMA(1, 0, At, B0); PG8_MMA(1, 1, At, B1); PG8_BAR; PG8_SCHED;
        }
        if (wr == 0) PG8_BAR;
        if constexpr (FP8) { asm volatile("s_nop 15\n\ts_nop 15" ::: "memory"); }
        E(acc, cur, wr, wc, fr, fq);
        if (!has_next) break;
#pragma unroll
        for (int a = 0; a < 2; ++a)
#pragma unroll
            for (int b = 0; b < 2; ++b)
#pragma unroll
                for (int m = 0; m < 4; ++m)
#pragma unroll
                    for (int n = 0; n < 2; ++n) acc[a][b][m][n] = (f32x4){0.f, 0.f, 0.f, 0.f};
        cur = nxt; cA = nA; cB = nB; ++ui;
#pragma unroll
        for (int h = 0; h < 2; ++h)
#pragma unroll
            for (int i = 0; i < 2; ++i) vAc[h][i] = vAn[h][i];
        if (wr == 1) PG8_BAR;
    }
    PG8_WAIT_V(0);
    PG8_BAR;
#undef PG8_SA
#undef PG8_SB
#undef PG8_STAGE_A
#undef PG8_STAGE_B
#undef PG8_LDA
#undef PG8_LDB
#undef PG8_MMA
#undef PG8_WAIT_V
#undef PG8_WAIT_L
#undef PG8_BAR
#undef PG8_SCHED
}
}
namespace pg8 {

struct EpiBf16 {
    static constexpr bool PERM = true;
    bf16_t* O; size_t ldc;
    __device__ __forceinline__ void operator()(const f32x4 (&acc)[2][2][4][2], const Unit& u, int wr, int wc, int fr, int fq) const {
        const size_t row0 = (size_t)u.pm * BM + wr * 64 + fr; const int col0 = u.pn * BM + wc * 32 + 8 * fq;
#pragma unroll
        for (int ai = 0; ai < 2; ++ai)
#pragma unroll
            for (int m = 0; m < 4; ++m) { bf16_t* rowp = O + (row0 + ai * HALF + m * 16) * ldc + col0;
#pragma unroll
                for (int bj = 0; bj < 2; ++bj) { const f32x4 v0 = acc[ai][bj][m][0], v1 = acc[ai][bj][m][1];
                    u32x4 w; w.x = cvt_pk_bf16(v0[0], v0[1]); w.y = cvt_pk_bf16(v0[2], v0[3]); w.z = cvt_pk_bf16(v1[0], v1[1]); w.w = cvt_pk_bf16(v1[2], v1[3]);
                    *(u32x4*)(rowp + bj * HALF) = w; } }
    }
};

struct EpiQKV {
    static constexpr bool PERM = false;
    bf16_t* Q; bf16_t* Kb; bf16_t* Vb; const float* ropec; const float* ropes;
    __device__ __forceinline__ void operator()(const f32x4 (&acc)[2][2][4][2], const Unit& u, int wr, int wc, int fr, int fq) const {
        const int sec = u.pn >> 1;
        const int bt = u.pm >> 4, t0 = (u.pm & 15) * BM;
        bf16_t* base; size_t rowb; float sc = 1.f;
        if (sec == 0) { base = Q; rowb = (size_t)u.pm * BM; sc = QSCALE; }
        else { base = (sec == 1) ? Kb : Vb; rowb = (size_t)bt * LKV + CTXL + t0; }
        const int colt = (u.pn & 1) * BM + wc * 32 + 4 * fq;
        const bool rope = sec < 2; const bool colpos = (wc & 1) != 0;
#pragma unroll
        for (int ai = 0; ai < 2; ++ai)
#pragma unroll
            for (int m = 0; m < 4; ++m) {
                const int rl = ai * HALF + wr * 64 + m * 16 + fr; const int t = t0 + rl;
                const int pos = colpos ? (t & 63) : (t >> 6);
                f32x4 cs = (f32x4){1.f, 1.f, 1.f, 1.f}, sn = (f32x4){0.f, 0.f, 0.f, 0.f};
                if (rope) { cs = *(const f32x4*)(ropec + pos * 16 + 4 * fq); sn = *(const f32x4*)(ropes + pos * 16 + 4 * fq); }
                bf16_t* rowp = base + (rowb + rl) * 512 + colt;
#pragma unroll
                for (int bj = 0; bj < 2; ++bj) {
                    const f32x4 a = acc[ai][bj][m][0], b = acc[ai][bj][m][1];
                    f32x4 oa, ob;
                    if (rope) { oa = (a * cs - b * sn) * sc; ob = (a * sn + b * cs) * sc; } else { oa = a; ob = b; }
                    u32x2 w0, w1; w0.x = cvt_pk_bf16(oa[0], oa[1]); w0.y = cvt_pk_bf16(oa[2], oa[3]); w1.x = cvt_pk_bf16(ob[0], ob[1]); w1.y = cvt_pk_bf16(ob[2], ob[3]);
                    *(u32x2*)(rowp + bj * HALF) = w0; *(u32x2*)(rowp + bj * HALF + 16) = w1; }
            }
    }
};

struct EpiCtxKV {
    static constexpr bool PERM = true;
    bf16_t* Kb; bf16_t* Vb;
    __device__ __forceinline__ void operator()(const f32x4 (&acc)[2][2][4][2], const Unit& u, int wr, int wc, int fr, int fq) const {
        bf16_t* base = (u.pn < 2) ? Kb : Vb; const size_t rowb = (size_t)u.pm * LKV; const int col0 = (u.pn & 1) * BM + wc * 32 + 8 * fq;
#pragma unroll
        for (int ai = 0; ai < 2; ++ai)
#pragma unroll
            for (int m = 0; m < 4; ++m) { bf16_t* rowp = base + (rowb + ai * HALF + wr * 64 + m * 16 + fr) * 512 + col0;
#pragma unroll
                for (int bj = 0; bj < 2; ++bj) { const f32x4 v0 = acc[ai][bj][m][0], v1 = acc[ai][bj][m][1];
                    u32x4 w; w.x = cvt_pk_bf16(v0[0], v0[1]); w.y = cvt_pk_bf16(v0[2], v0[3]); w.z = cvt_pk_bf16(v1[0], v1[1]); w.w = cvt_pk_bf16(v1[2], v1[3]);
                    *(u32x4*)(rowp + bj * HALF) = w; } }
    }
};

template <bool XF32> struct EpiResid {
    static constexpr bool PERM = true;
    const void* xin; bf16_t* out; const float* gate;   const float* bias;
    __device__ __forceinline__ void operator()(const f32x4 (&acc)[2][2][4][2], const Unit& u, int wr, int wc, int fr, int fq) const {
        const int bt = u.pm >> 4; const int col0 = u.pn * BM + wc * 32 + 8 * fq;
#pragma unroll
        for (int bj = 0; bj < 2; ++bj) {
            f32x4 gv[2], bv[2];
#pragma unroll
            for (int n = 0; n < 2; ++n) { gv[n] = *(const f32x4*)(gate + (size_t)bt * 6144 + col0 + bj * HALF + 4 * n);
                bv[n] = bias ? *(const f32x4*)(bias + col0 + bj * HALF + 4 * n) : (f32x4){0.f, 0.f, 0.f, 0.f}; }
#pragma unroll
            for (int ai = 0; ai < 2; ++ai)
#pragma unroll
                for (int m = 0; m < 4; ++m) { const size_t off = ((size_t)u.pm * BM + ai * HALF + wr * 64 + m * 16 + fr) * DM + col0 + bj * HALF;
                    f32x4 x0, x1;
                    if (XF32) { x0 = *(const f32x4*)((const float*)xin + off); x1 = *(const f32x4*)((const float*)xin + off + 4); }
                    else { const u32x4 r = *(const u32x4*)((const bf16_t*)xin + off); x0 = (f32x4){bflo(r.x), bfhi(r.x), bflo(r.y), bfhi(r.y)}; x1 = (f32x4){bflo(r.z), bfhi(r.z), bflo(r.w), bfhi(r.w)}; }
                    const f32x4 y0 = x0 + gv[0] * (acc[ai][bj][m][0] + bv[0]), y1 = x1 + gv[1] * (acc[ai][bj][m][1] + bv[1]);
                    u32x4 w; w.x = cvt_pk_bf16(y0[0], y0[1]); w.y = cvt_pk_bf16(y0[2], y0[3]); w.z = cvt_pk_bf16(y1[0], y1[1]); w.w = cvt_pk_bf16(y1[2], y1[3]);
                    *(u32x4*)(out + off) = w; }
        }
    }
};

template <int MODE> struct EpiGated {
    static constexpr bool PERM = true;
    bf16_t* O; size_t ldo; const float* ba; const float* bg;
    __device__ __forceinline__ void operator()(const f32x4 (&acc)[2][2][4][2], const Unit& u, int wr, int wc, int fr, int fq) const {
        const size_t row0 = (size_t)u.pm * BM + wr * 64 + fr; const int col0 = u.pn * 128 + wc * 32 + 8 * fq;
        f32x4 b0[2], b1[2];
#pragma unroll
        for (int bj = 0; bj < 2; ++bj) { b0[bj] = (f32x4){0.f, 0.f, 0.f, 0.f}; b1[bj] = b0[bj]; if (MODE == 1) { b0[bj] = *(const f32x4*)(ba + col0 + 4 * bj); b1[bj] = *(const f32x4*)(bg + col0 + 4 * bj); } }
#pragma unroll
        for (int ai = 0; ai < 2; ++ai)
#pragma unroll
            for (int m = 0; m < 4; ++m) { f32x4 o[2];
#pragma unroll
                for (int bj = 0; bj < 2; ++bj) { const f32x4 a = acc[ai][bj][m][0] + b0[bj], g = acc[ai][bj][m][1] + b1[bj];
#pragma unroll
                    for (int j = 0; j < 4; ++j) o[bj][j] = (MODE == 1) ? a[j] * sigmoid_f(g[j]) : silu_f(a[j]) * g[j]; }
                if (MODE == 2) { unsigned char* rowp = (unsigned char*)O + (row0 + ai * HALF + m * 16) * ldo + col0;
                    int p0 = 0, p1 = 0; p0 = __builtin_amdgcn_cvt_pk_fp8_f32(o[0][0], o[0][1], p0, false); p0 = __builtin_amdgcn_cvt_pk_fp8_f32(o[0][2], o[0][3], p0, true);
                    p1 = __builtin_amdgcn_cvt_pk_fp8_f32(o[1][0], o[1][1], p1, false); p1 = __builtin_amdgcn_cvt_pk_fp8_f32(o[1][2], o[1][3], p1, true);
                    *(u32x2*)rowp = (u32x2){(unsigned)p0, (unsigned)p1}; }
                else { bf16_t* rowp = O + (row0 + ai * HALF + m * 16) * ldo + col0;
                    u32x4 w; w.x = cvt_pk_bf16(o[0][0], o[0][1]); w.y = cvt_pk_bf16(o[0][2], o[0][3]); w.z = cvt_pk_bf16(o[1][0], o[1][1]); w.w = cvt_pk_bf16(o[1][2], o[1][3]);
                    *(u32x4*)rowp = w; } }
    }
};

struct EpiScatter {
    static constexpr bool PERM = true;
    bf16_t* Y0; bf16_t* Y1; const int* list; const LAS int* pref;
    __device__ __forceinline__ void operator()(const f32x4 (&acc)[2][2][4][2], const Unit& u, int wr, int wc, int fr, int fq) const {
        const int e = u.aux, j = u.pm - pref[e], cnt = pref[40 + e]; const int col0 = u.pn * BM + wc * 32 + 8 * fq;
#pragma unroll
        for (int ai = 0; ai < 2; ++ai)
#pragma unroll
            for (int m = 0; m < 4; ++m) { const int r = j * 256 + ai * HALF + wr * 64 + m * 16 + fr;
                bf16_t* rowp = Y1 + (size_t)NTOK * DM + col0;
                if (r < cnt) { const int ent = list[e * 32768 + r]; rowp = ((ent & 1) ? Y1 : Y0) + (size_t)(ent >> 1) * DM + col0; }
#pragma unroll
                for (int bj = 0; bj < 2; ++bj) { const f32x4 v0 = acc[ai][bj][m][0], v1 = acc[ai][bj][m][1];
                    u32x4 w; w.x = cvt_pk_bf16(v0[0], v0[1]); w.y = cvt_pk_bf16(v0[2], v0[3]); w.z = cvt_pk_bf16(v1[0], v1[1]); w.w = cvt_pk_bf16(v1[2], v1[3]);
                    *(u32x4*)(rowp + bj * HALF) = w; } }
    }
};

struct EpiLogits {
    static constexpr bool PERM = false;
    float* O;
    __device__ __forceinline__ void operator()(const f32x4 (&acc)[2][2][4][2], const Unit& u, int wr, int wc, int fr, int fq) const {
        if (wc >= 2) return;
#pragma unroll
        for (int ai = 0; ai < 2; ++ai)
#pragma unroll
            for (int m = 0; m < 4; ++m) { float* rowp = O + ((size_t)u.pm * BM + ai * HALF + wr * 64 + m * 16 + fr) * 64 + wc * 32 + 4 * fq;
#pragma unroll
                for (int n = 0; n < 2; ++n) *(f32x4*)(rowp + n * 16) = acc[ai][0][m][n]; }
    }
};
}
enum { I_X = 0, I_C, I_CTX, I_CCTX, I_ADAW, I_ADAB, I_N1G, I_N2G, I_FING, I_WIN0, I_WOUT0, I_LQ1, I_LK1, I_LQ2, I_LK2, I_SUBLN,
       I_HYSW, I_HYSB, I_HYW1, I_HYB1, I_HYFR1, I_HYW2, I_HYB2, I_HYFR2, I_HYW3, I_HYB3, I_HYBIAS,
       I_CVW1, I_CVB1, I_CVDWW, I_CVDWB, I_CVLNG, I_CVLNB, I_CVW2, I_CVB2, I_MWG, I_MBG, I_MWE, I_MBE, I_MGATE, I_MUP, I_MDOWN, N_IN };

struct Args { const float* in[N_IN]; float* out; unsigned char* ws; int ph_lo, ph_hi; };

struct Frame {
    LAS unsigned char* lds;
    int tid, lane, wave, G, bid;
    const float* const* in; float* out; unsigned char* ws;
};

struct RowMap { int mode, half, which0;
    __device__ __forceinline__ int operator()(int s) const { if (mode == 0) return s; const int w = which0 + s / half, h = s % half, t = h & 127;
        return 256 * (h >> 7) + 128 * ((t >> 2) & 1) + 32 * (t >> 5) + 8 * ((t >> 3) & 3) + 4 * w + (t & 3); } };
#ifndef CONF_FP8
#define CONF_FP8 1
#endif
struct P0Item { const float* W; bf16_t* WT; int K, N, k0, n0; RowMap rm; int fp8; };
constexpr int P0_I_IN = 16 * 6, P0_I_OUT = 16 * 2, P0_I_C1 = 16 * 4, P0_I_C2 = 16 * 2, P0_I_MOE = 64 * 48;
constexpr int P0_NITEMS = P0_I_IN + P0_I_OUT + P0_I_C1 + P0_I_C2 + P0_I_MOE;
__device__ __forceinline__ P0Item p0_item(Frame& F, int it) {
    P0Item I; int r = it; I.fp8 = 0;
    if (r < P0_I_IN) { I.W = F.in[I_WIN0]; I.WT = (bf16_t*)(F.ws + WS_WQKVH); I.K = 1024; I.N = 3072; I.rm = RowMap{0, 1, 0}; }
    else if ((r -= P0_I_IN) < P0_I_OUT) { I.W = F.in[I_WOUT0]; I.WT = (bf16_t*)(F.ws + WS_WO); I.K = 1024; I.N = 1024; I.rm = RowMap{0, 1, 0}; }
    else if ((r -= P0_I_OUT) < P0_I_C1) { I.W = F.in[I_CVW1]; I.WT = (bf16_t*)(F.ws + WS_WC1); I.K = 1024; I.N = 2048; I.rm = RowMap{1, 1024, 0}; I.fp8 = CONF_FP8; }
    else if ((r -= P0_I_C1) < P0_I_C2) { I.W = F.in[I_CVW2]; I.WT = (bf16_t*)(F.ws + WS_WC2); I.K = 1024; I.N = 1024; I.rm = RowMap{0, 1, 0}; I.fp8 = CONF_FP8; }
    else { r -= P0_I_C2; const int le = r / 48, q = r % 48; unsigned char* wb = F.ws + WS_WMOE + (size_t)le * 3 * MiB;
        I.fp8 = 1;
        if (q < 16) { I.W = F.in[I_MGATE] + (size_t)le * 1024 * 512; I.WT = (bf16_t*)wb; I.K = 1024; I.N = 512; I.rm = RowMap{1, 512, 0}; r = q; }
        else if (q < 32) { I.W = F.in[I_MUP] + (size_t)le * 1024 * 512; I.WT = (bf16_t*)wb; I.K = 1024; I.N = 512; I.rm = RowMap{1, 512, 1}; r = q - 16; }
        else { I.W = F.in[I_MDOWN] + (size_t)le * 512 * 1024; I.WT = (bf16_t*)(wb + 2 * MiB); I.K = 512; I.N = 1024; I.rm = RowMap{0, 1, 0}; r = q - 32; } }
    const int nblk = I.N / 512; I.k0 = 64 * (r / nblk); I.n0 = 512 * (r % nblk); return I;
}
__device__ __forceinline__ void p0_item_load(const P0Item& I, int tid, f32x4 (&v)[16]) {
#pragma unroll
    for (int i = 0; i < 16; ++i) v[i] = *(const f32x4*)(I.W + (size_t)(I.k0 + 4 * i + (tid >> 7)) * I.N + I.n0 + 4 * (tid & 127));
}
__device__ __forceinline__ void p0_item_to_lds(LAS float* scr, int tid, const f32x4 (&v)[16]) {
#pragma unroll
    for (int i = 0; i < 16; ++i) { LAS float* d = scr + (4 * i + (tid >> 7)) * 513 + 4 * (tid & 127); d[0] = v[i][0]; d[1] = v[i][1]; d[2] = v[i][2]; d[3] = v[i][3]; }
}
__device__ __forceinline__ void p0_item_store(const P0Item& I, const LAS float* scr, int tid) {
    if (I.fp8) {
#pragma unroll
        for (int j = 0; j < 4; ++j) { const int q = tid + 512 * j, n = q >> 2, c = q & 3; const LAS float* s = scr + (16 * c) * 513 + n; int w[4];
#pragma unroll
            for (int d = 0; d < 4; ++d) { int p = 0; p = __builtin_amdgcn_cvt_pk_fp8_f32(32.f * s[(4 * d) * 513], 32.f * s[(4 * d + 1) * 513], p, false);
                p = __builtin_amdgcn_cvt_pk_fp8_f32(32.f * s[(4 * d + 2) * 513], 32.f * s[(4 * d + 3) * 513], p, true); w[d] = p; }
            *(u32x4*)((unsigned char*)I.WT + (size_t)I.rm(I.n0 + n) * I.K + I.k0 + 16 * c) = (u32x4){(unsigned)w[0], (unsigned)w[1], (unsigned)w[2], (unsigned)w[3]}; }
        return; }
#pragma unroll
    for (int j = 0; j < 8; ++j) { const int q = tid + 512 * j, n = q >> 3, c = q & 7; const LAS float* s = scr + (8 * c) * 513 + n;
        u32x4 o; o.x = cvt_pk_bf16(s[0 * 513], s[1 * 513]); o.y = cvt_pk_bf16(s[2 * 513], s[3 * 513]); o.z = cvt_pk_bf16(s[4 * 513], s[5 * 513]); o.w = cvt_pk_bf16(s[6 * 513], s[7 * 513]);
        *(u32x4*)(I.WT + (size_t)I.rm(I.n0 + n) * I.K + I.k0 + 8 * c) = o; }
}
__device__ __forceinline__ void p0_router_weights(Frame& F) {
    bf16_t* wr = (bf16_t*)(F.ws + WS_WR);
    for (int idx = F.bid * NTHREADS + F.tid; idx < 2 * 256 * 1024; idx += F.G * NTHREADS) {
        const int l = idx >> 18, n = (idx >> 10) & 255, k = idx & 1023; float v = 0.f;
        if (n < 4) v = F.in[I_MWG][((size_t)l * 1024 + k) * 4 + n]; else if (n < 36) v = F.in[I_MWE][((size_t)l * 1024 + k) * 32 + (n - 4)];
        wr[idx] = (bf16_t)(cvt_pk_bf16(v, 0.f) & 0xffffu);
    }
}

__device__ __forceinline__ void p0_adaln_task(Frame& F, int task) {
    const int layer = task / 24, n0 = (task % 24) * 256;
    LAS float* sc = (LAS float*)F.lds;
    LAS f32x4* red = (LAS f32x4*)(F.lds + 36864);
    for (int i = F.tid; i < 9 * 1024; i += NTHREADS) { const int r = i >> 10, k = i & 1023; const float v = (r < 8) ? F.in[I_C][r * 1024 + k] : F.in[I_CCTX][k]; sc[i] = silu_f(v); }
    __syncthreads();
    const int cq = F.tid & 63, ks = F.tid >> 6;
    const float* W = F.in[I_ADAW] + (size_t)layer * 1024 * 6144 + n0 + 4 * cq;
    f32x4 acc[9];
#pragma unroll
    for (int r = 0; r < 9; ++r) acc[r] = (f32x4){0.f, 0.f, 0.f, 0.f};
#pragma unroll 16
    for (int k = ks * 128; k < ks * 128 + 128; ++k) { const f32x4 w = *(const f32x4*)(W + (size_t)k * 6144);
#pragma unroll
        for (int r = 0; r < 9; ++r) acc[r] += w * sc[r * 1024 + k]; }
#pragma unroll
    for (int r = 0; r < 9; ++r) red[(ks * 9 + r) * 64 + cq] = acc[r];
    __syncthreads();
    float* mod = (float*)(F.ws + WS_MOD) + (size_t)layer * 9 * 6144;
    for (int i = F.tid; i < 9 * 64; i += NTHREADS) { const int r = i >> 6, c2 = i & 63; f32x4 s = *(const f32x4*)(F.in[I_ADAB] + layer * 6144 + n0 + 4 * c2);
#pragma unroll
        for (int k8 = 0; k8 < 8; ++k8) s += red[(k8 * 9 + r) * 64 + c2];
        *(f32x4*)(mod + (size_t)r * 6144 + n0 + 4 * c2) = s; }
    __syncthreads();
}

constexpr float HY_MIN_DECAY = -15.350567286626973f, HY_MAX_DECAY = -3.0701134573253945f;
__device__ __forceinline__ void p0_hyfilter_task(Frame& F, int pb) {
    const int t0 = pb * 32;
    LAS float* z = (LAS float*)F.lds;
    LAS float* h1 = z + 32 * 33;
    LAS float* h2 = h1 + 32 * 64;
    for (int i = F.tid; i < 32 * 33; i += NTHREADS) { const int p = i / 33, e = i % 33; const int t = t0 + p; float v;
        if (e == 0) v = (float)t / 4095.0f;
        else { const int bi = (e - 1) & 15; const float band = 1e-4f + (float)bi * ((15.0f - 1e-4f) / 15.0f); const float ang = (6.283185307179586f / 4096.0f) * (float)t * band; v = (e <= 16) ? cosf(ang) : -sinf(ang); }
        z[i] = v; }
    __syncthreads();
    for (int i = F.tid; i < 32 * 64; i += NTHREADS) { const int p = i >> 6, j = i & 63; float s = F.in[I_HYB1][j];
        for (int e = 0; e < 33; ++e) s += z[p * 33 + e] * F.in[I_HYW1][e * 64 + j];
        h1[i] = sinf(F.in[I_HYFR1][j] * s); }
    __syncthreads();
    for (int i = F.tid; i < 32 * 64; i += NTHREADS) { const int p = i >> 6, j = i & 63; float s = F.in[I_HYB2][j];
        for (int e = 0; e < 64; ++e) s += h1[p * 64 + e] * F.in[I_HYW2][e * 64 + j];
        h2[i] = sinf(F.in[I_HYFR2][j] * s); }
    __syncthreads();
    const int c0 = 4 * F.tid;
    float* kraw = (float*)(F.ws + WS_KRAW);
    const f32x4 b3 = *(const f32x4*)(F.in[I_HYB3] + c0);
#pragma unroll 1
    for (int ph = 0; ph < 2; ++ph) {
        f32x4 acc[16];
#pragma unroll
        for (int p = 0; p < 16; ++p) acc[p] = b3;
        for (int j4 = 0; j4 < 16; ++j4) {
            f32x4 w[4];
#pragma unroll
            for (int jj = 0; jj < 4; ++jj) w[jj] = *(const f32x4*)(F.in[I_HYW3] + (size_t)(4 * j4 + jj) * 2048 + c0);
#pragma unroll
            for (int p = 0; p < 16; ++p) { const f32x4 hv = *(const LAS f32x4*)(h2 + (16 * ph + p) * 64 + 4 * j4);
                acc[p] += w[0] * hv[0] + w[1] * hv[1] + w[2] * hv[2] + w[3] * hv[3]; }
        }
#pragma unroll
        for (int cc = 0; cc < 4; ++cc) { const int col = c0 + cc, ch = col & 511;
            const float delta = fabsf(HY_MIN_DECAY + (float)ch * ((HY_MAX_DECAY - HY_MIN_DECAY) / 511.0f));
            float* dst = kraw + (size_t)col * 4096 + t0 + 16 * ph;
#pragma unroll
            for (int p4 = 0; p4 < 4; ++p4) { f32x4 o;
#pragma unroll
                for (int q = 0; q < 4; ++q) { const int p = 4 * p4 + q; const float tn = (float)(t0 + 16 * ph + p) / 4095.0f; o[q] = acc[p][cc] * __expf(-tn * delta); }
                *(f32x4*)(dst + 4 * p4) = o; } }
    }
    __syncthreads();
}

__device__ __forceinline__ void p0_tables_task(Frame& F) {
    float* tab = (float*)(F.ws + WS_TAB);
    for (int i = F.tid; i < 1024; i += NTHREADS) { const int pos = i >> 4, fi = i & 15; const float inv = powf(10000.0f, -(float)fi / 16.0f); const float ang = (float)pos * inv;
        tab[TB_ROPE_C + i] = cosf(ang); tab[TB_ROPE_S + i] = sinf(ang); }
    for (int i = F.tid; i < 256; i += NTHREADS) { float s, c; sincospif(2.0f * (float)i / 4096.0f, &s, &c); tab[TB_T4096 + 2 * i] = c; tab[TB_T4096 + 2 * i + 1] = -s; }
    for (int i = F.tid; i < 64; i += NTHREADS) { float s, c; sincospif(2.0f * (float)i / 8192.0f, &s, &c); tab[TB_T8A + 2 * i] = c; tab[TB_T8A + 2 * i + 1] = -s;
        sincospif(2.0f * (float)(64 * i) / 8192.0f, &s, &c); tab[TB_T8B + 2 * i] = c; tab[TB_T8B + 2 * i + 1] = -s; }
    if (F.tid < 64) { const float a = wave_sum(F.in[I_LQ1][F.lane] * F.in[I_LK1][F.lane]), b = wave_sum(F.in[I_LQ2][F.lane] * F.in[I_LK2][F.lane]);
        if (F.lane == 0) tab[TB_LAM] = expf(a) - expf(b) + 0.2f; }
}

__device__ __forceinline__ void p0_prologue(Frame& F, unsigned* ctr, volatile LAS unsigned* slot) {
    p0_router_weights(F);
#pragma unroll 1
    for (int t = F.bid; t < 48 + 128; t += F.G) { if (t < 48) p0_adaln_task(F, t); else p0_hyfilter_task(F, t - 48); }
    if (F.bid == 0) p0_tables_task(F);
    __syncthreads();
    LAS float* scr = (LAS float*)F.lds;
    if (F.tid == 0) slot[0] = __hip_atomic_fetch_add(ctr, 1u, RLX_AGENT);
    __syncthreads();
    int cur = (int)slot[0];
    f32x4 v[16];
    if (cur < P0_NITEMS) { const P0Item I = p0_item(F, cur); p0_item_load(I, F.tid, v); }
    while (cur < P0_NITEMS) {
        __syncthreads();
        p0_item_to_lds(scr, F.tid, v);
        if (F.tid == 0) slot[0] = __hip_atomic_fetch_add(ctr, 1u, RLX_AGENT);
        __syncthreads();
        const int nxt = (int)slot[0];
        if (nxt < P0_NITEMS) { const P0Item J = p0_item(F, nxt); p0_item_load(J, F.tid, v); }
        { const P0Item I = p0_item(F, cur); p0_item_store(I, scr, F.tid); }
        cur = nxt;
    }
    __syncthreads();
}

__device__ __forceinline__ void bf8_to_f32(const u32x4 r, f32x4& a, f32x4& b) { a = (f32x4){bflo(r.x), bfhi(r.x), bflo(r.y), bfhi(r.y)}; b = (f32x4){bflo(r.z), bfhi(r.z), bflo(r.w), bfhi(r.w)}; }
__device__ __forceinline__ void rms_mod_store(const f32x4 (&v)[4], const float* g, const float* sh, const float* sc, bf16_t* orow, float* frow, int lane) {
    float s = 0.f;
#pragma unroll
    for (int j = 0; j < 4; ++j) s += (v[j].x * v[j].x + v[j].y * v[j].y) + (v[j].z * v[j].z + v[j].w * v[j].w);
    const float rstd = 1.0f / sqrtf(wave_sum(s) * (1.0f / 1024.0f) + EPS);
#pragma unroll
    for (int h = 0; h < 2; ++h) { const int c = 8 * lane + 512 * h; f32x4 y0 = v[2 * h] * rstd * *(const f32x4*)(g + c), y1 = v[2 * h + 1] * rstd * *(const f32x4*)(g + c + 4);
        if (sc) { y0 = y0 * (*(const f32x4*)(sc + c) + 1.0f) + *(const f32x4*)(sh + c); y1 = y1 * (*(const f32x4*)(sc + c + 4) + 1.0f) + *(const f32x4*)(sh + c + 4); }
        if (orow) { u32x4 w; w.x = cvt_pk_bf16(y0[0], y0[1]); w.y = cvt_pk_bf16(y0[2], y0[3]); w.z = cvt_pk_bf16(y1[0], y1[1]); w.w = cvt_pk_bf16(y1[2], y1[3]); *(u32x4*)(orow + c) = w; }
        if (frow) { *(f32x4*)(frow + c) = y0; *(f32x4*)(frow + c + 4) = y1; } }
}

__device__ __forceinline__ void p1_norm_in(Frame& F) {
    const int gw = F.bid * NWAVES + F.wave, NGW = F.G * NWAVES;
    const float* mod = (const float*)(F.ws + WS_MOD);
#pragma unroll 1
    for (int r0 = gw; r0 < NTOK + NB * CTXL; r0 += 4 * NGW) {
        f32x4 v[4][4];
#pragma unroll
        for (int q = 0; q < 4; ++q) { const int r = r0 + q * NGW; if (r < NTOK + NB * CTXL) { const bool isx = r < NTOK; const int rr = isx ? r : r - NTOK;
            const float* xrow = (isx ? F.in[I_X] : F.in[I_CTX]) + (size_t)rr * DM;
#pragma unroll
            for (int j = 0; j < 4; ++j) v[q][j] = *(const f32x4*)(xrow + 8 * F.lane + 512 * (j >> 1) + 4 * (j & 1)); } }
#pragma unroll
        for (int q = 0; q < 4; ++q) { const int r = r0 + q * NGW; if (r < NTOK + NB * CTXL) { const bool isx = r < NTOK; const int rr = isx ? r : r - NTOK; const int b = isx ? (rr >> 12) : 8;
            bf16_t* orow = (bf16_t*)(F.ws + (isx ? WS_BUF0 : WS_OBT)) + (size_t)rr * DM;
            rms_mod_store(v[q], F.in[I_N1G], mod + (size_t)b * 6144 + 0, mod + (size_t)b * 6144 + 1024, orow, nullptr, F.lane); } }
    }
}

constexpr int MF_PITCH = 2064;
constexpr int MF_TILE = 0, MF_RED = 32 * MF_PITCH, MF_SEL = MF_RED + 8 * 32 * 65 * 4, MF_CNT = MF_SEL + 128 * 32;
__device__ __forceinline__ void moe_front(Frame& F, int layer) {
    LAS unsigned char* lds = F.lds;
    LAS float* red = (LAS float*)(lds + MF_RED);
    LAS int* lcnt = (LAS int*)(lds + MF_CNT); LAS int* lbase = lcnt + 32;
    const float* mod = (const float*)(F.ws + WS_MOD) + (size_t)layer * 9 * 6144;
    unsigned* gcnt = (unsigned*)(F.ws + WS_CTL) + CW_CNT + layer * 32 * 64;
    int* list = (int*)(F.ws + WS_LIST);
    int* tinfo = (int*)(F.ws + WS_TOK); float* tw = (float*)(F.ws + WS_TOK + 512 * 1024);
    const int l = F.lane, w = F.wave, r32 = l & 31, hi = l >> 5;
    bf16x8 wb[2][8];
    { const bf16_t* wr = (const bf16_t*)(F.ws + WS_WR) + (size_t)layer * 256 * 1024;
#pragma unroll
      for (int nb = 0; nb < 2; ++nb)
#pragma unroll
          for (int s = 0; s < 8; ++s) wb[nb][s] = *(const bf16x8*)(wr + (size_t)(32 * nb + r32) * 1024 + 128 * w + 16 * s + 8 * hi); }
    for (int blk = F.bid; blk < NTOK / 128; blk += F.G) {
        if (F.tid < 32) lcnt[F.tid] = 0;
        __syncthreads();
#pragma unroll 1
        for (int sg = 0; sg < 4; ++sg) {
            const int tok0 = blk * 128 + sg * 32;
            { f32x4 v[4][4];
#pragma unroll
              for (int q = 0; q < 4; ++q) { const bf16_t* xrow = (const bf16_t*)(F.ws + WS_X) + (size_t)(tok0 + 4 * w + q) * DM;
#pragma unroll
                  for (int h = 0; h < 2; ++h) { const u32x4 t = *(const u32x4*)(xrow + 8 * l + 512 * h); bf8_to_f32(t, v[q][2 * h], v[q][2 * h + 1]); } }
              const int b = tok0 >> 12;
              const float* g = F.in[I_N2G] + layer * DM; const float* sh = mod + (size_t)b * 6144 + 3 * 1024; const float* sc = mod + (size_t)b * 6144 + 4 * 1024;
#pragma unroll
              for (int q = 0; q < 4; ++q) { const int rl = 4 * w + q, r = tok0 + rl; float ssq = 0.f;
#pragma unroll
                  for (int j = 0; j < 4; ++j) ssq += (v[q][j].x * v[q][j].x + v[q][j].y * v[q][j].y) + (v[q][j].z * v[q][j].z + v[q][j].w * v[q][j].w);
                  const float rstd = 1.0f / sqrtf(wave_sum(ssq) * (1.0f / 1024.0f) + EPS);
                  unsigned char* orow = F.ws + WS_BUF0 + (size_t)r * DM;
#pragma unroll
                  for (int h = 0; h < 2; ++h) { const int c = 8 * l + 512 * h;
                      const f32x4 y0 = v[q][2 * h] * rstd * *(const f32x4*)(g + c) * (*(const f32x4*)(sc + c) + 1.0f) + *(const f32x4*)(sh + c);
                      const f32x4 y1 = v[q][2 * h + 1] * rstd * *(const f32x4*)(g + c + 4) * (*(const f32x4*)(sc + c + 4) + 1.0f) + *(const f32x4*)(sh + c + 4);
                      u32x4 pk; pk.x = cvt_pk_bf16(y0[0], y0[1]); pk.y = cvt_pk_bf16(y0[2], y0[3]); pk.z = cvt_pk_bf16(y1[0], y1[1]); pk.w = cvt_pk_bf16(y1[2], y1[3]);
                      *(LAS u32x4*)(lds + MF_TILE + rl * MF_PITCH + c * 2) = pk;
                      int p0 = 0, p1 = 0; p0 = __builtin_amdgcn_cvt_pk_fp8_f32(y0[0], y0[1], p0, false); p0 = __builtin_amdgcn_cvt_pk_fp8_f32(y0[2], y0[3], p0, true);
                      p1 = __builtin_amdgcn_cvt_pk_fp8_f32(y1[0], y1[1], p1, false); p1 = __builtin_amdgcn_cvt_pk_fp8_f32(y1[2], y1[3], p1, true);
                      *(u32x2*)(orow + c) = (u32x2){(unsigned)p0, (unsigned)p1}; } } }
            __syncthreads();
            { f32x16 d0, d1;
#pragma unroll
              for (int r = 0; r < 16; ++r) { d0[r] = 0.f; d1[r] = 0.f; }
#pragma unroll
              for (int s = 0; s < 8; ++s) { const bf16x8 a = *(const LAS bf16x8*)(lds + MF_TILE + r32 * MF_PITCH + (128 * w + 16 * s + 8 * hi) * 2);
                  d0 = __builtin_amdgcn_mfma_f32_32x32x16_bf16(a, wb[0][s], d0, 0, 0, 0); d1 = __builtin_amdgcn_mfma_f32_32x32x16_bf16(a, wb[1][s], d1, 0, 0, 0); }
#pragma unroll
              for (int r = 0; r < 16; ++r) { const int t = (r & 3) + 8 * (r >> 2) + 4 * hi; red[(w * 32 + t) * 65 + r32] = d0[r]; red[(w * 32 + t) * 65 + 32 + r32] = d1[r]; } }
            __syncthreads();
            if (F.tid < 32) { const int t = F.tid;
                int g = 0; float gm = -1e30f, gl[4];
#pragma unroll
                for (int i = 0; i < 4; ++i) { float sum = F.in[I_MBG][layer * 4 + i];
#pragma unroll
                    for (int ww = 0; ww < 8; ++ww) sum += red[(ww * 32 + t) * 65 + i];
                    gl[i] = sum; if (sum > gm) { gm = sum; g = i; } }
                float gs = 0.f;
#pragma unroll
                for (int i = 0; i < 4; ++i) gs += __expf(gl[i] - gm);
                const float gw = 1.0f / gs;
                float el[8];
#pragma unroll
                for (int i = 0; i < 8; ++i) { float sum = F.in[I_MBE][layer * 32 + 8 * g + i];
#pragma unroll
                    for (int ww = 0; ww < 8; ++ww) sum += red[(ww * 32 + t) * 65 + 4 + 8 * g + i];
                    el[i] = sum; }
                int i1 = 0; float m1 = -1e30f;
#pragma unroll
                for (int i = 0; i < 8; ++i) if (el[i] > m1) { m1 = el[i]; i1 = i; }
                int i2 = 0; float m2 = -1e30f;
#pragma unroll
                for (int i = 0; i < 8; ++i) if (i != i1 && el[i] > m2) { m2 = el[i]; i2 = i; }
                const float e2 = __expf(m2 - m1), w1 = gw / (1.0f + e2), w2 = gw * e2 / (1.0f + e2);
                const int x1 = g * 8 + i1, x2 = g * 8 + i2;
                const int p1 = __hip_atomic_fetch_add(&lcnt[x1], 1, __ATOMIC_RELAXED, __HIP_MEMORY_SCOPE_WORKGROUP), p2 = __hip_atomic_fetch_add(&lcnt[x2], 1, __ATOMIC_RELAXED, __HIP_MEMORY_SCOPE_WORKGROUP);
                LAS int* sel = (LAS int*)(lds + MF_SEL) + (sg * 32 + t) * 8;
                sel[0] = x1; sel[1] = p1; sel[2] = x2; sel[3] = p2; sel[4] = __float_as_int(w1); sel[5] = __float_as_int(w2); }
            __syncthreads();
        }
        if (F.tid < 32) lbase[F.tid] = (int)__hip_atomic_fetch_add(gcnt + F.tid * 64, (unsigned)lcnt[F.tid], RLX_AGENT);
        __syncthreads();
        if (F.tid < 128) { const LAS int* sel = (const LAS int*)(lds + MF_SEL) + F.tid * 8; const int tok = blk * 128 + F.tid;
            const int x1 = sel[0], x2 = sel[2], q1 = lbase[x1] + sel[1], q2 = lbase[x2] + sel[3];
            list[x1 * 32768 + q1] = 2 * tok; list[x2 * 32768 + q2] = 2 * tok + 1;
            *(int4*)(tinfo + 4 * (size_t)tok) = make_int4(x1, q1, x2, q2);
            *(float2*)(tw + 2 * (size_t)tok) = make_float2(__int_as_float(sel[4]), __int_as_float(sel[5])); }
        __syncthreads();
    }
}

__device__ __forceinline__ void moe_prefix(Frame& F, int layer, LAS int* pref) {
    const unsigned* gcnt = (const unsigned*)(F.ws + WS_CTL) + CW_CNT + layer * 32 * 64;
    if (F.tid == 0) { int s = 0; for (int e = 0; e < 32; ++e) { const int c = (int)gcnt[e * 64]; pref[e] = s; pref[40 + e] = c; s += (c + 255) >> 8; } pref[32] = s; }
    __syncthreads();
}

template <int MODE> __device__ __forceinline__ void moe_combine(Frame& F, int layer) {
    const int gw = F.bid * NWAVES + F.wave, NGW = F.G * NWAVES;
    const float* mod = (const float*)(F.ws + WS_MOD) + (size_t)layer * 9 * 6144;
    const float* modn = (const float*)(F.ws + WS_MOD) + (size_t)1 * 9 * 6144;
    const float* tw = (const float*)(F.ws + WS_TOK + 512 * 1024);
    const bf16_t* Y0 = (const bf16_t*)(F.ws + WS_BUF0); const bf16_t* Y1 = (const bf16_t*)(F.ws + WS_Y1);
    bf16_t* X = (bf16_t*)(F.ws + WS_X);
#pragma unroll 1
    for (int r0 = gw; r0 < NTOK; r0 += 4 * NGW) {
        f32x4 v[4][4];
#pragma unroll
        for (int q = 0; q < 4; ++q) { const int r = r0 + q * NGW; const int b = r >> 12;
            const float2 ww = *(const float2*)(tw + 2 * (size_t)r);
            const float* g2 = mod + (size_t)b * 6144 + 5 * 1024;
#pragma unroll
            for (int h = 0; h < 2; ++h) { const int c = 8 * F.lane + 512 * h;
                const u32x4 xr = *(const u32x4*)(X + (size_t)r * DM + c), ar = *(const u32x4*)(Y0 + (size_t)r * DM + c), br = *(const u32x4*)(Y1 + (size_t)r * DM + c);
                f32x4 x0, x1, a0, a1, b0, b1; bf8_to_f32(xr, x0, x1); bf8_to_f32(ar, a0, a1); bf8_to_f32(br, b0, b1);
                v[q][2 * h] = x0 + *(const f32x4*)(g2 + c) * (a0 * ww.x + b0 * ww.y); v[q][2 * h + 1] = x1 + *(const f32x4*)(g2 + c + 4) * (a1 * ww.x + b1 * ww.y); } }
#pragma unroll
        for (int q = 0; q < 4; ++q) { const int r = r0 + q * NGW; const int b = r >> 12;
            float ssq = 0.f;
#pragma unroll
            for (int j = 0; j < 4; ++j) ssq += (v[q][j].x * v[q][j].x + v[q][j].y * v[q][j].y) + (v[q][j].z * v[q][j].z + v[q][j].w * v[q][j].w);
            const float rstd = 1.0f / sqrtf(wave_sum(ssq) * (1.0f / 1024.0f) + EPS);
            const float* g = (MODE == 0) ? F.in[I_N1G] + DM : F.in[I_FING];
#pragma unroll
            for (int h = 0; h < 2; ++h) { const int c = 8 * F.lane + 512 * h;
                if (MODE == 0) { u32x4 pk; pk.x = cvt_pk_bf16(v[q][2 * h][0], v[q][2 * h][1]); pk.y = cvt_pk_bf16(v[q][2 * h][2], v[q][2 * h][3]); pk.z = cvt_pk_bf16(v[q][2 * h + 1][0], v[q][2 * h + 1][1]); pk.w = cvt_pk_bf16(v[q][2 * h + 1][2], v[q][2 * h + 1][3]);
                    *(u32x4*)(X + (size_t)r * DM + c) = pk; }
                f32x4 y0 = v[q][2 * h] * rstd * *(const f32x4*)(g + c), y1 = v[q][2 * h + 1] * rstd * *(const f32x4*)(g + c + 4);
                if (MODE == 0) { const float* sh = modn + (size_t)b * 6144; const float* sc = sh + 1024;
                    y0 = y0 * (*(const f32x4*)(sc + c) + 1.0f) + *(const f32x4*)(sh + c); y1 = y1 * (*(const f32x4*)(sc + c + 4) + 1.0f) + *(const f32x4*)(sh + c + 4);
                    if (CONF_FP8) { int p0 = 0, p1 = 0; p0 = __builtin_amdgcn_cvt_pk_fp8_f32(y0[0], y0[1], p0, false); p0 = __builtin_amdgcn_cvt_pk_fp8_f32(y0[2], y0[3], p0, true);
                        p1 = __builtin_amdgcn_cvt_pk_fp8_f32(y1[0], y1[1], p1, false); p1 = __builtin_amdgcn_cvt_pk_fp8_f32(y1[2], y1[3], p1, true);
                        *(u32x2*)(F.ws + WS_BUF0 + (size_t)r * DM + c) = (u32x2){(unsigned)p0, (unsigned)p1}; }
                    else { u32x4 pk; pk.x = cvt_pk_bf16(y0[0], y0[1]); pk.y = cvt_pk_bf16(y0[2], y0[3]); pk.z = cvt_pk_bf16(y1[0], y1[1]); pk.w = cvt_pk_bf16(y1[2], y1[3]);
                        *(u32x4*)((bf16_t*)(F.ws + WS_BUF0) + (size_t)r * DM + c) = pk; } }
                else { *(f32x4*)(F.out + (size_t)r * DM + c) = y0; *(f32x4*)(F.out + (size_t)r * DM + c + 4) = y1; } } }
    }
}

__device__ __forceinline__ void transpose_ob(Frame& F) {
    LAS bf16_t* scr = (LAS bf16_t*)(F.lds + F.wave * 16384);
    const int gw = F.bid * NWAVES + F.wave, NGW = F.G * NWAVES;
    const bf16_t* src = (const bf16_t*)(F.ws + WS_OBT); bf16_t* dst = (bf16_t*)(F.ws + WS_BUF0);
    const int r8 = F.lane >> 3, c8 = F.lane & 7;
    for (int it = gw; it < 8 * 512; it += NGW) {
        const int cb = it & 7, tb = it >> 3; const int c0 = cb * 64, t0 = tb * 64;
        u32x4 v[8];
#pragma unroll
        for (int i = 0; i < 8; ++i) v[i] = *(const u32x4*)(src + (size_t)(c0 + r8 + 8 * i) * NTOK + t0 + 8 * c8);
#pragma unroll
        for (int i = 0; i < 8; ++i) *(LAS u32x4*)(scr + (r8 + 8 * i) * 72 + 8 * c8) = v[i];
        LDS_WAIT(); asm volatile("" ::: "memory");
#pragma unroll
        for (int i = 0; i < 8; ++i) { const int t = r8 + 8 * i; unsigned short e[8];
#pragma unroll
            for (int k = 0; k < 8; ++k) e[k] = scr[(8 * c8 + k) * 72 + t];
            u32x4 o; o.x = e[0] | ((unsigned)e[1] << 16); o.y = e[2] | ((unsigned)e[3] << 16); o.z = e[4] | ((unsigned)e[5] << 16); o.w = e[6] | ((unsigned)e[7] << 16);
            *(u32x4*)(dst + (size_t)(t0 + t) * DM + 512 + c0 + 8 * c8) = o; }
        LDS_WAIT(); asm volatile("" ::: "memory");
    }
}

template <int SS> __device__ __forceinline__ void conv_step(f32x2 (&acc)[32], const f32x2 (&w)[31], const f32x2 bias, const unsigned rawv) {
    const f32x2 xin = (f32x2){bflo(rawv), bfhi(rawv)};
    acc[SS] = bias;
#pragma unroll
    for (int k = 0; k < 31; ++k) acc[(SS - k) & 31] += w[k] * xin;
}
constexpr int CV_TILE = 65536;
__device__ __forceinline__ void conv_ln_rows(Frame& F, const LAS bf16_t* tile, bf16_t* Obase  ) {
#pragma unroll 1
    for (int q = 0; q < 4; ++q) { const int rr = F.wave * 4 + q;
        f32x4 v[4]; float sm = 0.f;
#pragma unroll
        for (int h = 0; h < 2; ++h) { const u32x4 t = *(const LAS u32x4*)(tile + rr * 1024 + 8 * F.lane + 512 * h); bf8_to_f32(t, v[2 * h], v[2 * h + 1]); }
#pragma unroll
        for (int j = 0; j < 4; ++j) sm += (v[j].x + v[j].y) + (v[j].z + v[j].w);
        const float mean = wave_sum(sm) * (1.0f / 1024.0f); float s2 = 0.f;
#pragma unroll
        for (int j = 0; j < 4; ++j) { v[j] = v[j] - mean; s2 += (v[j].x * v[j].x + v[j].y * v[j].y) + (v[j].z * v[j].z + v[j].w * v[j].w); }
        const float rstd = 1.0f / sqrtf(wave_sum(s2) * (1.0f / 1024.0f) + EPS);
        bf16_t* orow = Obase + (size_t)rr * (CONF_FP8 ? DM / 2 : DM);
#pragma unroll
        for (int h = 0; h < 2; ++h) { const int c = 8 * F.lane + 512 * h;
            f32x4 y0 = v[2 * h] * rstd * *(const f32x4*)(F.in[I_CVLNG] + c) + *(const f32x4*)(F.in[I_CVLNB] + c), y1 = v[2 * h + 1] * rstd * *(const f32x4*)(F.in[I_CVLNG] + c + 4) + *(const f32x4*)(F.in[I_CVLNB] + c + 4);
#pragma unroll
            for (int e = 0; e < 4; ++e) { y0[e] = silu_f(y0[e]); y1[e] = silu_f(y1[e]); }
            if (CONF_FP8) { int p0 = 0, p1 = 0; p0 = __builtin_amdgcn_cvt_pk_fp8_f32(y0[0], y0[1], p0, false); p0 = __builtin_amdgcn_cvt_pk_fp8_f32(y0[2], y0[3], p0, true);
                p1 = __builtin_amdgcn_cvt_pk_fp8_f32(y1[0], y1[1], p1, false); p1 = __builtin_amdgcn_cvt_pk_fp8_f32(y1[2], y1[3], p1, true); *(u32x2*)((unsigned char*)orow + c) = (u32x2){(unsigned)p0, (unsigned)p1}; }
            else { u32x4 pk; pk.x = cvt_pk_bf16(y0[0], y0[1]); pk.y = cvt_pk_bf16(y0[2], y0[3]); pk.z = cvt_pk_bf16(y1[0], y1[1]); pk.w = cvt_pk_bf16(y1[2], y1[3]); *(u32x4*)(orow + c) = pk; } } }
}
__device__ __forceinline__ void conv_half_issue(Frame& F, const bf16_t* Abatch, int t0, int s1, LAS unsigned char* dst) {
    const char* zrow = (const char*)(F.ws + WS_CTL + 512 * 1024);
#pragma unroll
    for (int i = 0; i < 4; ++i) { const int p = F.tid + 512 * i, row = p >> 7, chn = p & 127; const int t = t0 - 15 + s1 + row;
        const char* src = (t >= 0 && t < SEQ) ? (const char*)(Abatch + (size_t)t * DM) + 16 * chn : zrow + 16 * chn;
        __builtin_amdgcn_global_load_lds((const unsigned*)src, (LAS unsigned*)(dst + i * 8192 + F.wave * 1024), 16, 0, 0); }
}
__device__ __forceinline__ void conv_ln_phase(Frame& F) {
    LAS unsigned char* stA = F.lds; LAS unsigned char* stB = F.lds + 32768; LAS bf16_t* tile = (LAS bf16_t*)(F.lds + CV_TILE);
    const bf16_t* A = (const bf16_t*)(F.ws + WS_GLU); bf16_t* O = (bf16_t*)(F.ws + WS_BUF0);
    const int ch = 2 * F.tid;
    f32x2 w[31];
#pragma unroll
    for (int k = 0; k < 31; ++k) w[k] = *(const f32x2*)(F.in[I_CVDWW] + k * 1024 + ch);
    const f32x2 bias = *(const f32x2*)(F.in[I_CVDWB] + ch);
    for (int blk = F.bid; blk < 256; blk += F.G) {
        const int b = blk >> 5, t0 = (blk & 31) * 128;
        const bf16_t* Ab = A + (size_t)b * SEQ * DM;
        f32x2 acc[32];
#pragma unroll
        for (int i = 0; i < 32; ++i) acc[i] = (f32x2){0.f, 0.f};
        __syncthreads();
        conv_half_issue(F, Ab, t0, 0, stA); conv_half_issue(F, Ab, t0, 16, stB);
#pragma unroll 1
        for (int s0 = 0; s0 < 160; s0 += 32) {
#define CV_STEP(SS) { conv_step<SS>(acc, w, bias, *(const LAS unsigned*)((SS < 16 ? stA : stB) + (SS & 15) * 2048 + 2 * ch)); const int o = s0 + SS - 30; \
                if (o >= 0 && o < 128) { const f32x2 r_ = acc[(SS + 2) & 31]; *(LAS unsigned*)(tile + ((SS + 2) & 31) * 1024 + ch) = cvt_pk_bf16(r_.x, r_.y); } \
                if (SS == 29 && o >= 0 && o < 128) { __syncthreads(); conv_ln_rows(F, tile, O + ((size_t)b * SEQ + t0 + (o - 31)) * (CONF_FP8 ? DM / 2 : DM)); __syncthreads(); } }
            VM_WAIT(); __syncthreads();
            CV_STEP(0) CV_STEP(1) CV_STEP(2) CV_STEP(3) CV_STEP(4) CV_STEP(5) CV_STEP(6) CV_STEP(7) CV_STEP(8) CV_STEP(9) CV_STEP(10) CV_STEP(11) CV_STEP(12) CV_STEP(13) CV_STEP(14) CV_STEP(15)
            __syncthreads();
            if (s0 + 32 < 160) conv_half_issue(F, Ab, t0, s0 + 32, stA);
            CV_STEP(16) CV_STEP(17) CV_STEP(18) CV_STEP(19) CV_STEP(20) CV_STEP(21) CV_STEP(22) CV_STEP(23) CV_STEP(24) CV_STEP(25) CV_STEP(26) CV_STEP(27) CV_STEP(28) CV_STEP(29) CV_STEP(30) CV_STEP(31)
            __syncthreads();
            if (s0 + 32 < 160) conv_half_issue(F, Ab, t0, s0 + 48, stB);
#undef CV_STEP
        }
    }
}
namespace att {
constexpr int KT = 64, NTILE = LKV / KT, ST_BYTES = 24576;
typedef short v4i16_t __attribute__((ext_vector_type(4)));

__device__ __forceinline__ f32x16 mfma32(bf16x8 a, bf16x8 b, f32x16 c) { return __builtin_amdgcn_mfma_f32_32x32x16_bf16(a, b, c, 0, 0, 0); }

__device__ __forceinline__ void attn_phase(Frame& F) {
    LAS unsigned char* lds = F.lds;
    const int l = F.lane, w = F.wave, tid = F.tid, r32 = l & 31, hi = l >> 5;
    const bf16_t* Qb = (const bf16_t*)(F.ws + WS_Q); const bf16_t* Kb = (const bf16_t*)(F.ws + WS_K); const bf16_t* Vb = (const bf16_t*)(F.ws + WS_V);
    bf16_t* Ob = (bf16_t*)(F.ws + WS_BUF0);
    const float lam = ((const float*)(F.ws + WS_TAB))[TB_LAM];
    const unsigned kbase_ = (unsigned)(r32 * 128), kx_ = (unsigned)((r32 >> 1) & 7);
    unsigned vbase_, vq4_;
    { const int g = l >> 4, i = l & 15, q4 = i >> 2, p4 = i & 3; const int row = 4 * (g >> 1) + q4;
      const int lowch = (2 * (g & 1) + (p4 >> 1)) ^ ((row >> 2) & 3);
      vbase_ = (unsigned)(8192 + row * 256 + (lowch << 4) + 8 * (p4 & 1)); vq4_ = (unsigned)q4; }
#define ATT_ISSUE(st, kv0) do { const size_t _ro = (size_t)(kv0) * 1024; int t_ = tid; asm volatile("" : "+v"(t_)); \
        const int krow = t_ >> 3; const unsigned ksrc = (unsigned)(krow * 1024 + (((t_ & 7) ^ ((krow >> 1) & 7)) << 4)); unsigned vsrc[2]; \
        _Pragma("unroll") for (int i_ = 0; i_ < 2; ++i_) { const int p = t_ + 512 * i_, vrow = p >> 4; vsrc[i_] = (unsigned)(vrow * 1024 + (((p & 15) ^ (((vrow & 3) << 2) | ((vrow >> 2) & 3))) << 4)); } \
        __builtin_amdgcn_global_load_lds((const unsigned*)(Kg + _ro + ksrc), (LAS unsigned*)(lds + (st) * ST_BYTES + w * 1024), 16, 0, 0); \
        __builtin_amdgcn_global_load_lds((const unsigned*)(Vg + _ro + vsrc[0]), (LAS unsigned*)(lds + (st) * ST_BYTES + 8192 + w * 1024), 16, 0, 0); \
        __builtin_amdgcn_global_load_lds((const unsigned*)(Vg + _ro + vsrc[1]), (LAS unsigned*)(lds + (st) * ST_BYTES + 16384 + w * 1024), 16, 0, 0); } while (0)

    for (int it = 0;; ++it) {
        int grp, qb;
        if (F.G == 256) { const int x = F.bid & 7, j = F.bid >> 3; if (it >= 2) break; grp = x * 4 + it * 2 + (j >> 4); qb = j & 15; }
        else { const int un = it * F.G + F.bid; if (un >= 512) break; grp = un >> 4; qb = un & 15; }
        const int b = grp >> 2, hp = grp & 3;
        const bf16_t* Qg = Qb + ((size_t)b * SEQ + qb * 256 + w * 32 + r32) * 512;
        const char* Vg = (const char*)(Vb + (size_t)b * LKV * 512 + hp * 128);
        f32x16 o1[4];
#pragma unroll 1
        for (int s = 0; s < 2; ++s) {
            const char* Kg = (const char*)(Kb + (size_t)b * LKV * 512 + (2 * hp + s) * 64);
            bf16x8 qf[4];
#pragma unroll
            for (int ds = 0; ds < 4; ++ds) qf[ds] = *(const bf16x8*)(Qg + (2 * hp + s) * 64 + ds * 16 + hi * 8);
            f32x16 O[4];
#pragma unroll
            for (int d = 0; d < 4; ++d)
#pragma unroll
                for (int r = 0; r < 16; ++r) O[d][r] = 0.f;
            float m = 0.f, lsum = 0.f;
            __syncthreads();
            ATT_ISSUE(0, 0);
#pragma unroll 1
            for (int j = 0; j < NTILE; ++j) {
                VM_WAIT(); __syncthreads();
                if (j + 1 < NTILE) ATT_ISSUE((j + 1) & 1, (j + 1) * KT);
                const LAS unsigned char* Ks = lds + (j & 1) * ST_BYTES;
                unsigned kbase = kbase_, kx = kx_, vbase = vbase_, vq4 = vq4_; asm volatile("" : "+v"(kbase), "+v"(kx), "+v"(vbase), "+v"(vq4));
                f32x16 p0, p1;
#pragma unroll
                for (int r = 0; r < 16; ++r) { p0[r] = 0.f; p1[r] = 0.f; }
#pragma unroll
                for (int ds = 0; ds < 4; ++ds) { const unsigned ka = kbase + ((((unsigned)(2 * ds + hi)) ^ kx) << 4); const bf16x8 k0 = *(const LAS bf16x8*)(Ks + ka), k1 = *(const LAS bf16x8*)(Ks + ka + 4096);
                    p0 = mfma32(k0, qf[ds], p0); p1 = mfma32(k1, qf[ds], p1); }
                if (j == 0) { float mx0 = fmaxf(p0[0], p1[0]);
#pragma unroll
                    for (int r = 1; r < 16; ++r) mx0 = fmaxf(mx0, fmaxf(p0[r], p1[r]));
                    m = fmaxf(mx0, __shfl_xor(mx0, 32)); }
                f32x2 e0[8], e1[8];
                { const f32x2 mm = (f32x2){m, m};
#pragma unroll
                  for (int r = 0; r < 8; ++r) { e0[r] = (f32x2){p0[2 * r], p0[2 * r + 1]} - mm; e1[r] = (f32x2){p1[2 * r], p1[2 * r + 1]} - mm; } }
                float mx = fmaxf(fmaxf(e0[0].x, e0[0].y), fmaxf(e1[0].x, e1[0].y));
#pragma unroll
                for (int r = 1; r < 8; ++r) { mx = fmaxf(fmaxf(mx, e0[r].x), e0[r].y); mx = fmaxf(fmaxf(mx, e1[r].x), e1[r].y); }
                mx = fmaxf(mx, __shfl_xor(mx, 32));
                if (!__all(mx <= 8.0f)) { const float dl = fmaxf(mx, 0.f), alpha = __builtin_amdgcn_exp2f(-dl);
#pragma unroll
                    for (int d = 0; d < 4; ++d) O[d] = O[d] * alpha;
                    lsum *= alpha; m += dl; const f32x2 dd = (f32x2){dl, dl};
#pragma unroll
                    for (int r = 0; r < 8; ++r) { e0[r] -= dd; e1[r] -= dd; } }
                { f32x2 acc = (f32x2){0.f, 0.f};
#pragma unroll
                  for (int r = 0; r < 8; ++r) { e0[r] = (f32x2){__builtin_amdgcn_exp2f(e0[r].x), __builtin_amdgcn_exp2f(e0[r].y)}; e1[r] = (f32x2){__builtin_amdgcn_exp2f(e1[r].x), __builtin_amdgcn_exp2f(e1[r].y)};
                      acc += e0[r] + e1[r]; }
                  lsum += acc.x + acc.y; }
                bf16x8 pb[4];
#pragma unroll
                for (int q = 0; q < 2; ++q) { u32x4 a, c;
                    a.x = cvt_pk_bf16(e0[4 * q + 0].x, e0[4 * q + 0].y); a.y = cvt_pk_bf16(e0[4 * q + 1].x, e0[4 * q + 1].y); a.z = cvt_pk_bf16(e0[4 * q + 2].x, e0[4 * q + 2].y); a.w = cvt_pk_bf16(e0[4 * q + 3].x, e0[4 * q + 3].y);
                    c.x = cvt_pk_bf16(e1[4 * q + 0].x, e1[4 * q + 0].y); c.y = cvt_pk_bf16(e1[4 * q + 1].x, e1[4 * q + 1].y); c.z = cvt_pk_bf16(e1[4 * q + 2].x, e1[4 * q + 2].y); c.w = cvt_pk_bf16(e1[4 * q + 3].x, e1[4 * q + 3].y);
                    pb[q] = __builtin_bit_cast(bf16x8, a); pb[2 + q] = __builtin_bit_cast(bf16x8, c); }
#pragma unroll
                for (int d = 0; d < 4; ++d) {
                    const unsigned va0 = vbase + ((((unsigned)d) ^ vq4) << 6), va1 = (va0 ^ 32u) + 2048u;
#pragma unroll
                    for (int kv = 0; kv < 4; ++kv) {
                        const v4i16_t lo = __builtin_amdgcn_ds_read_tr16_b64_v4i16((LAS v4i16_t*)(Ks + va0 + kv * 4096));
                        const v4i16_t hh = __builtin_amdgcn_ds_read_tr16_b64_v4i16((LAS v4i16_t*)(Ks + va1 + kv * 4096));
                        const bf16x8 vf = (bf16x8){lo[0], lo[1], lo[2], lo[3], hh[0], hh[1], hh[2], hh[3]};
                        O[d] = mfma32(vf, pb[kv], O[d]); } }
            }
            const float lt = lsum + __shfl_xor(lsum, 32);
            if (s == 0) { const float inv = 1.0f / lt;
#pragma unroll
                for (int d = 0; d < 4; ++d) o1[d] = O[d] * inv; }
            else { const float inv = lam / lt; float ss = 0.f;
#pragma unroll
                for (int d = 0; d < 4; ++d) { o1[d] = o1[d] - O[d] * inv;
#pragma unroll
                    for (int r = 0; r < 16; ++r) ss += o1[d][r] * o1[d][r]; }
                ss += __shfl_xor(ss, 32);
                const float rn = 0.8f / sqrtf(ss * (1.0f / 128.0f) + EPS);
                bf16_t* orow = Ob + ((size_t)b * SEQ + qb * 256 + w * 32 + r32) * DM + hp * 128 + 4 * hi;
#pragma unroll
                for (int d = 0; d < 4; ++d)
#pragma unroll
                    for (int q = 0; q < 4; ++q) { const f32x4 g4 = *(const f32x4*)(F.in[I_SUBLN] + 32 * d + 8 * q + 4 * hi);
                        u32x2 pk; pk.x = cvt_pk_bf16(o1[d][4 * q] * rn * g4[0], o1[d][4 * q + 1] * rn * g4[1]); pk.y = cvt_pk_bf16(o1[d][4 * q + 2] * rn * g4[2], o1[d][4 * q + 3] * rn * g4[3]);
                        *(u32x2*)(orow + 32 * d + 8 * q) = pk; }
            }
        }
    }
#undef ATT_ISSUE
}
}
namespace hy {
constexpr int FBUF = 4352 * 8;
constexpr int KOFF = 2 * FBUF;
constexpr int KLEN = 2192;
constexpr int RED_OFF = KOFF + 4 * KLEN * 8;
__device__ __forceinline__ int pad(int i) { return i + (i >> 4); }
__device__ __forceinline__ float sgpr_f(float v) { return __int_as_float(__builtin_amdgcn_readfirstlane(__float_as_int(v))); }
typedef f32x2 cx;
#ifndef HY_ASM
#define HY_ASM 3
#endif
#if HY_ASM & 1
__device__ __forceinline__ void c_mul_ip(cx& x, cx w) { cx t;
    asm("v_pk_mul_f32 %1, %0, %2 op_sel_hi:[0,1]\n\tv_pk_fma_f32 %0, %0, %2, %1 op_sel:[1,1,0] op_sel_hi:[1,0,1] neg_lo:[1,0,0]" : "+v"(x), "=&v"(t) : "v"(w)); }
__device__ __forceinline__ cx c_mul(cx x, cx w) { cx y;
    asm("v_pk_mul_f32 %0, %1, %2 op_sel_hi:[0,1]\n\tv_pk_fma_f32 %0, %1, %2, %0 op_sel:[1,1,0] op_sel_hi:[1,0,1] neg_lo:[1,0,0]" : "=&v"(y) : "v"(x), "v"(w)); return y; }
__device__ __forceinline__ void c_mul_sw_ip(cx& x, cx w) { cx t;
    asm("v_pk_mul_f32 %1, %0, %2 op_sel:[0,1] op_sel_hi:[0,0]\n\tv_pk_fma_f32 %0, %0, %2, %1 op_sel:[1,0,0] op_sel_hi:[1,1,1] neg_hi:[1,0,0]" : "+v"(x), "=&v"(t) : "v"(w)); }
__device__ __forceinline__ void c_mul_swc_ip(cx& x, cx w) { cx t;
    asm("v_pk_mul_f32 %1, %0, %2 op_sel:[0,1] op_sel_hi:[0,0]\n\tv_pk_fma_f32 %0, %0, %2, %1 op_sel:[1,0,0] op_sel_hi:[1,1,1] neg_lo:[0,0,1]" : "+v"(x), "=&v"(t) : "v"(w)); }
__device__ __forceinline__ void c_mul_k_ip(cx& x, cx w) { cx t;
    asm("v_pk_mul_f32 %1, %0, %2 op_sel_hi:[0,1]\n\tv_pk_fma_f32 %0, %0, %2, %1 op_sel:[1,1,0] op_sel_hi:[1,0,1] neg_lo:[1,0,0]" : "+v"(x), "=&v"(t) : "s"(w)); }
#else
__device__ __forceinline__ cx c_mul(cx x, cx w) { return (cx){x.x, x.x} * w + (cx){-x.y, x.y} * (cx){w.y, w.x}; }
__device__ __forceinline__ void c_mul_ip(cx& x, cx w) { x = c_mul(x, w); }
__device__ __forceinline__ void c_mul_k_ip(cx& x, cx w) { x = c_mul(x, w); }
__device__ __forceinline__ void c_mul_sw_ip(cx& x, cx w) { x = (cx){x.x, x.x} * (cx){w.y, w.x} + (cx){x.y, -x.y} * w; }
__device__ __forceinline__ void c_mul_swc_ip(cx& x, cx w) { c_mul_sw_ip(x, (cx){w.x, -w.y}); }
#endif
#if HY_ASM & 2
__device__ __forceinline__ cx c_mi(cx a, cx b) { cx d; asm("v_pk_add_f32 %0, %1, %2 op_sel:[0,1] op_sel_hi:[1,0] neg_hi:[0,1]" : "=v"(d) : "v"(a), "v"(b)); return d; }
__device__ __forceinline__ cx c_pi(cx a, cx b) { cx d; asm("v_pk_add_f32 %0, %1, %2 op_sel:[0,1] op_sel_hi:[1,0] neg_lo:[0,1]" : "=v"(d) : "v"(a), "v"(b)); return d; }
#else
__device__ __forceinline__ cx c_mi(cx a, cx b) { return a + (cx){b.y, -b.x}; }
__device__ __forceinline__ cx c_pi(cx a, cx b) { return a + (cx){-b.y, b.x}; }
#endif

__device__ __forceinline__ void dft4(cx& a, cx& b, cx& c, cx& d) {
    const cx s0 = a + c, d0 = a - c, s1 = b + d, d1 = b - d;
    a = s0 + s1; c = s0 - s1; b = c_mi(d0, d1); d = c_pi(d0, d1);
}
__device__ __forceinline__ void dft4_rc(cx& a, cx& b, cx& c, cx& d) {
    const cx s0 = c_mi(a, c), d0 = c_pi(a, c), s1 = b + d, d1 = b - d;
    a = s0 + s1; c = s0 - s1; b = c_mi(d0, d1); d = c_pi(d0, d1);
}
__device__ __forceinline__ void dft16(cx (&x)[16]) {
    constexpr float C1 = 0.9238795325112867f, S1 = 0.3826834323650898f, R = 0.7071067811865476f;
#pragma unroll
    for (int b = 0; b < 4; ++b) dft4(x[b], x[4 + b], x[8 + b], x[12 + b]);
    c_mul_k_ip(x[5], (cx){C1, -S1}); c_mul_k_ip(x[6], (cx){R, -R}); c_mul_k_ip(x[7], (cx){S1, -C1});
    c_mul_k_ip(x[9], (cx){R, -R});   c_mul_k_ip(x[11], (cx){-R, -R});
    c_mul_k_ip(x[13], (cx){S1, -C1}); c_mul_k_ip(x[14], (cx){-R, -R}); c_mul_k_ip(x[15], (cx){-C1, S1});
#pragma unroll
    for (int c = 0; c < 4; ++c) { if (c == 2) dft4_rc(x[8], x[9], x[10], x[11]); else dft4(x[4 * c], x[4 * c + 1], x[4 * c + 2], x[4 * c + 3]); }
    cx y[16];
#pragma unroll
    for (int k = 0; k < 16; ++k) y[k] = x[4 * (k & 3) + (k >> 2)];
#pragma unroll
    for (int k = 0; k < 16; ++k) x[k] = y[k];
}
__device__ __forceinline__ void twiddle_pow(cx (&x)[16], cx w) {
    cx p[16]; p[1] = w;
#pragma unroll
    for (int n = 2; n < 16; ++n) { const int a = n >> 1, b = n - a; p[n] = c_mul(p[a], p[b]); }
#pragma unroll
    for (int n = 1; n < 16; ++n) c_mul_ip(x[n], p[n]);
}
__device__ __forceinline__ void fft4096(cx (&x)[16], LAS f32x2* buf, int uw, int u, const cx w2, const cx w3) {
    dft16(x);
    { LAS f32x2* p = buf + pad(uw);
#pragma unroll
      for (int k = 0; k < 16; ++k) p[272 * k] = x[k]; }
    __syncthreads();
    { LAS f32x2* p = buf + 272 * (u >> 4) + (u & 15);
#pragma unroll
      for (int n = 0; n < 16; ++n) x[n] = *(const volatile LAS f32x2*)(p + 17 * n);
      twiddle_pow(x, w2);
      dft16(x);
#pragma unroll
      for (int k = 0; k < 16; ++k) p[17 * k] = x[k]; }
    __syncthreads();
    { const LAS f32x2* p = buf + 272 * (u >> 4) + 17 * (u & 15);
#pragma unroll
      for (int n = 0; n < 16; ++n) x[n] = *(const volatile LAS f32x2*)(p + n);
      twiddle_pow(x, w3);
      dft16(x); }
}
__device__ __forceinline__ void twiddle_w8192(cx (&x)[16], cx base, bool conj) {
    constexpr float C = 0.9807852804032304f, S = 0.1950903220161283f;
    cx w = conj ? (cx){base.x, -base.y} : base; const cx st = (cx){C, conj ? S : -S};
#pragma unroll
    for (int n = 0; n < 16; ++n) { c_mul_ip(x[n], w); c_mul_ip(w, st); }
}
struct SRow { u32x4 raw; bf16_t l, r; };
__device__ __forceinline__ void sconv_load(const bf16_t* row, int t0, SRow& R) {
    R.raw = *(const u32x4*)(row + t0); R.l = row[t0 > 0 ? t0 - 1 : 0]; R.r = row[t0 + 8 < SEQ ? t0 + 8 : SEQ - 1];
}
__device__ __forceinline__ void sconv_apply(const SRow& R, int t0, const f32x4 wb  , float (&out)[8]) {
    float x[10]; x[0] = t0 > 0 ? bf2f(R.l) : 0.f; x[9] = t0 + 8 < SEQ ? bf2f(R.r) : 0.f;
    x[1] = bflo(R.raw.x); x[2] = bfhi(R.raw.x); x[3] = bflo(R.raw.y); x[4] = bfhi(R.raw.y); x[5] = bflo(R.raw.z); x[6] = bfhi(R.raw.z); x[7] = bflo(R.raw.w); x[8] = bfhi(R.raw.w);
#pragma unroll
    for (int i = 0; i < 8; ++i) out[i] = wb[3] + wb[0] * x[i] + wb[1] * x[i + 1] + wb[2] * x[i + 2];
}

__device__ __forceinline__ void hyena_phase(Frame& F) {
    LAS f32x2* FB0 = (LAS f32x2*)F.lds; LAS f32x2* FB1 = (LAS f32x2*)(F.lds + FBUF);
    LAS f32x2* KH = (LAS f32x2*)(F.lds + KOFF);
    LAS float* red = (LAS float*)(F.lds + RED_OFF);
    const int tid = F.tid, half = tid >> 8, u_ = tid & 255, u1_ = (u_ >> 4) + 16 * (u_ & 15);
    LAS f32x2* myF = half ? FB1 : FB0;
    const float* tab = (const float*)(F.ws + WS_TAB);
    const f32x2* T4096 = (const f32x2*)(tab + TB_T4096); const f32x2* T8A = (const f32x2*)(tab + TB_T8A); const f32x2* T8B = (const f32x2*)(tab + TB_T8B);
#define HY_W8192(dst, idx) f32x2 dst; { const f32x2 a_ = T8A[(idx) & 63], b_ = T8B[(idx) >> 6]; dst = (f32x2){a_.x * b_.x - a_.y * b_.y, a_.x * b_.y + a_.y * b_.x}; }
    const cx tw2 = T4096[16 * (u_ >> 4)], tw3 = T4096[(u_ >> 4) + 16 * (u_ & 15)];
    HY_W8192(twu, u_); HY_W8192(twu1, u1_);
    const float* kraw = (const float*)(F.ws + WS_KRAW);
    const bf16_t* UT = (const bf16_t*)(F.ws + WS_UT); bf16_t* OBT = (bf16_t*)(F.ws + WS_OBT);
    const int j0 = 8 * tid, jp = 8 * tid + (tid >> 1);
    for (int c = F.bid; c < 512; c += F.G) {
        f32x4 wS[3];
#pragma unroll
        for (int s3 = 0; s3 < 3; ++s3) { const float* swp = F.in[I_HYSW] + 512 * s3 + c; wS[s3] = (f32x4){sgpr_f(swp[0]), sgpr_f(swp[1536]), sgpr_f(swp[3072]), sgpr_f(F.in[I_HYSB][512 * s3 + c])}; }
        const float bias0 = sgpr_f(F.in[I_HYBIAS][c]), bias1 = sgpr_f(F.in[I_HYBIAS][512 + c]);
        __syncthreads();
        { float an[2];
#pragma unroll
          for (int o = 0; o < 2; ++o) { const float* fw = kraw + (size_t)(1024 * o + c) * 4096; const float* bw = kraw + (size_t)(1024 * o + 512 + c) * 4096;
              float f[8], g[8];
              { const f32x4 fa = *(const f32x4*)(fw + j0), fb = *(const f32x4*)(fw + j0 + 4);
                const f32x4 ga = *(const f32x4*)(bw + 4088 - j0), gb = *(const f32x4*)(bw + 4092 - j0);
                const float g0 = tid > 0 ? bw[4096 - j0] : 0.f;
                f[0] = fa[0]; f[1] = fa[1]; f[2] = fa[2]; f[3] = fa[3]; f[4] = fb[0]; f[5] = fb[1]; f[6] = fb[2]; f[7] = fb[3];
                g[0] = g0; g[1] = gb[3]; g[2] = gb[2]; g[3] = gb[1]; g[4] = gb[0]; g[5] = ga[3]; g[6] = ga[2]; g[7] = ga[1]; }
              float a = 0.f;
#pragma unroll
              for (int i = 0; i < 8; ++i) { a += fabsf(f[i]) + fabsf(g[i]);
                  ((LAS float*)(FB0 + jp + i))[o] = f[i] + g[i]; ((LAS float*)(FB1 + jp + i))[o] = f[i] - g[i]; }
              an[o] = wave_sum(a);
              asm volatile("" ::: "memory"); }
          if (F.lane == 0) { red[F.wave] = an[0]; red[8 + F.wave] = an[1]; } }
        __syncthreads();
        float nrm0 = 0.f, nrm1 = 0.f;
#pragma unroll
        for (int i = 0; i < 8; ++i) { nrm0 += red[i]; nrm1 += red[8 + i]; }
        const float sc0 = 1.0f / (nrm0 * 8192.0f), sc1 = 1.0f / (nrm1 * 8192.0f);
        cx x[16];
        { int u = u_, u1 = u1_; asm volatile("" : "+v"(u), "+v"(u1));
#pragma unroll
        for (int n = 0; n < 16; ++n) x[n] = (myF + pad(u))[272 * n];
        __syncthreads();
        if (half) twiddle_w8192(x, twu, false);
        fft4096(x, myF, u, u, tw2, tw3);
        __syncthreads();
#pragma unroll
        for (int k = 0; k < 16; ++k) (myF + pad(u1))[272 * k] = x[k]; }
        __syncthreads();
        for (int kk = tid; kk < 2049; kk += 512) {
            { const f32x2 A = FB0[pad(kk)]; f32x2 B = FB0[pad((4096 - kk) & 4095)]; B.y = -B.y;
              KH[0 * KLEN + pad(kk)] = (f32x2){(A.x + B.x) * 0.5f * sc0, (A.y + B.y) * 0.5f * sc0};
              KH[2 * KLEN + pad(kk)] = (f32x2){(A.y - B.y) * 0.5f * sc1, -(A.x - B.x) * 0.5f * sc1}; }
            if (kk < 2048) { const f32x2 A = FB1[pad(kk)]; f32x2 B = FB1[pad(4095 - kk)]; B.y = -B.y;
              KH[1 * KLEN + pad(kk)] = (f32x2){(A.x + B.x) * 0.5f * sc0, (A.y + B.y) * 0.5f * sc0};
              KH[3 * KLEN + pad(kk)] = (f32x2){(A.y - B.y) * 0.5f * sc1, -(A.x - B.x) * 0.5f * sc1}; }
        }
        __syncthreads();
        SRow pv0, pv1, pa0, pa1;
        { const bf16_t* vr = UT + (size_t)c * NTOK; sconv_load(vr, j0, pv0); sconv_load(vr + SEQ, j0, pv1); }
#pragma unroll 1
        for (int bp = 0; bp < 4; ++bp) {
            const size_t rb = (size_t)(2 * bp) * SEQ;
            float zr[8], zi[8], vre[8], vim[8];
            sconv_apply(pv0, j0, wS[0], vre); sconv_apply(pv1, j0, wS[0], vim);
#pragma unroll
            for (int i = 0; i < 8; ++i) (FB0 + jp)[i] = (f32x2){vre[i], vim[i]};
            { const bf16_t* x1r = UT + (size_t)(512 + c) * NTOK + rb; sconv_load(x1r, j0, pa0); sconv_load(x1r + SEQ, j0, pa1); }
            __syncthreads();
#pragma unroll 1
            for (int ord = 0; ord < 2; ++ord) {
                int u = u_, u1 = u1_; asm volatile("" : "+v"(u), "+v"(u1));
#pragma unroll
                for (int n = 0; n < 16; ++n) x[n] = (FB0 + pad(u))[272 * n];
                __syncthreads();
                if (half) twiddle_w8192(x, twu, false);
                fft4096(x, myF, u, u, tw2, tw3);
                { const LAS f32x2* Kp = KH + (2 * ord + half) * KLEN;
                  const LAS f32x2* pf = Kp + pad(u1); const LAS f32x2* pm = Kp + pad((half ? 4095 : 4096) - u1);
#pragma unroll
                  for (int n = 0; n < 8; ++n) c_mul_sw_ip(x[n], pf[272 * n]);
                  { const bool mir = half || u1 > 0; f32x2 kv = *(mir ? pm - 272 * 8 : pf + 272 * 8); if (mir) kv.y = -kv.y; c_mul_sw_ip(x[8], kv); }
#pragma unroll
                  for (int n = 9; n < 16; ++n) c_mul_swc_ip(x[n], *(pm - 272 * n)); }
                __syncthreads();
                fft4096(x, myF, u1, u, tw2, tw3);
                if (half) twiddle_w8192(x, twu1, false);
                __syncthreads();
#pragma unroll
                for (int k = 0; k < 16; ++k) (myF + pad(u1))[272 * k] = x[k];
                __syncthreads();
                if (ord == 0) {
                    { float a0[8];
                      sconv_apply(pa0, j0, wS[1], a0);
#pragma unroll
                      for (int i = 0; i < 8; ++i) { const f32x2 e = (FB0 + jp)[i], o = (FB1 + jp)[i]; zr[i] = a0[i] * (e.y + o.y + bias0 * vre[i]); zi[i] = e.x + o.x + bias0 * vim[i]; } }
                    { float a1[8];
                      sconv_apply(pa1, j0, wS[1], a1);
#pragma unroll
                      for (int i = 0; i < 8; ++i) zi[i] *= a1[i]; }
                    { const bf16_t* x2r = UT + (size_t)(1024 + c) * NTOK + rb; sconv_load(x2r, j0, pa0); sconv_load(x2r + SEQ, j0, pa1);
                      const bf16_t* vn = UT + (size_t)c * NTOK + (size_t)(2 * (bp < 3 ? bp + 1 : 3)) * SEQ; sconv_load(vn, j0, pv0); sconv_load(vn + SEQ, j0, pv1); }
                    __syncthreads();
#pragma unroll
                    for (int i = 0; i < 8; ++i) (FB0 + jp)[i] = (f32x2){zr[i], zi[i]};
                    __syncthreads();
                } else {
                    float a0[8], a1[8], r0[8], r1[8];
                    sconv_apply(pa0, j0, wS[2], a0); sconv_apply(pa1, j0, wS[2], a1);
#pragma unroll
                    for (int i = 0; i < 8; ++i) { const f32x2 e = (FB0 + jp)[i], o = (FB1 + jp)[i];
                        r0[i] = a0[i] * (e.y + o.y + bias1 * zr[i]); r1[i] = a1[i] * (e.x + o.x + bias1 * zi[i]); }
                    u32x4 p0, p1;
                    p0.x = cvt_pk_bf16(r0[0], r0[1]); p0.y = cvt_pk_bf16(r0[2], r0[3]); p0.z = cvt_pk_bf16(r0[4], r0[5]); p0.w = cvt_pk_bf16(r0[6], r0[7]);
                    p1.x = cvt_pk_bf16(r1[0], r1[1]); p1.y = cvt_pk_bf16(r1[2], r1[3]); p1.z = cvt_pk_bf16(r1[4], r1[5]); p1.w = cvt_pk_bf16(r1[6], r1[7]);
                    *(u32x4*)(OBT + (size_t)c * NTOK + rb + j0) = p0; *(u32x4*)(OBT + (size_t)c * NTOK + rb + SEQ + j0) = p1;
                    __syncthreads();
                }
            }
        }
    }
}
#undef HY_W8192
}
template <bool GATH> struct MoeOrder {
    static constexpr bool GATHER = GATH;
    const LAS int* pref;
    int total, G, c, ncol, K;
    const char* A; const char* W; size_t wtile; const int* list;
    __device__ bool next(int i, pg8::Unit& u) const {
        const long L = (long)i * G + c; if (L >= total) return false;
        int id = (int)L; { const int q = total / 8, r = total % 8, xcd = id % 8, off = id / 8; id = (xcd < r ? xcd * (q + 1) : r * (q + 1) + (xcd - r) * q) + off; }
        const int rt = id / ncol, pn = id % ncol;
        int e = 0; while (e < 31 && pref[e + 1] <= rt) ++e;
        u.pm = rt; u.pn = pn; u.aux = e;
        u.a = GATH ? A : A + (size_t)rt * 256 * K * 2; u.b = W + (size_t)e * 3 * MiB + (size_t)pn * wtile;
        return true;
    }
    __device__ __forceinline__ void gather(const pg8::Unit& u, int R0, int R1, unsigned (&v)[2][2]) const {
        const int e = u.aux, j = u.pm - pref[e], cnt = pref[40 + e];
#pragma unroll
        for (int h = 0; h < 2; ++h)
#pragma unroll
            for (int i = 0; i < 2; ++i) { int r = j * 256 + h * 128 + (i ? R1 : R0); r = r < cnt ? r : 0; v[h][i] = (unsigned)(list[e * 32768 + r] >> 1) * (unsigned)(K * 2); }
    }
};

#ifndef MK_PER_PHASE
#define MK_PER_PHASE 0
#endif
constexpr int N_PHASES = 17;

__global__ void __launch_bounds__(NTHREADS, 2) fwd_kernel(Args args) {
    extern __shared__ __attribute__((aligned(16))) unsigned char lds_[];
    const int wave0_ = __builtin_amdgcn_readfirstlane((int)threadIdx.x >> 6);
#define MKFRAME(F) Frame F; { int t_ = wave0_ * 64 + (int)__builtin_amdgcn_mbcnt_hi(~0u, __builtin_amdgcn_mbcnt_lo(~0u, 0u)); asm volatile("" : "+v"(t_)); F.lds = (LAS unsigned char*)lds_; F.tid = t_; F.lane = t_ & 63; F.wave = __builtin_amdgcn_readfirstlane(t_ >> 6); \
        F.G = gridDim.x; F.bid = blockIdx.x; F.in = args.in; F.out = args.out; F.ws = args.ws; }
    volatile LAS unsigned* MISC = (volatile LAS unsigned*)((LAS unsigned char*)lds_ + MISC_OFF);
    if (threadIdx.x < 128) MISC[threadIdx.x] = 0u;
    __syncthreads();
    unsigned* ctl = (unsigned*)(args.ws + WS_CTL);
#define lo (args.ph_lo)
#define hi (args.ph_hi)
    if (hi - lo > 1) (void)xcd_barrier_post(ctl + CW_BAR, MISC, threadIdx.x == 0);
#ifndef PH_MASK
#define PH_MASK 0xFFFFFFFFu
#endif
#define IN(k) (lo <= (k) && (k) < hi)
#ifndef DUP_PHASE
#define DUP_PHASE -1
#endif
#define REP(k) _Pragma("unroll") for (int rep_ = 0; rep_ < ((DUP_PHASE) == (k) ? 2 : 1); ++rep_)
#ifdef TPROBE
    const unsigned long long t_start_ = __builtin_amdgcn_s_memrealtime(); unsigned long long t_mark_ = 0ull;
#define TMARK(k) do { if ((k) == (TPROBE)) t_mark_ = __builtin_amdgcn_s_memrealtime() - t_start_; } while (0)
#else
#define TMARK(k) do { } while (0)
#endif
#define SEAM(k) do { if (IN(k) && IN((k) + 1)) { XcdBarrier bar_; bar_.bar = (unsigned*)(args.ws + WS_CTL) + CW_BAR; bar_.x = xb_xcc_id(); bar_.st = (volatile LAS unsigned*)((LAS unsigned char*)lds_ + MISC_OFF); \
        xcd_barrier(bar_, wave0_ == 0 && __builtin_amdgcn_mbcnt_hi(~0u, __builtin_amdgcn_mbcnt_lo(~0u, 0u)) == 0u); } TMARK(k); } while (0)
#define WSP (args.ws)
#define mod0 ((const float*)(args.ws + WS_MOD))
#define mod1 (mod0 + 9 * 6144)
#define tab ((const float*)(args.ws + WS_TAB))

    if (IN(0)) { MKFRAME(F); p0_prologue(F, (unsigned*)(args.ws + WS_CTL) + CW_Q0, (volatile LAS unsigned*)((LAS unsigned char*)lds_ + MISC_OFF) + 4); }
    SEAM(0);
    if (IN(1)) REP(1) { MKFRAME(F); p1_norm_in(F); }
    SEAM(1);
    if (IN(2)) REP(2) { MKFRAME(F);
        { pg8::StaticOrder S; S.init(WSP + WS_BUF0, WSP + WS_WQKVH, NTOK, 1536, 1024, F.G, F.bid);
          pg8::EpiQKV E{(bf16_t*)(WSP + WS_Q), (bf16_t*)(WSP + WS_K), (bf16_t*)(WSP + WS_V), tab + TB_ROPE_C, tab + TB_ROPE_S};
          pg8::gemm_phase(F.lds, F.tid, 1024, S, E); }
        { pg8::StaticOrder S; S.init(WSP + WS_WQKVH + (size_t)1536 * 1024 * 2, WSP + WS_BUF0, 1536, NTOK, 1024, F.G, F.bid);
          pg8::EpiBf16 E{(bf16_t*)(WSP + WS_UT), (size_t)NTOK};
          pg8::gemm_phase(F.lds, F.tid, 1024, S, E); }
        { pg8::StaticOrder S; S.init(WSP + WS_OBT, WSP + WS_WQKVH + (size_t)512 * 1024 * 2, NB * CTXL, 1024, 1024, F.G, F.bid);
          pg8::EpiCtxKV E{(bf16_t*)(WSP + WS_K), (bf16_t*)(WSP + WS_V)};
          pg8::gemm_phase(F.lds, F.tid, 1024, S, E); }
    }
    SEAM(2);
    if (IN(3)) {
#ifndef NO_ATTN
        { MKFRAME(F); att::attn_phase(F); } __syncthreads();
#ifdef DUP_ATTN
        { MKFRAME(F); att::attn_phase(F); } __syncthreads();
#endif
#else
        { MKFRAME(F); bf16_t* o = (bf16_t*)(F.ws + WS_BUF0); for (size_t i = (size_t)F.bid * NTHREADS + F.tid; i < (size_t)NTOK * 64; i += (size_t)F.G * NTHREADS) { const size_t r = i >> 6, c8 = i & 63; *(u32x4*)(o + r * DM + c8 * 8) = (u32x4){0u, 0u, 0u, 0u}; } }
#endif
#ifndef NO_HYENA
        { MKFRAME(F); hy::hyena_phase(F); }
#ifdef DUP_HYENA
        __syncthreads(); { MKFRAME(F); hy::hyena_phase(F); }
#endif
#else
        { MKFRAME(F); bf16_t* o = (bf16_t*)(F.ws + WS_OBT); for (size_t i = (size_t)F.bid * NTHREADS + F.tid; i < (size_t)512 * NTOK / 8; i += (size_t)F.G * NTHREADS) *(u32x4*)(o + i * 8) = (u32x4){0u, 0u, 0u, 0u}; }
#endif
    }
    SEAM(3);
    if (IN(4)) REP(4) { MKFRAME(F); transpose_ob(F); }
    SEAM(4);
    if (IN(5)) REP(5) { MKFRAME(F);
        pg8::StaticOrder S; S.init(WSP + WS_BUF0, WSP + WS_WO, NTOK, 1024, 1024, F.G, F.bid);
        pg8::EpiResid<true> E{F.in[I_X], (bf16_t*)(WSP + WS_X), mod0 + 2 * 1024, nullptr};
        pg8::gemm_phase(F.lds, F.tid, 1024, S, E);
    }
    SEAM(5);
        if (IN(6 + 0)) { MKFRAME(F); moe_front(F, 0); }
        SEAM(6 + 0);
        if (IN(6 + 1)) REP(9) { MKFRAME(F);
            moe_prefix(F, 0, (LAS int*)((LAS unsigned char*)lds_ + MISC_OFF + 64));
            MoeOrder<true> S; LAS int* pref = (LAS int*)((LAS unsigned char*)lds_ + MISC_OFF + 64); S.pref = pref; S.total = pref[32] * 4; S.G = F.G; S.c = F.bid; S.ncol = 4; S.K = 512;
            S.A = (const char*)(WSP + WS_BUF0); S.W = (const char*)(WSP + WS_WMOE + (size_t)0 * 32 * 3 * MiB); S.wtile = (size_t)256 * 512 * 2; S.list = (const int*)(WSP + WS_LIST);
            pg8::EpiGated<2> E{(bf16_t*)(WSP + WS_H), (size_t)512, nullptr, nullptr};
            pg8::gemm_phase<pg8::EpiGated<2>, MoeOrder<true>, true, 127, 122>(F.lds, F.tid, 512, S, E);
        }
        SEAM(6 + 1);
        if (IN(6 + 2)) REP(10) { MKFRAME(F);
            moe_prefix(F, 0, (LAS int*)((LAS unsigned char*)lds_ + MISC_OFF + 64));
            MoeOrder<false> S; LAS int* pref = (LAS int*)((LAS unsigned char*)lds_ + MISC_OFF + 64); S.pref = pref; S.total = pref[32] * 4; S.G = F.G; S.c = F.bid; S.ncol = 4; S.K = 256;
            S.A = (const char*)(WSP + WS_H); S.W = (const char*)(WSP + WS_WMOE + (size_t)0 * 32 * 3 * MiB + 2 * MiB); S.wtile = (size_t)256 * 256 * 2; S.list = nullptr;
            pg8::EpiScatter E{(bf16_t*)(WSP + WS_BUF0), (bf16_t*)(WSP + WS_Y1), (const int*)(WSP + WS_LIST), pref};
            pg8::gemm_phase<pg8::EpiScatter, MoeOrder<false>, true, 127, 122>(F.lds, F.tid, 256, S, E);
        }
        SEAM(6 + 2);
        if (IN(6 + 3)) {
            MKFRAME(F); moe_combine<0>(F, 0);
        }
        SEAM(6 + 3);

            if (IN(10)) REP(12) { MKFRAME(F);
                pg8::StaticOrder S; S.init(WSP + WS_BUF0, WSP + WS_WC1, NTOK, 2048, CONF_FP8 ? 512 : 1024, F.G, F.bid);
                pg8::EpiGated<1> E{(bf16_t*)(WSP + WS_GLU), (size_t)1024, F.in[I_CVB1], F.in[I_CVB1] + 1024};
                pg8::gemm_phase<pg8::EpiGated<1>, pg8::StaticOrder, CONF_FP8 != 0, 127, CONF_FP8 ? 122 : 127>(F.lds, F.tid, CONF_FP8 ? 512 : 1024, S, E);
            }
            SEAM(10);
            if (IN(11)) REP(13) { MKFRAME(F); conv_ln_phase(F); }
            SEAM(11);
            if (IN(12)) { MKFRAME(F);
                pg8::StaticOrder S; S.init(WSP + WS_BUF0, WSP + WS_WC2, NTOK, 1024, CONF_FP8 ? 512 : 1024, F.G, F.bid);
                pg8::EpiResid<false> E{WSP + WS_X, (bf16_t*)(WSP + WS_X), mod1 + 2 * 1024, F.in[I_CVB2]};
                pg8::gemm_phase<pg8::EpiResid<false>, pg8::StaticOrder, CONF_FP8 != 0, 127, CONF_FP8 ? 122 : 127>(F.lds, F.tid, CONF_FP8 ? 512 : 1024, S, E);
            }
            SEAM(12);
        if (IN(13 + 0)) { MKFRAME(F); moe_front(F, 1); }
        SEAM(13 + 0);
        if (IN(13 + 1)) REP(9) { MKFRAME(F);
            moe_prefix(F, 1, (LAS int*)((LAS unsigned char*)lds_ + MISC_OFF + 64));
            MoeOrder<true> S; LAS int* pref = (LAS int*)((LAS unsigned char*)lds_ + MISC_OFF + 64); S.pref = pref; S.total = pref[32] * 4; S.G = F.G; S.c = F.bid; S.ncol = 4; S.K = 512;
            S.A = (const char*)(WSP + WS_BUF0); S.W = (const char*)(WSP + WS_WMOE + (size_t)1 * 32 * 3 * MiB); S.wtile = (size_t)256 * 512 * 2; S.list = (const int*)(WSP + WS_LIST);
            pg8::EpiGated<2> E{(bf16_t*)(WSP + WS_H), (size_t)512, nullptr, nullptr};
            pg8::gemm_phase<pg8::EpiGated<2>, MoeOrder<true>, true, 127, 122>(F.lds, F.tid, 512, S, E);
        }
        SEAM(13 + 1);
        if (IN(13 + 2)) REP(10) { MKFRAME(F);
            moe_prefix(F, 1, (LAS int*)((LAS unsigned char*)lds_ + MISC_OFF + 64));
            MoeOrder<false> S; LAS int* pref = (LAS int*)((LAS unsigned char*)lds_ + MISC_OFF + 64); S.pref = pref; S.total = pref[32] * 4; S.G = F.G; S.c = F.bid; S.ncol = 4; S.K = 256;
            S.A = (const char*)(WSP + WS_H); S.W = (const char*)(WSP + WS_WMOE + (size_t)1 * 32 * 3 * MiB + 2 * MiB); S.wtile = (size_t)256 * 256 * 2; S.list = nullptr;
            pg8::EpiScatter E{(bf16_t*)(WSP + WS_BUF0), (bf16_t*)(WSP + WS_Y1), (const int*)(WSP + WS_LIST), pref};
            pg8::gemm_phase<pg8::EpiScatter, MoeOrder<false>, true, 127, 122>(F.lds, F.tid, 256, S, E);
        }
        SEAM(13 + 2);
        if (IN(13 + 3)) {
            MKFRAME(F); moe_combine<1>(F, 1);
        }

#ifdef TPROBE
    if (blockIdx.x == 0 && threadIdx.x == 0) { const unsigned long long t1 = __builtin_amdgcn_s_memrealtime(); while (__builtin_amdgcn_s_memrealtime() - t1 < 4ull * t_mark_) __builtin_amdgcn_s_sleep(8); }
#endif
#undef IN
#undef SEAM
#undef lo
#undef hi
#undef WSP
#undef mod0
#undef mod1
#undef tab
#undef MKFRAME
}

extern "C" void kernel_launch(void* const* d_in, const int* in_sizes, int n_in, void* d_out, int out_size, void* d_ws, size_t ws_size, hipStream_t stream) {
    static int grid = 0;
    if (grid == 0) {
        if (n_in != N_IN || out_size != NTOK * DM || ws_size < WS_END) { grid = -1; return; }
        int dev = 0, cus = 0, per_cu = 0;
        if (hipGetDevice(&dev) != hipSuccess || hipDeviceGetAttribute(&cus, hipDeviceAttributeMultiprocessorCount, dev) != hipSuccess) { grid = -1; return; }
        if (hipFuncSetAttribute((const void*)fwd_kernel, hipFuncAttributeMaxDynamicSharedMemorySize, LDS_BYTES) != hipSuccess) { grid = -1; return; }
        (void)hipOccupancyMaxActiveBlocksPerMultiprocessor(&per_cu, (const void*)fwd_kernel, NTHREADS, LDS_BYTES);
        (void)hipGetLastError();
        grid = cus;
    }
    if (grid < 0) return;
    (void)hipMemsetAsync((char*)d_ws + WS_CTL, 0, CTL_ZERO_BYTES, stream);
    Args a{};
    for (int i = 0; i < N_IN; ++i) a.in[i] = (const float*)d_in[i];
    a.out = (float*)d_out; a.ws = (unsigned char*)d_ws;
#if MK_PER_PHASE
    for (int p = 0; p < N_PHASES; ++p) { a.ph_lo = p; a.ph_hi = p + 1; hipLaunchKernelGGL(fwd_kernel, dim3(grid), dim3(NTHREADS), LDS_BYTES, stream, a); }
#else
    a.ph_lo = 0; a.ph_hi = N_PHASES;
    hipLaunchKernelGGL(fwd_kernel, dim3(grid), dim3(NTHREADS), LDS_BYTES, stream, a);
#endif
}
```

```cpp
#define CONF_FP8 0
#include <hip/hip_runtime.h>
#include <stdint.h>
#include <math.h>

#define LAS __attribute__((address_space(3)))
#define GAS __attribute__((address_space(1)))
typedef unsigned short bf16_t;
typedef short bf16x8 __attribute__((ext_vector_type(8)));
typedef short s16x4 __attribute__((ext_vector_type(4)));
typedef float f32x2 __attribute__((ext_vector_type(2)));
typedef float f32x4 __attribute__((ext_vector_type(4)));
typedef float f32x16 __attribute__((ext_vector_type(16)));
typedef unsigned u32x2 __attribute__((ext_vector_type(2)));
typedef unsigned u32x4 __attribute__((ext_vector_type(4)));

constexpr int DM = 1024, NB = 8, SEQ = 4096, NTOK = NB * SEQ, CTXL = 256, LKV = CTXL + SEQ;
constexpr int NEXP = 32, DEXP = 512, SLOT_ROWS = 73728;
constexpr float EPS = 1e-6f;
constexpr float QSCALE = 0.125f * 1.4426950408889634f;

constexpr size_t MiB = 1u << 20;
constexpr size_t WS_CTL = 0, CTL_ZERO_BYTES = 1 * MiB;
constexpr size_t WS_MOD = 1 * MiB;
constexpr size_t WS_TAB = 2 * MiB;
constexpr size_t WS_TOK = 3 * MiB;
constexpr size_t WS_LIST = 4 * MiB;
constexpr size_t WS_LOGIT = 8 * MiB;
constexpr size_t WS_KRAW = 16 * MiB;
constexpr size_t WS_WR = 48 * MiB;
constexpr size_t WS_WQKVH = 50 * MiB;
constexpr size_t WS_WO = 56 * MiB;
constexpr size_t WS_WC1 = 58 * MiB;
constexpr size_t WS_WC2 = 62 * MiB;
constexpr size_t WS_WMOE = 64 * MiB;
constexpr size_t WS_BUF0 = 256 * MiB;
constexpr size_t WS_Q = 320 * MiB;
constexpr size_t WS_K = 352 * MiB;
constexpr size_t WS_V = 386 * MiB;
constexpr size_t WS_UT = 420 * MiB;
constexpr size_t WS_OBT = 516 * MiB;
constexpr size_t WS_X = 320 * MiB;
constexpr size_t WS_H = 448 * MiB;
constexpr size_t WS_Y1 = 520 * MiB;
constexpr size_t WS_GLU = 448 * MiB;
constexpr size_t WS_END = 585 * MiB;

constexpr int CW_TMO = 0;
constexpr int CW_BAR = 4096;
constexpr int CW_Q0 = 2048;
constexpr int CW_CNT = 8192;
constexpr int TB_ROPE_C = 0, TB_ROPE_S = 1024, TB_T4096 = 2048  , TB_T8A = 2560  , TB_T8B = 2688  , TB_LAM = 2816;

constexpr int RING_BYTES = 131072;
constexpr int MISC_OFF = 144384;
constexpr int LDS_BYTES = 147456;
constexpr int NWAVES = 8, NTHREADS = 512;

#define RLX_AGENT __ATOMIC_RELAXED, __HIP_MEMORY_SCOPE_AGENT
#define LDS_WAIT() asm volatile("s_waitcnt lgkmcnt(0)" ::: "memory")
#define VM_WAIT() asm volatile("s_waitcnt vmcnt(0)" ::: "memory")

__device__ __forceinline__ unsigned cvt_pk_bf16(float lo, float hi) { unsigned r; asm volatile("v_cvt_pk_bf16_f32 %0, %1, %2" : "=v"(r) : "v"(lo), "v"(hi)); return r; }
__device__ __forceinline__ float bf2f(bf16_t v) { return __uint_as_float((unsigned)v << 16); }
__device__ __forceinline__ float bflo(unsigned v) { return __uint_as_float(v << 16); }
__device__ __forceinline__ float bfhi(unsigned v) { return __uint_as_float(v & 0xffff0000u); }
__device__ __forceinline__ float wave_sum(float v) {
#pragma unroll
    for (int o = 1; o < 64; o <<= 1) v += __shfl_xor(v, o);
    return v;
}
__device__ __forceinline__ float sigmoid_f(float v) { return __builtin_amdgcn_rcpf(1.0f + __builtin_amdgcn_exp2f(-1.4426950408889634f * v)); }
__device__ __forceinline__ float silu_f(float v) { return v * sigmoid_f(v); }

#define XB_TMO      128
#define XB_XCNT(j)  (256  + 64 * (j))
#define XB_XSUB(j)  (1280 + 64 * (j))
#define XB_XGEN(j)  (2304 + 64 * (j))
#define XB_TOP      3328
#define XB_TOPGEN   3392
#define XCD_BAR_WORDS 3456
#define XB_SPIN_CAP (1u << 20)

__device__ __forceinline__ unsigned xb_ld(unsigned* p)              { return __hip_atomic_load(p, __ATOMIC_RELAXED, __HIP_MEMORY_SCOPE_AGENT); }
__device__ __forceinline__ unsigned xb_add(unsigned* p, unsigned v) { return __hip_atomic_fetch_add(p, v, __ATOMIC_RELAXED, __HIP_MEMORY_SCOPE_AGENT); }
__device__ __forceinline__ unsigned xb_xcc_id() { return (unsigned)__builtin_amdgcn_s_getreg((3 << 11) | 20) & 0xFu; }
#define XB_SPIN(cond, bar) do { unsigned _sp = 0; while (cond) { __builtin_amdgcn_s_sleep(1); \
    if ((++_sp & 255u) == 0u) { if (xb_ld(&(bar)[XB_TMO])) break; if (_sp > XB_SPIN_CAP) { atomicAdd(&(bar)[XB_TMO], 1u); break; } } } } while (0)

struct XcdBarrier { unsigned* bar; unsigned x; volatile LAS unsigned* st; };

__device__ __forceinline__ XcdBarrier xcd_barrier_post(unsigned* bar, volatile LAS unsigned* st, bool leader  ) {
    XcdBarrier b; b.bar = bar; b.x = xb_xcc_id(); b.st = st;
    if (leader) (void)xb_add(&bar[XB_XCNT(b.x)], 1u);
    return b;
}
__device__ __forceinline__ void xcd_barrier_complete(unsigned* bar, unsigned x, unsigned& nloc, unsigned& nx) {
    const unsigned G = gridDim.x * gridDim.y * gridDim.z;
    unsigned sum, cnt, mine, sp = 0u;
    for (;;) {
        sum = 0u; cnt = 0u; mine = 0u;
#pragma unroll
        for (unsigned j = 0; j < 16; ++j) { const unsigned c = xb_ld(&bar[XB_XCNT(j)]); sum += c; cnt += (c > 0u) ? 1u : 0u; mine = (j == x) ? c : mine; }
        if (sum == G) break;
        __builtin_amdgcn_s_sleep(1);
        if ((++sp & 255u) == 0u) { if (xb_ld(&bar[XB_TMO])) break; if (sp > XB_SPIN_CAP) { atomicAdd(&bar[XB_TMO], 1u); break; } }
    }
    nloc = mine > 0u ? mine : 1u; nx = cnt > 0u ? cnt : 1u;
}
__device__ __forceinline__ void xcd_barrier(const XcdBarrier& b, bool leader  ) {
    asm volatile("s_waitcnt vmcnt(0)" ::: "memory");
    __syncthreads();
    if (leader) {
        unsigned* bar = b.bar;
        __builtin_amdgcn_s_waitcnt(0);
        unsigned nloc = b.st[0], nx = b.st[1];
        if (nloc == 0u) { xcd_barrier_complete(bar, b.x, nloc, nx); b.st[0] = nloc; b.st[1] = nx; }
        const unsigned old = xb_add(&bar[XB_XSUB(b.x)], 1u);
        const unsigned gen = old / nloc;
        if (old + 1u == (gen + 1u) * nloc) {
            __builtin_amdgcn_fence(__ATOMIC_RELEASE, "agent");
            asm volatile("s_waitcnt vmcnt(0)" ::: "memory");
            const unsigned og = xb_add(&bar[XB_TOP], 1u);
            const unsigned tg = og / nx;
            if (og + 1u == (tg + 1u) * nx) xb_add(&bar[XB_TOPGEN], 1u);
            else XB_SPIN(xb_ld(&bar[XB_TOPGEN]) == tg, bar);
            __builtin_amdgcn_fence(__ATOMIC_ACQUIRE, "agent");
            xb_add(&bar[XB_XGEN(b.x)], 1u);
            asm volatile("s_waitcnt vmcnt(0)" ::: "memory");
        } else {
            XB_SPIN(xb_ld(&bar[XB_XGEN(b.x)]) == gen, bar);
            __builtin_amdgcn_fence(__ATOMIC_ACQUIRE, "agent");
            asm volatile("s_waitcnt vmcnt(0)" ::: "memory");
        }
    }
    __syncthreads();
}
namespace pg8 {
constexpr int BM = 256, BK = 64, HALF = 128, HTB = HALF * BK * 2, STAGE_BYTES = 8 * HTB, NXCD = 8, WGM = 8;

__host__ __device__ __forceinline__ int lds_byte(int r, int c) { const int st = (r >> 4) * 2 + (c >> 5), rr = r & 15, cc = c & 31, ob = rr * 64 + cc * 2; return st * 1024 + (ob ^ (((ob >> 9) & 1) << 5)); }
__host__ __device__ __forceinline__ void stage_rc(int b, int& R, int& C) { const int st = b / 1024, sb = b % 1024, swz = sb ^ (((sb >> 9) & 1) << 5); R = (st >> 1) * 16 + swz / 64; C = (st & 1) * 32 + (swz % 64) / 2; }
__host__ __device__ __forceinline__ int perm32(int rho) { const int n = rho >> 4, i = rho & 15; return 8 * (i >> 2) + 4 * n + (i & 3); }

struct Unit { int pm, pn; const char* a; const char* b; int aux; };

struct StaticOrder {
    static constexpr bool GATHER = false;
    int nM, nN, nwg, G, c; const char* A; const char* Bt; size_t tstep;
    __device__ void init(const void* A_, const void* Bt_, int M, int N, int K, int G_, int c_) { A = (const char*)A_; Bt = (const char*)Bt_; nM = M / BM; nN = N / BM; nwg = nM * nN; G = G_; c = c_; tstep = (size_t)BM * K * 2; }
    __device__ bool next(int i, Unit& u) const {
        const long L = (long)i * G + c; if (L >= nwg) return false;
        int wgid = (int)L; { const int q = nwg / NXCD, r = nwg % NXCD, xcd = wgid % NXCD, off = wgid / NXCD; wgid = (xcd < r ? xcd * (q + 1) : r * (q + 1) + (xcd - r) * q) + off; }
        const int nig = WGM * nN, gid = wgid / nig, fm = gid * WGM, gsz = (nM - fm) < WGM ? (nM - fm) : WGM;
        u.pm = fm + ((wgid % nig) % gsz); u.pn = (wgid % nig) / gsz; u.a = A + (size_t)u.pm * tstep; u.b = Bt + (size_t)u.pn * tstep; u.aux = 0; return true;
    }
    __device__ __forceinline__ void gather(const Unit&, int, int, unsigned (&)[2][2]) const {}
};

template <class Epi, class Sched, bool FP8 = false, int SCA = 127, int SCB = 127>
__device__ __forceinline__ void gemm_phase(LAS unsigned char* lds, int tid, const int K, const Sched& S, const Epi& E) {
    asm volatile("" : "+v"(tid));
    const int wid = __builtin_amdgcn_readfirstlane(tid >> 6), lane = tid & 63, wr = wid >> 2, wc = wid & 3, fr = lane & 15, fq = lane >> 4;
    const int nt = K / BK;
    const size_t kstep = (size_t)(BK * 2);
    const size_t hstep = (size_t)HALF * K * 2;
    int Rr[2], Cc[2];
    unsigned voffB[2];
#pragma unroll
    for (int i = 0; i < 2; ++i) { int R, C; stage_rc(tid * 16 + i * 8192, R, C); Rr[i] = R; Cc[i] = C; const int Rb = Epi::PERM ? ((R & ~31) + perm32(R & 31)) : R; voffB[i] = (unsigned)(Rb * K + C) * 2u; }
    unsigned vAc[2][2], vAn[2][2];
#pragma unroll
    for (int h = 0; h < 2; ++h)
#pragma unroll
        for (int i = 0; i < 2; ++i) { vAc[h][i] = (unsigned)((h * HALF + Rr[i]) * K + Cc[i]) * 2u; vAn[h][i] = vAc[h][i]; }
    const unsigned ldsw = (unsigned)wid * 1024u;
    const int aoff = lds_byte(wr * 64 + fr, fq * 8), boff = lds_byte(wc * 32 + fr, fq * 8);
#define PG8_SA(b, h) (((b) * 2 + (h)) * HTB)
#define PG8_SB(b, h) ((4 + (b) * 2 + (h)) * HTB)
#define PG8_STAGE_B(bufoff, gbase) do { _Pragma("unroll") for (int _i = 0; _i < 2; ++_i) \
        __builtin_amdgcn_global_load_lds((const unsigned*)((const char*)(gbase) + voffB[_i]), (LAS unsigned*)(lds + (bufoff) + ldsw + _i * 8192), 16, 0, 0); } while (0)
#define PG8_STAGE_A(bufoff, gbase, V, h) do { _Pragma("unroll") for (int _i = 0; _i < 2; ++_i) \
        __builtin_amdgcn_global_load_lds((const unsigned*)((const char*)(gbase) + (V)[h][_i]), (LAS unsigned*)(lds + (bufoff) + ldsw + _i * 8192), 16, 0, 0); } while (0)
#define PG8_LDA(dst, b, h) do { _Pragma("unroll") for (int m = 0; m < 4; ++m) { if constexpr (FP8) { const i32x4_ x0_ = *(const LAS i32x4_*)(lds + PG8_SA(b, h) + aoff + m * 2048), x1_ = *(const LAS i32x4_*)(lds + PG8_SA(b, h) + aoff + m * 2048 + 1024); \
            dst##8[m] = __builtin_shufflevector(x0_, x1_, 0, 1, 2, 3, 4, 5, 6, 7); } else { _Pragma("unroll") for (int k = 0; k < 2; ++k) dst[m][k] = *(const LAS bf16x8*)(lds + PG8_SA(b, h) + aoff + m * 2048 + k * 1024); } } } while (0)
#define PG8_LDB(dst, b, h) do { _Pragma("unroll") for (int n = 0; n < 2; ++n) { if constexpr (FP8) { const i32x4_ x0_ = *(const LAS i32x4_*)(lds + PG8_SB(b, h) + boff + n * 2048), x1_ = *(const LAS i32x4_*)(lds + PG8_SB(b, h) + boff + n * 2048 + 1024); \
            dst##8[n] = __builtin_shufflevector(x0_, x1_, 0, 1, 2, 3, 4, 5, 6, 7); } else { _Pragma("unroll") for (int k = 0; k < 2; ++k) dst[n][k] = *(const LAS bf16x8*)(lds + PG8_SB(b, h) + boff + n * 2048 + k * 1024); } } } while (0)
#define PG8_MMA(ai, bj, At, Bt) do { __builtin_amdgcn_s_setprio(1); _Pragma("unroll") for (int m = 0; m < 4; ++m) _Pragma("unroll") for (int n = 0; n < 2; ++n) { \
        if constexpr (FP8) asm volatile("v_mfma_scale_f32_16x16x128_f8f6f4 %0, %1, %2, %0, %3, %4 op_sel_hi:[0,0,0]" : "+v"(acc[ai][bj][m][n]) : "v"(Bt##8[n]), "v"(At##8[m]), "v"(sca_), "v"(scb_)); \
        else { _Pragma("unroll") for (int k = 0; k < 2; ++k) acc[ai][bj][m][n] = __builtin_amdgcn_mfma_f32_16x16x32_bf16(Bt[n][k], At[m][k], acc[ai][bj][m][n], 0, 0, 0); } } \
        __builtin_amdgcn_s_setprio(0); } while (0)
#define PG8_WAIT_V(n) asm volatile("s_waitcnt vmcnt(" #n ")" ::: "memory")
#define PG8_WAIT_L(n) asm volatile("s_waitcnt lgkmcnt(" #n ")" ::: "memory")
#define PG8_BAR __builtin_amdgcn_s_barrier()
#define PG8_SCHED __builtin_amdgcn_sched_barrier(0)
    Unit cur, nxt; int ui = 0;
    if (!S.next(0, cur)) return;
    if constexpr (Sched::GATHER) { S.gather(cur, Rr[0], Rr[1], vAc);
#pragma unroll
        for (int h = 0; h < 2; ++h)
#pragma unroll
            for (int i = 0; i < 2; ++i) vAc[h][i] += (unsigned)Cc[i] * 2u; }
    f32x4 acc[2][2][4][2];
#pragma unroll
    for (int a = 0; a < 2; ++a)
#pragma unroll
        for (int b = 0; b < 2; ++b)
#pragma unroll
            for (int m = 0; m < 4; ++m)
#pragma unroll
                for (int n = 0; n < 2; ++n) acc[a][b][m][n] = (f32x4){0.f, 0.f, 0.f, 0.f};
    typedef int i32x4_ __attribute__((ext_vector_type(4))); typedef int i32x8_ __attribute__((ext_vector_type(8)));
    bf16x8 At[4][2], B0[2][2], B1[2][2];
    i32x8_ At8[4], B08[2], B18[2]; const int sca_ = SCA * 0x01010101, scb_ = SCB * 0x01010101;
    const char* cA = cur.a; const char* cB = cur.b;
    PG8_STAGE_B(PG8_SB(0, 0), cB); PG8_STAGE_B(PG8_SB(0, 1), cB + hstep); PG8_STAGE_A(PG8_SA(0, 0), cA, vAc, 0); PG8_STAGE_A(PG8_SA(0, 1), cA, vAc, 1);
    if (wr == 1) PG8_BAR;
    PG8_WAIT_V(2); PG8_BAR;
    PG8_STAGE_B(PG8_SB(1, 0), cB + kstep); PG8_STAGE_A(PG8_SA(1, 0), cA + kstep, vAc, 0); PG8_STAGE_B(PG8_SB(1, 1), cB + hstep + kstep);
    PG8_WAIT_V(6); PG8_BAR;
    for (;;) {
        const bool has_next = S.next(ui + 1, nxt);
        if constexpr (Sched::GATHER) { if (has_next) { S.gather(nxt, Rr[0], Rr[1], vAn);
#pragma unroll
            for (int h = 0; h < 2; ++h)
#pragma unroll
                for (int i = 0; i < 2; ++i) vAn[h][i] += (unsigned)Cc[i] * 2u; } else {
#pragma unroll
            for (int h = 0; h < 2; ++h)
#pragma unroll
                for (int i = 0; i < 2; ++i) vAn[h][i] = vAc[h][i]; } }
        const char* nA = has_next ? nxt.a : cA; const char* nB = has_next ? nxt.b : cB;
        for (int t = 0; t < nt; t += 2) {
            const bool last = (t == nt - 2);
            const char* a1 = cA + (size_t)(t + 1) * kstep;
            const char* a2 = last ? nA : cA + (size_t)(t + 2) * kstep; const char* b2 = last ? nB : cB + (size_t)(t + 2) * kstep;
            const char* a3 = a2 + kstep; const char* b3 = b2 + kstep;
            unsigned v2[2][2];
#pragma unroll
            for (int h = 0; h < 2; ++h)
#pragma unroll
                for (int i = 0; i < 2; ++i) v2[h][i] = (Sched::GATHER && last) ? vAn[h][i] : vAc[h][i];
            PG8_LDB(B0, 0, 0); PG8_LDB(B1, 0, 1); PG8_SCHED; PG8_LDA(At, 0, 0); PG8_STAGE_A(PG8_SA(1, 1), a1, vAc, 1);
            PG8_WAIT_V(8); PG8_WAIT_L(0); PG8_BAR; PG8_MMA(0, 0, At, B0); PG8_MMA(0, 1, At, B1); PG8_BAR; PG8_SCHED;
            PG8_LDA(At, 0, 1); PG8_STAGE_B(PG8_SB(0, 0), b2); PG8_STAGE_B(PG8_SB(0, 1), b2 + hstep); PG8_STAGE_A(PG8_SA(0, 0), a2, v2, 0);
            PG8_WAIT_V(8); PG8_WAIT_L(0); PG8_BAR; PG8_MMA(1, 0, At, B0); PG8_MMA(1, 1, At, B1); PG8_BAR; PG8_SCHED;
            PG8_LDB(B0, 1, 0); PG8_LDB(B1, 1, 1); PG8_SCHED; PG8_LDA(At, 1, 0); PG8_STAGE_A(PG8_SA(0, 1), a2, v2, 1);
            PG8_WAIT_V(8); PG8_WAIT_L(0); PG8_BAR; PG8_MMA(0, 0, At, B0); PG8_MMA(0, 1, At, B1); PG8_BAR; PG8_SCHED;
            PG8_LDA(At, 1, 1); PG8_STAGE_B(PG8_SB(1, 0), b3); PG8_STAGE_B(PG8_SB(1, 1), b3 + hstep); PG8_STAGE_A(PG8_SA(1, 0), a3, v2, 0);
            PG8_WAIT_V(8); PG8_WAIT_L(0); PG8_BAR; PG8_MMA(1, 0, At, B0); PG8_MMA(1, 1, At, B1); PG8_BAR; PG8_SCHED;
        }
        if (wr == 0) PG8_BAR;
        if constexpr (FP8) { asm volatile("s_nop 15\n\ts_nop 15" ::: "memory"); }
        E(acc, cur, wr, wc, fr, fq);
        if (!has_next) break;
#pragma unroll
        for (int a = 0; a < 2; ++a)
#pragma unroll
            for (int b = 0; b < 2; ++b)
#pragma unroll
                for (int m = 0; m < 4; ++m)
#pragma unroll
                    for (int n = 0; n < 2; ++n) acc[a][b][m][n] = (f32x4){0.f, 0.f, 0.f, 0.f};
        cur = nxt; cA = nA; cB = nB; ++ui;
#pragma unroll
        for (int h = 0; h < 2; ++h)
#pragma unroll
            for (int i = 0; i < 2; ++i) vAc[h][i] = vAn[h][i];
        if (wr == 1) PG8_BAR;
    }
    PG8_WAIT_V(0);
    PG8_BAR;
#undef PG8_SA
#undef PG8_SB
#undef PG8_STAGE_A
#undef PG8_STAGE_B
#undef PG8_LDA
#undef PG8_LDB
#undef PG8_MMA
#undef PG8_WAIT_V
#undef PG8_WAIT_L
#undef PG8_BAR
#undef PG8_SCHED
}
}
namespace pg8 {

struct EpiBf16 {
    static constexpr bool PERM = true;
    bf16_t* O; size_t ldc;
    __device__ __forceinline__ void operator()(const f32x4 (&acc)[2][2][4][2], const Unit& u, int wr, int wc, int fr, int fq) const {
        const size_t row0 = (size_t)u.pm * BM + wr * 64 + fr; const int col0 = u.pn * BM + wc * 32 + 8 * fq;
#pragma unroll
        for (int ai = 0; ai < 2; ++ai)
#pragma unroll
            for (int m = 0; m < 4; ++m) { bf16_t* rowp = O + (row0 + ai * HALF + m * 16) * ldc + col0;
#pragma unroll
                for (int bj = 0; bj < 2; ++bj) { const f32x4 v0 = acc[ai][bj][m][0], v1 = acc[ai][bj][m][1];
                    u32x4 w; w.x = cvt_pk_bf16(v0[0], v0[1]); w.y = cvt_pk_bf16(v0[2], v0[3]); w.z = cvt_pk_bf16(v1[0], v1[1]); w.w = cvt_pk_bf16(v1[2], v1[3]);
                    *(u32x4*)(rowp + bj * HALF) = w; } }
    }
};

struct EpiQKV {
    static constexpr bool PERM = false;
    bf16_t* Q; bf16_t* Kb; bf16_t* Vb; const float* ropec; const float* ropes;
    __device__ __forceinline__ void operator()(const f32x4 (&acc)[2][2][4][2], const Unit& u, int wr, int wc, int fr, int fq) const {
        const int sec = u.pn >> 1;
        const int bt = u.pm >> 4, t0 = (u.pm & 15) * BM;
        bf16_t* base; size_t rowb; float sc = 1.f;
        if (sec == 0) { base = Q; rowb = (size_t)u.pm * BM; sc = QSCALE; }
        else { base = (sec == 1) ? Kb : Vb; rowb = (size_t)bt * LKV + CTXL + t0; }
        const int colt = (u.pn & 1) * BM + wc * 32 + 4 * fq;
        const bool rope = sec < 2; const bool colpos = (wc & 1) != 0;
#pragma unroll
        for (int ai = 0; ai < 2; ++ai)
#pragma unroll
            for (int m = 0; m < 4; ++m) {
                const int rl = ai * HALF + wr * 64 + m * 16 + fr; const int t = t0 + rl;
                const int pos = colpos ? (t & 63) : (t >> 6);
                f32x4 cs = (f32x4){1.f, 1.f, 1.f, 1.f}, sn = (f32x4){0.f, 0.f, 0.f, 0.f};
                if (rope) { cs = *(const f32x4*)(ropec + pos * 16 + 4 * fq); sn = *(const f32x4*)(ropes + pos * 16 + 4 * fq); }
                bf16_t* rowp = base + (rowb + rl) * 512 + colt;
#pragma unroll
                for (int bj = 0; bj < 2; ++bj) {
                    const f32x4 a = acc[ai][bj][m][0], b = acc[ai][bj][m][1];
                    f32x4 oa, ob;
                    if (rope) { oa = (a * cs - b * sn) * sc; ob = (a * sn + b * cs) * sc; } else { oa = a; ob = b; }
                    u32x2 w0, w1; w0.x = cvt_pk_bf16(oa[0], oa[1]); w0.y = cvt_pk_bf16(oa[2], oa[3]); w1.x = cvt_pk_bf16(ob[0], ob[1]); w1.y = cvt_pk_bf16(ob[2], ob[3]);
                    *(u32x2*)(rowp + bj * HALF) = w0; *(u32x2*)(rowp + bj * HALF + 16) = w1; }
            }
    }
};

struct EpiCtxKV {
    static constexpr bool PERM = true;
    bf16_t* Kb; bf16_t* Vb;
    __device__ __forceinline__ void operator()(const f32x4 (&acc)[2][2][4][2], const Unit& u, int wr, int wc, int fr, int fq) const {
        bf16_t* base = (u.pn < 2) ? Kb : Vb; const size_t rowb = (size_t)u.pm * LKV; const int col0 = (u.pn & 1) * BM + wc * 32 + 8 * fq;
#pragma unroll
        for (int ai = 0; ai < 2; ++ai)
#pragma unroll
            for (int m = 0; m < 4; ++m) { bf16_t* rowp = base + (rowb + ai * HALF + wr * 64 + m * 16 + fr) * 512 + col0;
#pragma unroll
                for (int bj = 0; bj < 2; ++bj) { const f32x4 v0 = acc[ai][bj][m][0], v1 = acc[ai][bj][m][1];
                    u32x4 w; w.x = cvt_pk_bf16(v0[0], v0[1]); w.y = cvt_pk_bf16(v0[2], v0[3]); w.z = cvt_pk_bf16(v1[0], v1[1]); w.w = cvt_pk_bf16(v1[2], v1[3]);
                    *(u32x4*)(rowp + bj * HALF) = w; } }
    }
};

template <bool XF32> struct EpiResid {
    static constexpr bool PERM = true;
    const void* xin; bf16_t* out; const float* gate;   const float* bias;
    __device__ __forceinline__ void operator()(const f32x4 (&acc)[2][2][4][2], const Unit& u, int wr, int wc, int fr, int fq) const {
        const int bt = u.pm >> 4; const int col0 = u.pn * BM + wc * 32 + 8 * fq;
#pragma unroll
        for (int bj = 0; bj < 2; ++bj) {
            f32x4 gv[2], bv[2];
#pragma unroll
            for (int n = 0; n < 2; ++n) { gv[n] = *(const f32x4*)(gate + (size_t)bt * 6144 + col0 + bj * HALF + 4 * n);
                bv[n] = bias ? *(const f32x4*)(bias + col0 + bj * HALF + 4 * n) : (f32x4){0.f, 0.f, 0.f, 0.f}; }
#pragma unroll
            for (int ai = 0; ai < 2; ++ai)
#pragma unroll
                for (int m = 0; m < 4; ++m) { const size_t off = ((size_t)u.pm * BM + ai * HALF + wr * 64 + m * 16 + fr) * DM + col0 + bj * HALF;
                    f32x4 x0, x1;
                    if (XF32) { x0 = *(const f32x4*)((const float*)xin + off); x1 = *(const f32x4*)((const float*)xin + off + 4); }
                    else { const u32x4 r = *(const u32x4*)((const bf16_t*)xin + off); x0 = (f32x4){bflo(r.x), bfhi(r.x), bflo(r.y), bfhi(r.y)}; x1 = (f32x4){bflo(r.z), bfhi(r.z), bflo(r.w), bfhi(r.w)}; }
                    const f32x4 y0 = x0 + gv[0] * (acc[ai][bj][m][0] + bv[0]), y1 = x1 + gv[1] * (acc[ai][bj][m][1] + bv[1]);
                    u32x4 w; w.x = cvt_pk_bf16(y0[0], y0[1]); w.y = cvt_pk_bf16(y0[2], y0[3]); w.z = cvt_pk_bf16(y1[0], y1[1]); w.w = cvt_pk_bf16(y1[2], y1[3]);
                    *(u32x4*)(out + off) = w; }
        }
    }
};

template <int MODE> struct EpiGated {
    static constexpr bool PERM = true;
    bf16_t* O; size_t ldo; const float* ba; const float* bg;
    __device__ __forceinline__ void operator()(const f32x4 (&acc)[2][2][4][2], const Unit& u, int wr, int wc, int fr, int fq) const {
        const size_t row0 = (size_t)u.pm * BM + wr * 64 + fr; const int col0 = u.pn * 128 + wc * 32 + 8 * fq;
        f32x4 b0[2], b1[2];
#pragma unroll
        for (int bj = 0; bj < 2; ++bj) { b0[bj] = (f32x4){0.f, 0.f, 0.f, 0.f}; b1[bj] = b0[bj]; if (MODE == 1) { b0[bj] = *(const f32x4*)(ba + col0 + 4 * bj); b1[bj] = *(const f32x4*)(bg + col0 + 4 * bj); } }
#pragma unroll
        for (int ai = 0; ai < 2; ++ai)
#pragma unroll
            for (int m = 0; m < 4; ++m) { f32x4 o[2];
#pragma unroll
                for (int bj = 0; bj < 2; ++bj) { const f32x4 a = acc[ai][bj][m][0] + b0[bj], g = acc[ai][bj][m][1] + b1[bj];
#pragma unroll
                    for (int j = 0; j < 4; ++j) o[bj][j] = (MODE == 1) ? a[j] * sigmoid_f(g[j]) : silu_f(a[j]) * g[j]; }
                if (MODE == 2) { unsigned char* rowp = (unsigned char*)O + (row0 + ai * HALF + m * 16) * ldo + col0;
                    int p0 = 0, p1 = 0; p0 = __builtin_amdgcn_cvt_pk_fp8_f32(o[0][0], o[0][1], p0, false); p0 = __builtin_amdgcn_cvt_pk_fp8_f32(o[0][2], o[0][3], p0, true);
                    p1 = __builtin_amdgcn_cvt_pk_fp8_f32(o[1][0], o[1][1], p1, false); p1 = __builtin_amdgcn_cvt_pk_fp8_f32(o[1][2], o[1][3], p1, true);
                    *(u32x2*)rowp = (u32x2){(unsigned)p0, (unsigned)p1}; }
                else { bf16_t* rowp = O + (row0 + ai * HALF + m * 16) * ldo + col0;
                    u32x4 w; w.x = cvt_pk_bf16(o[0][0], o[0][1]); w.y = cvt_pk_bf16(o[0][2], o[0][3]); w.z = cvt_pk_bf16(o[1][0], o[1][1]); w.w = cvt_pk_bf16(o[1][2], o[1][3]);
                    *(u32x4*)rowp = w; } }
    }
};

struct EpiScatter {
    static constexpr bool PERM = true;
    bf16_t* Y0; bf16_t* Y1; const int* list; const LAS int* pref;
    __device__ __forceinline__ void operator()(const f32x4 (&acc)[2][2][4][2], const Unit& u, int wr, int wc, int fr, int fq) const {
        const int e = u.aux, j = u.pm - pref[e], cnt = pref[40 + e]; const int col0 = u.pn * BM + wc * 32 + 8 * fq; const size_t dy = (size_t)((const char*)Y1 - (const char*)Y0);
#pragma unroll
        for (int ai = 0; ai < 2; ++ai) { int ent[4];
#pragma unroll
            for (int m = 0; m < 4; ++m) { const int r = j * 256 + ai * HALF + wr * 64 + m * 16 + fr; ent[m] = list[e * 32768 + (r < cnt ? r : 0)]; }
#pragma unroll
            for (int m = 0; m < 4; ++m) { const int r = j * 256 + ai * HALF + wr * 64 + m * 16 + fr; const int en = ent[m];
                const bool ok = r < cnt; const unsigned tok = ok ? (unsigned)(en >> 1) : (unsigned)NTOK; const bool second = ok ? (en & 1) : true;
                bf16_t* rowp = (bf16_t*)((char*)Y0 + (size_t)tok * (DM * 2) + (second ? dy : (size_t)0)) + col0;
#pragma unroll
                for (int bj = 0; bj < 2; ++bj) { const f32x4 v0 = acc[ai][bj][m][0], v1 = acc[ai][bj][m][1];
                    u32x4 w; w.x = cvt_pk_bf16(v0[0], v0[1]); w.y = cvt_pk_bf16(v0[2], v0[3]); w.z = cvt_pk_bf16(v1[0], v1[1]); w.w = cvt_pk_bf16(v1[2], v1[3]);
                    *(u32x4*)(rowp + bj * HALF) = w; } } }
    }
};

struct EpiLogits {
    static constexpr bool PERM = false;
    float* O;
    __device__ __forceinline__ void operator()(const f32x4 (&acc)[2][2][4][2], const Unit& u, int wr, int wc, int fr, int fq) const {
        if (wc >= 2) return;
#pragma unroll
        for (int ai = 0; ai < 2; ++ai)
#pragma unroll
            for (int m = 0; m < 4; ++m) { float* rowp = O + ((size_t)u.pm * BM + ai * HALF + wr * 64 + m * 16 + fr) * 64 + wc * 32 + 4 * fq;
#pragma unroll
                for (int n = 0; n < 2; ++n) *(f32x4*)(rowp + n * 16) = acc[ai][0][m][n]; }
    }
};
}
enum { I_X = 0, I_C, I_CTX, I_CCTX, I_ADAW, I_ADAB, I_N1G, I_N2G, I_FING, I_WIN0, I_WOUT0, I_LQ1, I_LK1, I_LQ2, I_LK2, I_SUBLN,
       I_HYSW, I_HYSB, I_HYW1, I_HYB1, I_HYFR1, I_HYW2, I_HYB2, I_HYFR2, I_HYW3, I_HYB3, I_HYBIAS,
       I_CVW1, I_CVB1, I_CVDWW, I_CVDWB, I_CVLNG, I_CVLNB, I_CVW2, I_CVB2, I_MWG, I_MBG, I_MWE, I_MBE, I_MGATE, I_MUP, I_MDOWN, N_IN };

struct Args { const float* in[N_IN]; float* out; unsigned char* ws; int ph_lo, ph_hi; };

struct Frame {
    LAS unsigned char* lds;
    int tid, lane, wave, G, bid;
    const float* const* in; float* out; unsigned char* ws;
};

struct RowMap { int mode, half, which0;
    __device__ __forceinline__ int operator()(int s) const { if (mode == 0) return s; const int w = which0 + s / half, h = s % half, t = h & 127;
        return 256 * (h >> 7) + 128 * ((t >> 2) & 1) + 32 * (t >> 5) + 8 * ((t >> 3) & 3) + 4 * w + (t & 3); } };
#ifndef CONF_FP8
#define CONF_FP8 1
#endif
struct P0Item { const float* W; bf16_t* WT; int K, N, k0, n0; RowMap rm; int fp8; };
constexpr int P0_I_IN = 16 * 6, P0_I_OUT = 16 * 2, P0_I_C1 = 16 * 4, P0_I_C2 = 16 * 2, P0_I_MOE = 64 * 48;
constexpr int P0_NITEMS = P0_I_IN + P0_I_OUT + P0_I_C1 + P0_I_C2 + P0_I_MOE;
__device__ __forceinline__ P0Item p0_item(Frame& F, int it) {
    P0Item I; int r = it; I.fp8 = 0;
    if (r < P0_I_IN) { I.W = F.in[I_WIN0]; I.WT = (bf16_t*)(F.ws + WS_WQKVH); I.K = 1024; I.N = 3072; I.rm = RowMap{0, 1, 0}; }
    else if ((r -= P0_I_IN) < P0_I_OUT) { I.W = F.in[I_WOUT0]; I.WT = (bf16_t*)(F.ws + WS_WO); I.K = 1024; I.N = 1024; I.rm = RowMap{0, 1, 0}; }
    else if ((r -= P0_I_OUT) < P0_I_C1) { I.W = F.in[I_CVW1]; I.WT = (bf16_t*)(F.ws + WS_WC1); I.K = 1024; I.N = 2048; I.rm = RowMap{1, 1024, 0}; I.fp8 = CONF_FP8; }
    else if ((r -= P0_I_C1) < P0_I_C2) { I.W = F.in[I_CVW2]; I.WT = (bf16_t*)(F.ws + WS_WC2); I.K = 1024; I.N = 1024; I.rm = RowMap{0, 1, 0}; I.fp8 = CONF_FP8; }
    else { r -= P0_I_C2; const int le = r / 48, q = r % 48; unsigned char* wb = F.ws + WS_WMOE + (size_t)le * 3 * MiB;
        I.fp8 = 1;
        if (q < 16) { I.W = F.in[I_MGATE] + (size_t)le * 1024 * 512; I.WT = (bf16_t*)wb; I.K = 1024; I.N = 512; I.rm = RowMap{1, 512, 0}; r = q; }
        else if (q < 32) { I.W = F.in[I_MUP] + (size_t)le * 1024 * 512; I.WT = (bf16_t*)wb; I.K = 1024; I.N = 512; I.rm = RowMap{1, 512, 1}; r = q - 16; }
        else { I.W = F.in[I_MDOWN] + (size_t)le * 512 * 1024; I.WT = (bf16_t*)(wb + 2 * MiB); I.K = 512; I.N = 1024; I.rm = RowMap{0, 1, 0}; r = q - 32; } }
    const int nblk = I.N / 512; I.k0 = 64 * (r / nblk); I.n0 = 512 * (r % nblk); return I;
}
__device__ __forceinline__ void p0_item_load(const P0Item& I, int tid, f32x4 (&v)[16]) {
#pragma unroll
    for (int i = 0; i < 16; ++i) v[i] = *(const f32x4*)(I.W + (size_t)(I.k0 + 4 * i + (tid >> 7)) * I.N + I.n0 + 4 * (tid & 127));
}
__device__ __forceinline__ void p0_item_to_lds(LAS float* scr, int tid, const f32x4 (&v)[16]) {
#pragma unroll
    for (int i = 0; i < 16; ++i) { LAS float* d = scr + (4 * i + (tid >> 7)) * 513 + 4 * (tid & 127); d[0] = v[i][0]; d[1] = v[i][1]; d[2] = v[i][2]; d[3] = v[i][3]; }
}
__device__ __forceinline__ void p0_item_store(const P0Item& I, const LAS float* scr, int tid) {
    if (I.fp8) {
#pragma unroll
        for (int j = 0; j < 4; ++j) { const int q = tid + 512 * j, n = q >> 2, c = q & 3; const LAS float* s = scr + (16 * c) * 513 + n; int w[4];
#pragma unroll
            for (int d = 0; d < 4; ++d) { int p = 0; p = __builtin_amdgcn_cvt_pk_fp8_f32(32.f * s[(4 * d) * 513], 32.f * s[(4 * d + 1) * 513], p, false);
                p = __builtin_amdgcn_cvt_pk_fp8_f32(32.f * s[(4 * d + 2) * 513], 32.f * s[(4 * d + 3) * 513], p, true); w[d] = p; }
            *(u32x4*)((unsigned char*)I.WT + (size_t)I.rm(I.n0 + n) * I.K + I.k0 + 16 * c) = (u32x4){(unsigned)w[0], (unsigned)w[1], (unsigned)w[2], (unsigned)w[3]}; }
        return; }
#pragma unroll
    for (int j = 0; j < 8; ++j) { const int q = tid + 512 * j, n = q >> 3, c = q & 7; const LAS float* s = scr + (8 * c) * 513 + n;
        u32x4 o; o.x = cvt_pk_bf16(s[0 * 513], s[1 * 513]); o.y = cvt_pk_bf16(s[2 * 513], s[3 * 513]); o.z = cvt_pk_bf16(s[4 * 513], s[5 * 513]); o.w = cvt_pk_bf16(s[6 * 513], s[7 * 513]);
        *(u32x4*)(I.WT + (size_t)I.rm(I.n0 + n) * I.K + I.k0 + 8 * c) = o; }
}
__device__ __forceinline__ void p0_router_weights(Frame& F) {
    bf16_t* wr = (bf16_t*)(F.ws + WS_WR);
    for (int idx = F.bid * NTHREADS + F.tid; idx < 2 * 256 * 1024; idx += F.G * NTHREADS) {
        const int l = idx >> 18, n = (idx >> 10) & 255, k = idx & 1023; float v = 0.f;
        if (n < 4) v = F.in[I_MWG][((size_t)l * 1024 + k) * 4 + n]; else if (n < 36) v = F.in[I_MWE][((size_t)l * 1024 + k) * 32 + (n - 4)];
        wr[idx] = (bf16_t)(cvt_pk_bf16(v, 0.f) & 0xffffu);
    }
}

__device__ __forceinline__ void p0_adaln_task(Frame& F, int task) {
    const int layer = task / 24, n0 = (task % 24) * 256;
    LAS float* sc = (LAS float*)F.lds;
    LAS f32x4* red = (LAS f32x4*)(F.lds + 36864);
    for (int i = F.tid; i < 9 * 1024; i += NTHREADS) { const int r = i >> 10, k = i & 1023; const float v = (r < 8) ? F.in[I_C][r * 1024 + k] : F.in[I_CCTX][k]; sc[i] = silu_f(v); }
    __syncthreads();
    const int cq = F.tid & 63, ks = F.tid >> 6;
    const float* W = F.in[I_ADAW] + (size_t)layer * 1024 * 6144 + n0 + 4 * cq;
    f32x4 acc[9];
#pragma unroll
    for (int r = 0; r < 9; ++r) acc[r] = (f32x4){0.f, 0.f, 0.f, 0.f};
#pragma unroll 16
    for (int k = ks * 128; k < ks * 128 + 128; ++k) { const f32x4 w = *(const f32x4*)(W + (size_t)k * 6144);
#pragma unroll
        for (int r = 0; r < 9; ++r) acc[r] += w * sc[r * 1024 + k]; }
#pragma unroll
    for (int r = 0; r < 9; ++r) red[(ks * 9 + r) * 64 + cq] = acc[r];
    __syncthreads();
    float* mod = (float*)(F.ws + WS_MOD) + (size_t)layer * 9 * 6144;
    for (int i = F.tid; i < 9 * 64; i += NTHREADS) { const int r = i >> 6, c2 = i & 63; f32x4 s = *(const f32x4*)(F.in[I_ADAB] + layer * 6144 + n0 + 4 * c2);
#pragma unroll
        for (int k8 = 0; k8 < 8; ++k8) s += red[(k8 * 9 + r) * 64 + c2];
        *(f32x4*)(mod + (size_t)r * 6144 + n0 + 4 * c2) = s; }
    __syncthreads();
}

constexpr float HY_MIN_DECAY = -15.350567286626973f, HY_MAX_DECAY = -3.0701134573253945f;
__device__ __forceinline__ void p0_hyfilter_task(Frame& F, int pb) {
    const int t0 = pb * 32;
    LAS float* z = (LAS float*)F.lds;
    LAS float* h1 = z + 32 * 33;
    LAS float* h2 = h1 + 32 * 64;
    for (int i = F.tid; i < 32 * 33; i += NTHREADS) { const int p = i / 33, e = i % 33; const int t = t0 + p; float v;
        if (e == 0) v = (float)t / 4095.0f;
        else { const int bi = (e - 1) & 15; const float band = 1e-4f + (float)bi * ((15.0f - 1e-4f) / 15.0f); const float ang = (6.283185307179586f / 4096.0f) * (float)t * band; v = (e <= 16) ? cosf(ang) : -sinf(ang); }
        z[i] = v; }
    __syncthreads();
    for (int i = F.tid; i < 32 * 64; i += NTHREADS) { const int p = i >> 6, j = i & 63; float s = F.in[I_HYB1][j];
        for (int e = 0; e < 33; ++e) s += z[p * 33 + e] * F.in[I_HYW1][e * 64 + j];
        h1[i] = sinf(F.in[I_HYFR1][j] * s); }
    __syncthreads();
    for (int i = F.tid; i < 32 * 64; i += NTHREADS) { const int p = i >> 6, j = i & 63; float s = F.in[I_HYB2][j];
        for (int e = 0; e < 64; ++e) s += h1[p * 64 + e] * F.in[I_HYW2][e * 64 + j];
        h2[i] = sinf(F.in[I_HYFR2][j] * s); }
    __syncthreads();
    const int c0 = 4 * F.tid;
    float* kraw = (float*)(F.ws + WS_KRAW);
    const f32x4 b3 = *(const f32x4*)(F.in[I_HYB3] + c0);
#pragma unroll 1
    for (int ph = 0; ph < 2; ++ph) {
        f32x4 acc[16];
#pragma unroll
        for (int p = 0; p < 16; ++p) acc[p] = b3;
        for (int j4 = 0; j4 < 16; ++j4) {
            f32x4 w[4];
#pragma unroll
            for (int jj = 0; jj < 4; ++jj) w[jj] = *(const f32x4*)(F.in[I_HYW3] + (size_t)(4 * j4 + jj) * 2048 + c0);
#pragma unroll
            for (int p = 0; p < 16; ++p) { const f32x4 hv = *(const LAS f32x4*)(h2 + (16 * ph + p) * 64 + 4 * j4);
                acc[p] += w[0] * hv[0] + w[1] * hv[1] + w[2] * hv[2] + w[3] * hv[3]; }
        }
#pragma unroll
        for (int cc = 0; cc < 4; ++cc) { const int col = c0 + cc, ch = col & 511;
            const float delta = fabsf(HY_MIN_DECAY + (float)ch * ((HY_MAX_DECAY - HY_MIN_DECAY) / 511.0f));
            float* dst = kraw + (size_t)col * 4096 + t0 + 16 * ph;
#pragma unroll
            for (int p4 = 0; p4 < 4; ++p4) { f32x4 o;
#pragma unroll
                for (int q = 0; q < 4; ++q) { const int p = 4 * p4 + q; const float tn = (float)(t0 + 16 * ph + p) / 4095.0f; o[q] = acc[p][cc] * __expf(-tn * delta); }
                *(f32x4*)(dst + 4 * p4) = o; } }
    }
    __syncthreads();
}

__device__ __forceinline__ void p0_tables_task(Frame& F) {
    float* tab = (float*)(F.ws + WS_TAB);
    for (int i = F.tid; i < 1024; i += NTHREADS) { const int pos = i >> 4, fi = i & 15; const float inv = powf(10000.0f, -(float)fi / 16.0f); const float ang = (float)pos * inv;
        tab[TB_ROPE_C + i] = cosf(ang); tab[TB_ROPE_S + i] = sinf(ang); }
    for (int i = F.tid; i < 256; i += NTHREADS) { float s, c; sincospif(2.0f * (float)i / 4096.0f, &s, &c); tab[TB_T4096 + 2 * i] = c; tab[TB_T4096 + 2 * i + 1] = -s; }
    for (int i = F.tid; i < 64; i += NTHREADS) { float s, c; sincospif(2.0f * (float)i / 8192.0f, &s, &c); tab[TB_T8A + 2 * i] = c; tab[TB_T8A + 2 * i + 1] = -s;
        sincospif(2.0f * (float)(64 * i) / 8192.0f, &s, &c); tab[TB_T8B + 2 * i] = c; tab[TB_T8B + 2 * i + 1] = -s; }
    if (F.tid < 64) { const float a = wave_sum(F.in[I_LQ1][F.lane] * F.in[I_LK1][F.lane]), b = wave_sum(F.in[I_LQ2][F.lane] * F.in[I_LK2][F.lane]);
        if (F.lane == 0) tab[TB_LAM] = expf(a) - expf(b) + 0.2f; }
}

__device__ __forceinline__ void p0_prologue(Frame& F, unsigned* ctr, volatile LAS unsigned* slot) {
    p0_router_weights(F);
#pragma unroll 1
    for (int t = F.bid; t < 48 + 128; t += F.G) { if (t < 48) p0_adaln_task(F, t); else p0_hyfilter_task(F, t - 48); }
    if (F.bid == 0) p0_tables_task(F);
    __syncthreads();
    LAS float* scr = (LAS float*)F.lds;
    if (F.tid == 0) slot[0] = __hip_atomic_fetch_add(ctr, 1u, RLX_AGENT);
    __syncthreads();
    int cur = (int)slot[0];
    f32x4 v[16];
    if (cur < P0_NITEMS) { const P0Item I = p0_item(F, cur); p0_item_load(I, F.tid, v); }
    while (cur < P0_NITEMS) {
        __syncthreads();
        p0_item_to_lds(scr, F.tid, v);
        if (F.tid == 0) slot[0] = __hip_atomic_fetch_add(ctr, 1u, RLX_AGENT);
        __syncthreads();
        const int nxt = (int)slot[0];
        if (nxt < P0_NITEMS) { const P0Item J = p0_item(F, nxt); p0_item_load(J, F.tid, v); }
        { const P0Item I = p0_item(F, cur); p0_item_store(I, scr, F.tid); }
        cur = nxt;
    }
    __syncthreads();
}

__device__ __forceinline__ void bf8_to_f32(const u32x4 r, f32x4& a, f32x4& b) { a = (f32x4){bflo(r.x), bfhi(r.x), bflo(r.y), bfhi(r.y)}; b = (f32x4){bflo(r.z), bfhi(r.z), bflo(r.w), bfhi(r.w)}; }
__device__ __forceinline__ void rms_mod_store(const f32x4 (&v)[4], const float* g, const float* sh, const float* sc, bf16_t* orow, float* frow, int lane) {
    float s = 0.f;
#pragma unroll
    for (int j = 0; j < 4; ++j) s += (v[j].x * v[j].x + v[j].y * v[j].y) + (v[j].z * v[j].z + v[j].w * v[j].w);
    const float rstd = 1.0f / sqrtf(wave_sum(s) * (1.0f / 1024.0f) + EPS);
#pragma unroll
    for (int h = 0; h < 2; ++h) { const int c = 8 * lane + 512 * h; f32x4 y0 = v[2 * h] * rstd * *(const f32x4*)(g + c), y1 = v[2 * h + 1] * rstd * *(const f32x4*)(g + c + 4);
        if (sc) { y0 = y0 * (*(const f32x4*)(sc + c) + 1.0f) + *(const f32x4*)(sh + c); y1 = y1 * (*(const f32x4*)(sc + c + 4) + 1.0f) + *(const f32x4*)(sh + c + 4); }
        if (orow) { u32x4 w; w.x = cvt_pk_bf16(y0[0], y0[1]); w.y = cvt_pk_bf16(y0[2], y0[3]); w.z = cvt_pk_bf16(y1[0], y1[1]); w.w = cvt_pk_bf16(y1[2], y1[3]); *(u32x4*)(orow + c) = w; }
        if (frow) { *(f32x4*)(frow + c) = y0; *(f32x4*)(frow + c + 4) = y1; } }
}

__device__ __forceinline__ void p1_norm_in(Frame& F) {
    const int gw = F.bid * NWAVES + F.wave, NGW = F.G * NWAVES;
    const float* mod = (const float*)(F.ws + WS_MOD);
#pragma unroll 1
    for (int r0 = gw; r0 < NTOK + NB * CTXL; r0 += 4 * NGW) {
        f32x4 v[4][4];
#pragma unroll
        for (int q = 0; q < 4; ++q) { const int r = r0 + q * NGW; if (r < NTOK + NB * CTXL) { const bool isx = r < NTOK; const int rr = isx ? r : r - NTOK;
            const float* xrow = (isx ? F.in[I_X] : F.in[I_CTX]) + (size_t)rr * DM;
#pragma unroll
            for (int j = 0; j < 4; ++j) v[q][j] = *(const f32x4*)(xrow + 8 * F.lane + 512 * (j >> 1) + 4 * (j & 1)); } }
#pragma unroll
        for (int q = 0; q < 4; ++q) { const int r = r0 + q * NGW; if (r < NTOK + NB * CTXL) { const bool isx = r < NTOK; const int rr = isx ? r : r - NTOK; const int b = isx ? (rr >> 12) : 8;
            bf16_t* orow = (bf16_t*)(F.ws + (isx ? WS_BUF0 : WS_OBT)) + (size_t)rr * DM;
            rms_mod_store(v[q], F.in[I_N1G], mod + (size_t)b * 6144 + 0, mod + (size_t)b * 6144 + 1024, orow, nullptr, F.lane); } }
    }
}

constexpr int MF_PITCH = 2064;
constexpr int MF_TILE = 0, MF_RED = 32 * MF_PITCH, MF_SEL = MF_RED + 8 * 32 * 65 * 4, MF_CNT = MF_SEL + 128 * 32;
__device__ __forceinline__ void moe_front(Frame& F, int layer) {
    LAS unsigned char* lds = F.lds;
    LAS float* red = (LAS float*)(lds + MF_RED);
    LAS int* lcnt = (LAS int*)(lds + MF_CNT); LAS int* lbase = lcnt + 32;
    const float* mod = (const float*)(F.ws + WS_MOD) + (size_t)layer * 9 * 6144;
    unsigned* gcnt = (unsigned*)(F.ws + WS_CTL) + CW_CNT + layer * 32 * 64;
    int* list = (int*)(F.ws + WS_LIST);
    int* tinfo = (int*)(F.ws + WS_TOK); float* tw = (float*)(F.ws + WS_TOK + 512 * 1024);
    const int l = F.lane, w = F.wave, r32 = l & 31, hi = l >> 5;
    bf16x8 wb[2][8];
    { const bf16_t* wr = (const bf16_t*)(F.ws + WS_WR) + (size_t)layer * 256 * 1024;
#pragma unroll
      for (int nb = 0; nb < 2; ++nb)
#pragma unroll
          for (int s = 0; s < 8; ++s) wb[nb][s] = *(const bf16x8*)(wr + (size_t)(32 * nb + r32) * 1024 + 128 * w + 16 * s + 8 * hi); }
    for (int blk = F.bid; blk < NTOK / 128; blk += F.G) {
        if (F.tid < 32) lcnt[F.tid] = 0;
        __syncthreads();
#pragma unroll 1
        for (int sg = 0; sg < 4; ++sg) {
            const int tok0 = blk * 128 + sg * 32;
            { f32x4 v[4][4];
#pragma unroll
              for (int q = 0; q < 4; ++q) { const bf16_t* xrow = (const bf16_t*)(F.ws + WS_X) + (size_t)(tok0 + 4 * w + q) * DM;
#pragma unroll
                  for (int h = 0; h < 2; ++h) { const u32x4 t = *(const u32x4*)(xrow + 8 * l + 512 * h); bf8_to_f32(t, v[q][2 * h], v[q][2 * h + 1]); } }
              const int b = tok0 >> 12;
              const float* g = F.in[I_N2G] + layer * DM; const float* sh = mod + (size_t)b * 6144 + 3 * 1024; const float* sc = mod + (size_t)b * 6144 + 4 * 1024;
#pragma unroll
              for (int q = 0; q < 4; ++q) { const int rl = 4 * w + q, r = tok0 + rl; float ssq = 0.f;
#pragma unroll
                  for (int j = 0; j < 4; ++j) ssq += (v[q][j].x * v[q][j].x + v[q][j].y * v[q][j].y) + (v[q][j].z * v[q][j].z + v[q][j].w * v[q][j].w);
                  const float rstd = 1.0f / sqrtf(wave_sum(ssq) * (1.0f / 1024.0f) + EPS);
                  unsigned char* orow = F.ws + WS_BUF0 + (size_t)r * DM;
#pragma unroll
                  for (int h = 0; h < 2; ++h) { const int c = 8 * l + 512 * h;
                      const f32x4 y0 = v[q][2 * h] * rstd * *(const f32x4*)(g + c) * (*(const f32x4*)(sc + c) + 1.0f) + *(const f32x4*)(sh + c);
                      const f32x4 y1 = v[q][2 * h + 1] * rstd * *(const f32x4*)(g + c + 4) * (*(const f32x4*)(sc + c + 4) + 1.0f) + *(const f32x4*)(sh + c + 4);
                      u32x4 pk; pk.x = cvt_pk_bf16(y0[0], y0[1]); pk.y = cvt_pk_bf16(y0[2], y0[3]); pk.z = cvt_pk_bf16(y1[0], y1[1]); pk.w = cvt_pk_bf16(y1[2], y1[3]);
                      *(LAS u32x4*)(lds + MF_TILE + rl * MF_PITCH + c * 2) = pk;
                      int p0 = 0, p1 = 0; p0 = __builtin_amdgcn_cvt_pk_fp8_f32(y0[0], y0[1], p0, false); p0 = __builtin_amdgcn_cvt_pk_fp8_f32(y0[2], y0[3], p0, true);
                      p1 = __builtin_amdgcn_cvt_pk_fp8_f32(y1[0], y1[1], p1, false); p1 = __builtin_amdgcn_cvt_pk_fp8_f32(y1[2], y1[3], p1, true);
                      *(u32x2*)(orow + c) = (u32x2){(unsigned)p0, (unsigned)p1}; } } }
            __syncthreads();
            { f32x16 d0, d1;
#pragma unroll
              for (int r = 0; r < 16; ++r) { d0[r] = 0.f; d1[r] = 0.f; }
#pragma unroll
              for (int s = 0; s < 8; ++s) { const bf16x8 a = *(const LAS bf16x8*)(lds + MF_TILE + r32 * MF_PITCH + (128 * w + 16 * s + 8 * hi) * 2);
                  d0 = __builtin_amdgcn_mfma_f32_32x32x16_bf16(a, wb[0][s], d0, 0, 0, 0); d1 = __builtin_amdgcn_mfma_f32_32x32x16_bf16(a, wb[1][s], d1, 0, 0, 0); }
#pragma unroll
              for (int r = 0; r < 16; ++r) { const int t = (r & 3) + 8 * (r >> 2) + 4 * hi; red[(w * 32 + t) * 65 + r32] = d0[r]; red[(w * 32 + t) * 65 + 32 + r32] = d1[r]; } }
            __syncthreads();
            if (F.tid < 32) { const int t = F.tid;
                int g = 0; float gm = -1e30f, gl[4];
#pragma unroll
                for (int i = 0; i < 4; ++i) { float sum = F.in[I_MBG][layer * 4 + i];
#pragma unroll
                    for (int ww = 0; ww < 8; ++ww) sum += red[(ww * 32 + t) * 65 + i];
                    gl[i] = sum; if (sum > gm) { gm = sum; g = i; } }
                float gs = 0.f;
#pragma unroll
                for (int i = 0; i < 4; ++i) gs += __expf(gl[i] - gm);
                const float gw = 1.0f / gs;
                float el[8];
#pragma unroll
                for (int i = 0; i < 8; ++i) { float sum = F.in[I_MBE][layer * 32 + 8 * g + i];
#pragma unroll
                    for (int ww = 0; ww < 8; ++ww) sum += red[(ww * 32 + t) * 65 + 4 + 8 * g + i];
                    el[i] = sum; }
                int i1 = 0; float m1 = -1e30f;
#pragma unroll
                for (int i = 0; i < 8; ++i) if (el[i] > m1) { m1 = el[i]; i1 = i; }
                int i2 = 0; float m2 = -1e30f;
#pragma unroll
                for (int i = 0; i < 8; ++i) if (i != i1 && el[i] > m2) { m2 = el[i]; i2 = i; }
                const float e2 = __expf(m2 - m1), w1 = gw / (1.0f + e2), w2 = gw * e2 / (1.0f + e2);
                const int x1 = g * 8 + i1, x2 = g * 8 + i2;
                const int p1 = __hip_atomic_fetch_add(&lcnt[x1], 1, __ATOMIC_RELAXED, __HIP_MEMORY_SCOPE_WORKGROUP), p2 = __hip_atomic_fetch_add(&lcnt[x2], 1, __ATOMIC_RELAXED, __HIP_MEMORY_SCOPE_WORKGROUP);
                LAS int* sel = (LAS int*)(lds + MF_SEL) + (sg * 32 + t) * 8;
                sel[0] = x1; sel[1] = p1; sel[2] = x2; sel[3] = p2; sel[4] = __float_as_int(w1); sel[5] = __float_as_int(w2); }
            __syncthreads();
        }
        if (F.tid < 32) lbase[F.tid] = (int)__hip_atomic_fetch_add(gcnt + F.tid * 64, (unsigned)lcnt[F.tid], RLX_AGENT);
        __syncthreads();
        if (F.tid < 128) { const LAS int* sel = (const LAS int*)(lds + MF_SEL) + F.tid * 8; const int tok = blk * 128 + F.tid;
            const int x1 = sel[0], x2 = sel[2], q1 = lbase[x1] + sel[1], q2 = lbase[x2] + sel[3];
            list[x1 * 32768 + q1] = 2 * tok; list[x2 * 32768 + q2] = 2 * tok + 1;
            *(int4*)(tinfo + 4 * (size_t)tok) = make_int4(x1, q1, x2, q2);
            *(float2*)(tw + 2 * (size_t)tok) = make_float2(__int_as_float(sel[4]), __int_as_float(sel[5])); }
        __syncthreads();
    }
}

__device__ __forceinline__ void moe_prefix(Frame& F, int layer, LAS int* pref) {
    const unsigned* gcnt = (const unsigned*)(F.ws + WS_CTL) + CW_CNT + layer * 32 * 64;
    if (F.tid == 0) { int s = 0; for (int e = 0; e < 32; ++e) { const int c = (int)gcnt[e * 64]; pref[e] = s; pref[40 + e] = c; s += (c + 255) >> 8; } pref[32] = s; }
    __syncthreads();
}

template <int MODE> __device__ __forceinline__ void moe_combine(Frame& F, int layer) {
    const int gw = F.bid * NWAVES + F.wave, NGW = F.G * NWAVES;
    const float* mod = (const float*)(F.ws + WS_MOD) + (size_t)layer * 9 * 6144;
    const float* modn = (const float*)(F.ws + WS_MOD) + (size_t)1 * 9 * 6144;
    const float* tw = (const float*)(F.ws + WS_TOK + 512 * 1024);
    const bf16_t* Y0 = (const bf16_t*)(F.ws + WS_BUF0); const bf16_t* Y1 = (const bf16_t*)(F.ws + WS_Y1);
    bf16_t* X = (bf16_t*)(F.ws + WS_X);
#pragma unroll 1
    for (int r0 = gw; r0 < NTOK; r0 += 4 * NGW) {
        f32x4 v[4][4];
#pragma unroll
        for (int q = 0; q < 4; ++q) { const int r = r0 + q * NGW; const int b = r >> 12;
            const float2 ww = *(const float2*)(tw + 2 * (size_t)r);
            const float* g2 = mod + (size_t)b * 6144 + 5 * 1024;
#pragma unroll
            for (int h = 0; h < 2; ++h) { const int c = 8 * F.lane + 512 * h;
                const u32x4 xr = *(const u32x4*)(X + (size_t)r * DM + c), ar = *(const u32x4*)(Y0 + (size_t)r * DM + c), br = *(const u32x4*)(Y1 + (size_t)r * DM + c);
                f32x4 x0, x1, a0, a1, b0, b1; bf8_to_f32(xr, x0, x1); bf8_to_f32(ar, a0, a1); bf8_to_f32(br, b0, b1);
                v[q][2 * h] = x0 + *(const f32x4*)(g2 + c) * (a0 * ww.x + b0 * ww.y); v[q][2 * h + 1] = x1 + *(const f32x4*)(g2 + c + 4) * (a1 * ww.x + b1 * ww.y); } }
#pragma unroll
        for (int q = 0; q < 4; ++q) { const int r = r0 + q * NGW; const int b = r >> 12;
            float ssq = 0.f;
#pragma unroll
            for (int j = 0; j < 4; ++j) ssq += (v[q][j].x * v[q][j].x + v[q][j].y * v[q][j].y) + (v[q][j].z * v[q][j].z + v[q][j].w * v[q][j].w);
            const float rstd = 1.0f / sqrtf(wave_sum(ssq) * (1.0f / 1024.0f) + EPS);
            const float* g = (MODE == 0) ? F.in[I_N1G] + DM : F.in[I_FING];
#pragma unroll
            for (int h = 0; h < 2; ++h) { const int c = 8 * F.lane + 512 * h;
                if (MODE == 0) { u32x4 pk; pk.x = cvt_pk_bf16(v[q][2 * h][0], v[q][2 * h][1]); pk.y = cvt_pk_bf16(v[q][2 * h][2], v[q][2 * h][3]); pk.z = cvt_pk_bf16(v[q][2 * h + 1][0], v[q][2 * h + 1][1]); pk.w = cvt_pk_bf16(v[q][2 * h + 1][2], v[q][2 * h + 1][3]);
                    *(u32x4*)(X + (size_t)r * DM + c) = pk; }
                f32x4 y0 = v[q][2 * h] * rstd * *(const f32x4*)(g + c), y1 = v[q][2 * h + 1] * rstd * *(const f32x4*)(g + c + 4);
                if (MODE == 0) { const float* sh = modn + (size_t)b * 6144; const float* sc = sh + 1024;
                    y0 = y0 * (*(const f32x4*)(sc + c) + 1.0f) + *(const f32x4*)(sh + c); y1 = y1 * (*(const f32x4*)(sc + c + 4) + 1.0f) + *(const f32x4*)(sh + c + 4);
                    if (CONF_FP8) { int p0 = 0, p1 = 0; p0 = __builtin_amdgcn_cvt_pk_fp8_f32(y0[0], y0[1], p0, false); p0 = __builtin_amdgcn_cvt_pk_fp8_f32(y0[2], y0[3], p0, true);
                        p1 = __builtin_amdgcn_cvt_pk_fp8_f32(y1[0], y1[1], p1, false); p1 = __builtin_amdgcn_cvt_pk_fp8_f32(y1[2], y1[3], p1, true);
                        *(u32x2*)(F.ws + WS_BUF0 + (size_t)r * DM + c) = (u32x2){(unsigned)p0, (unsigned)p1}; }
                    else { u32x4 pk; pk.x = cvt_pk_bf16(y0[0], y0[1]); pk.y = cvt_pk_bf16(y0[2], y0[3]); pk.z = cvt_pk_bf16(y1[0], y1[1]); pk.w = cvt_pk_bf16(y1[2], y1[3]);
                        *(u32x4*)((bf16_t*)(F.ws + WS_BUF0) + (size_t)r * DM + c) = pk; } }
                else { *(f32x4*)(F.out + (size_t)r * DM + c) = y0; *(f32x4*)(F.out + (size_t)r * DM + c + 4) = y1; } } }
    }
}

__device__ __forceinline__ void transpose_ob(Frame& F) {
    LAS bf16_t* scr = (LAS bf16_t*)(F.lds + F.wave * 16384);
    const int gw = F.bid * NWAVES + F.wave, NGW = F.G * NWAVES;
    const bf16_t* src = (const bf16_t*)(F.ws + WS_OBT); bf16_t* dst = (bf16_t*)(F.ws + WS_BUF0);
    const int r8 = F.lane >> 3, c8 = F.lane & 7;
    for (int it = gw; it < 8 * 512; it += NGW) {
        const int cb = it & 7, tb = it >> 3; const int c0 = cb * 64, t0 = tb * 64;
        u32x4 v[8];
#pragma unroll
        for (int i = 0; i < 8; ++i) v[i] = *(const u32x4*)(src + (size_t)(c0 + r8 + 8 * i) * NTOK + t0 + 8 * c8);
#pragma unroll
        for (int i = 0; i < 8; ++i) *(LAS u32x4*)(scr + (r8 + 8 * i) * 72 + 8 * c8) = v[i];
        LDS_WAIT(); asm volatile("" ::: "memory");
#pragma unroll
        for (int i = 0; i < 8; ++i) { const int t = r8 + 8 * i; unsigned short e[8];
#pragma unroll
            for (int k = 0; k < 8; ++k) e[k] = scr[(8 * c8 + k) * 72 + t];
            u32x4 o; o.x = e[0] | ((unsigned)e[1] << 16); o.y = e[2] | ((unsigned)e[3] << 16); o.z = e[4] | ((unsigned)e[5] << 16); o.w = e[6] | ((unsigned)e[7] << 16);
            *(u32x4*)(dst + (size_t)(t0 + t) * DM + 512 + c0 + 8 * c8) = o; }
        LDS_WAIT(); asm volatile("" ::: "memory");
    }
}

template <int SS> __device__ __forceinline__ void conv_step(f32x2 (&acc)[32], const f32x2 (&w)[31], const f32x2 bias, const unsigned rawv) {
    const f32x2 xin = (f32x2){bflo(rawv), bfhi(rawv)};
    acc[SS] = bias;
#pragma unroll
    for (int k = 0; k < 31; ++k) acc[(SS - k) & 31] += w[k] * xin;
}
constexpr int CV_TILE = 65536;
__device__ __forceinline__ void conv_ln_rows(Frame& F, const LAS bf16_t* tile, bf16_t* Obase  ) {
#pragma unroll 1
    for (int q = 0; q < 4; ++q) { const int rr = F.wave * 4 + q;
        f32x4 v[4]; float sm = 0.f;
#pragma unroll
        for (int h = 0; h < 2; ++h) { const u32x4 t = *(const LAS u32x4*)(tile + rr * 1024 + 8 * F.lane + 512 * h); bf8_to_f32(t, v[2 * h], v[2 * h + 1]); }
#pragma unroll
        for (int j = 0; j < 4; ++j) sm += (v[j].x + v[j].y) + (v[j].z + v[j].w);
        const float mean = wave_sum(sm) * (1.0f / 1024.0f); float s2 = 0.f;
#pragma unroll
        for (int j = 0; j < 4; ++j) { v[j] = v[j] - mean; s2 += (v[j].x * v[j].x + v[j].y * v[j].y) + (v[j].z * v[j].z + v[j].w * v[j].w); }
        const float rstd = 1.0f / sqrtf(wave_sum(s2) * (1.0f / 1024.0f) + EPS);
        bf16_t* orow = Obase + (size_t)rr * (CONF_FP8 ? DM / 2 : DM);
#pragma unroll
        for (int h = 0; h < 2; ++h) { const int c = 8 * F.lane + 512 * h;
            f32x4 y0 = v[2 * h] * rstd * *(const f32x4*)(F.in[I_CVLNG] + c) + *(const f32x4*)(F.in[I_CVLNB] + c), y1 = v[2 * h + 1] * rstd * *(const f32x4*)(F.in[I_CVLNG] + c + 4) + *(const f32x4*)(F.in[I_CVLNB] + c + 4);
#pragma unroll
            for (int e = 0; e < 4; ++e) { y0[e] = silu_f(y0[e]); y1[e] = silu_f(y1[e]); }
            if (CONF_FP8) { int p0 = 0, p1 = 0; p0 = __builtin_amdgcn_cvt_pk_fp8_f32(y0[0], y0[1], p0, false); p0 = __builtin_amdgcn_cvt_pk_fp8_f32(y0[2], y0[3], p0, true);
                p1 = __builtin_amdgcn_cvt_pk_fp8_f32(y1[0], y1[1], p1, false); p1 = __builtin_amdgcn_cvt_pk_fp8_f32(y1[2], y1[3], p1, true); *(u32x2*)((unsigned char*)orow + c) = (u32x2){(unsigned)p0, (unsigned)p1}; }
            else { u32x4 pk; pk.x = cvt_pk_bf16(y0[0], y0[1]); pk.y = cvt_pk_bf16(y0[2], y0[3]); pk.z = cvt_pk_bf16(y1[0], y1[1]); pk.w = cvt_pk_bf16(y1[2], y1[3]); *(u32x4*)(orow + c) = pk; } } }
}
__device__ __forceinline__ void conv_half_issue(Frame& F, const bf16_t* Abatch, int t0, int s1, LAS unsigned char* dst) {
    const char* zrow = (const char*)(F.ws + WS_CTL + 512 * 1024);
#pragma unroll
    for (int i = 0; i < 4; ++i) { const int p = F.tid + 512 * i, row = p >> 7, chn = p & 127; const int t = t0 - 15 + s1 + row;
        const char* src = (t >= 0 && t < SEQ) ? (const char*)(Abatch + (size_t)t * DM) + 16 * chn : zrow + 16 * chn;
        __builtin_amdgcn_global_load_lds((const unsigned*)src, (LAS unsigned*)(dst + i * 8192 + F.wave * 1024), 16, 0, 0); }
}
__device__ __forceinline__ void conv_ln_phase(Frame& F) {
    LAS unsigned char* stA = F.lds; LAS unsigned char* stB = F.lds + 32768; LAS bf16_t* tile = (LAS bf16_t*)(F.lds + CV_TILE);
    const bf16_t* A = (const bf16_t*)(F.ws + WS_GLU); bf16_t* O = (bf16_t*)(F.ws + WS_BUF0);
    const int ch = 2 * F.tid;
    f32x2 w[31];
#pragma unroll
    for (int k = 0; k < 31; ++k) w[k] = *(const f32x2*)(F.in[I_CVDWW] + k * 1024 + ch);
    const f32x2 bias = *(const f32x2*)(F.in[I_CVDWB] + ch);
    for (int blk = F.bid; blk < 256; blk += F.G) {
        const int b = blk >> 5, t0 = (blk & 31) * 128;
        const bf16_t* Ab = A + (size_t)b * SEQ * DM;
        f32x2 acc[32];
#pragma unroll
        for (int i = 0; i < 32; ++i) acc[i] = (f32x2){0.f, 0.f};
        __syncthreads();
        conv_half_issue(F, Ab, t0, 0, stA); conv_half_issue(F, Ab, t0, 16, stB);
#pragma unroll 1
        for (int s0 = 0; s0 < 160; s0 += 32) {
#define CV_STEP(SS) { conv_step<SS>(acc, w, bias, *(const LAS unsigned*)((SS < 16 ? stA : stB) + (SS & 15) * 2048 + 2 * ch)); const int o = s0 + SS - 30; \
                if (o >= 0 && o < 128) { const f32x2 r_ = acc[(SS + 2) & 31]; *(LAS unsigned*)(tile + ((SS + 2) & 31) * 1024 + ch) = cvt_pk_bf16(r_.x, r_.y); } \
                if (SS == 29 && o >= 0 && o < 128) { __syncthreads(); conv_ln_rows(F, tile, O + ((size_t)b * SEQ + t0 + (o - 31)) * (CONF_FP8 ? DM / 2 : DM)); __syncthreads(); } }
            VM_WAIT(); __syncthreads();
            CV_STEP(0) CV_STEP(1) CV_STEP(2) CV_STEP(3) CV_STEP(4) CV_STEP(5) CV_STEP(6) CV_STEP(7) CV_STEP(8) CV_STEP(9) CV_STEP(10) CV_STEP(11) CV_STEP(12) CV_STEP(13) CV_STEP(14) CV_STEP(15)
            __syncthreads();
            if (s0 + 32 < 160) conv_half_issue(F, Ab, t0, s0 + 32, stA);
            CV_STEP(16) CV_STEP(17) CV_STEP(18) CV_STEP(19) CV_STEP(20) CV_STEP(21) CV_STEP(22) CV_STEP(23) CV_STEP(24) CV_STEP(25) CV_STEP(26) CV_STEP(27) CV_STEP(28) CV_STEP(29) CV_STEP(30) CV_STEP(31)
            __syncthreads();
            if (s0 + 32 < 160) conv_half_issue(F, Ab, t0, s0 + 48, stB);
#undef CV_STEP
        }
    }
}
namespace att {
constexpr int KT = 64, NTILE = LKV / KT, ST_BYTES = 24576;
typedef short v4i16_t __attribute__((ext_vector_type(4)));

__device__ __forceinline__ f32x16 mfma32(bf16x8 a, bf16x8 b, f32x16 c) { return __builtin_amdgcn_mfma_f32_32x32x16_bf16(a, b, c, 0, 0, 0); }

__device__ __forceinline__ void attn_phase(Frame& F) {
    LAS unsigned char* lds = F.lds;
    const int l = F.lane, w = F.wave, tid = F.tid, r32 = l & 31, hi = l >> 5;
    const bf16_t* Qb = (const bf16_t*)(F.ws + WS_Q); const bf16_t* Kb = (const bf16_t*)(F.ws + WS_K); const bf16_t* Vb = (const bf16_t*)(F.ws + WS_V);
    bf16_t* Ob = (bf16_t*)(F.ws + WS_BUF0);
    const float lam = ((const float*)(F.ws + WS_TAB))[TB_LAM];
    const unsigned kbase_ = (unsigned)(r32 * 128), kx_ = (unsigned)((r32 >> 1) & 7);
    unsigned vbase_, vq4_;
    { const int g = l >> 4, i = l & 15, q4 = i >> 2, p4 = i & 3; const int row = 4 * (g >> 1) + q4;
      const int lowch = (2 * (g & 1) + (p4 >> 1)) ^ ((row >> 2) & 3);
      vbase_ = (unsigned)(8192 + row * 256 + (lowch << 4) + 8 * (p4 & 1)); vq4_ = (unsigned)q4; }
#define ATT_ISSUE(st, kv0) do { const size_t _ro = (size_t)(kv0) * 1024; int t_ = tid; asm volatile("" : "+v"(t_)); \
        const int krow = t_ >> 3; const unsigned ksrc = (unsigned)(krow * 1024 + (((t_ & 7) ^ ((krow >> 1) & 7)) << 4)); unsigned vsrc[2]; \
        _Pragma("unroll") for (int i_ = 0; i_ < 2; ++i_) { const int p = t_ + 512 * i_, vrow = p >> 4; vsrc[i_] = (unsigned)(vrow * 1024 + (((p & 15) ^ (((vrow & 3) << 2) | ((vrow >> 2) & 3))) << 4)); } \
        __builtin_amdgcn_global_load_lds((const unsigned*)(Kg + _ro + ksrc), (LAS unsigned*)(lds + (st) * ST_BYTES + w * 1024), 16, 0, 0); \
        __builtin_amdgcn_global_load_lds((const unsigned*)(Vg + _ro + vsrc[0]), (LAS unsigned*)(lds + (st) * ST_BYTES + 8192 + w * 1024), 16, 0, 0); \
        __builtin_amdgcn_global_load_lds((const unsigned*)(Vg + _ro + vsrc[1]), (LAS unsigned*)(lds + (st) * ST_BYTES + 16384 + w * 1024), 16, 0, 0); } while (0)

    for (int it = 0;; ++it) {
        int grp, qb;
        if (F.G == 256) { const int x = F.bid & 7, j = F.bid >> 3; if (it >= 2) break; grp = x * 4 + it * 2 + (j >> 4); qb = j & 15; }
        else { const int un = it * F.G + F.bid; if (un >= 512) break; grp = un >> 4; qb = un & 15; }
        const int b = grp >> 2, hp = grp & 3;
        const bf16_t* Qg = Qb + ((size_t)b * SEQ + qb * 256 + w * 32 + r32) * 512;
        const char* Vg = (const char*)(Vb + (size_t)b * LKV * 512 + hp * 128);
        f32x16 o1[4];
#pragma unroll 1
        for (int s = 0; s < 2; ++s) {
            const char* Kg = (const char*)(Kb + (size_t)b * LKV * 512 + (2 * hp + s) * 64);
            bf16x8 qf[4];
#pragma unroll
            for (int ds = 0; ds < 4; ++ds) qf[ds] = *(const bf16x8*)(Qg + (2 * hp + s) * 64 + ds * 16 + hi * 8);
            f32x16 O[4];
#pragma unroll
            for (int d = 0; d < 4; ++d)
#pragma unroll
                for (int r = 0; r < 16; ++r) O[d][r] = 0.f;
            float m = 0.f, lsum = 0.f;
            __syncthreads();
            ATT_ISSUE(0, 0);
#pragma unroll 1
            for (int j = 0; j < NTILE; ++j) {
                VM_WAIT(); __syncthreads();
                if (j + 1 < NTILE) ATT_ISSUE((j + 1) & 1, (j + 1) * KT);
                const LAS unsigned char* Ks = lds + (j & 1) * ST_BYTES;
                unsigned kbase = kbase_, kx = kx_, vbase = vbase_, vq4 = vq4_; asm volatile("" : "+v"(kbase), "+v"(kx), "+v"(vbase), "+v"(vq4));
                f32x16 p0, p1;
#pragma unroll
                for (int r = 0; r < 16; ++r) { p0[r] = 0.f; p1[r] = 0.f; }
#pragma unroll
                for (int ds = 0; ds < 4; ++ds) { const unsigned ka = kbase + ((((unsigned)(2 * ds + hi)) ^ kx) << 4); const bf16x8 k0 = *(const LAS bf16x8*)(Ks + ka), k1 = *(const LAS bf16x8*)(Ks + ka + 4096);
                    p0 = mfma32(k0, qf[ds], p0); p1 = mfma32(k1, qf[ds], p1); }
                if (j == 0) { float mx0 = fmaxf(p0[0], p1[0]);
#pragma unroll
                    for (int r = 1; r < 16; ++r) mx0 = fmaxf(mx0, fmaxf(p0[r], p1[r]));
                    m = fmaxf(mx0, __shfl_xor(mx0, 32)); }
                f32x2 e0[8], e1[8];
                { const f32x2 mm = (f32x2){m, m};
#pragma unroll
                  for (int r = 0; r < 8; ++r) { e0[r] = (f32x2){p0[2 * r], p0[2 * r + 1]} - mm; e1[r] = (f32x2){p1[2 * r], p1[2 * r + 1]} - mm; } }
                float mx = fmaxf(fmaxf(e0[0].x, e0[0].y), fmaxf(e1[0].x, e1[0].y));
#pragma unroll
                for (int r = 1; r < 8; ++r) { mx = fmaxf(fmaxf(mx, e0[r].x), e0[r].y); mx = fmaxf(fmaxf(mx, e1[r].x), e1[r].y); }
                mx = fmaxf(mx, __shfl_xor(mx, 32));
                if (!__all(mx <= 8.0f)) { const float dl = fmaxf(mx, 0.f), alpha = __builtin_amdgcn_exp2f(-dl);
#pragma unroll
                    for (int d = 0; d < 4; ++d) O[d] = O[d] * alpha;
                    lsum *= alpha; m += dl; const f32x2 dd = (f32x2){dl, dl};
#pragma unroll
                    for (int r = 0; r < 8; ++r) { e0[r] -= dd; e1[r] -= dd; } }
                { f32x2 acc = (f32x2){0.f, 0.f};
#pragma unroll
                  for (int r = 0; r < 8; ++r) { e0[r] = (f32x2){__builtin_amdgcn_exp2f(e0[r].x), __builtin_amdgcn_exp2f(e0[r].y)}; e1[r] = (f32x2){__builtin_amdgcn_exp2f(e1[r].x), __builtin_amdgcn_exp2f(e1[r].y)};
                      acc += e0[r] + e1[r]; }
                  lsum += acc.x + acc.y; }
                bf16x8 pb[4];
#pragma unroll
                for (int q = 0; q < 2; ++q) { u32x4 a, c;
                    a.x = cvt_pk_bf16(e0[4 * q + 0].x, e0[4 * q + 0].y); a.y = cvt_pk_bf16(e0[4 * q + 1].x, e0[4 * q + 1].y); a.z = cvt_pk_bf16(e0[4 * q + 2].x, e0[4 * q + 2].y); a.w = cvt_pk_bf16(e0[4 * q + 3].x, e0[4 * q + 3].y);
                    c.x = cvt_pk_bf16(e1[4 * q + 0].x, e1[4 * q + 0].y); c.y = cvt_pk_bf16(e1[4 * q + 1].x, e1[4 * q + 1].y); c.z = cvt_pk_bf16(e1[4 * q + 2].x, e1[4 * q + 2].y); c.w = cvt_pk_bf16(e1[4 * q + 3].x, e1[4 * q + 3].y);
                    pb[q] = __builtin_bit_cast(bf16x8, a); pb[2 + q] = __builtin_bit_cast(bf16x8, c); }
#pragma unroll
                for (int d = 0; d < 4; ++d) {
                    const unsigned va0 = vbase + ((((unsigned)d) ^ vq4) << 6), va1 = (va0 ^ 32u) + 2048u;
#pragma unroll
                    for (int kv = 0; kv < 4; ++kv) {
                        const v4i16_t lo = __builtin_amdgcn_ds_read_tr16_b64_v4i16((LAS v4i16_t*)(Ks + va0 + kv * 4096));
                        const v4i16_t hh = __builtin_amdgcn_ds_read_tr16_b64_v4i16((LAS v4i16_t*)(Ks + va1 + kv * 4096));
                        const bf16x8 vf = (bf16x8){lo[0], lo[1], lo[2], lo[3], hh[0], hh[1], hh[2], hh[3]};
                        O[d] = mfma32(vf, pb[kv], O[d]); } }
            }
            const float lt = lsum + __shfl_xor(lsum, 32);
            if (s == 0) { const float inv = 1.0f / lt;
#pragma unroll
                for (int d = 0; d < 4; ++d) o1[d] = O[d] * inv; }
            else { const float inv = lam / lt; float ss = 0.f;
#pragma unroll
                for (int d = 0; d < 4; ++d) { o1[d] = o1[d] - O[d] * inv;
#pragma unroll
                    for (int r = 0; r < 16; ++r) ss += o1[d][r] * o1[d][r]; }
                ss += __shfl_xor(ss, 32);
                const float rn = 0.8f / sqrtf(ss * (1.0f / 128.0f) + EPS);
                bf16_t* orow = Ob + ((size_t)b * SEQ + qb * 256 + w * 32 + r32) * DM + hp * 128 + 4 * hi;
#pragma unroll
                for (int d = 0; d < 4; ++d)
#pragma unroll
                    for (int q = 0; q < 4; ++q) { const f32x4 g4 = *(const f32x4*)(F.in[I_SUBLN] + 32 * d + 8 * q + 4 * hi);
                        u32x2 pk; pk.x = cvt_pk_bf16(o1[d][4 * q] * rn * g4[0], o1[d][4 * q + 1] * rn * g4[1]); pk.y = cvt_pk_bf16(o1[d][4 * q + 2] * rn * g4[2], o1[d][4 * q + 3] * rn * g4[3]);
                        *(u32x2*)(orow + 32 * d + 8 * q) = pk; }
            }
        }
    }
#undef ATT_ISSUE
}
}
namespace hy {
constexpr int FBUF = 4352 * 8;
constexpr int KOFF = 2 * FBUF;
constexpr int KLEN = 2192;
constexpr int RED_OFF = KOFF + 4 * KLEN * 8;
__device__ __forceinline__ int pad(int i) { return i + (i >> 4); }
__device__ __forceinline__ float sgpr_f(float v) { return __int_as_float(__builtin_amdgcn_readfirstlane(__float_as_int(v))); }
typedef f32x2 cx;
#ifndef HY_ASM
#define HY_ASM 3
#endif
#if HY_ASM & 1
__device__ __forceinline__ void c_mul_ip(cx& x, cx w) { cx t;
    asm("v_pk_mul_f32 %1, %0, %2 op_sel_hi:[0,1]\n\tv_pk_fma_f32 %0, %0, %2, %1 op_sel:[1,1,0] op_sel_hi:[1,0,1] neg_lo:[1,0,0]" : "+v"(x), "=&v"(t) : "v"(w)); }
__device__ __forceinline__ cx c_mul(cx x, cx w) { cx y;
    asm("v_pk_mul_f32 %0, %1, %2 op_sel_hi:[0,1]\n\tv_pk_fma_f32 %0, %1, %2, %0 op_sel:[1,1,0] op_sel_hi:[1,0,1] neg_lo:[1,0,0]" : "=&v"(y) : "v"(x), "v"(w)); return y; }
__device__ __forceinline__ void c_mul_sw_ip(cx& x, cx w) { cx t;
    asm("v_pk_mul_f32 %1, %0, %2 op_sel:[0,1] op_sel_hi:[0,0]\n\tv_pk_fma_f32 %0, %0, %2, %1 op_sel:[1,0,0] op_sel_hi:[1,1,1] neg_hi:[1,0,0]" : "+v"(x), "=&v"(t) : "v"(w)); }
__device__ __forceinline__ void c_mul_swc_ip(cx& x, cx w) { cx t;
    asm("v_pk_mul_f32 %1, %0, %2 op_sel:[0,1] op_sel_hi:[0,0]\n\tv_pk_fma_f32 %0, %0, %2, %1 op_sel:[1,0,0] op_sel_hi:[1,1,1] neg_lo:[0,0,1]" : "+v"(x), "=&v"(t) : "v"(w)); }
__device__ __forceinline__ void c_mul_k_ip(cx& x, cx w) { cx t;
    asm("v_pk_mul_f32 %1, %0, %2 op_sel_hi:[0,1]\n\tv_pk_fma_f32 %0, %0, %2, %1 op_sel:[1,1,0] op_sel_hi:[1,0,1] neg_lo:[1,0,0]" : "+v"(x), "=&v"(t) : "s"(w)); }
#else
__device__ __forceinline__ cx c_mul(cx x, cx w) { return (cx){x.x, x.x} * w + (cx){-x.y, x.y} * (cx){w.y, w.x}; }
__device__ __forceinline__ void c_mul_ip(cx& x, cx w) { x = c_mul(x, w); }
__device__ __forceinline__ void c_mul_k_ip(cx& x, cx w) { x = c_mul(x, w); }
__device__ __forceinline__ void c_mul_sw_ip(cx& x, cx w) { x = (cx){x.x, x.x} * (cx){w.y, w.x} + (cx){x.y, -x.y} * w; }
__device__ __forceinline__ void c_mul_swc_ip(cx& x, cx w) { c_mul_sw_ip(x, (cx){w.x, -w.y}); }
#endif
#if HY_ASM & 2
__device__ __forceinline__ cx c_mi(cx a, cx b) { cx d; asm("v_pk_add_f32 %0, %1, %2 op_sel:[0,1] op_sel_hi:[1,0] neg_hi:[0,1]" : "=v"(d) : "v"(a), "v"(b)); return d; }
__device__ __forceinline__ cx c_pi(cx a, cx b) { cx d; asm("v_pk_add_f32 %0, %1, %2 op_sel:[0,1] op_sel_hi:[1,0] neg_lo:[0,1]" : "=v"(d) : "v"(a), "v"(b)); return d; }
#else
__device__ __forceinline__ cx c_mi(cx a, cx b) { return a + (cx){b.y, -b.x}; }
__device__ __forceinline__ cx c_pi(cx a, cx b) { return a + (cx){-b.y, b.x}; }
#endif

__device__ __forceinline__ void dft4(cx& a, cx& b, cx& c, cx& d) {
    const cx s0 = a + c, d0 = a - c, s1 = b + d, d1 = b - d;
    a = s0 + s1; c = s0 - s1; b = c_mi(d0, d1); d = c_pi(d0, d1);
}
__device__ __forceinline__ void dft4_rc(cx& a, cx& b, cx& c, cx& d) {
    const cx s0 = c_mi(a, c), d0 = c_pi(a, c), s1 = b + d, d1 = b - d;
    a = s0 + s1; c = s0 - s1; b = c_mi(d0, d1); d = c_pi(d0, d1);
}
__device__ __forceinline__ void dft16(cx (&x)[16]) {
    constexpr float C1 = 0.9238795325112867f, S1 = 0.3826834323650898f, R = 0.7071067811865476f;
#pragma unroll
    for (int b = 0; b < 4; ++b) dft4(x[b], x[4 + b], x[8 + b], x[12 + b]);
    c_mul_k_ip(x[5], (cx){C1, -S1}); c_mul_k_ip(x[6], (cx){R, -R}); c_mul_k_ip(x[7], (cx){S1, -C1});
    c_mul_k_ip(x[9], (cx){R, -R});   c_mul_k_ip(x[11], (cx){-R, -R});
    c_mul_k_ip(x[13], (cx){S1, -C1}); c_mul_k_ip(x[14], (cx){-R, -R}); c_mul_k_ip(x[15], (cx){-C1, S1});
#pragma unroll
    for (int c = 0; c < 4; ++c) { if (c == 2) dft4_rc(x[8], x[9], x[10], x[11]); else dft4(x[4 * c], x[4 * c + 1], x[4 * c + 2], x[4 * c + 3]); }
    cx y[16];
#pragma unroll
    for (int k = 0; k < 16; ++k) y[k] = x[4 * (k & 3) + (k >> 2)];
#pragma unroll
    for (int k = 0; k < 16; ++k) x[k] = y[k];
}
__device__ __forceinline__ void twiddle_pow(cx (&x)[16], cx w) {
    cx p[16]; p[1] = w;
#pragma unroll
    for (int n = 2; n < 16; ++n) { const int a = n >> 1, b = n - a; p[n] = c_mul(p[a], p[b]); }
#pragma unroll
    for (int n = 1; n < 16; ++n) c_mul_ip(x[n], p[n]);
}
__device__ __forceinline__ void fft4096(cx (&x)[16], LAS f32x2* buf, int uw, int u, const cx w2, const cx w3) {
    dft16(x);
    { LAS f32x2* p = buf + pad(uw);
#pragma unroll
      for (int k = 0; k < 16; ++k) p[272 * k] = x[k]; }
    __syncthreads();
    { LAS f32x2* p = buf + 272 * (u >> 4) + (u & 15);
#pragma unroll
      for (int n = 0; n < 16; ++n) x[n] = *(const volatile LAS f32x2*)(p + 17 * n);
      twiddle_pow(x, w2);
      dft16(x);
#pragma unroll
      for (int k = 0; k < 16; ++k) p[17 * k] = x[k]; }
    __syncthreads();
    { const LAS f32x2* p = buf + 272 * (u >> 4) + 17 * (u & 15);
#pragma unroll
      for (int n = 0; n < 16; ++n) x[n] = *(const volatile LAS f32x2*)(p + n);
      twiddle_pow(x, w3);
      dft16(x); }
}
__device__ __forceinline__ void twiddle_w8192(cx (&x)[16], cx base, bool conj) {
    constexpr float C = 0.9807852804032304f, S = 0.1950903220161283f;
    cx w = conj ? (cx){base.x, -base.y} : base; const cx st = (cx){C, conj ? S : -S};
#pragma unroll
    for (int n = 0; n < 16; ++n) { c_mul_ip(x[n], w); c_mul_ip(w, st); }
}
struct SRow { u32x4 raw; bf16_t l, r; };
__device__ __forceinline__ void sconv_load(const bf16_t* row, int t0, SRow& R) {
    R.raw = *(const u32x4*)(row + t0); R.l = row[t0 > 0 ? t0 - 1 : 0]; R.r = row[t0 + 8 < SEQ ? t0 + 8 : SEQ - 1];
}
__device__ __forceinline__ void sconv_apply(const SRow& R, int t0, const f32x4 wb  , float (&out)[8]) {
    float x[10]; x[0] = t0 > 0 ? bf2f(R.l) : 0.f; x[9] = t0 + 8 < SEQ ? bf2f(R.r) : 0.f;
    x[1] = bflo(R.raw.x); x[2] = bfhi(R.raw.x); x[3] = bflo(R.raw.y); x[4] = bfhi(R.raw.y); x[5] = bflo(R.raw.z); x[6] = bfhi(R.raw.z); x[7] = bflo(R.raw.w); x[8] = bfhi(R.raw.w);
#pragma unroll
    for (int i = 0; i < 8; ++i) out[i] = wb[3] + wb[0] * x[i] + wb[1] * x[i + 1] + wb[2] * x[i + 2];
}

__device__ __forceinline__ void hyena_phase(Frame& F) {
    LAS f32x2* FB0 = (LAS f32x2*)F.lds; LAS f32x2* FB1 = (LAS f32x2*)(F.lds + FBUF);
    LAS f32x2* KH = (LAS f32x2*)(F.lds + KOFF);
    LAS float* red = (LAS float*)(F.lds + RED_OFF);
    const int tid = F.tid, half = tid >> 8, u_ = tid & 255, u1_ = (u_ >> 4) + 16 * (u_ & 15);
    LAS f32x2* myF = half ? FB1 : FB0;
    const float* tab = (const float*)(F.ws + WS_TAB);
    const f32x2* T4096 = (const f32x2*)(tab + TB_T4096); const f32x2* T8A = (const f32x2*)(tab + TB_T8A); const f32x2* T8B = (const f32x2*)(tab + TB_T8B);
#define HY_W8192(dst, idx) f32x2 dst; { const f32x2 a_ = T8A[(idx) & 63], b_ = T8B[(idx) >> 6]; dst = (f32x2){a_.x * b_.x - a_.y * b_.y, a_.x * b_.y + a_.y * b_.x}; }
    const cx tw2 = T4096[16 * (u_ >> 4)], tw3 = T4096[(u_ >> 4) + 16 * (u_ & 15)];
    HY_W8192(twu, u_); HY_W8192(twu1, u1_);
    const float* kraw = (const float*)(F.ws + WS_KRAW);
    const bf16_t* UT = (const bf16_t*)(F.ws + WS_UT); bf16_t* OBT = (bf16_t*)(F.ws + WS_OBT);
    const int j0 = 8 * tid, jp = 8 * tid + (tid >> 1);
    for (int c = F.bid; c < 512; c += F.G) {
        f32x4 wS[3];
#pragma unroll
        for (int s3 = 0; s3 < 3; ++s3) { const float* swp = F.in[I_HYSW] + 512 * s3 + c; wS[s3] = (f32x4){sgpr_f(swp[0]), sgpr_f(swp[1536]), sgpr_f(swp[3072]), sgpr_f(F.in[I_HYSB][512 * s3 + c])}; }
        const float bias0 = sgpr_f(F.in[I_HYBIAS][c]), bias1 = sgpr_f(F.in[I_HYBIAS][512 + c]);
        __syncthreads();
        { float an[2];
#pragma unroll
          for (int o = 0; o < 2; ++o) { const float* fw = kraw + (size_t)(1024 * o + c) * 4096; const float* bw = kraw + (size_t)(1024 * o + 512 + c) * 4096;
              float f[8], g[8];
              { const f32x4 fa = *(const f32x4*)(fw + j0), fb = *(const f32x4*)(fw + j0 + 4);
                const f32x4 ga = *(const f32x4*)(bw + 4088 - j0), gb = *(const f32x4*)(bw + 4092 - j0);
                const float g0 = tid > 0 ? bw[4096 - j0] : 0.f;
                f[0] = fa[0]; f[1] = fa[1]; f[2] = fa[2]; f[3] = fa[3]; f[4] = fb[0]; f[5] = fb[1]; f[6] = fb[2]; f[7] = fb[3];
                g[0] = g0; g[1] = gb[3]; g[2] = gb[2]; g[3] = gb[1]; g[4] = gb[0]; g[5] = ga[3]; g[6] = ga[2]; g[7] = ga[1]; }
              float a = 0.f;
#pragma unroll
              for (int i = 0; i < 8; ++i) { a += fabsf(f[i]) + fabsf(g[i]);
                  ((LAS float*)(FB0 + jp + i))[o] = f[i] + g[i]; ((LAS float*)(FB1 + jp + i))[o] = f[i] - g[i]; }
              an[o] = wave_sum(a);
              asm volatile("" ::: "memory"); }
          if (F.lane == 0) { red[F.wave] = an[0]; red[8 + F.wave] = an[1]; } }
        __syncthreads();
        float nrm0 = 0.f, nrm1 = 0.f;
#pragma unroll
        for (int i = 0; i < 8; ++i) { nrm0 += red[i]; nrm1 += red[8 + i]; }
        const float sc0 = 1.0f / (nrm0 * 8192.0f), sc1 = 1.0f / (nrm1 * 8192.0f);
        cx x[16];
        { int u = u_, u1 = u1_; asm volatile("" : "+v"(u), "+v"(u1));
#pragma unroll
        for (int n = 0; n < 16; ++n) x[n] = (myF + pad(u))[272 * n];
        __syncthreads();
        if (half) twiddle_w8192(x, twu, false);
        fft4096(x, myF, u, u, tw2, tw3);
        __syncthreads();
#pragma unroll
        for (int k = 0; k < 16; ++k) (myF + pad(u1))[272 * k] = x[k]; }
        __syncthreads();
        for (int kk = tid; kk < 2049; kk += 512) {
            { const f32x2 A = FB0[pad(kk)]; f32x2 B = FB0[pad((4096 - kk) & 4095)]; B.y = -B.y;
              KH[0 * KLEN + pad(kk)] = (f32x2){(A.x + B.x) * 0.5f * sc0, (A.y + B.y) * 0.5f * sc0};
              KH[2 * KLEN + pad(kk)] = (f32x2){(A.y - B.y) * 0.5f * sc1, -(A.x - B.x) * 0.5f * sc1}; }
            if (kk < 2048) { const f32x2 A = FB1[pad(kk)]; f32x2 B = FB1[pad(4095 - kk)]; B.y = -B.y;
              KH[1 * KLEN + pad(kk)] = (f32x2){(A.x + B.x) * 0.5f * sc0, (A.y + B.y) * 0.5f * sc0};
              KH[3 * KLEN + pad(kk)] = (f32x2){(A.y - B.y) * 0.5f * sc1, -(A.x - B.x) * 0.5f * sc1}; }
        }
        __syncthreads();
        SRow pv0, pv1, pa0, pa1;
        { const bf16_t* vr = UT + (size_t)c * NTOK; sconv_load(vr, j0, pv0); sconv_load(vr + SEQ, j0, pv1); }
#pragma unroll 1
        for (int bp = 0; bp < 4; ++bp) {
            const size_t rb = (size_t)(2 * bp) * SEQ;
            float zr[8], zi[8], vre[8], vim[8];
            sconv_apply(pv0, j0, wS[0], vre); sconv_apply(pv1, j0, wS[0], vim);
#pragma unroll
            for (int i = 0; i < 8; ++i) (FB0 + jp)[i] = (f32x2){vre[i], vim[i]};
            { const bf16_t* x1r = UT + (size_t)(512 + c) * NTOK + rb; sconv_load(x1r, j0, pa0); sconv_load(x1r + SEQ, j0, pa1); }
            __syncthreads();
#pragma unroll 1
            for (int ord = 0; ord < 2; ++ord) {
                int u = u_, u1 = u1_; asm volatile("" : "+v"(u), "+v"(u1));
#pragma unroll
                for (int n = 0; n < 16; ++n) x[n] = (FB0 + pad(u))[272 * n];
                __syncthreads();
                if (half) twiddle_w8192(x, twu, false);
                fft4096(x, myF, u, u, tw2, tw3);
                { const LAS f32x2* Kp = KH + (2 * ord + half) * KLEN;
                  const LAS f32x2* pf = Kp + pad(u1); const LAS f32x2* pm = Kp + pad((half ? 4095 : 4096) - u1);
#pragma unroll
                  for (int n = 0; n < 8; ++n) c_mul_sw_ip(x[n], pf[272 * n]);
                  { const bool mir = half || u1 > 0; f32x2 kv = *(mir ? pm - 272 * 8 : pf + 272 * 8); if (mir) kv.y = -kv.y; c_mul_sw_ip(x[8], kv); }
#pragma unroll
                  for (int n = 9; n < 16; ++n) c_mul_swc_ip(x[n], *(pm - 272 * n)); }
                __syncthreads();
                fft4096(x, myF, u1, u, tw2, tw3);
                if (half) twiddle_w8192(x, twu1, false);
                __syncthreads();
#pragma unroll
                for (int k = 0; k < 16; ++k) (myF + pad(u1))[272 * k] = x[k];
                __syncthreads();
                if (ord == 0) {
                    { float a0[8];
                      sconv_apply(pa0, j0, wS[1], a0);
#pragma unroll
                      for (int i = 0; i < 8; ++i) { const f32x2 e = (FB0 + jp)[i], o = (FB1 + jp)[i]; zr[i] = a0[i] * (e.y + o.y + bias0 * vre[i]); zi[i] = e.x + o.x + bias0 * vim[i]; } }
                    { float a1[8];
                      sconv_apply(pa1, j0, wS[1], a1);
#pragma unroll
                      for (int i = 0; i < 8; ++i) zi[i] *= a1[i]; }
                    { const bf16_t* x2r = UT + (size_t)(1024 + c) * NTOK + rb; sconv_load(x2r, j0, pa0); sconv_load(x2r + SEQ, j0, pa1);
                      const bf16_t* vn = UT + (size_t)c * NTOK + (size_t)(2 * (bp < 3 ? bp + 1 : 3)) * SEQ; sconv_load(vn, j0, pv0); sconv_load(vn + SEQ, j0, pv1); }
                    __syncthreads();
#pragma unroll
                    for (int i = 0; i < 8; ++i) (FB0 + jp)[i] = (f32x2){zr[i], zi[i]};
                    __syncthreads();
                } else {
                    float a0[8], a1[8], r0[8], r1[8];
                    sconv_apply(pa0, j0, wS[2], a0); sconv_apply(pa1, j0, wS[2], a1);
#pragma unroll
                    for (int i = 0; i < 8; ++i) { const f32x2 e = (FB0 + jp)[i], o = (FB1 + jp)[i];
                        r0[i] = a0[i] * (e.y + o.y + bias1 * zr[i]); r1[i] = a1[i] * (e.x + o.x + bias1 * zi[i]); }
                    u32x4 p0, p1;
                    p0.x = cvt_pk_bf16(r0[0], r0[1]); p0.y = cvt_pk_bf16(r0[2], r0[3]); p0.z = cvt_pk_bf16(r0[4], r0[5]); p0.w = cvt_pk_bf16(r0[6], r0[7]);
                    p1.x = cvt_pk_bf16(r1[0], r1[1]); p1.y = cvt_pk_bf16(r1[2], r1[3]); p1.z = cvt_pk_bf16(r1[4], r1[5]); p1.w = cvt_pk_bf16(r1[6], r1[7]);
                    *(u32x4*)(OBT + (size_t)c * NTOK + rb + j0) = p0; *(u32x4*)(OBT + (size_t)c * NTOK + rb + SEQ + j0) = p1;
                    __syncthreads();
                }
            }
        }
    }
}
#undef HY_W8192
}
template <bool GATH> struct MoeOrder {
    static constexpr bool GATHER = GATH;
    const LAS int* pref;
    int total, G, c, ncol, K;
    const char* A; const char* W; size_t wtile; const int* list;
    __device__ bool next(int i, pg8::Unit& u) const {
        const long L = (long)i * G + c; if (L >= total) return false;
        int id = (int)L; { const int q = total / 8, r = total % 8, xcd = id % 8, off = id / 8; id = (xcd < r ? xcd * (q + 1) : r * (q + 1) + (xcd - r) * q) + off; }
        const int rt = id / ncol, pn = id % ncol;
        int e = 0; while (e < 31 && pref[e + 1] <= rt) ++e;
        u.pm = rt; u.pn = pn; u.aux = e;
        u.a = GATH ? A : A + (size_t)rt * 256 * K * 2; u.b = W + (size_t)e * 3 * MiB + (size_t)pn * wtile;
        return true;
    }
    __device__ __forceinline__ void gather(const pg8::Unit& u, int R0, int R1, unsigned (&v)[2][2]) const {
        const int e = u.aux, j = u.pm - pref[e], cnt = pref[40 + e];
#pragma unroll
        for (int h = 0; h < 2; ++h)
#pragma unroll
            for (int i = 0; i < 2; ++i) { int r = j * 256 + h * 128 + (i ? R1 : R0); r = r < cnt ? r : 0; v[h][i] = (unsigned)(list[e * 32768 + r] >> 1) * (unsigned)(K * 2); }
    }
};

#ifndef MK_PER_PHASE
#define MK_PER_PHASE 0
#endif
constexpr int N_PHASES = 17;

__global__ void __launch_bounds__(NTHREADS, 2) fwd_kernel(Args args) {
    extern __shared__ __attribute__((aligned(16))) unsigned char lds_[];
    const int wave0_ = __builtin_amdgcn_readfirstlane((int)threadIdx.x >> 6);
#define MKFRAME(F) Frame F; { int t_ = wave0_ * 64 + (int)__builtin_amdgcn_mbcnt_hi(~0u, __builtin_amdgcn_mbcnt_lo(~0u, 0u)); asm volatile("" : "+v"(t_)); F.lds = (LAS unsigned char*)lds_; F.tid = t_; F.lane = t_ & 63; F.wave = __builtin_amdgcn_readfirstlane(t_ >> 6); \
        F.G = gridDim.x; F.bid = blockIdx.x; F.in = args.in; F.out = args.out; F.ws = args.ws; }
    volatile LAS unsigned* MISC = (volatile LAS unsigned*)((LAS unsigned char*)lds_ + MISC_OFF);
    if (threadIdx.x < 128) MISC[threadIdx.x] = 0u;
    __syncthreads();
    unsigned* ctl = (unsigned*)(args.ws + WS_CTL);
#define lo (args.ph_lo)
#define hi (args.ph_hi)
    if (hi - lo > 1) (void)xcd_barrier_post(ctl + CW_BAR, MISC, threadIdx.x == 0);
#ifndef PH_MASK
#define PH_MASK 0xFFFFFFFFu
#endif
#define IN(k) (lo <= (k) && (k) < hi)
#ifndef DUP_PHASE
#define DUP_PHASE -1
#endif
#define REP(k) _Pragma("unroll") for (int rep_ = 0; rep_ < ((DUP_PHASE) == (k) ? 2 : 1); ++rep_)
#ifdef TPROBE
    const unsigned long long t_start_ = __builtin_amdgcn_s_memrealtime(); unsigned long long t_mark_ = 0ull;
#define TMARK(k) do { if ((k) == (TPROBE)) t_mark_ = __builtin_amdgcn_s_memrealtime() - t_start_; } while (0)
#else
#define TMARK(k) do { } while (0)
#endif
#define SEAM(k) do { if (IN(k) && IN((k) + 1)) { XcdBarrier bar_; bar_.bar = (unsigned*)(args.ws + WS_CTL) + CW_BAR; bar_.x = xb_xcc_id(); bar_.st = (volatile LAS unsigned*)((LAS unsigned char*)lds_ + MISC_OFF); \
        xcd_barrier(bar_, wave0_ == 0 && __builtin_amdgcn_mbcnt_hi(~0u, __builtin_amdgcn_mbcnt_lo(~0u, 0u)) == 0u); } TMARK(k); } while (0)
#define WSP (args.ws)
#define mod0 ((const float*)(args.ws + WS_MOD))
#define mod1 (mod0 + 9 * 6144)
#define tab ((const float*)(args.ws + WS_TAB))

    if (IN(0)) { MKFRAME(F); p0_prologue(F, (unsigned*)(args.ws + WS_CTL) + CW_Q0, (volatile LAS unsigned*)((LAS unsigned char*)lds_ + MISC_OFF) + 4); }
    SEAM(0);
    if (IN(1)) REP(1) { MKFRAME(F); p1_norm_in(F); }
    SEAM(1);
    if (IN(2)) REP(2) { MKFRAME(F);
        { pg8::StaticOrder S; S.init(WSP + WS_BUF0, WSP + WS_WQKVH, NTOK, 1536, 1024, F.G, F.bid);
          pg8::EpiQKV E{(bf16_t*)(WSP + WS_Q), (bf16_t*)(WSP + WS_K), (bf16_t*)(WSP + WS_V), tab + TB_ROPE_C, tab + TB_ROPE_S};
          pg8::gemm_phase(F.lds, F.tid, 1024, S, E); }
        { pg8::StaticOrder S; S.init(WSP + WS_WQKVH + (size_t)1536 * 1024 * 2, WSP + WS_BUF0, 1536, NTOK, 1024, F.G, F.bid);
          pg8::EpiBf16 E{(bf16_t*)(WSP + WS_UT), (size_t)NTOK};
          pg8::gemm_phase(F.lds, F.tid, 1024, S, E); }
        { pg8::StaticOrder S; S.init(WSP + WS_OBT, WSP + WS_WQKVH + (size_t)512 * 1024 * 2, NB * CTXL, 1024, 1024, F.G, F.bid);
          pg8::EpiCtxKV E{(bf16_t*)(WSP + WS_K), (bf16_t*)(WSP + WS_V)};
          pg8::gemm_phase(F.lds, F.tid, 1024, S, E); }
    }
    SEAM(2);
    if (IN(3)) {
#ifndef NO_ATTN
        { MKFRAME(F); att::attn_phase(F); } __syncthreads();
#ifdef DUP_ATTN
        { MKFRAME(F); att::attn_phase(F); } __syncthreads();
#endif
#else
        { MKFRAME(F); bf16_t* o = (bf16_t*)(F.ws + WS_BUF0); for (size_t i = (size_t)F.bid * NTHREADS + F.tid; i < (size_t)NTOK * 64; i += (size_t)F.G * NTHREADS) { const size_t r = i >> 6, c8 = i & 63; *(u32x4*)(o + r * DM + c8 * 8) = (u32x4){0u, 0u, 0u, 0u}; } }
#endif
#ifndef NO_HYENA
        { MKFRAME(F); hy::hyena_phase(F); }
#ifdef DUP_HYENA
        __syncthreads(); { MKFRAME(F); hy::hyena_phase(F); }
#endif
#else
        { MKFRAME(F); bf16_t* o = (bf16_t*)(F.ws + WS_OBT); for (size_t i = (size_t)F.bid * NTHREADS + F.tid; i < (size_t)512 * NTOK / 8; i += (size_t)F.G * NTHREADS) *(u32x4*)(o + i * 8) = (u32x4){0u, 0u, 0u, 0u}; }
#endif
    }
    SEAM(3);
    if (IN(4)) REP(4) { MKFRAME(F); transpose_ob(F); }
    SEAM(4);
    if (IN(5)) REP(5) { MKFRAME(F);
        pg8::StaticOrder S; S.init(WSP + WS_BUF0, WSP + WS_WO, NTOK, 1024, 1024, F.G, F.bid);
        pg8::EpiResid<true> E{F.in[I_X], (bf16_t*)(WSP + WS_X), mod0 + 2 * 1024, nullptr};
        pg8::gemm_phase(F.lds, F.tid, 1024, S, E);
    }
    SEAM(5);
        if (IN(6 + 0)) { MKFRAME(F); moe_front(F, 0); }
        SEAM(6 + 0);
        if (IN(6 + 1)) REP(9) { MKFRAME(F);
            moe_prefix(F, 0, (LAS int*)((LAS unsigned char*)lds_ + MISC_OFF + 64));
            MoeOrder<true> S; LAS int* pref = (LAS int*)((LAS unsigned char*)lds_ + MISC_OFF + 64); S.pref = pref; S.total = pref[32] * 4; S.G = F.G; S.c = F.bid; S.ncol = 4; S.K = 512;
            S.A = (const char*)(WSP + WS_BUF0); S.W = (const char*)(WSP + WS_WMOE + (size_t)0 * 32 * 3 * MiB); S.wtile = (size_t)256 * 512 * 2; S.list = (const int*)(WSP + WS_LIST);
            pg8::EpiGated<2> E{(bf16_t*)(WSP + WS_H), (size_t)512, nullptr, nullptr};
            pg8::gemm_phase<pg8::EpiGated<2>, MoeOrder<true>, true, 127, 122>(F.lds, F.tid, 512, S, E);
        }
        SEAM(6 + 1);
        if (IN(6 + 2)) REP(10) { MKFRAME(F);
            moe_prefix(F, 0, (LAS int*)((LAS unsigned char*)lds_ + MISC_OFF + 64));
            MoeOrder<false> S; LAS int* pref = (LAS int*)((LAS unsigned char*)lds_ + MISC_OFF + 64); S.pref = pref; S.total = pref[32] * 4; S.G = F.G; S.c = F.bid; S.ncol = 4; S.K = 256;
            S.A = (const char*)(WSP + WS_H); S.W = (const char*)(WSP + WS_WMOE + (size_t)0 * 32 * 3 * MiB + 2 * MiB); S.wtile = (size_t)256 * 256 * 2; S.list = nullptr;
            pg8::EpiScatter E{(bf16_t*)(WSP + WS_BUF0), (bf16_t*)(WSP + WS_Y1), (const int*)(WSP + WS_LIST), pref};
            pg8::gemm_phase<pg8::EpiScatter, MoeOrder<false>, true, 127, 122>(F.lds, F.tid, 256, S, E);
        }
        SEAM(6 + 2);
        if (IN(6 + 3)) {
            MKFRAME(F); moe_combine<0>(F, 0);
        }
        SEAM(6 + 3);

            if (IN(10)) REP(12) { MKFRAME(F);
                pg8::StaticOrder S; S.init(WSP + WS_BUF0, WSP + WS_WC1, NTOK, 2048, CONF_FP8 ? 512 : 1024, F.G, F.bid);
                pg8::EpiGated<1> E{(bf16_t*)(WSP + WS_GLU), (size_t)1024, F.in[I_CVB1], F.in[I_CVB1] + 1024};
                pg8::gemm_phase<pg8::EpiGated<1>, pg8::StaticOrder, CONF_FP8 != 0, 127, CONF_FP8 ? 122 : 127>(F.lds, F.tid, CONF_FP8 ? 512 : 1024, S, E);
            }
            SEAM(10);
            if (IN(11)) REP(13) { MKFRAME(F); conv_ln_phase(F); }
            SEAM(11);
            if (IN(12)) { MKFRAME(F);
                pg8::StaticOrder S; S.init(WSP + WS_BUF0, WSP + WS_WC2, NTOK, 1024, CONF_FP8 ? 512 : 1024, F.G, F.bid);
                pg8::EpiResid<false> E{WSP + WS_X, (bf16_t*)(WSP + WS_X), mod1 + 2 * 1024, F.in[I_CVB2]};
                pg8::gemm_phase<pg8::EpiResid<false>, pg8::StaticOrder, CONF_FP8 != 0, 127, CONF_FP8 ? 122 : 127>(F.lds, F.tid, CONF_FP8 ? 512 : 1024, S, E);
            }
            SEAM(12);
        if (IN(13 + 0)) { MKFRAME(F); moe_front(F, 1); }
        SEAM(13 + 0);
        if (IN(13 + 1)) REP(9) { MKFRAME(F);
            moe_prefix(F, 1, (LAS int*)((LAS unsigned char*)lds_ + MISC_OFF + 64));
            MoeOrder<true> S; LAS int* pref = (LAS int*)((LAS unsigned char*)lds_ + MISC_OFF + 64); S.pref = pref; S.total = pref[32] * 4; S.G = F.G; S.c = F.bid; S.ncol = 4; S.K = 512;
            S.A = (const char*)(WSP + WS_BUF0); S.W = (const char*)(WSP + WS_WMOE + (size_t)1 * 32 * 3 * MiB); S.wtile = (size_t)256 * 512 * 2; S.list = (const int*)(WSP + WS_LIST);
            pg8::EpiGated<2> E{(bf16_t*)(WSP + WS_H), (size_t)512, nullptr, nullptr};
            pg8::gemm_phase<pg8::EpiGated<2>, MoeOrder<true>, true, 127, 122>(F.lds, F.tid, 512, S, E);
        }
        SEAM(13 + 1);
        if (IN(13 + 2)) REP(10) { MKFRAME(F);
            moe_prefix(F, 1, (LAS int*)((LAS unsigned char*)lds_ + MISC_OFF + 64));
            MoeOrder<false> S; LAS int* pref = (LAS int*)((LAS unsigned char*)lds_ + MISC_OFF + 64); S.pref = pref; S.total = pref[32] * 4; S.G = F.G; S.c = F.bid; S.ncol = 4; S.K = 256;
            S.A = (const char*)(WSP + WS_H); S.W = (const char*)(WSP + WS_WMOE + (size_t)1 * 32 * 3 * MiB + 2 * MiB); S.wtile = (size_t)256 * 256 * 2; S.list = nullptr;
            pg8::EpiScatter E{(bf16_t*)(WSP + WS_BUF0), (bf16_t*)(WSP + WS_Y1), (const int*)(WSP + WS_LIST), pref};
            pg8::gemm_phase<pg8::EpiScatter, MoeOrder<false>, true, 127, 122>(F.lds, F.tid, 256, S, E);
        }
        SEAM(13 + 2);
        if (IN(13 + 3)) {
            MKFRAME(F); moe_combine<1>(F, 1);
        }

#ifdef TPROBE
    if (blockIdx.x == 0 && threadIdx.x == 0) { const unsigned long long t1 = __builtin_amdgcn_s_memrealtime(); while (__builtin_amdgcn_s_memrealtime() - t1 < 4ull * t_mark_) __builtin_amdgcn_s_sleep(8); }
#endif
#undef IN
#undef SEAM
#undef lo
#undef hi
#undef WSP
#undef mod0
#undef mod1
#undef tab
#undef MKFRAME
}

extern "C" void kernel_launch(void* const* d_in, const int* in_sizes, int n_in, void* d_out, int out_size, void* d_ws, size_t ws_size, hipStream_t stream) {
    static int grid = 0;
    if (grid == 0) {
        if (n_in != N_IN || out_size != NTOK * DM || ws_size < WS_END) { grid = -1; return; }
        int dev = 0, cus = 0, per_cu = 0;
        if (hipGetDevice(&dev) != hipSuccess || hipDeviceGetAttribute(&cus, hipDeviceAttributeMultiprocessorCount, dev) != hipSuccess) { grid = -1; return; }
        if (hipFuncSetAttribute((const void*)fwd_kernel, hipFuncAttributeMaxDynamicSharedMemorySize, LDS_BYTES) != hipSuccess) { grid = -1; return; }
        (void)hipOccupancyMaxActiveBlocksPerMultiprocessor(&per_cu, (const void*)fwd_kernel, NTHREADS, LDS_BYTES);
        (void)hipGetLastError();
        grid = cus;
    }
    if (grid < 0) return;
    (void)hipMemsetAsync((char*)d_ws + WS_CTL, 0, CTL_ZERO_BYTES, stream);
    Args a{};
    for (int i = 0; i < N_IN; ++i) a.in[i] = (const float*)d_in[i];
    a.out = (float*)d_out; a.ws = (unsigned char*)d_ws;
#if MK_PER_PHASE
    for (int p = 0; p < N_PHASES; ++p) { a.ph_lo = p; a.ph_hi = p + 1; hipLaunchKernelGGL(fwd_kernel, dim3(grid), dim3(NTHREADS), LDS_BYTES, stream, a); }
#else
    a.ph_lo = 0; a.ph_hi = N_PHASES;
    hipLaunchKernelGGL(fwd_kernel, dim3(grid), dim3(NTHREADS), LDS_BYTES, stream, a);
#endif
}
```

```cpp
#define CONF_FP8 0
#include <hip/hip_runtime.h>
#include <stdint.h>
#include <math.h>

#define LAS __attribute__((address_space(3)))
#define GAS __attribute__((address_space(1)))
typedef unsigned short bf16_t;
typedef short bf16x8 __attribute__((ext_vector_type(8)));
typedef short s16x4 __attribute__((ext_vector_type(4)));
typedef float f32x2 __attribute__((ext_vector_type(2)));
typedef float f32x4 __attribute__((ext_vector_type(4)));
typedef float f32x16 __attribute__((ext_vector_type(16)));
typedef unsigned u32x2 __attribute__((ext_vector_type(2)));
typedef unsigned u32x4 __attribute__((ext_vector_type(4)));

constexpr int DM = 1024, NB = 8, SEQ = 4096, NTOK = NB * SEQ, CTXL = 256, LKV = CTXL + SEQ;
constexpr int NEXP = 32, DEXP = 512, SLOT_ROWS = 73728;
constexpr float EPS = 1e-6f;
constexpr float QSCALE = 0.125f * 1.4426950408889634f;

constexpr size_t MiB = 1u << 20;
constexpr size_t WS_CTL = 0, CTL_ZERO_BYTES = 1 * MiB;
constexpr size_t WS_MOD = 1 * MiB;
constexpr size_t WS_TAB = 2 * MiB;
constexpr size_t WS_TOK = 3 * MiB;
constexpr size_t WS_LIST = 4 * MiB;
constexpr size_t WS_LOGIT = 8 * MiB;
constexpr size_t WS_KRAW = 16 * MiB;
constexpr size_t WS_WR = 48 * MiB;
constexpr size_t WS_WQKVH = 50 * MiB;
constexpr size_t WS_WO = 56 * MiB;
constexpr size_t WS_WC1 = 58 * MiB;
constexpr size_t WS_WC2 = 62 * MiB;
constexpr size_t WS_WMOE = 64 * MiB;
constexpr size_t WS_BUF0 = 256 * MiB;
constexpr size_t WS_Q = 320 * MiB;
constexpr size_t WS_K = 352 * MiB;
constexpr size_t WS_V = 386 * MiB;
constexpr size_t WS_UT = 420 * MiB;
constexpr size_t WS_OBT = 516 * MiB;
constexpr size_t WS_X = 320 * MiB;
constexpr size_t WS_H = 448 * MiB;
constexpr size_t WS_Y1 = 520 * MiB;
constexpr size_t WS_GLU = 448 * MiB;
constexpr size_t WS_END = 585 * MiB;

constexpr int CW_TMO = 0;
constexpr int CW_BAR = 4096;
constexpr int CW_Q0 = 2048;
constexpr int CW_CNT = 8192;
constexpr int TB_ROPE_C = 0, TB_ROPE_S = 1024, TB_T4096 = 2048  , TB_T8A = 2560  , TB_T8B = 2688  , TB_LAM = 2816;

constexpr int RING_BYTES = 131072;
constexpr int MISC_OFF = 144384;
constexpr int LDS_BYTES = 147456;
constexpr int NWAVES = 8, NTHREADS = 512;

#define RLX_AGENT __ATOMIC_RELAXED, __HIP_MEMORY_SCOPE_AGENT
#define LDS_WAIT() asm volatile("s_waitcnt lgkmcnt(0)" ::: "memory")
#define VM_WAIT() asm volatile("s_waitcnt vmcnt(0)" ::: "memory")

__device__ __forceinline__ unsigned cvt_pk_bf16(float lo, float hi) { unsigned r; asm volatile("v_cvt_pk_bf16_f32 %0, %1, %2" : "=v"(r) : "v"(lo), "v"(hi)); return r; }
__device__ __forceinline__ float bf2f(bf16_t v) { return __uint_as_float((unsigned)v << 16); }
__device__ __forceinline__ float bflo(unsigned v) { return __uint_as_float(v << 16); }
__device__ __forceinline__ float bfhi(unsigned v) { return __uint_as_float(v & 0xffff0000u); }
__device__ __forceinline__ float wave_sum(float v) {
#pragma unroll
    for (int o = 1; o < 64; o <<= 1) v += __shfl_xor(v, o);
    return v;
}
__device__ __forceinline__ float sigmoid_f(float v) { return __builtin_amdgcn_rcpf(1.0f + __builtin_amdgcn_exp2f(-1.4426950408889634f * v)); }
__device__ __forceinline__ float silu_f(float v) { return v * sigmoid_f(v); }

#define XB_TMO      128
#define XB_XCNT(j)  (256  + 64 * (j))
#define XB_XSUB(j)  (1280 + 64 * (j))
#define XB_XGEN(j)  (2304 + 64 * (j))
#define XB_TOP      3328
#define XB_TOPGEN   3392
#define XCD_BAR_WORDS 3456
#define XB_SPIN_CAP (1u << 20)

__device__ __forceinline__ unsigned xb_ld(unsigned* p)              { return __hip_atomic_load(p, __ATOMIC_RELAXED, __HIP_MEMORY_SCOPE_AGENT); }
__device__ __forceinline__ unsigned xb_add(unsigned* p, unsigned v) { return __hip_atomic_fetch_add(p, v, __ATOMIC_RELAXED, __HIP_MEMORY_SCOPE_AGENT); }
__device__ __forceinline__ unsigned xb_xcc_id() { return (unsigned)__builtin_amdgcn_s_getreg((3 << 11) | 20) & 0xFu; }
#define XB_SPIN(cond, bar) do { unsigned _sp = 0; while (cond) { __builtin_amdgcn_s_sleep(1); \
    if ((++_sp & 255u) == 0u) { if (xb_ld(&(bar)[XB_TMO])) break; if (_sp > XB_SPIN_CAP) { atomicAdd(&(bar)[XB_TMO], 1u); break; } } } } while (0)

struct XcdBarrier { unsigned* bar; unsigned x; volatile LAS unsigned* st; };

__device__ __forceinline__ XcdBarrier xcd_barrier_post(unsigned* bar, volatile LAS unsigned* st, bool leader  ) {
    XcdBarrier b; b.bar = bar; b.x = xb_xcc_id(); b.st = st;
    if (leader) (void)xb_add(&bar[XB_XCNT(b.x)], 1u);
    return b;
}
__device__ __forceinline__ void xcd_barrier_complete(unsigned* bar, unsigned x, unsigned& nloc, unsigned& nx) {
    const unsigned G = gridDim.x * gridDim.y * gridDim.z;
    unsigned sum, cnt, mine, sp = 0u;
    for (;;) {
        sum = 0u; cnt = 0u; mine = 0u;
#pragma unroll
        for (unsigned j = 0; j < 16; ++j) { const unsigned c = xb_ld(&bar[XB_XCNT(j)]); sum += c; cnt += (c > 0u) ? 1u : 0u; mine = (j == x) ? c : mine; }
        if (sum == G) break;
        __builtin_amdgcn_s_sleep(1);
        if ((++sp & 255u) == 0u) { if (xb_ld(&bar[XB_TMO])) break; if (sp > XB_SPIN_CAP) { atomicAdd(&bar[XB_TMO], 1u); break; } }
    }
    nloc = mine > 0u ? mine : 1u; nx = cnt > 0u ? cnt : 1u;
}
__device__ __forceinline__ void xcd_barrier(const XcdBarrier& b, bool leader  ) {
    asm volatile("s_waitcnt vmcnt(0)" ::: "memory");
    __syncthreads();
    if (leader) {
        unsigned* bar = b.bar;
        __builtin_amdgcn_s_waitcnt(0);
        unsigned nloc = b.st[0], nx = b.st[1];
        if (nloc == 0u) { xcd_barrier_complete(bar, b.x, nloc, nx); b.st[0] = nloc; b.st[1] = nx; }
        const unsigned old = xb_add(&bar[XB_XSUB(b.x)], 1u);
        const unsigned gen = old / nloc;
        if (old + 1u == (gen + 1u) * nloc) {
            __builtin_amdgcn_fence(__ATOMIC_RELEASE, "agent");
            asm volatile("s_waitcnt vmcnt(0)" ::: "memory");
            const unsigned og = xb_add(&bar[XB_TOP], 1u);
            const unsigned tg = og / nx;
            if (og + 1u == (tg + 1u) * nx) xb_add(&bar[XB_TOPGEN], 1u);
            else XB_SPIN(xb_ld(&bar[XB_TOPGEN]) == tg, bar);
            __builtin_amdgcn_fence(__ATOMIC_ACQUIRE, "agent");
            xb_add(&bar[XB_XGEN(b.x)], 1u);
            asm volatile("s_waitcnt vmcnt(0)" ::: "memory");
        } else {
            XB_SPIN(xb_ld(&bar[XB_XGEN(b.x)]) == gen, bar);
            __builtin_amdgcn_fence(__ATOMIC_ACQUIRE, "agent");
            asm volatile("s_waitcnt vmcnt(0)" ::: "memory");
        }
    }
    __syncthreads();
}
namespace pg8 {
constexpr int BM = 256, BK = 64, HALF = 128, HTB = HALF * BK * 2, STAGE_BYTES = 8 * HTB, NXCD = 8, WGM = 8;

__host__ __device__ __forceinline__ int lds_byte(int r, int c) { const int st = (r >> 4) * 2 + (c >> 5), rr = r & 15, cc = c & 31, ob = rr * 64 + cc * 2; return st * 1024 + (ob ^ (((ob >> 9) & 1) << 5)); }
__host__ __device__ __forceinline__ void stage_rc(int b, int& R, int& C) { const int st = b / 1024, sb = b % 1024, swz = sb ^ (((sb >> 9) & 1) << 5); R = (st >> 1) * 16 + swz / 64; C = (st & 1) * 32 + (swz % 64) / 2; }
__host__ __device__ __forceinline__ int perm32(int rho) { const int n = rho >> 4, i = rho & 15; return 8 * (i >> 2) + 4 * n + (i & 3); }

struct Unit { int pm, pn; const char* a; const char* b; int aux; };

struct StaticOrder {
    static constexpr bool GATHER = false;
    int nM, nN, nwg, G, c; const char* A; const char* Bt; size_t tstep;
    __device__ void init(const void* A_, const void* Bt_, int M, int N, int K, int G_, int c_) { A = (const char*)A_; Bt = (const char*)Bt_; nM = M / BM; nN = N / BM; nwg = nM * nN; G = G_; c = c_; tstep = (size_t)BM * K * 2; }
    __device__ bool next(int i, Unit& u) const {
        const long L = (long)i * G + c; if (L >= nwg) return false;
        int wgid = (int)L; { const int q = nwg / NXCD, r = nwg % NXCD, xcd = wgid % NXCD, off = wgid / NXCD; wgid = (xcd < r ? xcd * (q + 1) : r * (q + 1) + (xcd - r) * q) + off; }
        const int nig = WGM * nN, gid = wgid / nig, fm = gid * WGM, gsz = (nM - fm) < WGM ? (nM - fm) : WGM;
        u.pm = fm + ((wgid % nig) % gsz); u.pn = (wgid % nig) / gsz; u.a = A + (size_t)u.pm * tstep; u.b = Bt + (size_t)u.pn * tstep; u.aux = 0; return true;
    }
    __device__ __forceinline__ void gather(const Unit&, int, int, unsigned (&)[2][2]) const {}
};

template <class Epi, class Sched, bool FP8 = false, int SCA = 127, int SCB = 127>
__device__ __forceinline__ void gemm_phase(LAS unsigned char* lds, int tid, const int K, const Sched& S, const Epi& E) {
    asm volatile("" : "+v"(tid));
    const int wid = __builtin_amdgcn_readfirstlane(tid >> 6), lane = tid & 63, wr = wid >> 2, wc = wid & 3, fr = lane & 15, fq = lane >> 4;
    const int nt = K / BK;
    const size_t kstep = (size_t)(BK * 2);
    const size_t hstep = (size_t)HALF * K * 2;
    int Rr[2], Cc[2];
    unsigned voffB[2];
#pragma unroll
    for (int i = 0; i < 2; ++i) { int R, C; stage_rc(tid * 16 + i * 8192, R, C); Rr[i] = R; Cc[i] = C; const int Rb = Epi::PERM ? ((R & ~31) + perm32(R & 31)) : R; voffB[i] = (unsigned)(Rb * K + C) * 2u; }
    unsigned vAc[2][2], vAn[2][2];
#pragma unroll
    for (int h = 0; h < 2; ++h)
#pragma unroll
        for (int i = 0; i < 2; ++i) { vAc[h][i] = (unsigned)((h * HALF + Rr[i]) * K + Cc[i]) * 2u; vAn[h][i] = vAc[h][i]; }
    const unsigned ldsw = (unsigned)wid * 1024u;
    const int aoff = lds_byte(wr * 64 + fr, fq * 8), boff = lds_byte(wc * 32 + fr, fq * 8);
#define PG8_SA(b, h) (((b) * 2 + (h)) * HTB)
#define PG8_SB(b, h) ((4 + (b) * 2 + (h)) * HTB)
#define PG8_STAGE_B(bufoff, gbase) do { _Pragma("unroll") for (int _i = 0; _i < 2; ++_i) \
        __builtin_amdgcn_global_load_lds((const unsigned*)((const char*)(gbase) + voffB[_i]), (LAS unsigned*)(lds + (bufoff) + ldsw + _i * 8192), 16, 0, 0); } while (0)
#define PG8_STAGE_A(bufoff, gbase, V, h) do { _Pragma("unroll") for (int _i = 0; _i < 2; ++_i) \
        __builtin_amdgcn_global_load_lds((const unsigned*)((const char*)(gbase) + (V)[h][_i]), (LAS unsigned*)(lds + (bufoff) + ldsw + _i * 8192), 16, 0, 0); } while (0)
#define PG8_LDA(dst, b, h) do { _Pragma("unroll") for (int m = 0; m < 4; ++m) { if constexpr (FP8) { const i32x4_ x0_ = *(const LAS i32x4_*)(lds + PG8_SA(b, h) + aoff + m * 2048), x1_ = *(const LAS i32x4_*)(lds + PG8_SA(b, h) + aoff + m * 2048 + 1024); \
            dst##8[m] = __builtin_shufflevector(x0_, x1_, 0, 1, 2, 3, 4, 5, 6, 7); } else { _Pragma("unroll") for (int k = 0; k < 2; ++k) dst[m][k] = *(const LAS bf16x8*)(lds + PG8_SA(b, h) + aoff + m * 2048 + k * 1024); } } } while (0)
#define PG8_LDB(dst, b, h) do { _Pragma("unroll") for (int n = 0; n < 2; ++n) { if constexpr (FP8) { const i32x4_ x0_ = *(const LAS i32x4_*)(lds + PG8_SB(b, h) + boff + n * 2048), x1_ = *(const LAS i32x4_*)(lds + PG8_SB(b, h) + boff + n * 2048 + 1024); \
            dst##8[n] = __builtin_shufflevector(x0_, x1_, 0, 1, 2, 3, 4, 5, 6, 7); } else { _Pragma("unroll") for (int k = 0; k < 2; ++k) dst[n][k] = *(const LAS bf16x8*)(lds + PG8_SB(b, h) + boff + n * 2048 + k * 1024); } } } while (0)
#define PG8_MMA(ai, bj, At, Bt) do { __builtin_amdgcn_s_setprio(1); _Pragma("unroll") for (int m = 0; m < 4; ++m) _Pragma("unroll") for (int n = 0; n < 2; ++n) { \
        if constexpr (FP8) asm volatile("v_mfma_scale_f32_16x16x128_f8f6f4 %0, %1, %2, %0, %3, %4 op_sel_hi:[0,0,0]" : "+v"(acc[ai][bj][m][n]) : "v"(Bt##8[n]), "v"(At##8[m]), "v"(sca_), "v"(scb_)); \
        else { _Pragma("unroll") for (int k = 0; k < 2; ++k) acc[ai][bj][m][n] = __builtin_amdgcn_mfma_f32_16x16x32_bf16(Bt[n][k], At[m][k], acc[ai][bj][m][n], 0, 0, 0); } } \
        __builtin_amdgcn_s_setprio(0); } while (0)
#define PG8_WAIT_V(n) asm volatile("s_waitcnt vmcnt(" #n ")" ::: "memory")
#define PG8_WAIT_L(n) asm volatile("s_waitcnt lgkmcnt(" #n ")" ::: "memory")
#define PG8_BAR __builtin_amdgcn_s_barrier()
#define PG8_SCHED __builtin_amdgcn_sched_barrier(0)
    Unit cur, nxt; int ui = 0;
    if (!S.next(0, cur)) return;
    if constexpr (Sched::GATHER) { S.gather(cur, Rr[0], Rr[1], vAc);
#pragma unroll
        for (int h = 0; h < 2; ++h)
#pragma unroll
            for (int i = 0; i < 2; ++i) vAc[h][i] += (unsigned)Cc[i] * 2u; }
    f32x4 acc[2][2][4][2];
#pragma unroll
    for (int a = 0; a < 2; ++a)
#pragma unroll
        for (int b = 0; b < 2; ++b)
#pragma unroll
            for (int m = 0; m < 4; ++m)
#pragma unroll
                for (int n = 0; n < 2; ++n) acc[a][b][m][n] = (f32x4){0.f, 0.f, 0.f, 0.f};
    typedef int i32x4_ __attribute__((ext_vector_type(4))); typedef int i32x8_ __attribute__((ext_vector_type(8)));
    bf16x8 At[4][2], B0[2][2], B1[2][2];
    i32x8_ At8[4], B08[2], B18[2]; const int sca_ = SCA * 0x01010101, scb_ = SCB * 0x01010101;
    const char* cA = cur.a; const char* cB = cur.b;
    PG8_STAGE_B(PG8_SB(0, 0), cB); PG8_STAGE_B(PG8_SB(0, 1), cB + hstep); PG8_STAGE_A(PG8_SA(0, 0), cA, vAc, 0); PG8_STAGE_A(PG8_SA(0, 1), cA, vAc, 1);
    if (wr == 1) PG8_BAR;
    PG8_WAIT_V(2); PG8_BAR;
    PG8_STAGE_B(PG8_SB(1, 0), cB + kstep); PG8_STAGE_A(PG8_SA(1, 0), cA + kstep, vAc, 0); PG8_STAGE_B(PG8_SB(1, 1), cB + hstep + kstep);
    PG8_WAIT_V(6); PG8_BAR;
    for (;;) {
        const bool has_next = S.next(ui + 1, nxt);
        if constexpr (Sched::GATHER) { if (has_next) { S.gather(nxt, Rr[0], Rr[1], vAn);
#pragma unroll
            for (int h = 0; h < 2; ++h)
#pragma unroll
                for (int i = 0; i < 2; ++i) vAn[h][i] += (unsigned)Cc[i] * 2u; } else {
#pragma unroll
            for (int h = 0; h < 2; ++h)
#pragma unroll
                for (int i = 0; i < 2; ++i) vAn[h][i] = vAc[h][i]; } }
        const char* nA = has_next ? nxt.a : cA; const char* nB = has_next ? nxt.b : cB;
        for (int t = 0; t < nt; t += 2) {
            const bool last = (t == nt - 2);
            const char* a1 = cA + (size_t)(t + 1) * kstep;
            const char* a2 = last ? nA : cA + (size_t)(t + 2) * kstep; const char* b2 = last ? nB : cB + (size_t)(t + 2) * kstep;
            const char* a3 = a2 + kstep; const char* b3 = b2 + kstep;
            unsigned v2[2][2];
#pragma unroll
            for (int h = 0; h < 2; ++h)
#pragma unroll
                for (int i = 0; i < 2; ++i) v2[h][i] = (Sched::GATHER && last) ? vAn[h][i] : vAc[h][i];
            PG8_LDB(B0, 0, 0); PG8_LDB(B1, 0, 1); PG8_SCHED; PG8_LDA(At, 0, 0); PG8_STAGE_A(PG8_SA(1, 1), a1, vAc, 1);
            PG8_WAIT_V(8); PG8_WAIT_L(0); PG8_BAR; PG8_MMA(0, 0, At, B0); PG8_MMA(0, 1, At, B1); PG8_BAR; PG8_SCHED;
            PG8_LDA(At, 0, 1); PG8_STAGE_B(PG8_SB(0, 0), b2); PG8_STAGE_B(PG8_SB(0, 1), b2 + hstep); PG8_STAGE_A(PG8_SA(0, 0), a2, v2, 0);
            PG8_WAIT_V(8); PG8_WAIT_L(0); PG8_BAR; PG8_MMA(1, 0, At, B0); PG8_MMA(1, 1, At, B1); PG8_BAR; PG8_SCHED;
            PG8_LDB(B0, 1, 0); PG8_LDB(B1, 1, 1); PG8_SCHED; PG8_LDA(At, 1, 0); PG8_STAGE_A(PG8_SA(0, 1), a2, v2, 1);
            PG8_WAIT_V(8); PG8_WAIT_L(0); PG8_BAR; PG8_MMA(0, 0, At, B0); PG8_MMA(0, 1, At, B1); PG8_BAR; PG8_SCHED;
            PG8_LDA(At, 1, 1); PG8_STAGE_B(PG8_SB(1, 0), b3); PG8_STAGE_B(PG8_SB(1, 1), b3 + hstep); PG8_STAGE_A(PG8_SA(1, 0), a3, v2, 0);
            PG8_WAIT_V(8); PG8_WAIT_L(0); PG8_BAR; PG8_MMA(1, 0, At, B0); PG8_MMA(1, 1, At, B1); PG8_BAR; PG8_SCHED;
        }
        if (wr == 0) PG8_BAR;
        if constexpr (FP8) { asm volatile("s_nop 15\n\ts_nop 15" ::: "memory"); }
        E(acc, cur, wr, wc, fr, fq);
        if (!has_next) break;
#pragma unroll
        for (int a = 0; a < 2; ++a)
#pragma unroll
            for (int b = 0; b < 2; ++b)
#pragma unroll
                for (int m = 0; m < 4; ++m)
#pragma unroll
                    for (int n = 0; n < 2; ++n) acc[a][b][m][n] = (f32x4){0.f, 0.f, 0.f, 0.f};
        cur = nxt; cA = nA; cB = nB; ++ui;
#pragma unroll
        for (int h = 0; h < 2; ++h)
#pragma unroll
            for (int i = 0; i < 2; ++i) vAc[h][i] = vAn[h][i];
        if (wr == 1) PG8_BAR;
    }
    PG8_WAIT_V(0);
    PG8_BAR;
#undef PG8_SA
#undef PG8_SB
#undef PG8_STAGE_A
#undef PG8_STAGE_B
#undef PG8_LDA
#undef PG8_LDB
#undef PG8_MMA
#undef PG8_WAIT_V
#undef PG8_WAIT_L
#undef PG8_BAR
#undef PG8_SCHED
}
}
namespace pg8 {

struct EpiBf16 {
    static constexpr bool PERM = true;
    bf16_t* O; size_t ldc;
    __device__ __forceinline__ void operator()(const f32x4 (&acc)[2][2][4][2], const Unit& u, int wr, int wc, int fr, int fq) const {
        const size_t row0 = (size_t)u.pm * BM + wr * 64 + fr; const int col0 = u.pn * BM + wc * 32 + 8 * fq;
#pragma unroll
        for (int ai = 0; ai < 2; ++ai)
#pragma unroll
            for (int m = 0; m < 4; ++m) { bf16_t* rowp = O + (row0 + ai * HALF + m * 16) * ldc + col0;
#pragma unroll
                for (int bj = 0; bj < 2; ++bj) { const f32x4 v0 = acc[ai][bj][m][0], v1 = acc[ai][bj][m][1];
                    u32x4 w; w.x = cvt_pk_bf16(v0[0], v0[1]); w.y = cvt_pk_bf16(v0[2], v0[3]); w.z = cvt_pk_bf16(v1[0], v1[1]); w.w = cvt_pk_bf16(v1[2], v1[3]);
                    *(u32x4*)(rowp + bj * HALF) = w; } }
    }
};

struct EpiQKV {
    static constexpr bool PERM = false;
    bf16_t* Q; bf16_t* Kb; bf16_t* Vb; const float* ropec; const float* ropes;
    __device__ __forceinline__ void operator()(const f32x4 (&acc)[2][2][4][2], const Unit& u, int wr, int wc, int fr, int fq) const {
        const int sec = u.pn >> 1;
        const int bt = u.pm >> 4, t0 = (u.pm & 15) * BM;
        bf16_t* base; size_t rowb; float sc = 1.f;
        if (sec == 0) { base = Q; rowb = (size_t)u.pm * BM; sc = QSCALE; }
        else { base = (sec == 1) ? Kb : Vb; rowb = (size_t)bt * LKV + CTXL + t0; }
        const int colt = (u.pn & 1) * BM + wc * 32 + 4 * fq;
        const bool rope = sec < 2; const bool colpos = (wc & 1) != 0;
#pragma unroll
        for (int ai = 0; ai < 2; ++ai)
#pragma unroll
            for (int m = 0; m < 4; ++m) {
                const int rl = ai * HALF + wr * 64 + m * 16 + fr; const int t = t0 + rl;
                const int pos = colpos ? (t & 63) : (t >> 6);
                f32x4 cs = (f32x4){1.f, 1.f, 1.f, 1.f}, sn = (f32x4){0.f, 0.f, 0.f, 0.f};
                if (rope) { cs = *(const f32x4*)(ropec + pos * 16 + 4 * fq); sn = *(const f32x4*)(ropes + pos * 16 + 4 * fq); }
                bf16_t* rowp = base + (rowb + rl) * 512 + colt;
#pragma unroll
                for (int bj = 0; bj < 2; ++bj) {
                    const f32x4 a = acc[ai][bj][m][0], b = acc[ai][bj][m][1];
                    f32x4 oa, ob;
                    if (rope) { oa = (a * cs - b * sn) * sc; ob = (a * sn + b * cs) * sc; } else { oa = a; ob = b; }
                    u32x2 w0, w1; w0.x = cvt_pk_bf16(oa[0], oa[1]); w0.y = cvt_pk_bf16(oa[2], oa[3]); w1.x = cvt_pk_bf16(ob[0], ob[1]); w1.y = cvt_pk_bf16(ob[2], ob[3]);
                    *(u32x2*)(rowp + bj * HALF) = w0; *(u32x2*)(rowp + bj * HALF + 16) = w1; }
            }
    }
};

struct EpiCtxKV {
    static constexpr bool PERM = true;
    bf16_t* Kb; bf16_t* Vb;
    __device__ __forceinline__ void operator()(const f32x4 (&acc)[2][2][4][2], const Unit& u, int wr, int wc, int fr, int fq) const {
        bf16_t* base = (u.pn < 2) ? Kb : Vb; const size_t rowb = (size_t)u.pm * LKV; const int col0 = (u.pn & 1) * BM + wc * 32 + 8 * fq;
#pragma unroll
        for (int ai = 0; ai < 2; ++ai)
#pragma unroll
            for (int m = 0; m < 4; ++m) { bf16_t* rowp = base + (rowb + ai * HALF + wr * 64 + m * 16 + fr) * 512 + col0;
#pragma unroll
                for (int bj = 0; bj < 2; ++bj) { const f32x4 v0 = acc[ai][bj][m][0], v1 = acc[ai][bj][m][1];
                    u32x4 w; w.x = cvt_pk_bf16(v0[0], v0[1]); w.y = cvt_pk_bf16(v0[2], v0[3]); w.z = cvt_pk_bf16(v1[0], v1[1]); w.w = cvt_pk_bf16(v1[2], v1[3]);
                    *(u32x4*)(rowp + bj * HALF) = w; } }
    }
};

template <bool XF32> struct EpiResid {
    static constexpr bool PERM = true;
    const void* xin; bf16_t* out; const float* gate;   const float* bias;
    __device__ __forceinline__ void operator()(const f32x4 (&acc)[2][2][4][2], const Unit& u, int wr, int wc, int fr, int fq) const {
        const int bt = u.pm >> 4; const int col0 = u.pn * BM + wc * 32 + 8 * fq;
#pragma unroll
        for (int bj = 0; bj < 2; ++bj) {
            f32x4 gv[2], bv[2];
#pragma unroll
            for (int n = 0; n < 2; ++n) { gv[n] = *(const f32x4*)(gate + (size_t)bt * 6144 + col0 + bj * HALF + 4 * n);
                bv[n] = bias ? *(const f32x4*)(bias + col0 + bj * HALF + 4 * n) : (f32x4){0.f, 0.f, 0.f, 0.f}; }
#pragma unroll
            for (int ai = 0; ai < 2; ++ai)
#pragma unroll
                for (int m = 0; m < 4; ++m) { const size_t off = ((size_t)u.pm * BM + ai * HALF + wr * 64 + m * 16 + fr) * DM + col0 + bj * HALF;
                    f32x4 x0, x1;
                    if (XF32) { x0 = *(const f32x4*)((const float*)xin + off); x1 = *(const f32x4*)((const float*)xin + off + 4); }
                    else { const u32x4 r = *(const u32x4*)((const bf16_t*)xin + off); x0 = (f32x4){bflo(r.x), bfhi(r.x), bflo(r.y), bfhi(r.y)}; x1 = (f32x4){bflo(r.z), bfhi(r.z), bflo(r.w), bfhi(r.w)}; }
                    const f32x4 y0 = x0 + gv[0] * (acc[ai][bj][m][0] + bv[0]), y1 = x1 + gv[1] * (acc[ai][bj][m][1] + bv[1]);
                    u32x4 w; w.x = cvt_pk_bf16(y0[0], y0[1]); w.y = cvt_pk_bf16(y0[2], y0[3]); w.z = cvt_pk_bf16(y1[0], y1[1]); w.w = cvt_pk_bf16(y1[2], y1[3]);
                    *(u32x4*)(out + off) = w; }
        }
    }
};

template <int MODE> struct EpiGated {
    static constexpr bool PERM = true;
    bf16_t* O; size_t ldo; const float* ba; const float* bg;
    __device__ __forceinline__ void operator()(const f32x4 (&acc)[2][2][4][2], const Unit& u, int wr, int wc, int fr, int fq) const {
        const size_t row0 = (size_t)u.pm * BM + wr * 64 + fr; const int col0 = u.pn * 128 + wc * 32 + 8 * fq;
        f32x4 b0[2], b1[2];
#pragma unroll
        for (int bj = 0; bj < 2; ++bj) { b0[bj] = (f32x4){0.f, 0.f, 0.f, 0.f}; b1[bj] = b0[bj]; if (MODE == 1) { b0[bj] = *(const f32x4*)(ba + col0 + 4 * bj); b1[bj] = *(const f32x4*)(bg + col0 + 4 * bj); } }
#pragma unroll
        for (int ai = 0; ai < 2; ++ai)
#pragma unroll
            for (int m = 0; m < 4; ++m) { f32x4 o[2];
#pragma unroll
                for (int bj = 0; bj < 2; ++bj) { const f32x4 a = acc[ai][bj][m][0] + b0[bj], g = acc[ai][bj][m][1] + b1[bj];
#pragma unroll
                    for (int j = 0; j < 4; ++j) o[bj][j] = (MODE == 1) ? a[j] * sigmoid_f(g[j]) : silu_f(a[j]) * g[j]; }
                if (MODE == 2) { unsigned char* rowp = (unsigned char*)O + (row0 + ai * HALF + m * 16) * ldo + col0;
                    int p0 = 0, p1 = 0; p0 = __builtin_amdgcn_cvt_pk_fp8_f32(o[0][0], o[0][1], p0, false); p0 = __builtin_amdgcn_cvt_pk_fp8_f32(o[0][2], o[0][3], p0, true);
                    p1 = __builtin_amdgcn_cvt_pk_fp8_f32(o[1][0], o[1][1], p1, false); p1 = __builtin_amdgcn_cvt_pk_fp8_f32(o[1][2], o[1][3], p1, true);
                    *(u32x2*)rowp = (u32x2){(unsigned)p0, (unsigned)p1}; }
                else { bf16_t* rowp = O + (row0 + ai * HALF + m * 16) * ldo + col0;
                    u32x4 w; w.x = cvt_pk_bf16(o[0][0], o[0][1]); w.y = cvt_pk_bf16(o[0][2], o[0][3]); w.z = cvt_pk_bf16(o[1][0], o[1][1]); w.w = cvt_pk_bf16(o[1][2], o[1][3]);
                    *(u32x4*)rowp = w; } }
    }
};

struct EpiScatter {
    static constexpr bool PERM = true;
    bf16_t* Y0; bf16_t* Y1; const int* list; const LAS int* pref;
    __device__ __forceinline__ void operator()(const f32x4 (&acc)[2][2][4][2], const Unit& u, int wr, int wc, int fr, int fq) const {
        const int e = u.aux, j = u.pm - pref[e], cnt = pref[40 + e]; const int col0 = u.pn * BM + wc * 32 + 8 * fq; const size_t dy = (size_t)((const char*)Y1 - (const char*)Y0);
#pragma unroll
        for (int ai = 0; ai < 2; ++ai) { int ent[4];
#pragma unroll
            for (int m = 0; m < 4; ++m) { const int r = j * 256 + ai * HALF + wr * 64 + m * 16 + fr; ent[m] = list[e * 32768 + (r < cnt ? r : 0)]; }
#pragma unroll
            for (int m = 0; m < 4; ++m) { const int r = j * 256 + ai * HALF + wr * 64 + m * 16 + fr; const int en = ent[m];
                const bool ok = r < cnt; const unsigned tok = ok ? (unsigned)(en >> 1) : (unsigned)NTOK; const bool second = ok ? (en & 1) : true;
                bf16_t* rowp = (bf16_t*)((char*)Y0 + (size_t)tok * (DM * 2) + (second ? dy : (size_t)0)) + col0;
#pragma unroll
                for (int bj = 0; bj < 2; ++bj) { const f32x4 v0 = acc[ai][bj][m][0], v1 = acc[ai][bj][m][1];
                    u32x4 w; w.x = cvt_pk_bf16(v0[0], v0[1]); w.y = cvt_pk_bf16(v0[2], v0[3]); w.z = cvt_pk_bf16(v1[0], v1[1]); w.w = cvt_pk_bf16(v1[2], v1[3]);
                    *(u32x4*)(rowp + bj * HALF) = w; } } }
    }
};

struct EpiLogits {
    static constexpr bool PERM = false;
    float* O;
    __device__ __forceinline__ void operator()(const f32x4 (&acc)[2][2][4][2], const Unit& u, int wr, int wc, int fr, int fq) const {
        if (wc >= 2) return;
#pragma unroll
        for (int ai = 0; ai < 2; ++ai)
#pragma unroll
            for (int m = 0; m < 4; ++m) { float* rowp = O + ((size_t)u.pm * BM + ai * HALF + wr * 64 + m * 16 + fr) * 64 + wc * 32 + 4 * fq;
#pragma unroll
                for (int n = 0; n < 2; ++n) *(f32x4*)(rowp + n * 16) = acc[ai][0][m][n]; }
    }
};
}
enum { I_X = 0, I_C, I_CTX, I_CCTX, I_ADAW, I_ADAB, I_N1G, I_N2G, I_FING, I_WIN0, I_WOUT0, I_LQ1, I_LK1, I_LQ2, I_LK2, I_SUBLN,
       I_HYSW, I_HYSB, I_HYW1, I_HYB1, I_HYFR1, I_HYW2, I_HYB2, I_HYFR2, I_HYW3, I_HYB3, I_HYBIAS,
       I_CVW1, I_CVB1, I_CVDWW, I_CVDWB, I_CVLNG, I_CVLNB, I_CVW2, I_CVB2, I_MWG, I_MBG, I_MWE, I_MBE, I_MGATE, I_MUP, I_MDOWN, N_IN };

struct Args { const float* in[N_IN]; float* out; unsigned char* ws; int ph_lo, ph_hi; };

struct Frame {
    LAS unsigned char* lds;
    int tid, lane, wave, G, bid;
    const float* const* in; float* out; unsigned char* ws;
};

struct RowMap { int mode, half, which0;
    __device__ __forceinline__ int operator()(int s) const { if (mode == 0) return s; const int w = which0 + s / half, h = s % half, t = h & 127;
        return 256 * (h >> 7) + 128 * ((t >> 2) & 1) + 32 * (t >> 5) + 8 * ((t >> 3) & 3) + 4 * w + (t & 3); } };
#ifndef CONF_FP8
#define CONF_FP8 1
#endif
struct P0Item { const float* W; bf16_t* WT; int K, N, k0, n0; RowMap rm; int fp8; };
constexpr int P0_I_IN = 16 * 6, P0_I_OUT = 16 * 2, P0_I_C1 = 16 * 4, P0_I_C2 = 16 * 2, P0_I_MOE = 64 * 48;
constexpr int P0_NITEMS = P0_I_IN + P0_I_OUT + P0_I_C1 + P0_I_C2 + P0_I_MOE;
__device__ __forceinline__ P0Item p0_item(Frame& F, int it) {
    P0Item I; int r = it; I.fp8 = 0;
    if (r < P0_I_IN) { I.W = F.in[I_WIN0]; I.WT = (bf16_t*)(F.ws + WS_WQKVH); I.K = 1024; I.N = 3072; I.rm = RowMap{0, 1, 0}; }
    else if ((r -= P0_I_IN) < P0_I_OUT) { I.W = F.in[I_WOUT0]; I.WT = (bf16_t*)(F.ws + WS_WO); I.K = 1024; I.N = 1024; I.rm = RowMap{0, 1, 0}; }
    else if ((r -= P0_I_OUT) < P0_I_C1) { I.W = F.in[I_CVW1]; I.WT = (bf16_t*)(F.ws + WS_WC1); I.K = 1024; I.N = 2048; I.rm = RowMap{1, 1024, 0}; I.fp8 = CONF_FP8; }
    else if ((r -= P0_I_C1) < P0_I_C2) { I.W = F.in[I_CVW2]; I.WT = (bf16_t*)(F.ws + WS_WC2); I.K = 1024; I.N = 1024; I.rm = RowMap{0, 1, 0}; I.fp8 = CONF_FP8; }
    else { r -= P0_I_C2; const int le = r / 48, q = r % 48; unsigned char* wb = F.ws + WS_WMOE + (size_t)le * 3 * MiB;
        I.fp8 = 1;
        if (q < 16) { I.W = F.in[I_MGATE] + (size_t)le * 1024 * 512; I.WT = (bf16_t*)wb; I.K = 1024; I.N = 512; I.rm = RowMap{1, 512, 0}; r = q; }
        else if (q < 32) { I.W = F.in[I_MUP] + (size_t)le * 1024 * 512; I.WT = (bf16_t*)wb; I.K = 1024; I.N = 512; I.rm = RowMap{1, 512, 1}; r = q - 16; }
        else { I.W = F.in[I_MDOWN] + (size_t)le * 512 * 1024; I.WT = (bf16_t*)(wb + 2 * MiB); I.K = 512; I.N = 1024; I.rm = RowMap{0, 1, 0}; r = q - 32; } }
    const int nblk = I.N / 512; I.k0 = 64 * (r / nblk); I.n0 = 512 * (r % nblk); return I;
}
__device__ __forceinline__ void p0_item_load(const P0Item& I, int tid, f32x4 (&v)[16]) {
#pragma unroll
    for (int i = 0; i < 16; ++i) v[i] = *(const f32x4*)(I.W + (size_t)(I.k0 + 4 * i + (tid >> 7)) * I.N + I.n0 + 4 * (tid & 127));
}
__device__ __forceinline__ void p0_item_to_lds(LAS float* scr, int tid, const f32x4 (&v)[16]) {
#pragma unroll
    for (int i = 0; i < 16; ++i) { LAS float* d = scr + (4 * i + (tid >> 7)) * 513 + 4 * (tid & 127); d[0] = v[i][0]; d[1] = v[i][1]; d[2] = v[i][2]; d[3] = v[i][3]; }
}
__device__ __forceinline__ void p0_item_store(const P0Item& I, const LAS float* scr, int tid) {
    if (I.fp8) {
#pragma unroll
        for (int j = 0; j < 4; ++j) { const int q = tid + 512 * j, n = q >> 2, c = q & 3; const LAS float* s = scr + (16 * c) * 513 + n; int w[4];
#pragma unroll
            for (int d = 0; d < 4; ++d) { int p = 0; p = __builtin_amdgcn_cvt_pk_fp8_f32(32.f * s[(4 * d) * 513], 32.f * s[(4 * d + 1) * 513], p, false);
                p = __builtin_amdgcn_cvt_pk_fp8_f32(32.f * s[(4 * d + 2) * 513], 32.f * s[(4 * d + 3) * 513], p, true); w[d] = p; }
            *(u32x4*)((unsigned char*)I.WT + (size_t)I.rm(I.n0 + n) * I.K + I.k0 + 16 * c) = (u32x4){(unsigned)w[0], (unsigned)w[1], (unsigned)w[2], (unsigned)w[3]}; }
        return; }
#pragma unroll
    for (int j = 0; j < 8; ++j) { const int q = tid + 512 * j, n = q >> 3, c = q & 7; const LAS float* s = scr + (8 * c) * 513 + n;
        u32x4 o; o.x = cvt_pk_bf16(s[0 * 513], s[1 * 513]); o.y = cvt_pk_bf16(s[2 * 513], s[3 * 513]); o.z = cvt_pk_bf16(s[4 * 513], s[5 * 513]); o.w = cvt_pk_bf16(s[6 * 513], s[7 * 513]);
        *(u32x4*)(I.WT + (size_t)I.rm(I.n0 + n) * I.K + I.k0 + 8 * c) = o; }
}
__device__ __forceinline__ void p0_router_weights(Frame& F) {
    bf16_t* wr = (bf16_t*)(F.ws + WS_WR);
    for (int idx = F.bid * NTHREADS + F.tid; idx < 2 * 256 * 1024; idx += F.G * NTHREADS) {
        const int l = idx >> 18, n = (idx >> 10) & 255, k = idx & 1023; float v = 0.f;
        if (n < 4) v = F.in[I_MWG][((size_t)l * 1024 + k) * 4 + n]; else if (n < 36) v = F.in[I_MWE][((size_t)l * 1024 + k) * 32 + (n - 4)];
        wr[idx] = (bf16_t)(cvt_pk_bf16(v, 0.f) & 0xffffu);
    }
}

__device__ __forceinline__ void p0_adaln_task(Frame& F, int task) {
    const int layer = task / 24, n0 = (task % 24) * 256;
    LAS float* sc = (LAS float*)F.lds;
    LAS f32x4* red = (LAS f32x4*)(F.lds + 36864);
    for (int i = F.tid; i < 9 * 1024; i += NTHREADS) { const int r = i >> 10, k = i & 1023; const float v = (r < 8) ? F.in[I_C][r * 1024 + k] : F.in[I_CCTX][k]; sc[i] = silu_f(v); }
    __syncthreads();
    const int cq = F.tid & 63, ks = F.tid >> 6;
    const float* W = F.in[I_ADAW] + (size_t)layer * 1024 * 6144 + n0 + 4 * cq;
    f32x4 acc[9];
#pragma unroll
    for (int r = 0; r < 9; ++r) acc[r] = (f32x4){0.f, 0.f, 0.f, 0.f};
#pragma unroll 16
    for (int k = ks * 128; k < ks * 128 + 128; ++k) { const f32x4 w = *(const f32x4*)(W + (size_t)k * 6144);
#pragma unroll
        for (int r = 0; r < 9; ++r) acc[r] += w * sc[r * 1024 + k]; }
#pragma unroll
    for (int r = 0; r < 9; ++r) red[(ks * 9 + r) * 64 + cq] = acc[r];
    __syncthreads();
    float* mod = (float*)(F.ws + WS_MOD) + (size_t)layer * 9 * 6144;
    for (int i = F.tid; i < 9 * 64; i += NTHREADS) { const int r = i >> 6, c2 = i & 63; f32x4 s = *(const f32x4*)(F.in[I_ADAB] + layer * 6144 + n0 + 4 * c2);
#pragma unroll
        for (int k8 = 0; k8 < 8; ++k8) s += red[(k8 * 9 + r) * 64 + c2];
        *(f32x4*)(mod + (size_t)r * 6144 + n0 + 4 * c2) = s; }
    __syncthreads();
}

constexpr float HY_MIN_DECAY = -15.350567286626973f, HY_MAX_DECAY = -3.0701134573253945f;
__device__ __forceinline__ void p0_hyfilter_task(Frame& F, int pb) {
    const int t0 = pb * 32;
    LAS float* z = (LAS float*)F.lds;
    LAS float* h1 = z + 32 * 33;
    LAS float* h2 = h1 + 32 * 64;
    for (int i = F.tid; i < 32 * 33; i += NTHREADS) { const int p = i / 33, e = i % 33; const int t = t0 + p; float v;
        if (e == 0) v = (float)t / 4095.0f;
        else { const int bi = (e - 1) & 15; const float band = 1e-4f + (float)bi * ((15.0f - 1e-4f) / 15.0f); const float ang = (6.283185307179586f / 4096.0f) * (float)t * band; v = (e <= 16) ? cosf(ang) : -sinf(ang); }
        z[i] = v; }
    __syncthreads();
    for (int i = F.tid; i < 32 * 64; i += NTHREADS) { const int p = i >> 6, j = i & 63; float s = F.in[I_HYB1][j];
        for (int e = 0; e < 33; ++e) s += z[p * 33 + e] * F.in[I_HYW1][e * 64 + j];
        h1[i] = sinf(F.in[I_HYFR1][j] * s); }
    __syncthreads();
    for (int i = F.tid; i < 32 * 64; i += NTHREADS) { const int p = i >> 6, j = i & 63; float s = F.in[I_HYB2][j];
        for (int e = 0; e < 64; ++e) s += h1[p * 64 + e] * F.in[I_HYW2][e * 64 + j];
        h2[i] = sinf(F.in[I_HYFR2][j] * s); }
    __syncthreads();
    const int c0 = 4 * F.tid;
    float* kraw = (float*)(F.ws + WS_KRAW);
    const f32x4 b3 = *(const f32x4*)(F.in[I_HYB3] + c0);
#pragma unroll 1
    for (int ph = 0; ph < 2; ++ph) {
        f32x4 acc[16];
#pragma unroll
        for (int p = 0; p < 16; ++p) acc[p] = b3;
        for (int j4 = 0; j4 < 16; ++j4) {
            f32x4 w[4];
#pragma unroll
            for (int jj = 0; jj < 4; ++jj) w[jj] = *(const f32x4*)(F.in[I_HYW3] + (size_t)(4 * j4 + jj) * 2048 + c0);
#pragma unroll
            for (int p = 0; p < 16; ++p) { const f32x4 hv = *(const LAS f32x4*)(h2 + (16 * ph + p) * 64 + 4 * j4);
                acc[p] += w[0] * hv[0] + w[1] * hv[1] + w[2] * hv[2] + w[3] * hv[3]; }
        }
#pragma unroll
        for (int cc = 0; cc < 4; ++cc) { const int col = c0 + cc, ch = col & 511;
            const float delta = fabsf(HY_MIN_DECAY + (float)ch * ((HY_MAX_DECAY - HY_MIN_DECAY) / 511.0f));
            float* dst = kraw + (size_t)col * 4096 + t0 + 16 * ph;
#pragma unroll
            for (int p4 = 0; p4 < 4; ++p4) { f32x4 o;
#pragma unroll
                for (int q = 0; q < 4; ++q) { const int p = 4 * p4 + q; const float tn = (float)(t0 + 16 * ph + p) / 4095.0f; o[q] = acc[p][cc] * __expf(-tn * delta); }
                *(f32x4*)(dst + 4 * p4) = o; } }
    }
    __syncthreads();
}

__device__ __forceinline__ void p0_tables_task(Frame& F) {
    float* tab = (float*)(F.ws + WS_TAB);
    for (int i = F.tid; i < 1024; i += NTHREADS) { const int pos = i >> 4, fi = i & 15; const float inv = powf(10000.0f, -(float)fi / 16.0f); const float ang = (float)pos * inv;
        tab[TB_ROPE_C + i] = cosf(ang); tab[TB_ROPE_S + i] = sinf(ang); }
    for (int i = F.tid; i < 256; i += NTHREADS) { float s, c; sincospif(2.0f * (float)i / 4096.0f, &s, &c); tab[TB_T4096 + 2 * i] = c; tab[TB_T4096 + 2 * i + 1] = -s; }
    for (int i = F.tid; i < 64; i += NTHREADS) { float s, c; sincospif(2.0f * (float)i / 8192.0f, &s, &c); tab[TB_T8A + 2 * i] = c; tab[TB_T8A + 2 * i + 1] = -s;
        sincospif(2.0f * (float)(64 * i) / 8192.0f, &s, &c); tab[TB_T8B + 2 * i] = c; tab[TB_T8B + 2 * i + 1] = -s; }
    if (F.tid < 64) { const float a = wave_sum(F.in[I_LQ1][F.lane] * F.in[I_LK1][F.lane]), b = wave_sum(F.in[I_LQ2][F.lane] * F.in[I_LK2][F.lane]);
        if (F.lane == 0) tab[TB_LAM] = expf(a) - expf(b) + 0.2f; }
}

__device__ __forceinline__ void p0_prologue(Frame& F, unsigned* ctr, volatile LAS unsigned* slot) {
    p0_router_weights(F);
#pragma unroll 1
    for (int t = F.bid; t < 48 + 128; t += F.G) { if (t < 48) p0_adaln_task(F, t); else p0_hyfilter_task(F, t - 48); }
    if (F.bid == 0) p0_tables_task(F);
    __syncthreads();
    LAS float* scr = (LAS float*)F.lds;
    if (F.tid == 0) slot[0] = __hip_atomic_fetch_add(ctr, 1u, RLX_AGENT);
    __syncthreads();
    int cur = (int)slot[0];
    f32x4 v[16];
    if (cur < P0_NITEMS) { const P0Item I = p0_item(F, cur); p0_item_load(I, F.tid, v); }
    while (cur < P0_NITEMS) {
        __syncthreads();
        p0_item_to_lds(scr, F.tid, v);
        if (F.tid == 0) slot[0] = __hip_atomic_fetch_add(ctr, 1u, RLX_AGENT);
        __syncthreads();
        const int nxt = (int)slot[0];
        if (nxt < P0_NITEMS) { const P0Item J = p0_item(F, nxt); p0_item_load(J, F.tid, v); }
        { const P0Item I = p0_item(F, cur); p0_item_store(I, scr, F.tid); }
        cur = nxt;
    }
    __syncthreads();
}

__device__ __forceinline__ void bf8_to_f32(const u32x4 r, f32x4& a, f32x4& b) { a = (f32x4){bflo(r.x), bfhi(r.x), bflo(r.y), bfhi(r.y)}; b = (f32x4){bflo(r.z), bfhi(r.z), bflo(r.w), bfhi(r.w)}; }
__device__ __forceinline__ void rms_mod_store(const f32x4 (&v)[4], const float* g, const float* sh, const float* sc, bf16_t* orow, float* frow, int lane) {
    float s = 0.f;
#pragma unroll
    for (int j = 0; j < 4; ++j) s += (v[j].x * v[j].x + v[j].y * v[j].y) + (v[j].z * v[j].z + v[j].w * v[j].w);
    const float rstd = 1.0f / sqrtf(wave_sum(s) * (1.0f / 1024.0f) + EPS);
#pragma unroll
    for (int h = 0; h < 2; ++h) { const int c = 8 * lane + 512 * h; f32x4 y0 = v[2 * h] * rstd * *(const f32x4*)(g + c), y1 = v[2 * h + 1] * rstd * *(const f32x4*)(g + c + 4);
        if (sc) { y0 = y0 * (*(const f32x4*)(sc + c) + 1.0f) + *(const f32x4*)(sh + c); y1 = y1 * (*(const f32x4*)(sc + c + 4) + 1.0f) + *(const f32x4*)(sh + c + 4); }
        if (orow) { u32x4 w; w.x = cvt_pk_bf16(y0[0], y0[1]); w.y = cvt_pk_bf16(y0[2], y0[3]); w.z = cvt_pk_bf16(y1[0], y1[1]); w.w = cvt_pk_bf16(y1[2], y1[3]); *(u32x4*)(orow + c) = w; }
        if (frow) { *(f32x4*)(frow + c) = y0; *(f32x4*)(frow + c + 4) = y1; } }
}

__device__ __forceinline__ void p1_norm_in(Frame& F) {
    const int gw = F.bid * NWAVES + F.wave, NGW = F.G * NWAVES;
    const float* mod = (const float*)(F.ws + WS_MOD);
#pragma unroll 1
    for (int r0 = gw; r0 < NTOK + NB * CTXL; r0 += 4 * NGW) {
        f32x4 v[4][4];
#pragma unroll
        for (int q = 0; q < 4; ++q) { const int r = r0 + q * NGW; if (r < NTOK + NB * CTXL) { const bool isx = r < NTOK; const int rr = isx ? r : r - NTOK;
            const float* xrow = (isx ? F.in[I_X] : F.in[I_CTX]) + (size_t)rr * DM;
#pragma unroll
            for (int j = 0; j < 4; ++j) v[q][j] = *(const f32x4*)(xrow + 8 * F.lane + 512 * (j >> 1) + 4 * (j & 1)); } }
#pragma unroll
        for (int q = 0; q < 4; ++q) { const int r = r0 + q * NGW; if (r < NTOK + NB * CTXL) { const bool isx = r < NTOK; const int rr = isx ? r : r - NTOK; const int b = isx ? (rr >> 12) : 8;
            bf16_t* orow = (bf16_t*)(F.ws + (isx ? WS_BUF0 : WS_OBT)) + (size_t)rr * DM;
            rms_mod_store(v[q], F.in[I_N1G], mod + (size_t)b * 6144 + 0, mod + (size_t)b * 6144 + 1024, orow, nullptr, F.lane); } }
    }
}

constexpr int MF_PITCH = 2064;
constexpr int MF_TILE = 0, MF_RED = 32 * MF_PITCH, MF_SEL = MF_RED + 8 * 32 * 65 * 4, MF_CNT = MF_SEL + 128 * 32;
__device__ __forceinline__ void moe_front(Frame& F, int layer) {
    LAS unsigned char* lds = F.lds;
    LAS float* red = (LAS float*)(lds + MF_RED);
    LAS int* lcnt = (LAS int*)(lds + MF_CNT); LAS int* lbase = lcnt + 32;
    const float* mod = (const float*)(F.ws + WS_MOD) + (size_t)layer * 9 * 6144;
    unsigned* gcnt = (unsigned*)(F.ws + WS_CTL) + CW_CNT + layer * 32 * 64;
    int* list = (int*)(F.ws + WS_LIST);
    int* tinfo = (int*)(F.ws + WS_TOK); float* tw = (float*)(F.ws + WS_TOK + 512 * 1024);
    const int l = F.lane, w = F.wave, r32 = l & 31, hi = l >> 5;
    bf16x8 wb[2][8];
    { const bf16_t* wr = (const bf16_t*)(F.ws + WS_WR) + (size_t)layer * 256 * 1024;
#pragma unroll
      for (int nb = 0; nb < 2; ++nb)
#pragma unroll
          for (int s = 0; s < 8; ++s) wb[nb][s] = *(const bf16x8*)(wr + (size_t)(32 * nb + r32) * 1024 + 128 * w + 16 * s + 8 * hi); }
    for (int blk = F.bid; blk < NTOK / 128; blk += F.G) {
        if (F.tid < 32) lcnt[F.tid] = 0;
        __syncthreads();
#pragma unroll 1
        for (int sg = 0; sg < 4; ++sg) {
            const int tok0 = blk * 128 + sg * 32;
            { f32x4 v[4][4];
#pragma unroll
              for (int q = 0; q < 4; ++q) { const bf16_t* xrow = (const bf16_t*)(F.ws + WS_X) + (size_t)(tok0 + 4 * w + q) * DM;
#pragma unroll
                  for (int h = 0; h < 2; ++h) { const u32x4 t = *(const u32x4*)(xrow + 8 * l + 512 * h); bf8_to_f32(t, v[q][2 * h], v[q][2 * h + 1]); } }
              const int b = tok0 >> 12;
              const float* g = F.in[I_N2G] + layer * DM; const float* sh = mod + (size_t)b * 6144 + 3 * 1024; const float* sc = mod + (size_t)b * 6144 + 4 * 1024;
#pragma unroll
              for (int q = 0; q < 4; ++q) { const int rl = 4 * w + q, r = tok0 + rl; float ssq = 0.f;
#pragma unroll
                  for (int j = 0; j < 4; ++j) ssq += (v[q][j].x * v[q][j].x + v[q][j].y * v[q][j].y) + (v[q][j].z * v[q][j].z + v[q][j].w * v[q][j].w);
                  const float rstd = 1.0f / sqrtf(wave_sum(ssq) * (1.0f / 1024.0f) + EPS);
                  unsigned char* orow = F.ws + WS_BUF0 + (size_t)r * DM;
#pragma unroll
                  for (int h = 0; h < 2; ++h) { const int c = 8 * l + 512 * h;
                      const f32x4 y0 = v[q][2 * h] * rstd * *(const f32x4*)(g + c) * (*(const f32x4*)(sc + c) + 1.0f) + *(const f32x4*)(sh + c);
                      const f32x4 y1 = v[q][2 * h + 1] * rstd * *(const f32x4*)(g + c + 4) * (*(const f32x4*)(sc + c + 4) + 1.0f) + *(const f32x4*)(sh + c + 4);
                      u32x4 pk; pk.x = cvt_pk_bf16(y0[0], y0[1]); pk.y = cvt_pk_bf16(y0[2], y0[3]); pk.z = cvt_pk_bf16(y1[0], y1[1]); pk.w = cvt_pk_bf16(y1[2], y1[3]);
                      *(LAS u32x4*)(lds + MF_TILE + rl * MF_PITCH + c * 2) = pk;
                      int p0 = 0, p1 = 0; p0 = __builtin_amdgcn_cvt_pk_fp8_f32(y0[0], y0[1], p0, false); p0 = __builtin_amdgcn_cvt_pk_fp8_f32(y0[2], y0[3], p0, true);
                      p1 = __builtin_amdgcn_cvt_pk_fp8_f32(y1[0], y1[1], p1, false); p1 = __builtin_amdgcn_cvt_pk_fp8_f32(y1[2], y1[3], p1, true);
                      *(u32x2*)(orow + c) = (u32x2){(unsigned)p0, (unsigned)p1}; } } }
            __syncthreads();
            { f32x16 d0, d1;
#pragma unroll
              for (int r = 0; r < 16; ++r) { d0[r] = 0.f; d1[r] = 0.f; }
#pragma unroll
              for (int s = 0; s < 8; ++s) { const bf16x8 a = *(const LAS bf16x8*)(lds + MF_TILE + r32 * MF_PITCH + (128 * w + 16 * s + 8 * hi) * 2);
                  d0 = __builtin_amdgcn_mfma_f32_32x32x16_bf16(a, wb[0][s], d0, 0, 0, 0); d1 = __builtin_amdgcn_mfma_f32_32x32x16_bf16(a, wb[1][s], d1, 0, 0, 0); }
#pragma unroll
              for (int r = 0; r < 16; ++r) { const int t = (r & 3) + 8 * (r >> 2) + 4 * hi; red[(w * 32 + t) * 65 + r32] = d0[r]; red[(w * 32 + t) * 65 + 32 + r32] = d1[r]; } }
            __syncthreads();
            if (F.tid < 32) { const int t = F.tid;
                int g = 0; float gm = -1e30f, gl[4];
#pragma unroll
                for (int i = 0; i < 4; ++i) { float sum = F.in[I_MBG][layer * 4 + i];
#pragma unroll
                    for (int ww = 0; ww < 8; ++ww) sum += red[(ww * 32 + t) * 65 + i];
                    gl[i] = sum; if (sum > gm) { gm = sum; g = i; } }
                float gs = 0.f;
#pragma unroll
                for (int i = 0; i < 4; ++i) gs += __expf(gl[i] - gm);
                const float gw = 1.0f / gs;
                float el[8];
#pragma unroll
                for (int i = 0; i < 8; ++i) { float sum = F.in[I_MBE][layer * 32 + 8 * g + i];
#pragma unroll
                    for (int ww = 0; ww < 8; ++ww) sum += red[(ww * 32 + t) * 65 + 4 + 8 * g + i];
                    el[i] = sum; }
                int i1 = 0; float m1 = -1e30f;
#pragma unroll
                for (int i = 0; i < 8; ++i) if (el[i] > m1) { m1 = el[i]; i1 = i; }
                int i2 = 0; float m2 = -1e30f;
#pragma unroll
                for (int i = 0; i < 8; ++i) if (i != i1 && el[i] > m2) { m2 = el[i]; i2 = i; }
                const float e2 = __expf(m2 - m1), w1 = gw / (1.0f + e2), w2 = gw * e2 / (1.0f + e2);
                const int x1 = g * 8 + i1, x2 = g * 8 + i2;
                const int p1 = __hip_atomic_fetch_add(&lcnt[x1], 1, __ATOMIC_RELAXED, __HIP_MEMORY_SCOPE_WORKGROUP), p2 = __hip_atomic_fetch_add(&lcnt[x2], 1, __ATOMIC_RELAXED, __HIP_MEMORY_SCOPE_WORKGROUP);
                LAS int* sel = (LAS int*)(lds + MF_SEL) + (sg * 32 + t) * 8;
                sel[0] = x1; sel[1] = p1; sel[2] = x2; sel[3] = p2; sel[4] = __float_as_int(w1); sel[5] = __float_as_int(w2); }
            __syncthreads();
        }
        if (F.tid < 32) lbase[F.tid] = (int)__hip_atomic_fetch_add(gcnt + F.tid * 64, (unsigned)lcnt[F.tid], RLX_AGENT);
        __syncthreads();
        if (F.tid < 128) { const LAS int* sel = (const LAS int*)(lds + MF_SEL) + F.tid * 8; const int tok = blk * 128 + F.tid;
            const int x1 = sel[0], x2 = sel[2], q1 = lbase[x1] + sel[1], q2 = lbase[x2] + sel[3];
            list[x1 * 32768 + q1] = 2 * tok; list[x2 * 32768 + q2] = 2 * tok + 1;
            *(int4*)(tinfo + 4 * (size_t)tok) = make_int4(x1, q1, x2, q2);
            *(float2*)(tw + 2 * (size_t)tok) = make_float2(__int_as_float(sel[4]), __int_as_float(sel[5])); }
        __syncthreads();
    }
}

__device__ __forceinline__ void moe_prefix(Frame& F, int layer, LAS int* pref) {
    const unsigned* gcnt = (const unsigned*)(F.ws + WS_CTL) + CW_CNT + layer * 32 * 64;
    if (F.tid == 0) { int s = 0; for (int e = 0; e < 32; ++e) { const int c = (int)gcnt[e * 64]; pref[e] = s; pref[40 + e] = c; s += (c + 255) >> 8; } pref[32] = s; }
    __syncthreads();
}

template <int MODE> __device__ __forceinline__ void moe_combine(Frame& F, int layer) {
    const int gw = F.bid * NWAVES + F.wave, NGW = F.G * NWAVES;
    const float* mod = (const float*)(F.ws + WS_MOD) + (size_t)layer * 9 * 6144;
    const float* modn = (const float*)(F.ws + WS_MOD) + (size_t)1 * 9 * 6144;
    const float* tw = (const float*)(F.ws + WS_TOK + 512 * 1024);
    const bf16_t* Y0 = (const bf16_t*)(F.ws + WS_BUF0); const bf16_t* Y1 = (const bf16_t*)(F.ws + WS_Y1);
    bf16_t* X = (bf16_t*)(F.ws + WS_X);
#pragma unroll 1
    for (int r0 = gw; r0 < NTOK; r0 += 4 * NGW) {
        f32x4 v[4][4];
#pragma unroll
        for (int q = 0; q < 4; ++q) { const int r = r0 + q * NGW; const int b = r >> 12;
            const float2 ww = *(const float2*)(tw + 2 * (size_t)r);
            const float* g2 = mod + (size_t)b * 6144 + 5 * 1024;
#pragma unroll
            for (int h = 0; h < 2; ++h) { const int c = 8 * F.lane + 512 * h;
                const u32x4 xr = *(const u32x4*)(X + (size_t)r * DM + c), ar = *(const u32x4*)(Y0 + (size_t)r * DM + c), br = *(const u32x4*)(Y1 + (size_t)r * DM + c);
                f32x4 x0, x1, a0, a1, b0, b1; bf8_to_f32(xr, x0, x1); bf8_to_f32(ar, a0, a1); bf8_to_f32(br, b0, b1);
                v[q][2 * h] = x0 + *(const f32x4*)(g2 + c) * (a0 * ww.x + b0 * ww.y); v[q][2 * h + 1] = x1 + *(const f32x4*)(g2 + c + 4) * (a1 * ww.x + b1 * ww.y); } }
#pragma unroll
        for (int q = 0; q < 4; ++q) { const int r = r0 + q * NGW; const int b = r >> 12;
            float ssq = 0.f;
#pragma unroll
            for (int j = 0; j < 4; ++j) ssq += (v[q][j].x * v[q][j].x + v[q][j].y * v[q][j].y) + (v[q][j].z * v[q][j].z + v[q][j].w * v[q][j].w);
            const float rstd = 1.0f / sqrtf(wave_sum(ssq) * (1.0f / 1024.0f) + EPS);
            const float* g = (MODE == 0) ? F.in[I_N1G] + DM : F.in[I_FING];
#pragma unroll
            for (int h = 0; h < 2; ++h) { const int c = 8 * F.lane + 512 * h;
                if (MODE == 0) { u32x4 pk; pk.x = cvt_pk_bf16(v[q][2 * h][0], v[q][2 * h][1]); pk.y = cvt_pk_bf16(v[q][2 * h][2], v[q][2 * h][3]); pk.z = cvt_pk_bf16(v[q][2 * h + 1][0], v[q][2 * h + 1][1]); pk.w = cvt_pk_bf16(v[q][2 * h + 1][2], v[q][2 * h + 1][3]);
                    *(u32x4*)(X + (size_t)r * DM + c) = pk; }
                f32x4 y0 = v[q][2 * h] * rstd * *(const f32x4*)(g + c), y1 = v[q][2 * h + 1] * rstd * *(const f32x4*)(g + c + 4);
                if (MODE == 0) { const float* sh = modn + (size_t)b * 6144; const float* sc = sh + 1024;
                    y0 = y0 * (*(const f32x4*)(sc + c) + 1.0f) + *(const f32x4*)(sh + c); y1 = y1 * (*(const f32x4*)(sc + c + 4) + 1.0f) + *(const f32x4*)(sh + c + 4);
                    if (CONF_FP8) { int p0 = 0, p1 = 0; p0 = __builtin_amdgcn_cvt_pk_fp8_f32(y0[0], y0[1], p0, false); p0 = __builtin_amdgcn_cvt_pk_fp8_f32(y0[2], y0[3], p0, true);
                        p1 = __builtin_amdgcn_cvt_pk_fp8_f32(y1[0], y1[1], p1, false); p1 = __builtin_amdgcn_cvt_pk_fp8_f32(y1[2], y1[3], p1, true);
                        *(u32x2*)(F.ws + WS_BUF0 + (size_t)r * DM + c) = (u32x2){(unsigned)p0, (unsigned)p1}; }
                    else { u32x4 pk; pk.x = cvt_pk_bf16(y0[0], y0[1]); pk.y = cvt_pk_bf16(y0[2], y0[3]); pk.z = cvt_pk_bf16(y1[0], y1[1]); pk.w = cvt_pk_bf16(y1[2], y1[3]);
                        *(u32x4*)((bf16_t*)(F.ws + WS_BUF0) + (size_t)r * DM + c) = pk; } }
                else { *(f32x4*)(F.out + (size_t)r * DM + c) = y0; *(f32x4*)(F.out + (size_t)r * DM + c + 4) = y1; } } }
    }
}

__device__ __forceinline__ void transpose_ob(Frame& F) {
    LAS bf16_t* scr = (LAS bf16_t*)(F.lds + F.wave * 16384);
    const int gw = F.bid * NWAVES + F.wave, NGW = F.G * NWAVES;
    const bf16_t* src = (const bf16_t*)(F.ws + WS_OBT); bf16_t* dst = (bf16_t*)(F.ws + WS_BUF0);
    const int r8 = F.lane >> 3, c8 = F.lane & 7;
    for (int it = gw; it < 8 * 512; it += NGW) {
        const int cb = it & 7, tb = it >> 3; const int c0 = cb * 64, t0 = tb * 64;
        u32x4 v[8];
#pragma unroll
        for (int i = 0; i < 8; ++i) v[i] = *(const u32x4*)(src + (size_t)(c0 + r8 + 8 * i) * NTOK + t0 + 8 * c8);
#pragma unroll
        for (int i = 0; i < 8; ++i) *(LAS u32x4*)(scr + (r8 + 8 * i) * 72 + 8 * c8) = v[i];
        LDS_WAIT(); asm volatile("" ::: "memory");
#pragma unroll
        for (int i = 0; i < 8; ++i) { const int t = r8 + 8 * i; unsigned short e[8];
#pragma unroll
            for (int k = 0; k < 8; ++k) e[k] = scr[(8 * c8 + k) * 72 + t];
            u32x4 o; o.x = e[0] | ((unsigned)e[1] << 16); o.y = e[2] | ((unsigned)e[3] << 16); o.z = e[4] | ((unsigned)e[5] << 16); o.w = e[6] | ((unsigned)e[7] << 16);
            *(u32x4*)(dst + (size_t)(t0 + t) * DM + 512 + c0 + 8 * c8) = o; }
        LDS_WAIT(); asm volatile("" ::: "memory");
    }
}

template <int SS> __device__ __forceinline__ void conv_step(f32x2 (&acc)[32], const f32x2 (&w)[31], const f32x2 bias, const unsigned rawv) {
    const f32x2 xin = (f32x2){bflo(rawv), bfhi(rawv)};
    acc[SS] = bias;
#pragma unroll
    for (int k = 0; k < 31; ++k) acc[(SS - k) & 31] += w[k] * xin;
}
constexpr int CV_TILE = 65536;
__device__ __forceinline__ void conv_ln_rows(Frame& F, const LAS bf16_t* tile, bf16_t* Obase  ) {
#pragma unroll 1
    for (int q = 0; q < 4; ++q) { const int rr = F.wave * 4 + q;
        f32x4 v[4]; float sm = 0.f;
#pragma unroll
        for (int h = 0; h < 2; ++h) { const u32x4 t = *(const LAS u32x4*)(tile + rr * 1024 + 8 * F.lane + 512 * h); bf8_to_f32(t, v[2 * h], v[2 * h + 1]); }
#pragma unroll
        for (int j = 0; j < 4; ++j) sm += (v[j].x + v[j].y) + (v[j].z + v[j].w);
        const float mean = wave_sum(sm) * (1.0f / 1024.0f); float s2 = 0.f;
#pragma unroll
        for (int j = 0; j < 4; ++j) { v[j] = v[j] - mean; s2 += (v[j].x * v[j].x + v[j].y * v[j].y) + (v[j].z * v[j].z + v[j].w * v[j].w); }
        const float rstd = 1.0f / sqrtf(wave_sum(s2) * (1.0f / 1024.0f) + EPS);
        bf16_t* orow = Obase + (size_t)rr * (CONF_FP8 ? DM / 2 : DM);
#pragma unroll
        for (int h = 0; h < 2; ++h) { const int c = 8 * F.lane + 512 * h;
            f32x4 y0 = v[2 * h] * rstd * *(const f32x4*)(F.in[I_CVLNG] + c) + *(const f32x4*)(F.in[I_CVLNB] + c), y1 = v[2 * h + 1] * rstd * *(const f32x4*)(F.in[I_CVLNG] + c + 4) + *(const f32x4*)(F.in[I_CVLNB] + c + 4);
#pragma unroll
            for (int e = 0; e < 4; ++e) { y0[e] = silu_f(y0[e]); y1[e] = silu_f(y1[e]); }
            if (CONF_FP8) { int p0 = 0, p1 = 0; p0 = __builtin_amdgcn_cvt_pk_fp8_f32(y0[0], y0[1], p0, false); p0 = __builtin_amdgcn_cvt_pk_fp8_f32(y0[2], y0[3], p0, true);
                p1 = __builtin_amdgcn_cvt_pk_fp8_f32(y1[0], y1[1], p1, false); p1 = __builtin_amdgcn_cvt_pk_fp8_f32(y1[2], y1[3], p1, true); *(u32x2*)((unsigned char*)orow + c) = (u32x2){(unsigned)p0, (unsigned)p1}; }
            else { u32x4 pk; pk.x = cvt_pk_bf16(y0[0], y0[1]); pk.y = cvt_pk_bf16(y0[2], y0[3]); pk.z = cvt_pk_bf16(y1[0], y1[1]); pk.w = cvt_pk_bf16(y1[2], y1[3]); *(u32x4*)(orow + c) = pk; } } }
}
__device__ __forceinline__ void conv_half_issue(Frame& F, const bf16_t* Abatch, int t0, int s1, LAS unsigned char* dst) {
    const char* zrow = (const char*)(F.ws + WS_CTL + 512 * 1024);
#pragma unroll
    for (int i = 0; i < 4; ++i) { const int p = F.tid + 512 * i, row = p >> 7, chn = p & 127; const int t = t0 - 15 + s1 + row;
        const char* src = (t >= 0 && t < SEQ) ? (const char*)(Abatch + (size_t)t * DM) + 16 * chn : zrow + 16 * chn;
        __builtin_amdgcn_global_load_lds((const unsigned*)src, (LAS unsigned*)(dst + i * 8192 + F.wave * 1024), 16, 0, 0); }
}
__device__ __forceinline__ void conv_ln_phase(Frame& F) {
    LAS unsigned char* stA = F.lds; LAS unsigned char* stB = F.lds + 32768; LAS bf16_t* tile = (LAS bf16_t*)(F.lds + CV_TILE);
    const bf16_t* A = (const bf16_t*)(F.ws + WS_GLU); bf16_t* O = (bf16_t*)(F.ws + WS_BUF0);
    const int ch = 2 * F.tid;
    f32x2 w[31];
#pragma unroll
    for (int k = 0; k < 31; ++k) w[k] = *(const f32x2*)(F.in[I_CVDWW] + k * 1024 + ch);
    const f32x2 bias = *(const f32x2*)(F.in[I_CVDWB] + ch);
    for (int blk = F.bid; blk < 256; blk += F.G) {
        const int b = blk >> 5, t0 = (blk & 31) * 128;
        const bf16_t* Ab = A + (size_t)b * SEQ * DM;
        f32x2 acc[32];
#pragma unroll
        for (int i = 0; i < 32; ++i) acc[i] = (f32x2){0.f, 0.f};
        __syncthreads();
        conv_half_issue(F, Ab, t0, 0, stA); conv_half_issue(F, Ab, t0, 16, stB);
#pragma unroll 1
        for (int s0 = 0; s0 < 160; s0 += 32) {
#define CV_STEP(SS) { conv_step<SS>(acc, w, bias, *(const LAS unsigned*)((SS < 16 ? stA : stB) + (SS & 15) * 2048 + 2 * ch)); const int o = s0 + SS - 30; \
                if (o >= 0 && o < 128) { const f32x2 r_ = acc[(SS + 2) & 31]; *(LAS unsigned*)(tile + ((SS + 2) & 31) * 1024 + ch) = cvt_pk_bf16(r_.x, r_.y); } \
                if (SS == 29 && o >= 0 && o < 128) { __syncthreads(); conv_ln_rows(F, tile, O + ((size_t)b * SEQ + t0 + (o - 31)) * (CONF_FP8 ? DM / 2 : DM)); __syncthreads(); } }
            VM_WAIT(); __syncthreads();
            CV_STEP(0) CV_STEP(1) CV_STEP(2) CV_STEP(3) CV_STEP(4) CV_STEP(5) CV_STEP(6) CV_STEP(7) CV_STEP(8) CV_STEP(9) CV_STEP(10) CV_STEP(11) CV_STEP(12) CV_STEP(13) CV_STEP(14) CV_STEP(15)
            __syncthreads();
            if (s0 + 32 < 160) conv_half_issue(F, Ab, t0, s0 + 32, stA);
            CV_STEP(16) CV_STEP(17) CV_STEP(18) CV_STEP(19) CV_STEP(20) CV_STEP(21) CV_STEP(22) CV_STEP(23) CV_STEP(24) CV_STEP(25) CV_STEP(26) CV_STEP(27) CV_STEP(28) CV_STEP(29) CV_STEP(30) CV_STEP(31)
            __syncthreads();
            if (s0 + 32 < 160) conv_half_issue(F, Ab, t0, s0 + 48, stB);
#undef CV_STEP
        }
    }
}
namespace att {
constexpr int KT = 64, NTILE = LKV / KT, ST_BYTES = 24576;
typedef short v4i16_t __attribute__((ext_vector_type(4)));

__device__ __forceinline__ f32x16 mfma32(bf16x8 a, bf16x8 b, f32x16 c) { return __builtin_amdgcn_mfma_f32_32x32x16_bf16(a, b, c, 0, 0, 0); }

__device__ __forceinline__ void attn_phase(Frame& F) {
    LAS unsigned char* lds = F.lds;
    const int l = F.lane, w = F.wave, tid = F.tid, r32 = l & 31, hi = l >> 5;
    const bf16_t* Qb = (const bf16_t*)(F.ws + WS_Q); const bf16_t* Kb = (const bf16_t*)(F.ws + WS_K); const bf16_t* Vb = (const bf16_t*)(F.ws + WS_V);
    bf16_t* Ob = (bf16_t*)(F.ws + WS_BUF0);
    const float lam = ((const float*)(F.ws + WS_TAB))[TB_LAM];
    const unsigned kbase_ = (unsigned)(r32 * 128), kx_ = (unsigned)((r32 >> 1) & 7);
    unsigned vbase_, vq4_;
    { const int g = l >> 4, i = l & 15, q4 = i >> 2, p4 = i & 3; const int row = 4 * (g >> 1) + q4;
      const int lowch = (2 * (g & 1) + (p4 >> 1)) ^ ((row >> 2) & 3);
      vbase_ = (unsigned)(8192 + row * 256 + (lowch << 4) + 8 * (p4 & 1)); vq4_ = (unsigned)q4; }
#define ATT_ISSUE(st, kv0) do { const size_t _ro = (size_t)(kv0) * 1024; int t_ = tid; asm volatile("" : "+v"(t_)); \
        const int krow = t_ >> 3; const unsigned ksrc = (unsigned)(krow * 1024 + (((t_ & 7) ^ ((krow >> 1) & 7)) << 4)); unsigned vsrc[2]; \
        _Pragma("unroll") for (int i_ = 0; i_ < 2; ++i_) { const int p = t_ + 512 * i_, vrow = p >> 4; vsrc[i_] = (unsigned)(vrow * 1024 + (((p & 15) ^ (((vrow & 3) << 2) | ((vrow >> 2) & 3))) << 4)); } \
        __builtin_amdgcn_global_load_lds((const unsigned*)(Kg + _ro + ksrc), (LAS unsigned*)(lds + (st) * ST_BYTES + w * 1024), 16, 0, 0); \
        __builtin_amdgcn_global_load_lds((const unsigned*)(Vg + _ro + vsrc[0]), (LAS unsigned*)(lds + (st) * ST_BYTES + 8192 + w * 1024), 16, 0, 0); \
        __builtin_amdgcn_global_load_lds((const unsigned*)(Vg + _ro + vsrc[1]), (LAS unsigned*)(lds + (st) * ST_BYTES + 16384 + w * 1024), 16, 0, 0); } while (0)

    for (int it = 0;; ++it) {
        int grp, qb;
        if (F.G == 256) { const int x = F.bid & 7, j = F.bid >> 3; if (it >= 2) break; grp = x * 4 + it * 2 + (j >> 4); qb = j & 15; }
        else { const int un = it * F.G + F.bid; if (un >= 512) break; grp = un >> 4; qb = un & 15; }
        const int b = grp >> 2, hp = grp & 3;
        const bf16_t* Qg = Qb + ((size_t)b * SEQ + qb * 256 + w * 32 + r32) * 512;
        const char* Vg = (const char*)(Vb + (size_t)b * LKV * 512 + hp * 128);
        f32x16 o1[4];
#pragma unroll 1
        for (int s = 0; s < 2; ++s) {
            const char* Kg = (const char*)(Kb + (size_t)b * LKV * 512 + (2 * hp + s) * 64);
            bf16x8 qf[4];
#pragma unroll
            for (int ds = 0; ds < 4; ++ds) qf[ds] = *(const bf16x8*)(Qg + (2 * hp + s) * 64 + ds * 16 + hi * 8);
            f32x16 O[4];
#pragma unroll
            for (int d = 0; d < 4; ++d)
#pragma unroll
                for (int r = 0; r < 16; ++r) O[d][r] = 0.f;
            float m = 0.f, lsum = 0.f;
            __syncthreads();
            ATT_ISSUE(0, 0);
#pragma unroll 1
            for (int j = 0; j < NTILE; ++j) {
                VM_WAIT(); __syncthreads();
                if (j + 1 < NTILE) ATT_ISSUE((j + 1) & 1, (j + 1) * KT);
                const LAS unsigned char* Ks = lds + (j & 1) * ST_BYTES;
                unsigned kbase = kbase_, kx = kx_, vbase = vbase_, vq4 = vq4_; asm volatile("" : "+v"(kbase), "+v"(kx), "+v"(vbase), "+v"(vq4));
                f32x16 p0, p1;
#pragma unroll
                for (int r = 0; r < 16; ++r) { p0[r] = 0.f; p1[r] = 0.f; }
#pragma unroll
                for (int ds = 0; ds < 4; ++ds) { const unsigned ka = kbase + ((((unsigned)(2 * ds + hi)) ^ kx) << 4); const bf16x8 k0 = *(const LAS bf16x8*)(Ks + ka), k1 = *(const LAS bf16x8*)(Ks + ka + 4096);
                    p0 = mfma32(k0, qf[ds], p0); p1 = mfma32(k1, qf[ds], p1); }
                if (j == 0) { float mx0 = fmaxf(p0[0], p1[0]);
#pragma unroll
                    for (int r = 1; r < 16; ++r) mx0 = fmaxf(mx0, fmaxf(p0[r], p1[r]));
                    m = fmaxf(mx0, __shfl_xor(mx0, 32)); }
                f32x2 e0[8], e1[8];
                { const f32x2 mm = (f32x2){m, m};
#pragma unroll
                  for (int r = 0; r < 8; ++r) { e0[r] = (f32x2){p0[2 * r], p0[2 * r + 1]} - mm; e1[r] = (f32x2){p1[2 * r], p1[2 * r + 1]} - mm; } }
                float mx = fmaxf(fmaxf(e0[0].x, e0[0].y), fmaxf(e1[0].x, e1[0].y));
#pragma unroll
                for (int r = 1; r < 8; ++r) { mx = fmaxf(fmaxf(mx, e0[r].x), e0[r].y); mx = fmaxf(fmaxf(mx, e1[r].x), e1[r].y); }
                mx = fmaxf(mx, __shfl_xor(mx, 32));
                if (!__all(mx <= 8.0f)) { const float dl = fmaxf(mx, 0.f), alpha = __builtin_amdgcn_exp2f(-dl);
#pragma unroll
                    for (int d = 0; d < 4; ++d) O[d] = O[d] * alpha;
                    lsum *= alpha; m += dl; const f32x2 dd = (f32x2){dl, dl};
#pragma unroll
                    for (int r = 0; r < 8; ++r) { e0[r] -= dd; e1[r] -= dd; } }
                { f32x2 acc = (f32x2){0.f, 0.f};
#pragma unroll
                  for (int r = 0; r < 8; ++r) { e0[r] = (f32x2){__builtin_amdgcn_exp2f(e0[r].x), __builtin_amdgcn_exp2f(e0[r].y)}; e1[r] = (f32x2){__builtin_amdgcn_exp2f(e1[r].x), __builtin_amdgcn_exp2f(e1[r].y)};
                      acc += e0[r] + e1[r]; }
                  lsum += acc.x + acc.y; }
                bf16x8 pb[4];
#pragma unroll
                for (int q = 0; q < 2; ++q) { u32x4 a, c;
                    a.x = cvt_pk_bf16(e0[4 * q + 0].x, e0[4 * q + 0].y); a.y = cvt_pk_bf16(e0[4 * q + 1].x, e0[4 * q + 1].y); a.z = cvt_pk_bf16(e0[4 * q + 2].x, e0[4 * q + 2].y); a.w = cvt_pk_bf16(e0[4 * q + 3].x, e0[4 * q + 3].y);
                    c.x = cvt_pk_bf16(e1[4 * q + 0].x, e1[4 * q + 0].y); c.y = cvt_pk_bf16(e1[4 * q + 1].x, e1[4 * q + 1].y); c.z = cvt_pk_bf16(e1[4 * q + 2].x, e1[4 * q + 2].y); c.w = cvt_pk_bf16(e1[4 * q + 3].x, e1[4 * q + 3].y);
                    pb[q] = __builtin_bit_cast(bf16x8, a); pb[2 + q] = __builtin_bit_cast(bf16x8, c); }
#pragma unroll
                for (int d = 0; d < 4; ++d) {
                    const unsigned va0 = vbase + ((((unsigned)d) ^ vq4) << 6), va1 = (va0 ^ 32u) + 2048u;
#pragma unroll
                    for (int kv = 0; kv < 4; ++kv) {
                        const v4i16_t lo = __builtin_amdgcn_ds_read_tr16_b64_v4i16((LAS v4i16_t*)(Ks + va0 + kv * 4096));
                        const v4i16_t hh = __builtin_amdgcn_ds_read_tr16_b64_v4i16((LAS v4i16_t*)(Ks + va1 + kv * 4096));
                        const bf16x8 vf = (bf16x8){lo[0], lo[1], lo[2], lo[3], hh[0], hh[1], hh[2], hh[3]};
                        O[d] = mfma32(vf, pb[kv], O[d]); } }
            }
            const float lt = lsum + __shfl_xor(lsum, 32);
            if (s == 0) { const float inv = 1.0f / lt;
#pragma unroll
                for (int d = 0; d < 4; ++d) o1[d] = O[d] * inv; }
            else { const float inv = lam / lt; float ss = 0.f;
#pragma unroll
                for (int d = 0; d < 4; ++d) { o1[d] = o1[d] - O[d] * inv;
#pragma unroll
                    for (int r = 0; r < 16; ++r) ss += o1[d][r] * o1[d][r]; }
                ss += __shfl_xor(ss, 32);
                const float rn = 0.8f / sqrtf(ss * (1.0f / 128.0f) + EPS);
                bf16_t* orow = Ob + ((size_t)b * SEQ + qb * 256 + w * 32 + r32) * DM + hp * 128 + 4 * hi;
#pragma unroll
                for (int d = 0; d < 4; ++d)
#pragma unroll
                    for (int q = 0; q < 4; ++q) { const f32x4 g4 = *(const f32x4*)(F.in[I_SUBLN] + 32 * d + 8 * q + 4 * hi);
                        u32x2 pk; pk.x = cvt_pk_bf16(o1[d][4 * q] * rn * g4[0], o1[d][4 * q + 1] * rn * g4[1]); pk.y = cvt_pk_bf16(o1[d][4 * q + 2] * rn * g4[2], o1[d][4 * q + 3] * rn * g4[3]);
                        *(u32x2*)(orow + 32 * d + 8 * q) = pk; }
            }
        }
    }
#undef ATT_ISSUE
}
}
namespace hy {
constexpr int FBUF = 4352 * 8;
constexpr int KOFF = 2 * FBUF;
constexpr int KLEN = 2192;
constexpr int RED_OFF = KOFF + 4 * KLEN * 8;
__device__ __forceinline__ int pad(int i) { return i + (i >> 4); }
__device__ __forceinline__ float sgpr_f(float v) { return __int_as_float(__builtin_amdgcn_readfirstlane(__float_as_int(v))); }
typedef f32x2 cx;
#ifndef HY_ASM
#define HY_ASM 3
#endif
#if HY_ASM & 1
__device__ __forceinline__ void c_mul_ip(cx& x, cx w) { cx t;
    asm("v_pk_mul_f32 %1, %0, %2 op_sel_hi:[0,1]\n\tv_pk_fma_f32 %0, %0, %2, %1 op_sel:[1,1,0] op_sel_hi:[1,0,1] neg_lo:[1,0,0]" : "+v"(x), "=&v"(t) : "v"(w)); }
__device__ __forceinline__ cx c_mul(cx x, cx w) { cx y;
    asm("v_pk_mul_f32 %0, %1, %2 op_sel_hi:[0,1]\n\tv_pk_fma_f32 %0, %1, %2, %0 op_sel:[1,1,0] op_sel_hi:[1,0,1] neg_lo:[1,0,0]" : "=&v"(y) : "v"(x), "v"(w)); return y; }
__device__ __forceinline__ void c_mul_sw_ip(cx& x, cx w) { cx t;
    asm("v_pk_mul_f32 %1, %0, %2 op_sel:[0,1] op_sel_hi:[0,0]\n\tv_pk_fma_f32 %0, %0, %2, %1 op_sel:[1,0,0] op_sel_hi:[1,1,1] neg_hi:[1,0,0]" : "+v"(x), "=&v"(t) : "v"(w)); }
__device__ __forceinline__ void c_mul_swc_ip(cx& x, cx w) { cx t;
    asm("v_pk_mul_f32 %1, %0, %2 op_sel:[0,1] op_sel_hi:[0,0]\n\tv_pk_fma_f32 %0, %0, %2, %1 op_sel:[1,0,0] op_sel_hi:[1,1,1] neg_lo:[0,0,1]" : "+v"(x), "=&v"(t) : "v"(w)); }
__device__ __forceinline__ void c_mul_k_ip(cx& x, cx w) { cx t;
    asm("v_pk_mul_f32 %1, %0, %2 op_sel_hi:[0,1]\n\tv_pk_fma_f32 %0, %0, %2, %1 op_sel:[1,1,0] op_sel_hi:[1,0,1] neg_lo:[1,0,0]" : "+v"(x), "=&v"(t) : "s"(w)); }
#else
__device__ __forceinline__ cx c_mul(cx x, cx w) { return (cx){x.x, x.x} * w + (cx){-x.y, x.y} * (cx){w.y, w.x}; }
__device__ __forceinline__ void c_mul_ip(cx& x, cx w) { x = c_mul(x, w); }
__device__ __forceinline__ void c_mul_k_ip(cx& x, cx w) { x = c_mul(x, w); }
__device__ __forceinline__ void c_mul_sw_ip(cx& x, cx w) { x = (cx){x.x, x.x} * (cx){w.y, w.x} + (cx){x.y, -x.y} * w; }
__device__ __forceinline__ void c_mul_swc_ip(cx& x, cx w) { c_mul_sw_ip(x, (cx){w.x, -w.y}); }
#endif
#if HY_ASM & 2
__device__ __forceinline__ cx c_mi(cx a, cx b) { cx d; asm("v_pk_add_f32 %0, %1, %2 op_sel:[0,1] op_sel_hi:[1,0] neg_hi:[0,1]" : "=v"(d) : "v"(a), "v"(b)); return d; }
__device__ __forceinline__ cx c_pi(cx a, cx b) { cx d; asm("v_pk_add_f32 %0, %1, %2 op_sel:[0,1] op_sel_hi:[1,0] neg_lo:[0,1]" : "=v"(d) : "v"(a), "v"(b)); return d; }
#else
__device__ __forceinline__ cx c_mi(cx a, cx b) { return a + (cx){b.y, -b.x}; }
__device__ __forceinline__ cx c_pi(cx a, cx b) { return a + (cx){-b.y, b.x}; }
#endif

__device__ __forceinline__ void dft4(cx& a, cx& b, cx& c, cx& d) {
    const cx s0 = a + c, d0 = a - c, s1 = b + d, d1 = b - d;
    a = s0 + s1; c = s0 - s1; b = c_mi(d0, d1); d = c_pi(d0, d1);
}
__device__ __forceinline__ void dft4_rc(cx& a, cx& b, cx& c, cx& d) {
    const cx s0 = c_mi(a, c), d0 = c_pi(a, c), s1 = b + d, d1 = b - d;
    a = s0 + s1; c = s0 - s1; b = c_mi(d0, d1); d = c_pi(d0, d1);
}
__device__ __forceinline__ void dft16(cx (&x)[16]) {
    constexpr float C1 = 0.9238795325112867f, S1 = 0.3826834323650898f, R = 0.7071067811865476f;
#pragma unroll
    for (int b = 0; b < 4; ++b) dft4(x[b], x[4 + b], x[8 + b], x[12 + b]);
    c_mul_k_ip(x[5], (cx){C1, -S1}); c_mul_k_ip(x[6], (cx){R, -R}); c_mul_k_ip(x[7], (cx){S1, -C1});
    c_mul_k_ip(x[9], (cx){R, -R});   c_mul_k_ip(x[11], (cx){-R, -R});
    c_mul_k_ip(x[13], (cx){S1, -C1}); c_mul_k_ip(x[14], (cx){-R, -R}); c_mul_k_ip(x[15], (cx){-C1, S1});
#pragma unroll
    for (int c = 0; c < 4; ++c) { if (c == 2) dft4_rc(x[8], x[9], x[10], x[11]); else dft4(x[4 * c], x[4 * c + 1], x[4 * c + 2], x[4 * c + 3]); }
    cx y[16];
#pragma unroll
    for (int k = 0; k < 16; ++k) y[k] = x[4 * (k & 3) + (k >> 2)];
#pragma unroll
    for (int k = 0; k < 16; ++k) x[k] = y[k];
}
__device__ __forceinline__ void twiddle_pow(cx (&x)[16], cx w) {
    cx p[16]; p[1] = w;
#pragma unroll
    for (int n = 2; n < 16; ++n) { const int a = n >> 1, b = n - a; p[n] = c_mul(p[a], p[b]); }
#pragma unroll
    for (int n = 1; n < 16; ++n) c_mul_ip(x[n], p[n]);
}
__device__ __forceinline__ void fft4096(cx (&x)[16], LAS f32x2* buf, int uw, int u, const cx w2, const cx w3) {
    dft16(x);
    { LAS f32x2* p = buf + pad(uw);
#pragma unroll
      for (int k = 0; k < 16; ++k) p[272 * k] = x[k]; }
    __syncthreads();
    { LAS f32x2* p = buf + 272 * (u >> 4) + (u & 15);
#pragma unroll
      for (int n = 0; n < 16; ++n) x[n] = *(const volatile LAS f32x2*)(p + 17 * n);
      twiddle_pow(x, w2);
      dft16(x);
#pragma unroll
      for (int k = 0; k < 16; ++k) p[17 * k] = x[k]; }
    __syncthreads();
    { const LAS f32x2* p = buf + 272 * (u >> 4) + 17 * (u & 15);
#pragma unroll
      for (int n = 0; n < 16; ++n) x[n] = *(const volatile LAS f32x2*)(p + n);
      twiddle_pow(x, w3);
      dft16(x); }
}
__device__ __forceinline__ void twiddle_w8192(cx (&x)[16], cx base, bool conj) {
    constexpr float C = 0.9807852804032304f, S = 0.1950903220161283f;
    cx w = conj ? (cx){base.x, -base.y} : base; const cx st = (cx){C, conj ? S : -S};
#pragma unroll
    for (int n = 0; n < 16; ++n) { c_mul_ip(x[n], w); c_mul_ip(w, st); }
}
struct SRow { u32x4 raw; bf16_t l, r; };
__device__ __forceinline__ void sconv_load(const bf16_t* row, int t0, SRow& R) {
    R.raw = *(const u32x4*)(row + t0); R.l = row[t0 > 0 ? t0 - 1 : 0]; R.r = row[t0 + 8 < SEQ ? t0 + 8 : SEQ - 1];
}
__device__ __forceinline__ void sconv_apply(const SRow& R, int t0, const f32x4 wb  , float (&out)[8]) {
    float x[10]; x[0] = t0 > 0 ? bf2f(R.l) : 0.f; x[9] = t0 + 8 < SEQ ? bf2f(R.r) : 0.f;
    x[1] = bflo(R.raw.x); x[2] = bfhi(R.raw.x); x[3] = bflo(R.raw.y); x[4] = bfhi(R.raw.y); x[5] = bflo(R.raw.z); x[6] = bfhi(R.raw.z); x[7] = bflo(R.raw.w); x[8] = bfhi(R.raw.w);
#pragma unroll
    for (int i = 0; i < 8; ++i) out[i] = wb[3] + wb[0] * x[i] + wb[1] * x[i + 1] + wb[2] * x[i + 2];
}

__device__ __forceinline__ void hyena_phase(Frame& F) {
    LAS f32x2* FB0 = (LAS f32x2*)F.lds; LAS f32x2* FB1 = (LAS f32x2*)(F.lds + FBUF);
    LAS f32x2* KH = (LAS f32x2*)(F.lds + KOFF);
    LAS float* red = (LAS float*)(F.lds + RED_OFF);
    const int tid = F.tid, half = tid >> 8, u_ = tid & 255, u1_ = (u_ >> 4) + 16 * (u_ & 15);
    LAS f32x2* myF = half ? FB1 : FB0;
    const float* tab = (const float*)(F.ws + WS_TAB);
    const f32x2* T4096 = (const f32x2*)(tab + TB_T4096); const f32x2* T8A = (const f32x2*)(tab + TB_T8A); const f32x2* T8B = (const f32x2*)(tab + TB_T8B);
#define HY_W8192(dst, idx) f32x2 dst; { const f32x2 a_ = T8A[(idx) & 63], b_ = T8B[(idx) >> 6]; dst = (f32x2){a_.x * b_.x - a_.y * b_.y, a_.x * b_.y + a_.y * b_.x}; }
    const cx tw2 = T4096[16 * (u_ >> 4)], tw3 = T4096[(u_ >> 4) + 16 * (u_ & 15)];
    HY_W8192(twu, u_); HY_W8192(twu1, u1_);
    const float* kraw = (const float*)(F.ws + WS_KRAW);
    const bf16_t* UT = (const bf16_t*)(F.ws + WS_UT); bf16_t* OBT = (bf16_t*)(F.ws + WS_OBT);
    const int j0 = 8 * tid, jp = 8 * tid + (tid >> 1);
    for (int c = F.bid; c < 512; c += F.G) {
        f32x4 wS[3];
#pragma unroll
        for (int s3 = 0; s3 < 3; ++s3) { const float* swp = F.in[I_HYSW] + 512 * s3 + c; wS[s3] = (f32x4){sgpr_f(swp[0]), sgpr_f(swp[1536]), sgpr_f(swp[3072]), sgpr_f(F.in[I_HYSB][512 * s3 + c])}; }
        const float bias0 = sgpr_f(F.in[I_HYBIAS][c]), bias1 = sgpr_f(F.in[I_HYBIAS][512 + c]);
        __syncthreads();
        { float an[2];
#pragma unroll
          for (int o = 0; o < 2; ++o) { const float* fw = kraw + (size_t)(1024 * o + c) * 4096; const float* bw = kraw + (size_t)(1024 * o + 512 + c) * 4096;
              float f[8], g[8];
              { const f32x4 fa = *(const f32x4*)(fw + j0), fb = *(const f32x4*)(fw + j0 + 4);
                const f32x4 ga = *(const f32x4*)(bw + 4088 - j0), gb = *(const f32x4*)(bw + 4092 - j0);
                const float g0 = tid > 0 ? bw[4096 - j0] : 0.f;
                f[0] = fa[0]; f[1] = fa[1]; f[2] = fa[2]; f[3] = fa[3]; f[4] = fb[0]; f[5] = fb[1]; f[6] = fb[2]; f[7] = fb[3];
                g[0] = g0; g[1] = gb[3]; g[2] = gb[2]; g[3] = gb[1]; g[4] = gb[0]; g[5] = ga[3]; g[6] = ga[2]; g[7] = ga[1]; }
              float a = 0.f;
#pragma unroll
              for (int i = 0; i < 8; ++i) { a += fabsf(f[i]) + fabsf(g[i]);
                  ((LAS float*)(FB0 + jp + i))[o] = f[i] + g[i]; ((LAS float*)(FB1 + jp + i))[o] = f[i] - g[i]; }
              an[o] = wave_sum(a);
              asm volatile("" ::: "memory"); }
          if (F.lane == 0) { red[F.wave] = an[0]; red[8 + F.wave] = an[1]; } }
        __syncthreads();
        float nrm0 = 0.f, nrm1 = 0.f;
#pragma unroll
        for (int i = 0; i < 8; ++i) { nrm0 += red[i]; nrm1 += red[8 + i]; }
        const float sc0 = 1.0f / (nrm0 * 8192.0f), sc1 = 1.0f / (nrm1 * 8192.0f);
        cx x[16];
        { int u = u_, u1 = u1_; asm volatile("" : "+v"(u), "+v"(u1));
#pragma unroll
        for (int n = 0; n < 16; ++n) x[n] = (myF + pad(u))[272 * n];
        __syncthreads();
        if (half) twiddle_w8192(x, twu, false);
        fft4096(x, myF, u, u, tw2, tw3);
        __syncthreads();
#pragma unroll
        for (int k = 0; k < 16; ++k) (myF + pad(u1))[272 * k] = x[k]; }
        __syncthreads();
        for (int kk = tid; kk < 2049; kk += 512) {
            { const f32x2 A = FB0[pad(kk)]; f32x2 B = FB0[pad((4096 - kk) & 4095)]; B.y = -B.y;
              KH[0 * KLEN + pad(kk)] = (f32x2){(A.x + B.x) * 0.5f * sc0, (A.y + B.y) * 0.5f * sc0};
              KH[2 * KLEN + pad(kk)] = (f32x2){(A.y - B.y) * 0.5f * sc1, -(A.x - B.x) * 0.5f * sc1}; }
            if (kk < 2048) { const f32x2 A = FB1[pad(kk)]; f32x2 B = FB1[pad(4095 - kk)]; B.y = -B.y;
              KH[1 * KLEN + pad(kk)] = (f32x2){(A.x + B.x) * 0.5f * sc0, (A.y + B.y) * 0.5f * sc0};
              KH[3 * KLEN + pad(kk)] = (f32x2){(A.y - B.y) * 0.5f * sc1, -(A.x - B.x) * 0.5f * sc1}; }
        }
        __syncthreads();
        SRow pv0, pv1, pa0, pa1;
        { const bf16_t* vr = UT + (size_t)c * NTOK; sconv_load(vr, j0, pv0); sconv_load(vr + SEQ, j0, pv1); }
#pragma unroll 1
        for (int bp = 0; bp < 4; ++bp) {
            const size_t rb = (size_t)(2 * bp) * SEQ;
            float zr[8], zi[8], vre[8], vim[8];
            sconv_apply(pv0, j0, wS[0], vre); sconv_apply(pv1, j0, wS[0], vim);
#pragma unroll
            for (int i = 0; i < 8; ++i) (FB0 + jp)[i] = (f32x2){vre[i], vim[i]};
            { const bf16_t* x1r = UT + (size_t)(512 + c) * NTOK + rb; sconv_load(x1r, j0, pa0); sconv_load(x1r + SEQ, j0, pa1); }
            __syncthreads();
#pragma unroll 1
            for (int ord = 0; ord < 2; ++ord) {
                int u = u_, u1 = u1_; asm volatile("" : "+v"(u), "+v"(u1));
#pragma unroll
                for (int n = 0; n < 16; ++n) x[n] = (FB0 + pad(u))[272 * n];
                __syncthreads();
                if (half) twiddle_w8192(x, twu, false);
                fft4096(x, myF, u, u, tw2, tw3);
                { const LAS f32x2* Kp = KH + (2 * ord + half) * KLEN;
                  const LAS f32x2* pf = Kp + pad(u1); const LAS f32x2* pm = Kp + pad((half ? 4095 : 4096) - u1);
#pragma unroll
                  for (int n = 0; n < 8; ++n) c_mul_sw_ip(x[n], pf[272 * n]);
                  { const bool mir = half || u1 > 0; f32x2 kv = *(mir ? pm - 272 * 8 : pf + 272 * 8); if (mir) kv.y = -kv.y; c_mul_sw_ip(x[8], kv); }
#pragma unroll
                  for (int n = 9; n < 16; ++n) c_mul_swc_ip(x[n], *(pm - 272 * n)); }
                __syncthreads();
                fft4096(x, myF, u1, u, tw2, tw3);
                if (half) twiddle_w8192(x, twu1, false);
                __syncthreads();
#pragma unroll
                for (int k = 0; k < 16; ++k) (myF + pad(u1))[272 * k] = x[k];
                __syncthreads();
                if (ord == 0) {
                    { float a0[8];
                      sconv_apply(pa0, j0, wS[1], a0);
#pragma unroll
                      for (int i = 0; i < 8; ++i) { const f32x2 e = (FB0 + jp)[i], o = (FB1 + jp)[i]; zr[i] = a0[i] * (e.y + o.y + bias0 * vre[i]); zi[i] = e.x + o.x + bias0 * vim[i]; } }
                    { float a1[8];
                      sconv_apply(pa1, j0, wS[1], a1);
#pragma unroll
                      for (int i = 0; i < 8; ++i) zi[i] *= a1[i]; }
                    { const bf16_t* x2r = UT + (size_t)(1024 + c) * NTOK + rb; sconv_load(x2r, j0, pa0); sconv_load(x2r + SEQ, j0, pa1);
                      const bf16_t* vn = UT + (size_t)c * NTOK + (size_t)(2 * (bp < 3 ? bp + 1 : 3)) * SEQ; sconv_load(vn, j0, pv0); sconv_load(vn + SEQ, j0, pv1); }
                    __syncthreads();
#pragma unroll
                    for (int i = 0; i < 8; ++i) (FB0 + jp)[i] = (f32x2){zr[i], zi[i]};
                    __syncthreads();
                } else {
                    float a0[8], a1[8], r0[8], r1[8];
                    sconv_apply(pa0, j0, wS[2], a0); sconv_apply(pa1, j0, wS[2], a1);
#pragma unroll
                    for (int i = 0; i < 8; ++i) { const f32x2 e = (FB0 + jp)[i], o = (FB1 + jp)[i];
                        r0[i] = a0[i] * (e.y + o.y + bias1 * zr[i]); r1[i] = a1[i] * (e.x + o.x + bias1 * zi[i]); }
                    u32x4 p0, p1;
                    p0.x = cvt_pk_bf16(r0[0], r0[1]); p0.y = cvt_pk_bf16(r0[2], r0[3]); p0.z = cvt_pk_bf16(r0[4], r0[5]); p0.w = cvt_pk_bf16(r0[6], r0[7]);
                    p1.x = cvt_pk_bf16(r1[0], r1[1]); p1.y = cvt_pk_bf16(r1[2], r1[3]); p1.z = cvt_pk_bf16(r1[4], r1[5]); p1.w = cvt_pk_bf16(r1[6], r1[7]);
                    *(u32x4*)(OBT + (size_t)c * NTOK + rb + j0) = p0; *(u32x4*)(OBT + (size_t)c * NTOK + rb + SEQ + j0) = p1;
                    __syncthreads();
                }
            }
        }
    }
}
#undef HY_W8192
}
template <bool GATH> struct MoeOrder {
    static constexpr bool GATHER = GATH;
    const LAS int* pref;
    int total, G, c, ncol, K;
    const char* A; const char* W; size_t wtile; const int* list;
    __device__ bool next(int i, pg8::Unit& u) const {
        const long L = (long)i * G + c; if (L >= total) return false;
        int id = (int)L; { const int q = total / 8, r = total % 8, xcd = id % 8, off = id / 8; id = (xcd < r ? xcd * (q + 1) : r * (q + 1) + (xcd - r) * q) + off; }
        const int rt = id / ncol, pn = id % ncol;
        int e = 0;
#pragma unroll
        for (int k = 1; k < 32; ++k) e += (pref[k] <= rt) ? 1 : 0;
        u.pm = rt; u.pn = pn; u.aux = e;
        u.a = GATH ? A : A + (size_t)rt * 256 * K * 2; u.b = W + (size_t)e * 3 * MiB + (size_t)pn * wtile;
        return true;
    }
    __device__ __forceinline__ void gather(const pg8::Unit& u, int R0, int R1, unsigned (&v)[2][2]) const {
        const int e = u.aux, j = u.pm - pref[e], cnt = pref[40 + e];
#pragma unroll
        for (int h = 0; h < 2; ++h)
#pragma unroll
            for (int i = 0; i < 2; ++i) { int r = j * 256 + h * 128 + (i ? R1 : R0); r = r < cnt ? r : 0; v[h][i] = (unsigned)(list[e * 32768 + r] >> 1) * (unsigned)(K * 2); }
    }
};

#ifndef MK_PER_PHASE
#define MK_PER_PHASE 0
#endif
constexpr int N_PHASES = 17;

__global__ void __launch_bounds__(NTHREADS, 2) fwd_kernel(Args args) {
    extern __shared__ __attribute__((aligned(16))) unsigned char lds_[];
    const int wave0_ = __builtin_amdgcn_readfirstlane((int)threadIdx.x >> 6);
#define MKFRAME(F) Frame F; { int t_ = wave0_ * 64 + (int)__builtin_amdgcn_mbcnt_hi(~0u, __builtin_amdgcn_mbcnt_lo(~0u, 0u)); asm volatile("" : "+v"(t_)); F.lds = (LAS unsigned char*)lds_; F.tid = t_; F.lane = t_ & 63; F.wave = __builtin_amdgcn_readfirstlane(t_ >> 6); \
        F.G = gridDim.x; F.bid = blockIdx.x; F.in = args.in; F.out = args.out; F.ws = args.ws; }
    volatile LAS unsigned* MISC = (volatile LAS unsigned*)((LAS unsigned char*)lds_ + MISC_OFF);
    if (threadIdx.x < 128) MISC[threadIdx.x] = 0u;
    __syncthreads();
    unsigned* ctl = (unsigned*)(args.ws + WS_CTL);
#define lo (args.ph_lo)
#define hi (args.ph_hi)
    if (hi - lo > 1) (void)xcd_barrier_post(ctl + CW_BAR, MISC, threadIdx.x == 0);
#ifndef PH_MASK
#define PH_MASK 0xFFFFFFFFu
#endif
#define IN(k) (lo <= (k) && (k) < hi)
#ifndef DUP_PHASE
#define DUP_PHASE -1
#endif
#define REP(k) _Pragma("unroll") for (int rep_ = 0; rep_ < ((DUP_PHASE) == (k) ? 2 : 1); ++rep_)
#ifdef TPROBE
    const unsigned long long t_start_ = __builtin_amdgcn_s_memrealtime(); unsigned long long t_mark_ = 0ull;
#define TMARK(k) do { if ((k) == (TPROBE)) t_mark_ = __builtin_amdgcn_s_memrealtime() - t_start_; } while (0)
#else
#define TMARK(k) do { } while (0)
#endif
#define SEAM(k) do { if (IN(k) && IN((k) + 1)) { XcdBarrier bar_; bar_.bar = (unsigned*)(args.ws + WS_CTL) + CW_BAR; bar_.x = xb_xcc_id(); bar_.st = (volatile LAS unsigned*)((LAS unsigned char*)lds_ + MISC_OFF); \
        xcd_barrier(bar_, wave0_ == 0 && __builtin_amdgcn_mbcnt_hi(~0u, __builtin_amdgcn_mbcnt_lo(~0u, 0u)) == 0u); } TMARK(k); } while (0)
#define WSP (args.ws)
#define mod0 ((const float*)(args.ws + WS_MOD))
#define mod1 (mod0 + 9 * 6144)
#define tab ((const float*)(args.ws + WS_TAB))

    if (IN(0)) { MKFRAME(F); p0_prologue(F, (unsigned*)(args.ws + WS_CTL) + CW_Q0, (volatile LAS unsigned*)((LAS unsigned char*)lds_ + MISC_OFF) + 4); }
    SEAM(0);
    if (IN(1)) REP(1) { MKFRAME(F); p1_norm_in(F); }
    SEAM(1);
    if (IN(2)) REP(2) { MKFRAME(F);
        { pg8::StaticOrder S; S.init(WSP + WS_BUF0, WSP + WS_WQKVH, NTOK, 1536, 1024, F.G, F.bid);
          pg8::EpiQKV E{(bf16_t*)(WSP + WS_Q), (bf16_t*)(WSP + WS_K), (bf16_t*)(WSP + WS_V), tab + TB_ROPE_C, tab + TB_ROPE_S};
          pg8::gemm_phase(F.lds, F.tid, 1024, S, E); }
        { pg8::StaticOrder S; S.init(WSP + WS_WQKVH + (size_t)1536 * 1024 * 2, WSP + WS_BUF0, 1536, NTOK, 1024, F.G, F.bid);
          pg8::EpiBf16 E{(bf16_t*)(WSP + WS_UT), (size_t)NTOK};
          pg8::gemm_phase(F.lds, F.tid, 1024, S, E); }
        { pg8::StaticOrder S; S.init(WSP + WS_OBT, WSP + WS_WQKVH + (size_t)512 * 1024 * 2, NB * CTXL, 1024, 1024, F.G, F.bid);
          pg8::EpiCtxKV E{(bf16_t*)(WSP + WS_K), (bf16_t*)(WSP + WS_V)};
          pg8::gemm_phase(F.lds, F.tid, 1024, S, E); }
    }
    SEAM(2);
    if (IN(3)) {
#ifndef NO_ATTN
        { MKFRAME(F); att::attn_phase(F); } __syncthreads();
#ifdef DUP_ATTN
        { MKFRAME(F); att::attn_phase(F); } __syncthreads();
#endif
#else
        { MKFRAME(F); bf16_t* o = (bf16_t*)(F.ws + WS_BUF0); for (size_t i = (size_t)F.bid * NTHREADS + F.tid; i < (size_t)NTOK * 64; i += (size_t)F.G * NTHREADS) { const size_t r = i >> 6, c8 = i & 63; *(u32x4*)(o + r * DM + c8 * 8) = (u32x4){0u, 0u, 0u, 0u}; } }
#endif
#ifndef NO_HYENA
        { MKFRAME(F); hy::hyena_phase(F); }
#ifdef DUP_HYENA
        __syncthreads(); { MKFRAME(F); hy::hyena_phase(F); }
#endif
#else
        { MKFRAME(F); bf16_t* o = (bf16_t*)(F.ws + WS_OBT); for (size_t i = (size_t)F.bid * NTHREADS + F.tid; i < (size_t)512 * NTOK / 8; i += (size_t)F.G * NTHREADS) *(u32x4*)(o + i * 8) = (u32x4){0u, 0u, 0u, 0u}; }
#endif
    }
    SEAM(3);
    if (IN(4)) REP(4) { MKFRAME(F); transpose_ob(F); }
    SEAM(4);
    if (IN(5)) REP(5) { MKFRAME(F);
        pg8::StaticOrder S; S.init(WSP + WS_BUF0, WSP + WS_WO, NTOK, 1024, 1024, F.G, F.bid);
        pg8::EpiResid<true> E{F.in[I_X], (bf16_t*)(WSP + WS_X), mod0 + 2 * 1024, nullptr};
        pg8::gemm_phase(F.lds, F.tid, 1024, S, E);
    }
    SEAM(5);
        if (IN(6 + 0)) { MKFRAME(F); moe_front(F, 0); }
        SEAM(6 + 0);
        if (IN(6 + 1)) REP(9) { MKFRAME(F);
            moe_prefix(F, 0, (LAS int*)((LAS unsigned char*)lds_ + MISC_OFF + 64));
            MoeOrder<true> S; LAS int* pref = (LAS int*)((LAS unsigned char*)lds_ + MISC_OFF + 64); S.pref = pref; S.total = pref[32] * 4; S.G = F.G; S.c = F.bid; S.ncol = 4; S.K = 512;
            S.A = (const char*)(WSP + WS_BUF0); S.W = (const char*)(WSP + WS_WMOE + (size_t)0 * 32 * 3 * MiB); S.wtile = (size_t)256 * 512 * 2; S.list = (const int*)(WSP + WS_LIST);
            pg8::EpiGated<2> E{(bf16_t*)(WSP + WS_H), (size_t)512, nullptr, nullptr};
            pg8::gemm_phase<pg8::EpiGated<2>, MoeOrder<true>, true, 127, 122>(F.lds, F.tid, 512, S, E);
        }
        SEAM(6 + 1);
        if (IN(6 + 2)) REP(10) { MKFRAME(F);
            moe_prefix(F, 0, (LAS int*)((LAS unsigned char*)lds_ + MISC_OFF + 64));
            MoeOrder<false> S; LAS int* pref = (LAS int*)((LAS unsigned char*)lds_ + MISC_OFF + 64); S.pref = pref; S.total = pref[32] * 4; S.G = F.G; S.c = F.bid; S.ncol = 4; S.K = 256;
            S.A = (const char*)(WSP + WS_H); S.W = (const char*)(WSP + WS_WMOE + (size_t)0 * 32 * 3 * MiB + 2 * MiB); S.wtile = (size_t)256 * 256 * 2; S.list = nullptr;
            pg8::EpiScatter E{(bf16_t*)(WSP + WS_BUF0), (bf16_t*)(WSP + WS_Y1), (const int*)(WSP + WS_LIST), pref};
            pg8::gemm_phase<pg8::EpiScatter, MoeOrder<false>, true, 127, 122>(F.lds, F.tid, 256, S, E);
        }
        SEAM(6 + 2);
        if (IN(6 + 3)) {
            MKFRAME(F); moe_combine<0>(F, 0);
        }
        SEAM(6 + 3);

            if (IN(10)) REP(12) { MKFRAME(F);
                pg8::StaticOrder S; S.init(WSP + WS_BUF0, WSP + WS_WC1, NTOK, 2048, CONF_FP8 ? 512 : 1024, F.G, F.bid);
                pg8::EpiGated<1> E{(bf16_t*)(WSP + WS_GLU), (size_t)1024, F.in[I_CVB1], F.in[I_CVB1] + 1024};
                pg8::gemm_phase<pg8::EpiGated<1>, pg8::StaticOrder, CONF_FP8 != 0, 127, CONF_FP8 ? 122 : 127>(F.lds, F.tid, CONF_FP8 ? 512 : 1024, S, E);
            }
            SEAM(10);
            if (IN(11)) REP(13) { MKFRAME(F); conv_ln_phase(F); }
            SEAM(11);
            if (IN(12)) { MKFRAME(F);
                pg8::StaticOrder S; S.init(WSP + WS_BUF0, WSP + WS_WC2, NTOK, 1024, CONF_FP8 ? 512 : 1024, F.G, F.bid);
                pg8::EpiResid<false> E{WSP + WS_X, (bf16_t*)(WSP + WS_X), mod1 + 2 * 1024, F.in[I_CVB2]};
                pg8::gemm_phase<pg8::EpiResid<false>, pg8::StaticOrder, CONF_FP8 != 0, 127, CONF_FP8 ? 122 : 127>(F.lds, F.tid, CONF_FP8 ? 512 : 1024, S, E);
            }
            SEAM(12);
        if (IN(13 + 0)) { MKFRAME(F); moe_front(F, 1); }
        SEAM(13 + 0);
        if (IN(13 + 1)) REP(9) { MKFRAME(F);
            moe_prefix(F, 1, (LAS int*)((LAS unsigned char*)lds_ + MISC_OFF + 64));
            MoeOrder<true> S; LAS int* pref = (LAS int*)((LAS unsigned char*)lds_ + MISC_OFF + 64); S.pref = pref; S.total = pref[32] * 4; S.G = F.G; S.c = F.bid; S.ncol = 4; S.K = 512;
            S.A = (const char*)(WSP + WS_BUF0); S.W = (const char*)(WSP + WS_WMOE + (size_t)1 * 32 * 3 * MiB); S.wtile = (size_t)256 * 512 * 2; S.list = (const int*)(WSP + WS_LIST);
            pg8::EpiGated<2> E{(bf16_t*)(WSP + WS_H), (size_t)512, nullptr, nullptr};
            pg8::gemm_phase<pg8::EpiGated<2>, MoeOrder<true>, true, 127, 122>(F.lds, F.tid, 512, S, E);
        }
        SEAM(13 + 1);
        if (IN(13 + 2)) REP(10) { MKFRAME(F);
            moe_prefix(F, 1, (LAS int*)((LAS unsigned char*)lds_ + MISC_OFF + 64));
            MoeOrder<false> S; LAS int* pref = (LAS int*)((LAS unsigned char*)lds_ + MISC_OFF + 64); S.pref = pref; S.total = pref[32] * 4; S.G = F.G; S.c = F.bid; S.ncol = 4; S.K = 256;
            S.A = (const char*)(WSP + WS_H); S.W = (const char*)(WSP + WS_WMOE + (size_t)1 * 32 * 3 * MiB + 2 * MiB); S.wtile = (size_t)256 * 256 * 2; S.list = nullptr;
            pg8::EpiScatter E{(bf16_t*)(WSP + WS_BUF0), (bf16_t*)(WSP + WS_Y1), (const int*)(WSP + WS_LIST), pref};
            pg8::gemm_phase<pg8::EpiScatter, MoeOrder<false>, true, 127, 122>(F.lds, F.tid, 256, S, E);
        }
        SEAM(13 + 2);
        if (IN(13 + 3)) {
            MKFRAME(F); moe_combine<1>(F, 1);
        }

#ifdef TPROBE
    if (blockIdx.x == 0 && threadIdx.x == 0) { const unsigned long long t1 = __builtin_amdgcn_s_memrealtime(); while (__builtin_amdgcn_s_memrealtime() - t1 < 4ull * t_mark_) __builtin_amdgcn_s_sleep(8); }
#endif
#undef IN
#undef SEAM
#undef lo
#undef hi
#undef WSP
#undef mod0
#undef mod1
#undef tab
#undef MKFRAME
}

extern "C" void kernel_launch(void* const* d_in, const int* in_sizes, int n_in, void* d_out, int out_size, void* d_ws, size_t ws_size, hipStream_t stream) {
    static int grid = 0;
    if (grid == 0) {
        if (n_in != N_IN || out_size != NTOK * DM || ws_size < WS_END) { grid = -1; return; }
        int dev = 0, cus = 0, per_cu = 0;
        if (hipGetDevice(&dev) != hipSuccess || hipDeviceGetAttribute(&cus, hipDeviceAttributeMultiprocessorCount, dev) != hipSuccess) { grid = -1; return; }
        if (hipFuncSetAttribute((const void*)fwd_kernel, hipFuncAttributeMaxDynamicSharedMemorySize, LDS_BYTES) != hipSuccess) { grid = -1; return; }
        (void)hipOccupancyMaxActiveBlocksPerMultiprocessor(&per_cu, (const void*)fwd_kernel, NTHREADS, LDS_BYTES);
        (void)hipGetLastError();
        grid = cus;
    }
    if (grid < 0) return;
    (void)hipMemsetAsync((char*)d_ws + WS_CTL, 0, CTL_ZERO_BYTES, stream);
    Args a{};
    for (int i = 0; i < N_IN; ++i) a.in[i] = (const float*)d_in[i];
    a.out = (float*)d_out; a.ws = (unsigned char*)d_ws;
#if MK_PER_PHASE
    for (int p = 0; p < N_PHASES; ++p) { a.ph_lo = p; a.ph_hi = p + 1; hipLaunchKernelGGL(fwd_kernel, dim3(grid), dim3(NTHREADS), LDS_BYTES, stream, a); }
#else
    a.ph_lo = 0; a.ph_hi = N_PHASES;
    hipLaunchKernelGGL(fwd_kernel, dim3(grid), dim3(NTHREADS), LDS_BYTES, stream, a);
#endif
}
```

```cpp
#define CONF_FP8 1
#define OUT_FP8 1
#include <hip/hip_runtime.h>
#include <stdint.h>
#include <math.h>

#define LAS __attribute__((address_space(3)))
#define GAS __attribute__((address_space(1)))
typedef unsigned short bf16_t;
typedef short bf16x8 __attribute__((ext_vector_type(8)));
typedef short s16x4 __attribute__((ext_vector_type(4)));
typedef float f32x2 __attribute__((ext_vector_type(2)));
typedef float f32x4 __attribute__((ext_vector_type(4)));
typedef float f32x16 __attribute__((ext_vector_type(16)));
typedef unsigned u32x2 __attribute__((ext_vector_type(2)));
typedef unsigned u32x4 __attribute__((ext_vector_type(4)));

constexpr int DM = 1024, NB = 8, SEQ = 4096, NTOK = NB * SEQ, CTXL = 256, LKV = CTXL + SEQ;
constexpr int NEXP = 32, DEXP = 512, SLOT_ROWS = 73728;
constexpr float EPS = 1e-6f;
constexpr float QSCALE = 0.125f * 1.4426950408889634f;

constexpr size_t MiB = 1u << 20;
constexpr size_t WS_CTL = 0, CTL_ZERO_BYTES = 1 * MiB;
constexpr size_t WS_MOD = 1 * MiB;
constexpr size_t WS_TAB = 2 * MiB;
constexpr size_t WS_TOK = 3 * MiB;
constexpr size_t WS_LIST = 4 * MiB;
constexpr size_t WS_LOGIT = 8 * MiB;
constexpr size_t WS_KRAW = 16 * MiB;
constexpr size_t WS_WR = 48 * MiB;
constexpr size_t WS_WQKVH = 50 * MiB;
constexpr size_t WS_WO = 56 * MiB;
constexpr size_t WS_WC1 = 58 * MiB;
constexpr size_t WS_WC2 = 62 * MiB;
constexpr size_t WS_WMOE = 64 * MiB;
constexpr size_t WS_BUF0 = 256 * MiB;
constexpr size_t WS_Q = 320 * MiB;
constexpr size_t WS_K = 352 * MiB;
constexpr size_t WS_V = 386 * MiB;
constexpr size_t WS_UT = 420 * MiB;
constexpr size_t WS_OBT = 516 * MiB;
constexpr size_t WS_X = 320 * MiB;
constexpr size_t WS_H = 448 * MiB;
constexpr size_t WS_Y1 = 520 * MiB;
constexpr size_t WS_GLU = 448 * MiB;
constexpr size_t WS_Y0 = 384 * MiB;
constexpr size_t WS_END = 585 * MiB;

constexpr int CW_TMO = 0;
constexpr int CW_BAR = 4096;
constexpr int CW_Q0 = 2048;
constexpr int CW_CNT = 8192;
constexpr int CW_RT = 16384;
constexpr int TB_ROPE_C = 0, TB_ROPE_S = 1024, TB_T4096 = 2048  , TB_T8A = 2560  , TB_T8B = 2688  , TB_LAM = 2816;

constexpr int RING_BYTES = 131072;
constexpr int MISC_OFF = 144384;
constexpr int LDS_BYTES = 147456;
constexpr int NWAVES = 8, NTHREADS = 512;

#define RLX_AGENT __ATOMIC_RELAXED, __HIP_MEMORY_SCOPE_AGENT
#define LDS_WAIT() asm volatile("s_waitcnt lgkmcnt(0)" ::: "memory")
#define VM_WAIT() asm volatile("s_waitcnt vmcnt(0)" ::: "memory")

__device__ __forceinline__ unsigned cvt_pk_bf16(float lo, float hi) { unsigned r; asm volatile("v_cvt_pk_bf16_f32 %0, %1, %2" : "=v"(r) : "v"(lo), "v"(hi)); return r; }
__device__ __forceinline__ float bf2f(bf16_t v) { return __uint_as_float((unsigned)v << 16); }
__device__ __forceinline__ float bflo(unsigned v) { return __uint_as_float(v << 16); }
__device__ __forceinline__ float bfhi(unsigned v) { return __uint_as_float(v & 0xffff0000u); }
__device__ __forceinline__ float wave_sum(float v) {
    v += __int_as_float(__builtin_amdgcn_update_dpp(0, __float_as_int(v), 0xB1, 0xF, 0xF, true));
    v += __int_as_float(__builtin_amdgcn_update_dpp(0, __float_as_int(v), 0x4E, 0xF, 0xF, true));
    v += __int_as_float(__builtin_amdgcn_update_dpp(0, __float_as_int(v), 0x141, 0xF, 0xF, true));
    v += __int_as_float(__builtin_amdgcn_update_dpp(0, __float_as_int(v), 0x140, 0xF, 0xF, true));
    const int vi = __float_as_int(v);
    return (__int_as_float(__builtin_amdgcn_readlane(vi, 0)) + __int_as_float(__builtin_amdgcn_readlane(vi, 16)))
         + (__int_as_float(__builtin_amdgcn_readlane(vi, 32)) + __int_as_float(__builtin_amdgcn_readlane(vi, 48)));
}
__device__ __forceinline__ float sigmoid_f(float v) { return __builtin_amdgcn_rcpf(1.0f + __builtin_amdgcn_exp2f(-1.4426950408889634f * v)); }
__device__ __forceinline__ float silu_f(float v) { return v * sigmoid_f(v); }

#define XB_TMO      128
#define XB_XCNT(j)  (256  + 64 * (j))
#define XB_XSUB(j)  (1280 + 64 * (j))
#define XB_XGEN(j)  (2304 + 64 * (j))
#define XB_TOP      3328
#define XB_TOPGEN   3392
#define XCD_BAR_WORDS 3456
#define XB_SPIN_CAP (1u << 20)

__device__ __forceinline__ unsigned xb_ld(unsigned* p)              { return __hip_atomic_load(p, __ATOMIC_RELAXED, __HIP_MEMORY_SCOPE_AGENT); }
__device__ __forceinline__ unsigned xb_add(unsigned* p, unsigned v) { return __hip_atomic_fetch_add(p, v, __ATOMIC_RELAXED, __HIP_MEMORY_SCOPE_AGENT); }
__device__ __forceinline__ unsigned xb_xcc_id() { return (unsigned)__builtin_amdgcn_s_getreg((3 << 11) | 20) & 0xFu; }
#define XB_SPIN(cond, bar) do { unsigned _sp = 0; while (cond) { __builtin_amdgcn_s_sleep(1); \
    if ((++_sp & 255u) == 0u) { if (xb_ld(&(bar)[XB_TMO])) break; if (_sp > XB_SPIN_CAP) { atomicAdd(&(bar)[XB_TMO], 1u); break; } } } } while (0)

struct XcdBarrier { unsigned* bar; unsigned x; volatile LAS unsigned* st; };

__device__ __forceinline__ XcdBarrier xcd_barrier_post(unsigned* bar, volatile LAS unsigned* st, bool leader  ) {
    XcdBarrier b; b.bar = bar; b.x = xb_xcc_id(); b.st = st;
    if (leader) (void)xb_add(&bar[XB_XCNT(b.x)], 1u);
    return b;
}
__device__ __forceinline__ void xcd_barrier_complete(unsigned* bar, unsigned x, unsigned& nloc, unsigned& nx) {
    const unsigned G = gridDim.x * gridDim.y * gridDim.z;
    unsigned sum, cnt, mine, sp = 0u;
    for (;;) {
        sum = 0u; cnt = 0u; mine = 0u;
#pragma unroll
        for (unsigned j = 0; j < 16; ++j) { const unsigned c = xb_ld(&bar[XB_XCNT(j)]); sum += c; cnt += (c > 0u) ? 1u : 0u; mine = (j == x) ? c : mine; }
        if (sum == G) break;
        __builtin_amdgcn_s_sleep(1);
        if ((++sp & 255u) == 0u) { if (xb_ld(&bar[XB_TMO])) break; if (sp > XB_SPIN_CAP) { atomicAdd(&bar[XB_TMO], 1u); break; } }
    }
    nloc = mine > 0u ? mine : 1u; nx = cnt > 0u ? cnt : 1u;
}
__device__ __forceinline__ void xcd_barrier(const XcdBarrier& b, bool leader  ) {
    asm volatile("s_waitcnt vmcnt(0)" ::: "memory");
    __syncthreads();
    if (leader) {
        unsigned* bar = b.bar;
        __builtin_amdgcn_s_waitcnt(0);
        unsigned nloc = b.st[0], nx = b.st[1];
        if (nloc == 0u) { xcd_barrier_complete(bar, b.x, nloc, nx); b.st[0] = nloc; b.st[1] = nx; }
        const unsigned old = xb_add(&bar[XB_XSUB(b.x)], 1u);
        const unsigned gen = old / nloc;
        if (old + 1u == (gen + 1u) * nloc) {
            __builtin_amdgcn_fence(__ATOMIC_RELEASE, "agent");
            asm volatile("s_waitcnt vmcnt(0)" ::: "memory");
            const unsigned og = xb_add(&bar[XB_TOP], 1u);
            const unsigned tg = og / nx;
            if (og + 1u == (tg + 1u) * nx) xb_add(&bar[XB_TOPGEN], 1u);
            else XB_SPIN(xb_ld(&bar[XB_TOPGEN]) == tg, bar);
            __builtin_amdgcn_fence(__ATOMIC_ACQUIRE, "agent");
            xb_add(&bar[XB_XGEN(b.x)], 1u);
            asm volatile("s_waitcnt vmcnt(0)" ::: "memory");
        } else {
            XB_SPIN(xb_ld(&bar[XB_XGEN(b.x)]) == gen, bar);
            __builtin_amdgcn_fence(__ATOMIC_ACQUIRE, "agent");
            asm volatile("s_waitcnt vmcnt(0)" ::: "memory");
        }
    }
    __syncthreads();
}
namespace pg8 {
constexpr int BM = 256, BK = 64, HALF = 128, HTB = HALF * BK * 2, STAGE_BYTES = 8 * HTB, NXCD = 8, WGM = 8;

__host__ __device__ __forceinline__ int lds_byte(int r, int c) { const int st = (r >> 4) * 2 + (c >> 5), rr = r & 15, cc = c & 31, ob = rr * 64 + cc * 2; return st * 1024 + (ob ^ (((ob >> 9) & 1) << 5)); }
__host__ __device__ __forceinline__ void stage_rc(int b, int& R, int& C) { const int st = b / 1024, sb = b % 1024, swz = sb ^ (((sb >> 9) & 1) << 5); R = (st >> 1) * 16 + swz / 64; C = (st & 1) * 32 + (swz % 64) / 2; }
__host__ __device__ __forceinline__ int perm32(int rho) { const int n = rho >> 4, i = rho & 15; return 8 * (i >> 2) + 4 * n + (i & 3); }

struct Unit { int pm, pn; const char* a; const char* b; int aux; };

struct StaticOrder {
    static constexpr bool GATHER = false; static constexpr bool HOOK = false;
    int nM, nN, nwg, G, c; const char* A; const char* Bt; size_t tstep;
    __device__ void init(const void* A_, const void* Bt_, int M, int N, int K, int G_, int c_) { A = (const char*)A_; Bt = (const char*)Bt_; nM = M / BM; nN = N / BM; nwg = nM * nN; G = G_; c = c_; tstep = (size_t)BM * K * 2; }
    __device__ bool next(int i, Unit& u) const {
        const long L = (long)i * G + c; if (L >= nwg) return false;
        int wgid = (int)L; { const int q = nwg / NXCD, r = nwg % NXCD, xcd = wgid % NXCD, off = wgid / NXCD; wgid = (xcd < r ? xcd * (q + 1) : r * (q + 1) + (xcd - r) * q) + off; }
        const int nig = WGM * nN, gid = wgid / nig, fm = gid * WGM, gsz = (nM - fm) < WGM ? (nM - fm) : WGM;
        u.pm = fm + ((wgid % nig) % gsz); u.pn = (wgid % nig) / gsz; u.a = A + (size_t)u.pm * tstep; u.b = Bt + (size_t)u.pn * tstep; u.aux = 0; return true;
    }
    __device__ __forceinline__ void gather(const Unit&, int, int, unsigned (&)[2][2]) const {}
};

template <class Epi, class Sched, bool FP8 = false, int SCA = 127, int SCB = 127>
__device__ __forceinline__ void gemm_phase(LAS unsigned char* lds, int tid, const int K, const Sched& S, const Epi& E) {
    asm volatile("" : "+v"(tid));
    const int wid = __builtin_amdgcn_readfirstlane(tid >> 6), lane = tid & 63, wr = wid >> 2, wc = wid & 3, fr = lane & 15, fq = lane >> 4;
    const int nt = K / BK;
    const size_t kstep = (size_t)(BK * 2);
    const size_t hstep = (size_t)HALF * K * 2;
    int Rr[2], Cc[2];
    unsigned voffB[2];
#pragma unroll
    for (int i = 0; i < 2; ++i) { int R, C; stage_rc(tid * 16 + i * 8192, R, C); Rr[i] = R; Cc[i] = C; const int Rb = Epi::PERM ? ((R & ~31) + perm32(R & 31)) : R; voffB[i] = (unsigned)(Rb * K + C) * 2u; }
    unsigned vAc[2][2], vAn[2][2];
#pragma unroll
    for (int h = 0; h < 2; ++h)
#pragma unroll
        for (int i = 0; i < 2; ++i) { vAc[h][i] = (unsigned)((h * HALF + Rr[i]) * K + Cc[i]) * 2u; vAn[h][i] = vAc[h][i]; }
    const unsigned ldsw = (unsigned)wid * 1024u;
    const int aoff = lds_byte(wr * 64 + fr, fq * 8), boff = lds_byte(wc * 32 + fr, fq * 8);
#define PG8_SA(b, h) (((b) * 2 + (h)) * HTB)
#define PG8_SB(b, h) ((4 + (b) * 2 + (h)) * HTB)
#define PG8_STAGE_B(bufoff, gbase) do { _Pragma("unroll") for (int _i = 0; _i < 2; ++_i) \
        __builtin_amdgcn_global_load_lds((const unsigned*)((const char*)(gbase) + voffB[_i]), (LAS unsigned*)(lds + (bufoff) + ldsw + _i * 8192), 16, 0, 0); } while (0)
#define PG8_STAGE_A(bufoff, gbase, V, h) do { _Pragma("unroll") for (int _i = 0; _i < 2; ++_i) \
        __builtin_amdgcn_global_load_lds((const unsigned*)((const char*)(gbase) + (V)[h][_i]), (LAS unsigned*)(lds + (bufoff) + ldsw + _i * 8192), 16, 0, 0); } while (0)
#define PG8_LDA(dst, b, h) do { _Pragma("unroll") for (int m = 0; m < 4; ++m) { if constexpr (FP8) { const i32x4_ x0_ = *(const LAS i32x4_*)(lds + PG8_SA(b, h) + aoff + m * 2048), x1_ = *(const LAS i32x4_*)(lds + PG8_SA(b, h) + aoff + m * 2048 + 1024); \
            dst##8[m] = __builtin_shufflevector(x0_, x1_, 0, 1, 2, 3, 4, 5, 6, 7); } else { _Pragma("unroll") for (int k = 0; k < 2; ++k) dst[m][k] = *(const LAS bf16x8*)(lds + PG8_SA(b, h) + aoff + m * 2048 + k * 1024); } } } while (0)
#define PG8_LDB(dst, b, h) do { _Pragma("unroll") for (int n = 0; n < 2; ++n) { if constexpr (FP8) { const i32x4_ x0_ = *(const LAS i32x4_*)(lds + PG8_SB(b, h) + boff + n * 2048), x1_ = *(const LAS i32x4_*)(lds + PG8_SB(b, h) + boff + n * 2048 + 1024); \
            dst##8[n] = __builtin_shufflevector(x0_, x1_, 0, 1, 2, 3, 4, 5, 6, 7); } else { _Pragma("unroll") for (int k = 0; k < 2; ++k) dst[n][k] = *(const LAS bf16x8*)(lds + PG8_SB(b, h) + boff + n * 2048 + k * 1024); } } } while (0)
#define PG8_MMA(ai, bj, At, Bt) do { __builtin_amdgcn_s_setprio(1); _Pragma("unroll") for (int m = 0; m < 4; ++m) _Pragma("unroll") for (int n = 0; n < 2; ++n) { \
        if constexpr (FP8) asm volatile("v_mfma_scale_f32_16x16x128_f8f6f4 %0, %1, %2, %0, %3, %4 op_sel_hi:[0,0,0]" : "+v"(acc[ai][bj][m][n]) : "v"(Bt##8[n]), "v"(At##8[m]), "v"(sca_), "v"(scb_)); \
        else { _Pragma("unroll") for (int k = 0; k < 2; ++k) acc[ai][bj][m][n] = __builtin_amdgcn_mfma_f32_16x16x32_bf16(Bt[n][k], At[m][k], acc[ai][bj][m][n], 0, 0, 0); } } \
        __builtin_amdgcn_s_setprio(0); } while (0)
#define PG8_WAIT_V(n) asm volatile("s_waitcnt vmcnt(" #n ")" ::: "memory")
#define PG8_WAIT_L(n) asm volatile("s_waitcnt lgkmcnt(" #n ")" ::: "memory")
#define PG8_BAR __builtin_amdgcn_s_barrier()
#define PG8_SCHED __builtin_amdgcn_sched_barrier(0)
    Unit cur, nxt; int ui = 0;
    if (!S.next(0, cur)) return;
    if constexpr (Sched::HOOK) S.a_wait(cur, S.a_peek(cur, wid, lane), wid, lane);
    if constexpr (Sched::GATHER) { S.gather(cur, Rr[0], Rr[1], vAc);
#pragma unroll
        for (int h = 0; h < 2; ++h)
#pragma unroll
            for (int i = 0; i < 2; ++i) vAc[h][i] += (unsigned)Cc[i] * 2u; }
    f32x4 acc[2][2][4][2];
#pragma unroll
    for (int a = 0; a < 2; ++a)
#pragma unroll
        for (int b = 0; b < 2; ++b)
#pragma unroll
            for (int m = 0; m < 4; ++m)
#pragma unroll
                for (int n = 0; n < 2; ++n) acc[a][b][m][n] = (f32x4){0.f, 0.f, 0.f, 0.f};
    typedef int i32x4_ __attribute__((ext_vector_type(4))); typedef int i32x8_ __attribute__((ext_vector_type(8)));
    bf16x8 At[4][2], B0[2][2], B1[2][2];
    i32x8_ At8[4], B08[2], B18[2]; const int sca_ = SCA * 0x01010101, scb_ = SCB * 0x01010101;
    const char* cA = cur.a; const char* cB = cur.b;
    PG8_STAGE_B(PG8_SB(0, 0), cB); PG8_STAGE_B(PG8_SB(0, 1), cB + hstep); PG8_STAGE_A(PG8_SA(0, 0), cA, vAc, 0); PG8_STAGE_A(PG8_SA(0, 1), cA, vAc, 1);
    if (wr == 1) PG8_BAR;
    PG8_WAIT_V(2); PG8_BAR;
    PG8_STAGE_B(PG8_SB(1, 0), cB + kstep); PG8_STAGE_A(PG8_SA(1, 0), cA + kstep, vAc, 0); PG8_STAGE_B(PG8_SB(1, 1), cB + hstep + kstep);
    PG8_WAIT_V(6); PG8_BAR;
    for (;;) {
        const bool has_next = S.next(ui + 1, nxt);
        if constexpr (Sched::GATHER) { if (has_next) { S.gather(nxt, Rr[0], Rr[1], vAn);
#pragma unroll
            for (int h = 0; h < 2; ++h)
#pragma unroll
                for (int i = 0; i < 2; ++i) vAn[h][i] += (unsigned)Cc[i] * 2u; } else {
#pragma unroll
            for (int h = 0; h < 2; ++h)
#pragma unroll
                for (int i = 0; i < 2; ++i) vAn[h][i] = vAc[h][i]; } }
        const char* nA = has_next ? nxt.a : cA; const char* nB = has_next ? nxt.b : cB;
        unsigned peek_ = 0u; if constexpr (Sched::HOOK) { if (has_next) peek_ = S.a_peek(nxt, wid, lane); }
        for (int t = 0; t < nt; t += 2) {
            const bool last = (t == nt - 2);
            if constexpr (Sched::HOOK) { if (last && has_next) S.a_wait(nxt, peek_, wid, lane); }
            const char* a1 = cA + (size_t)(t + 1) * kstep;
            const char* a2 = last ? nA : cA + (size_t)(t + 2) * kstep; const char* b2 = last ? nB : cB + (size_t)(t + 2) * kstep;
            const char* a3 = a2 + kstep; const char* b3 = b2 + kstep;
            unsigned v2[2][2];
#pragma unroll
            for (int h = 0; h < 2; ++h)
#pragma unroll
                for (int i = 0; i < 2; ++i) v2[h][i] = (Sched::GATHER && last) ? vAn[h][i] : vAc[h][i];
            PG8_LDB(B0, 0, 0); PG8_LDB(B1, 0, 1); PG8_SCHED; PG8_LDA(At, 0, 0); PG8_STAGE_A(PG8_SA(1, 1), a1, vAc, 1);
            PG8_WAIT_V(8); PG8_WAIT_L(0); PG8_BAR; PG8_MMA(0, 0, At, B0); PG8_MMA(0, 1, At, B1); PG8_BAR; PG8_SCHED;
            PG8_LDA(At, 0, 1); PG8_STAGE_B(PG8_SB(0, 0), b2); PG8_STAGE_B(PG8_SB(0, 1), b2 + hstep); PG8_STAGE_A(PG8_SA(0, 0), a2, v2, 0);
            PG8_WAIT_V(8); PG8_WAIT_L(0); PG8_BAR; PG8_MMA(1, 0, At, B0); PG8_MMA(1, 1, At, B1); PG8_BAR; PG8_SCHED;
            PG8_LDB(B0, 1, 0); PG8_LDB(B1, 1, 1); PG8_SCHED; PG8_LDA(At, 1, 0); PG8_STAGE_A(PG8_SA(0, 1), a2, v2, 1);
            PG8_WAIT_V(8); PG8_WAIT_L(0); PG8_BAR; PG8_MMA(0, 0, At, B0); PG8_MMA(0, 1, At, B1); PG8_BAR; PG8_SCHED;
            PG8_LDA(At, 1, 1); PG8_STAGE_B(PG8_SB(1, 0), b3); PG8_STAGE_B(PG8_SB(1, 1), b3 + hstep); PG8_STAGE_A(PG8_SA(1, 0), a3, v2, 0);
            PG8_WAIT_V(8); PG8_WAIT_L(0); PG8_BAR; PG8_MMA(1, 0, At, B0); PG8_MMA(1, 1, At, B1); PG8_BAR; PG8_SCHED;
        }
        if (wr == 0) PG8_BAR;
        if constexpr (FP8) { asm volatile("s_nop 15\n\ts_nop 15" ::: "memory"); }
        E(acc, cur, wr, wc, fr, fq);
        if (!has_next) break;
#pragma unroll
        for (int a = 0; a < 2; ++a)
#pragma unroll
            for (int b = 0; b < 2; ++b)
#pragma unroll
                for (int m = 0; m < 4; ++m)
#pragma unroll
                    for (int n = 0; n < 2; ++n) acc[a][b][m][n] = (f32x4){0.f, 0.f, 0.f, 0.f};
        cur = nxt; cA = nA; cB = nB; ++ui;
#pragma unroll
        for (int h = 0; h < 2; ++h)
#pragma unroll
            for (int i = 0; i < 2; ++i) vAc[h][i] = vAn[h][i];
        if (wr == 1) PG8_BAR;
    }
    PG8_WAIT_V(0);
    PG8_BAR;
#undef PG8_SA
#undef PG8_SB
#undef PG8_STAGE_A
#undef PG8_STAGE_B
#undef PG8_LDA
#undef PG8_LDB
#undef PG8_MMA
#undef PG8_WAIT_V
#undef PG8_WAIT_L
#undef PG8_BAR
#undef PG8_SCHED
}
}
namespace pg8 {

struct EpiBf16 {
    static constexpr bool PERM = true;
    bf16_t* O; size_t ldc;
    __device__ __forceinline__ void operator()(const f32x4 (&acc)[2][2][4][2], const Unit& u, int wr, int wc, int fr, int fq) const {
        const size_t row0 = (size_t)u.pm * BM + wr * 64 + fr; const int col0 = u.pn * BM + wc * 32 + 8 * fq;
#pragma unroll
        for (int ai = 0; ai < 2; ++ai)
#pragma unroll
            for (int m = 0; m < 4; ++m) { bf16_t* rowp = O + (row0 + ai * HALF + m * 16) * ldc + col0;
#pragma unroll
                for (int bj = 0; bj < 2; ++bj) { const f32x4 v0 = acc[ai][bj][m][0], v1 = acc[ai][bj][m][1];
                    u32x4 w; w.x = cvt_pk_bf16(v0[0], v0[1]); w.y = cvt_pk_bf16(v0[2], v0[3]); w.z = cvt_pk_bf16(v1[0], v1[1]); w.w = cvt_pk_bf16(v1[2], v1[3]);
                    *(u32x4*)(rowp + bj * HALF) = w; } }
    }
};

struct EpiQKV {
    static constexpr bool PERM = false;
    bf16_t* Q; bf16_t* Kb; bf16_t* Vb; const float* ropec; const float* ropes;
    int pn0;
    __device__ __forceinline__ void operator()(const f32x4 (&acc)[2][2][4][2], const Unit& u, int wr, int wc, int fr, int fq) const {
        const int pn = u.pn + pn0; const int sec = pn >> 1;
        const int bt = u.pm >> 4, t0 = (u.pm & 15) * BM;
        bf16_t* base; size_t rowb; float sc = 1.f;
        if (sec == 0) { base = Q; rowb = (size_t)u.pm * BM; sc = QSCALE; }
        else { base = (sec == 1) ? Kb : Vb; rowb = (size_t)bt * LKV + CTXL + t0; }
        const int colt = (pn & 1) * BM + wc * 32 + 4 * fq;
        const bool rope = sec < 2; const bool colpos = (wc & 1) != 0;
#pragma unroll
        for (int ai = 0; ai < 2; ++ai)
#pragma unroll
            for (int m = 0; m < 4; ++m) {
                const int rl = ai * HALF + wr * 64 + m * 16 + fr; const int t = t0 + rl;
                const int pos = colpos ? (t & 63) : (t >> 6);
                f32x4 cs = (f32x4){1.f, 1.f, 1.f, 1.f}, sn = (f32x4){0.f, 0.f, 0.f, 0.f};
                if (rope) { cs = *(const f32x4*)(ropec + pos * 16 + 4 * fq); sn = *(const f32x4*)(ropes + pos * 16 + 4 * fq); }
                bf16_t* rowp = base + (rowb + rl) * 512 + colt;
#pragma unroll
                for (int bj = 0; bj < 2; ++bj) {
                    const f32x4 a = acc[ai][bj][m][0], b = acc[ai][bj][m][1];
                    f32x4 oa, ob;
                    if (rope) { oa = (a * cs - b * sn) * sc; ob = (a * sn + b * cs) * sc; } else { oa = a; ob = b; }
                    u32x2 w0, w1; w0.x = cvt_pk_bf16(oa[0], oa[1]); w0.y = cvt_pk_bf16(oa[2], oa[3]); w1.x = cvt_pk_bf16(ob[0], ob[1]); w1.y = cvt_pk_bf16(ob[2], ob[3]);
                    *(u32x2*)(rowp + bj * HALF) = w0; *(u32x2*)(rowp + bj * HALF + 16) = w1; }
            }
    }
};

struct EpiCtxKV {
    static constexpr bool PERM = true;
    bf16_t* Kb; bf16_t* Vb;
    __device__ __forceinline__ void operator()(const f32x4 (&acc)[2][2][4][2], const Unit& u, int wr, int wc, int fr, int fq) const {
        bf16_t* base = (u.pn < 2) ? Kb : Vb; const size_t rowb = (size_t)u.pm * LKV; const int col0 = (u.pn & 1) * BM + wc * 32 + 8 * fq;
#pragma unroll
        for (int ai = 0; ai < 2; ++ai)
#pragma unroll
            for (int m = 0; m < 4; ++m) { bf16_t* rowp = base + (rowb + ai * HALF + wr * 64 + m * 16 + fr) * 512 + col0;
#pragma unroll
                for (int bj = 0; bj < 2; ++bj) { const f32x4 v0 = acc[ai][bj][m][0], v1 = acc[ai][bj][m][1];
                    u32x4 w; w.x = cvt_pk_bf16(v0[0], v0[1]); w.y = cvt_pk_bf16(v0[2], v0[3]); w.z = cvt_pk_bf16(v1[0], v1[1]); w.w = cvt_pk_bf16(v1[2], v1[3]);
                    *(u32x4*)(rowp + bj * HALF) = w; } }
    }
};

template <bool XF32> struct EpiResid {
    static constexpr bool PERM = true;
    const void* xin; bf16_t* out; const float* gate;   const float* bias;
    __device__ __forceinline__ void operator()(const f32x4 (&acc)[2][2][4][2], const Unit& u, int wr, int wc, int fr, int fq) const {
        const int bt = u.pm >> 4; const int col0 = u.pn * BM + wc * 32 + 8 * fq;
        constexpr int NB_ = XF32 ? 4 : 8;
#pragma unroll
        for (int bj = 0; bj < 2; ++bj) {
            f32x4 gv[2], bv[2];
#pragma unroll
            for (int n = 0; n < 2; ++n) { gv[n] = *(const f32x4*)(gate + (size_t)bt * 6144 + col0 + bj * HALF + 4 * n);
                bv[n] = bias ? *(const f32x4*)(bias + col0 + bj * HALF + 4 * n) : (f32x4){0.f, 0.f, 0.f, 0.f}; }
#pragma unroll
            for (int b0 = 0; b0 < 8; b0 += NB_) {
                f32x4 x0[NB_], x1[NB_];
#pragma unroll
                for (int q = 0; q < NB_; ++q) { const int ai = (b0 + q) >> 2, m = (b0 + q) & 3;
                    const size_t off = ((size_t)u.pm * BM + ai * HALF + wr * 64 + m * 16 + fr) * DM + col0 + bj * HALF;
                    if (XF32) { x0[q] = *(const f32x4*)((const float*)xin + off); x1[q] = *(const f32x4*)((const float*)xin + off + 4); }
                    else { const u32x4 r = *(const u32x4*)((const bf16_t*)xin + off); x0[q] = __builtin_bit_cast(f32x4, r); } }
                asm volatile("" ::: "memory");
#pragma unroll
                for (int q = 0; q < NB_; ++q) { const int ai = (b0 + q) >> 2, m = (b0 + q) & 3;
                    const size_t off = ((size_t)u.pm * BM + ai * HALF + wr * 64 + m * 16 + fr) * DM + col0 + bj * HALF;
                    f32x4 xa, xb;
                    if (XF32) { xa = x0[q]; xb = x1[q]; }
                    else { const u32x4 r = __builtin_bit_cast(u32x4, x0[q]); xa = (f32x4){bflo(r.x), bfhi(r.x), bflo(r.y), bfhi(r.y)}; xb = (f32x4){bflo(r.z), bfhi(r.z), bflo(r.w), bfhi(r.w)}; }
                    const f32x4 y0 = xa + gv[0] * (acc[ai][bj][m][0] + bv[0]), y1 = xb + gv[1] * (acc[ai][bj][m][1] + bv[1]);
                    u32x4 w; w.x = cvt_pk_bf16(y0[0], y0[1]); w.y = cvt_pk_bf16(y0[2], y0[3]); w.z = cvt_pk_bf16(y1[0], y1[1]); w.w = cvt_pk_bf16(y1[2], y1[3]);
                    *(u32x4*)(out + off) = w; }
            }
        }
    }
};

template <int MODE> __device__ __forceinline__ f32x4 gate4(const f32x4 a, const f32x4 g) {
    const f32x4 x = (MODE == 1) ? g : a;
    const f32x4 t = x * (-1.4426950408889634f);
    f32x4 e;
#pragma unroll
    for (int j = 0; j < 4; ++j) e[j] = __builtin_amdgcn_exp2f(t[j]);
    const f32x4 d = e + 1.0f;
    f32x4 r;
#pragma unroll
    for (int j = 0; j < 4; ++j) r[j] = __builtin_amdgcn_rcpf(d[j]);
    return (MODE == 1) ? a * r : (a * r) * g;
}
template <int MODE> struct EpiGated {
    static constexpr bool PERM = true;
    bf16_t* O; size_t ldo; const float* ba; const float* bg;
    __device__ __forceinline__ void operator()(const f32x4 (&acc)[2][2][4][2], const Unit& u, int wr, int wc, int fr, int fq) const {
        const size_t row0 = (size_t)u.pm * BM + wr * 64 + fr; const int col0 = u.pn * 128 + wc * 32 + 8 * fq;
        f32x4 b0[2], b1[2];
#pragma unroll
        for (int bj = 0; bj < 2; ++bj) { b0[bj] = (f32x4){0.f, 0.f, 0.f, 0.f}; b1[bj] = b0[bj]; if (MODE == 1) { b0[bj] = *(const f32x4*)(ba + col0 + 4 * bj); b1[bj] = *(const f32x4*)(bg + col0 + 4 * bj); } }
#pragma unroll
        for (int ai = 0; ai < 2; ++ai)
#pragma unroll
            for (int m = 0; m < 4; ++m) { f32x4 o[2];
#pragma unroll
                for (int bj = 0; bj < 2; ++bj) { f32x4 a = acc[ai][bj][m][0], g = acc[ai][bj][m][1]; if (MODE == 1) { a = a + b0[bj]; g = g + b1[bj]; }
                    o[bj] = gate4<MODE>(a, g); }
                if (MODE == 2) { unsigned char* rowp = (unsigned char*)O + (row0 + ai * HALF + m * 16) * ldo + col0;
                    int p0 = 0, p1 = 0; p0 = __builtin_amdgcn_cvt_pk_fp8_f32(o[0][0], o[0][1], p0, false); p0 = __builtin_amdgcn_cvt_pk_fp8_f32(o[0][2], o[0][3], p0, true);
                    p1 = __builtin_amdgcn_cvt_pk_fp8_f32(o[1][0], o[1][1], p1, false); p1 = __builtin_amdgcn_cvt_pk_fp8_f32(o[1][2], o[1][3], p1, true);
                    *(u32x2*)rowp = (u32x2){(unsigned)p0, (unsigned)p1}; }
                else { bf16_t* rowp = O + (row0 + ai * HALF + m * 16) * ldo + col0;
                    u32x4 w; w.x = cvt_pk_bf16(o[0][0], o[0][1]); w.y = cvt_pk_bf16(o[0][2], o[0][3]); w.z = cvt_pk_bf16(o[1][0], o[1][1]); w.w = cvt_pk_bf16(o[1][2], o[1][3]);
                    *(u32x4*)rowp = w; } }
    }
};

struct EpiGatedPub {
    static constexpr bool PERM = true;
    unsigned char* O; size_t ldo; unsigned* rtc;
    __device__ __forceinline__ void operator()(const f32x4 (&acc)[2][2][4][2], const Unit& u, int wr, int wc, int fr, int fq) const {
        const size_t row0 = (size_t)u.pm * BM + wr * 64 + fr; const int col0 = u.pn * 128 + wc * 32 + 8 * fq;
#pragma unroll
        for (int ai = 0; ai < 2; ++ai)
#pragma unroll
            for (int m = 0; m < 4; ++m) { f32x4 o[2];
#pragma unroll
                for (int bj = 0; bj < 2; ++bj) o[bj] = gate4<2>(acc[ai][bj][m][0], acc[ai][bj][m][1]);
                unsigned char* rowp = O + (row0 + ai * HALF + m * 16) * ldo + col0;
                int p0 = 0, p1 = 0; p0 = __builtin_amdgcn_cvt_pk_fp8_f32(o[0][0], o[0][1], p0, false); p0 = __builtin_amdgcn_cvt_pk_fp8_f32(o[0][2], o[0][3], p0, true);
                p1 = __builtin_amdgcn_cvt_pk_fp8_f32(o[1][0], o[1][1], p1, false); p1 = __builtin_amdgcn_cvt_pk_fp8_f32(o[1][2], o[1][3], p1, true);
                const u32x2 w = (u32x2){(unsigned)p0, (unsigned)p1};
                asm volatile("global_store_dwordx2 %0, %1, off sc1" :: "v"(rowp), "v"(w) : "memory"); }
        asm volatile("s_waitcnt vmcnt(0)" ::: "memory");
        if (fr == 0 && fq == 0) (void)__hip_atomic_fetch_add(rtc + u.pm, 1u, RLX_AGENT);
    }
};

struct EpiScatter {
    static constexpr bool PERM = true;
    bf16_t* Y0; bf16_t* Y1; const int* list; const LAS int* pref;
    __device__ __forceinline__ void operator()(const f32x4 (&acc)[2][2][4][2], const Unit& u, int wr, int wc, int fr, int fq) const {
        const int e = u.aux, j = u.pm - pref[e], cnt = pref[40 + e]; const int col0 = u.pn * BM + wc * 32 + 8 * fq; const size_t dy = (size_t)((const char*)Y1 - (const char*)Y0);
#pragma unroll
        for (int ai = 0; ai < 2; ++ai) { int ent[4];
#pragma unroll
            for (int m = 0; m < 4; ++m) { const int r = j * 256 + ai * HALF + wr * 64 + m * 16 + fr; ent[m] = list[e * 32768 + (r < cnt ? r : 0)]; }
#pragma unroll
            for (int m = 0; m < 4; ++m) { const int r = j * 256 + ai * HALF + wr * 64 + m * 16 + fr; const int en = ent[m];
                const bool ok = r < cnt; const unsigned tok = ok ? (unsigned)(en >> 1) : (unsigned)NTOK; const bool second = ok ? (en & 1) : true;
                unsigned char* rowp = (unsigned char*)Y0 + (size_t)tok * DM + (second ? dy : (size_t)0) + col0;
#pragma unroll
                for (int bj = 0; bj < 2; ++bj) { const f32x4 v0 = acc[ai][bj][m][0] * 16.0f, v1 = acc[ai][bj][m][1] * 16.0f;
                    int p0 = 0, p1 = 0; p0 = __builtin_amdgcn_cvt_pk_fp8_f32(v0[0], v0[1], p0, false); p0 = __builtin_amdgcn_cvt_pk_fp8_f32(v0[2], v0[3], p0, true);
                    p1 = __builtin_amdgcn_cvt_pk_fp8_f32(v1[0], v1[1], p1, false); p1 = __builtin_amdgcn_cvt_pk_fp8_f32(v1[2], v1[3], p1, true);
                    *(u32x2*)(rowp + bj * HALF) = (u32x2){(unsigned)p0, (unsigned)p1}; } } }
    }
};

struct EpiLogits {
    static constexpr bool PERM = false;
    float* O;
    __device__ __forceinline__ void operator()(const f32x4 (&acc)[2][2][4][2], const Unit& u, int wr, int wc, int fr, int fq) const {
        if (wc >= 2) return;
#pragma unroll
        for (int ai = 0; ai < 2; ++ai)
#pragma unroll
            for (int m = 0; m < 4; ++m) { float* rowp = O + ((size_t)u.pm * BM + ai * HALF + wr * 64 + m * 16 + fr) * 64 + wc * 32 + 4 * fq;
#pragma unroll
                for (int n = 0; n < 2; ++n) *(f32x4*)(rowp + n * 16) = acc[ai][0][m][n]; }
    }
};
}
enum { I_X = 0, I_C, I_CTX, I_CCTX, I_ADAW, I_ADAB, I_N1G, I_N2G, I_FING, I_WIN0, I_WOUT0, I_LQ1, I_LK1, I_LQ2, I_LK2, I_SUBLN,
       I_HYSW, I_HYSB, I_HYW1, I_HYB1, I_HYFR1, I_HYW2, I_HYB2, I_HYFR2, I_HYW3, I_HYB3, I_HYBIAS,
       I_CVW1, I_CVB1, I_CVDWW, I_CVDWB, I_CVLNG, I_CVLNB, I_CVW2, I_CVB2, I_MWG, I_MBG, I_MWE, I_MBE, I_MGATE, I_MUP, I_MDOWN, N_IN };

struct Args { const float* in[N_IN]; float* out; unsigned char* ws; int ph_lo, ph_hi; };

struct Frame {
    LAS unsigned char* lds;
    int tid, lane, wave, G, bid;
    const float* const* in; float* out; unsigned char* ws;
};

struct RowMap { int mode, half, which0;
    __device__ __forceinline__ int operator()(int s) const { if (mode == 0) return s; const int w = which0 + s / half, h = s % half, t = h & 127;
        return 256 * (h >> 7) + 128 * ((t >> 2) & 1) + 32 * (t >> 5) + 8 * ((t >> 3) & 3) + 4 * w + (t & 3); } };
#ifndef CONF_FP8
#define CONF_FP8 1
#endif
struct P0Item { const float* W; bf16_t* WT; int K, N, k0, n0; RowMap rm; int fp8; };
constexpr int P0_I_IN = 16 * 6, P0_I_OUT = 16 * 2, P0_I_C1 = 16 * 4, P0_I_C2 = 16 * 2, P0_I_MOE = 64 * 48;
constexpr int P0_I_KV8 = 16 * 2;
constexpr int P0_NITEMS = P0_I_IN + P0_I_OUT + P0_I_C1 + P0_I_C2 + P0_I_MOE + P0_I_KV8;
__device__ __forceinline__ P0Item p0_item(Frame& F, int it) {
    P0Item I; int r = it; I.fp8 = 0;
    if (it >= P0_NITEMS - P0_I_KV8) { const int q = it - (P0_NITEMS - P0_I_KV8);
        I.W = F.in[I_WIN0]; I.K = 1024; I.N = 3072; I.rm = RowMap{0, 1, 0}; I.fp8 = 1; I.k0 = 64 * (q >> 1); I.n0 = 512 + 512 * (q & 1);
        I.WT = (bf16_t*)(F.ws + WS_WQKVH + 4 * MiB + 512 * 1024 - (size_t)512 * 1024); return I; }
    if (r < P0_I_IN) { I.W = F.in[I_WIN0]; I.WT = (bf16_t*)(F.ws + WS_WQKVH); I.K = 1024; I.N = 3072; I.rm = RowMap{0, 1, 0}; }
    else if ((r -= P0_I_IN) < P0_I_OUT) { I.W = F.in[I_WOUT0]; I.WT = (bf16_t*)(F.ws + WS_WO); I.K = 1024; I.N = 1024; I.rm = RowMap{0, 1, 0}; I.fp8 = OUT_FP8; }
    else if ((r -= P0_I_OUT) < P0_I_C1) { I.W = F.in[I_CVW1]; I.WT = (bf16_t*)(F.ws + WS_WC1); I.K = 1024; I.N = 2048; I.rm = RowMap{1, 1024, 0}; I.fp8 = CONF_FP8; }
    else if ((r -= P0_I_C1) < P0_I_C2) { I.W = F.in[I_CVW2]; I.WT = (bf16_t*)(F.ws + WS_WC2); I.K = 1024; I.N = 1024; I.rm = RowMap{0, 1, 0}; I.fp8 = CONF_FP8; }
    else { r -= P0_I_C2; const int le = r / 48, q = r % 48; unsigned char* wb = F.ws + WS_WMOE + (size_t)le * 3 * MiB;
        I.fp8 = 1;
        if (q < 16) { I.W = F.in[I_MGATE] + (size_t)le * 1024 * 512; I.WT = (bf16_t*)wb; I.K = 1024; I.N = 512; I.rm = RowMap{1, 512, 0}; r = q; }
        else if (q < 32) { I.W = F.in[I_MUP] + (size_t)le * 1024 * 512; I.WT = (bf16_t*)wb; I.K = 1024; I.N = 512; I.rm = RowMap{1, 512, 1}; r = q - 16; }
        else { I.W = F.in[I_MDOWN] + (size_t)le * 512 * 1024; I.WT = (bf16_t*)(wb + 2 * MiB); I.K = 512; I.N = 1024; I.rm = RowMap{0, 1, 0}; r = q - 32; } }
    const int nblk = I.N / 512; I.k0 = 64 * (r / nblk); I.n0 = 512 * (r % nblk);
    if (it < P0_I_IN && I.n0 >= 1536) { I.fp8 = 1; I.WT = (bf16_t*)(F.ws + WS_WQKVH + 3 * MiB - (size_t)1536 * 1024); }
    return I;
}
__device__ __forceinline__ void p0_item_load(const P0Item& I, int tid, f32x4 (&v)[16]) {
#pragma unroll
    for (int i = 0; i < 16; ++i) v[i] = *(const f32x4*)(I.W + (size_t)(I.k0 + 4 * i + (tid >> 7)) * I.N + I.n0 + 4 * (tid & 127));
}
__device__ __forceinline__ void p0_item_to_lds(LAS float* scr, int tid, const f32x4 (&v)[16]) {
#pragma unroll
    for (int i = 0; i < 16; ++i) { LAS float* d = scr + (4 * i + (tid >> 7)) * 513 + 4 * (tid & 127); d[0] = v[i][0]; d[1] = v[i][1]; d[2] = v[i][2]; d[3] = v[i][3]; }
}
__device__ __forceinline__ void p0_item_store(const P0Item& I, const LAS float* scr, int tid) {
    if (I.fp8) {
#pragma unroll
        for (int j = 0; j < 4; ++j) { const int q = tid + 512 * j, n = q >> 2, c = q & 3; const LAS float* s = scr + (16 * c) * 513 + n; int w[4];
#pragma unroll
            for (int d = 0; d < 4; ++d) { int p = 0; p = __builtin_amdgcn_cvt_pk_fp8_f32(32.f * s[(4 * d) * 513], 32.f * s[(4 * d + 1) * 513], p, false);
                p = __builtin_amdgcn_cvt_pk_fp8_f32(32.f * s[(4 * d + 2) * 513], 32.f * s[(4 * d + 3) * 513], p, true); w[d] = p; }
            *(u32x4*)((unsigned char*)I.WT + (size_t)I.rm(I.n0 + n) * I.K + I.k0 + 16 * c) = (u32x4){(unsigned)w[0], (unsigned)w[1], (unsigned)w[2], (unsigned)w[3]}; }
        return; }
#pragma unroll
    for (int j = 0; j < 8; ++j) { const int q = tid + 512 * j, n = q >> 3, c = q & 7; const LAS float* s = scr + (8 * c) * 513 + n;
        u32x4 o; o.x = cvt_pk_bf16(s[0 * 513], s[1 * 513]); o.y = cvt_pk_bf16(s[2 * 513], s[3 * 513]); o.z = cvt_pk_bf16(s[4 * 513], s[5 * 513]); o.w = cvt_pk_bf16(s[6 * 513], s[7 * 513]);
        *(u32x4*)(I.WT + (size_t)I.rm(I.n0 + n) * I.K + I.k0 + 8 * c) = o; }
}
__device__ __forceinline__ void p0_router_weights(Frame& F) {
    bf16_t* wr = (bf16_t*)(F.ws + WS_WR);
    for (int idx = F.bid * NTHREADS + F.tid; idx < 2 * 256 * 1024; idx += F.G * NTHREADS) {
        const int l = idx >> 18, n = (idx >> 10) & 255, k = idx & 1023; float v = 0.f;
        if (n < 4) v = F.in[I_MWG][((size_t)l * 1024 + k) * 4 + n]; else if (n < 36) v = F.in[I_MWE][((size_t)l * 1024 + k) * 32 + (n - 4)];
        wr[idx] = (bf16_t)(cvt_pk_bf16(v, 0.f) & 0xffffu);
    }
}

__device__ __forceinline__ void p0_adaln_task(Frame& F, int task) {
    const int layer = task / 24, n0 = (task % 24) * 256;
    LAS float* sc = (LAS float*)F.lds;
    LAS f32x4* red = (LAS f32x4*)(F.lds + 36864);
    for (int i = F.tid; i < 9 * 1024; i += NTHREADS) { const int r = i >> 10, k = i & 1023; const float v = (r < 8) ? F.in[I_C][r * 1024 + k] : F.in[I_CCTX][k]; sc[i] = silu_f(v); }
    __syncthreads();
    const int cq = F.tid & 63, ks = F.tid >> 6;
    const float* W = F.in[I_ADAW] + (size_t)layer * 1024 * 6144 + n0 + 4 * cq;
    f32x4 acc[9];
#pragma unroll
    for (int r = 0; r < 9; ++r) acc[r] = (f32x4){0.f, 0.f, 0.f, 0.f};
#pragma unroll 16
    for (int k = ks * 128; k < ks * 128 + 128; ++k) { const f32x4 w = *(const f32x4*)(W + (size_t)k * 6144);
#pragma unroll
        for (int r = 0; r < 9; ++r) acc[r] += w * sc[r * 1024 + k]; }
#pragma unroll
    for (int r = 0; r < 9; ++r) red[(ks * 9 + r) * 64 + cq] = acc[r];
    __syncthreads();
    float* mod = (float*)(F.ws + WS_MOD) + (size_t)layer * 9 * 6144;
    for (int i = F.tid; i < 9 * 64; i += NTHREADS) { const int r = i >> 6, c2 = i & 63; f32x4 s = *(const f32x4*)(F.in[I_ADAB] + layer * 6144 + n0 + 4 * c2);
#pragma unroll
        for (int k8 = 0; k8 < 8; ++k8) s += red[(k8 * 9 + r) * 64 + c2];
        *(f32x4*)(mod + (size_t)r * 6144 + n0 + 4 * c2) = s; }
    __syncthreads();
}

constexpr float HY_MIN_DECAY = -15.350567286626973f, HY_MAX_DECAY = -3.0701134573253945f;
__device__ __forceinline__ void p0_hyfilter_task(Frame& F, int pb) {
    const int t0 = pb * 32;
    LAS float* z = (LAS float*)F.lds;
    LAS float* h1 = z + 32 * 33;
    LAS float* h2 = h1 + 32 * 64;
    for (int i = F.tid; i < 32 * 33; i += NTHREADS) { const int p = i / 33, e = i % 33; const int t = t0 + p; float v;
        if (e == 0) v = (float)t / 4095.0f;
        else { const int bi = (e - 1) & 15; const float band = 1e-4f + (float)bi * ((15.0f - 1e-4f) / 15.0f); const float ang = (6.283185307179586f / 4096.0f) * (float)t * band; v = (e <= 16) ? cosf(ang) : -sinf(ang); }
        z[i] = v; }
    __syncthreads();
    for (int i = F.tid; i < 32 * 64; i += NTHREADS) { const int p = i >> 6, j = i & 63; float s = F.in[I_HYB1][j];
        for (int e = 0; e < 33; ++e) s += z[p * 33 + e] * F.in[I_HYW1][e * 64 + j];
        h1[i] = sinf(F.in[I_HYFR1][j] * s); }
    __syncthreads();
    for (int i = F.tid; i < 32 * 64; i += NTHREADS) { const int p = i >> 6, j = i & 63; float s = F.in[I_HYB2][j];
        for (int e = 0; e < 64; ++e) s += h1[p * 64 + e] * F.in[I_HYW2][e * 64 + j];
        h2[i] = sinf(F.in[I_HYFR2][j] * s); }
    __syncthreads();
    const int c0 = 4 * F.tid;
    float* kraw = (float*)(F.ws + WS_KRAW);
    const f32x4 b3 = *(const f32x4*)(F.in[I_HYB3] + c0);
#pragma unroll 1
    for (int ph = 0; ph < 2; ++ph) {
        f32x4 acc[16];
#pragma unroll
        for (int p = 0; p < 16; ++p) acc[p] = b3;
        for (int j4 = 0; j4 < 16; ++j4) {
            f32x4 w[4];
#pragma unroll
            for (int jj = 0; jj < 4; ++jj) w[jj] = *(const f32x4*)(F.in[I_HYW3] + (size_t)(4 * j4 + jj) * 2048 + c0);
#pragma unroll
            for (int p = 0; p < 16; ++p) { const f32x4 hv = *(const LAS f32x4*)(h2 + (16 * ph + p) * 64 + 4 * j4);
                acc[p] += w[0] * hv[0] + w[1] * hv[1] + w[2] * hv[2] + w[3] * hv[3]; }
        }
#pragma unroll
        for (int cc = 0; cc < 4; ++cc) { const int col = c0 + cc, ch = col & 511;
            const float delta = fabsf(HY_MIN_DECAY + (float)ch * ((HY_MAX_DECAY - HY_MIN_DECAY) / 511.0f));
            float* dst = kraw + (size_t)col * 4096 + t0 + 16 * ph;
#pragma unroll
            for (int p4 = 0; p4 < 4; ++p4) { f32x4 o;
#pragma unroll
                for (int q = 0; q < 4; ++q) { const int p = 4 * p4 + q; const float tn = (float)(t0 + 16 * ph + p) / 4095.0f; o[q] = acc[p][cc] * __expf(-tn * delta); }
                *(f32x4*)(dst + 4 * p4) = o; } }
    }
    __syncthreads();
}

__device__ __forceinline__ void p0_tables_task(Frame& F) {
    float* tab = (float*)(F.ws + WS_TAB);
    for (int i = F.tid; i < 1024; i += NTHREADS) { const int pos = i >> 4, fi = i & 15; const float inv = powf(10000.0f, -(float)fi / 16.0f); const float ang = (float)pos * inv;
        tab[TB_ROPE_C + i] = cosf(ang); tab[TB_ROPE_S + i] = sinf(ang); }
    for (int i = F.tid; i < 256; i += NTHREADS) { float s, c; sincospif(2.0f * (float)i / 4096.0f, &s, &c); tab[TB_T4096 + 2 * i] = c; tab[TB_T4096 + 2 * i + 1] = -s; }
    for (int i = F.tid; i < 64; i += NTHREADS) { float s, c; sincospif(2.0f * (float)i / 8192.0f, &s, &c); tab[TB_T8A + 2 * i] = c; tab[TB_T8A + 2 * i + 1] = -s;
        sincospif(2.0f * (float)(64 * i) / 8192.0f, &s, &c); tab[TB_T8B + 2 * i] = c; tab[TB_T8B + 2 * i + 1] = -s; }
    if (F.tid < 64) { const float a = wave_sum(F.in[I_LQ1][F.lane] * F.in[I_LK1][F.lane]), b = wave_sum(F.in[I_LQ2][F.lane] * F.in[I_LK2][F.lane]);
        if (F.lane == 0) tab[TB_LAM] = expf(a) - expf(b) + 0.2f; }
}

__device__ __forceinline__ void p0_prologue(Frame& F, unsigned* ctr, volatile LAS unsigned* slot) {
    p0_router_weights(F);
#pragma unroll 1
    for (int t = F.bid; t < 48 + 128; t += F.G) { if (t < 48) p0_adaln_task(F, t); else p0_hyfilter_task(F, t - 48); }
    if (F.bid == 0) p0_tables_task(F);
    __syncthreads();
    LAS float* scr = (LAS float*)F.lds;
    if (F.tid == 0) { slot[0] = __hip_atomic_fetch_add(ctr, 1u, RLX_AGENT); slot[1] = __hip_atomic_fetch_add(ctr, 1u, RLX_AGENT); }
    __syncthreads();
    int cur = (int)slot[0], nxt = (int)slot[1];
    f32x4 va[16], vb[16];
    if (cur < P0_NITEMS) { const P0Item I = p0_item(F, cur); p0_item_load(I, F.tid, va); }
    if (nxt < P0_NITEMS) { const P0Item I = p0_item(F, nxt); p0_item_load(I, F.tid, vb); }
    unsigned got = 0; if (F.tid == 0) got = __hip_atomic_fetch_add(ctr, 1u, RLX_AGENT);
    __syncthreads();
#define P0_HALF(VV) { if (F.tid == 0) slot[0] = got; \
        __syncthreads();                                     \
        const int nn = (int)slot[0]; \
        p0_item_to_lds(scr, F.tid, VV); \
        if (F.tid == 0) got = __hip_atomic_fetch_add(ctr, 1u, RLX_AGENT); \
        __syncthreads(); \
        if (nn < P0_NITEMS) { const P0Item J = p0_item(F, nn); p0_item_load(J, F.tid, VV); } \
        { const P0Item I = p0_item(F, cur); p0_item_store(I, scr, F.tid); } \
        cur = nxt; nxt = nn; }
    while (cur < P0_NITEMS) {
        P0_HALF(va)
        if (cur >= P0_NITEMS) break;
        P0_HALF(vb)
    }
#undef P0_HALF
    __syncthreads();
}

__device__ __forceinline__ void bf8_to_f32(const u32x4 r, f32x4& a, f32x4& b) { a = (f32x4){bflo(r.x), bfhi(r.x), bflo(r.y), bfhi(r.y)}; b = (f32x4){bflo(r.z), bfhi(r.z), bflo(r.w), bfhi(r.w)}; }
__device__ __forceinline__ void fp8x8_to_f32(const u32x2 r, f32x4& a, f32x4& b) {
    const f32x2 a0 = __builtin_amdgcn_cvt_pk_f32_fp8((int)r.x, false), a1 = __builtin_amdgcn_cvt_pk_f32_fp8((int)r.x, true), b0 = __builtin_amdgcn_cvt_pk_f32_fp8((int)r.y, false), b1 = __builtin_amdgcn_cvt_pk_f32_fp8((int)r.y, true);
    a = (f32x4){a0.x, a0.y, a1.x, a1.y}; b = (f32x4){b0.x, b0.y, b1.x, b1.y}; }
__device__ __forceinline__ void rms_mod_store(const f32x4 (&v)[4], const float* g, const float* sh, const float* sc, bf16_t* orow, float* frow, int lane, unsigned char* o8 = nullptr) {
    float s = 0.f;
#pragma unroll
    for (int j = 0; j < 4; ++j) s += (v[j].x * v[j].x + v[j].y * v[j].y) + (v[j].z * v[j].z + v[j].w * v[j].w);
    const float rstd = 1.0f / sqrtf(wave_sum(s) * (1.0f / 1024.0f) + EPS);
#pragma unroll
    for (int h = 0; h < 2; ++h) { const int c = 8 * lane + 512 * h; f32x4 y0 = v[2 * h] * rstd * *(const f32x4*)(g + c), y1 = v[2 * h + 1] * rstd * *(const f32x4*)(g + c + 4);
        if (sc) { y0 = y0 * (*(const f32x4*)(sc + c) + 1.0f) + *(const f32x4*)(sh + c); y1 = y1 * (*(const f32x4*)(sc + c + 4) + 1.0f) + *(const f32x4*)(sh + c + 4); }
        if (orow) { u32x4 w; w.x = cvt_pk_bf16(y0[0], y0[1]); w.y = cvt_pk_bf16(y0[2], y0[3]); w.z = cvt_pk_bf16(y1[0], y1[1]); w.w = cvt_pk_bf16(y1[2], y1[3]); *(u32x4*)(orow + c) = w; }
        if (frow) { *(f32x4*)(frow + c) = y0; *(f32x4*)(frow + c + 4) = y1; }
        if (o8) { int p0 = 0, p1 = 0; p0 = __builtin_amdgcn_cvt_pk_fp8_f32(y0[0], y0[1], p0, false); p0 = __builtin_amdgcn_cvt_pk_fp8_f32(y0[2], y0[3], p0, true);
            p1 = __builtin_amdgcn_cvt_pk_fp8_f32(y1[0], y1[1], p1, false); p1 = __builtin_amdgcn_cvt_pk_fp8_f32(y1[2], y1[3], p1, true); *(u32x2*)(o8 + c) = (u32x2){(unsigned)p0, (unsigned)p1}; } }
}

__device__ __forceinline__ void p1_norm_in(Frame& F) {
    const int gw = F.bid * NWAVES + F.wave, NGW = F.G * NWAVES;
    const float* mod = (const float*)(F.ws + WS_MOD);
#pragma unroll 1
    for (int r0 = gw; r0 < NTOK + NB * CTXL; r0 += 4 * NGW) {
        f32x4 v[4][4];
#pragma unroll
        for (int q = 0; q < 4; ++q) { const int r = r0 + q * NGW; if (r < NTOK + NB * CTXL) { const bool isx = r < NTOK; const int rr = isx ? r : r - NTOK;
            const float* xrow = (isx ? F.in[I_X] : F.in[I_CTX]) + (size_t)rr * DM;
#pragma unroll
            for (int j = 0; j < 4; ++j) v[q][j] = *(const f32x4*)(xrow + 8 * F.lane + 512 * (j >> 1) + 4 * (j & 1)); } }
#pragma unroll
        for (int q = 0; q < 4; ++q) { const int r = r0 + q * NGW; if (r < NTOK + NB * CTXL) { const bool isx = r < NTOK; const int rr = isx ? r : r - NTOK; const int b = isx ? (rr >> 12) : 8;
            bf16_t* orow = (bf16_t*)(F.ws + (isx ? WS_BUF0 : WS_OBT)) + (size_t)rr * DM;
            rms_mod_store(v[q], F.in[I_N1G], mod + (size_t)b * 6144 + 0, mod + (size_t)b * 6144 + 1024, orow, nullptr, F.lane, F.ws + WS_Y1 + (size_t)(isx ? rr : NTOK + rr) * DM); } }
    }
}

constexpr int MF_PITCH = 2064;
constexpr int MF_TILE = 0, MF_RED = 32 * MF_PITCH, MF_SEL = MF_RED + 8 * 32 * 65 * 4, MF_CNT = MF_SEL + 128 * 32;
__device__ __forceinline__ void moe_front(Frame& F, int layer) {
    LAS unsigned char* lds = F.lds;
    LAS float* red = (LAS float*)(lds + MF_RED);
    LAS int* lcnt = (LAS int*)(lds + MF_CNT); LAS int* lbase = lcnt + 32;
    const float* mod = (const float*)(F.ws + WS_MOD) + (size_t)layer * 9 * 6144;
    unsigned* gcnt = (unsigned*)(F.ws + WS_CTL) + CW_CNT + layer * 32 * 64;
    int* list = (int*)(F.ws + WS_LIST);
    int* tinfo = (int*)(F.ws + WS_TOK); float* tw = (float*)(F.ws + WS_TOK + 512 * 1024);
    const int l = F.lane, w = F.wave, r32 = l & 31, hi = l >> 5;
    bf16x8 wb[2][8];
    { const bf16_t* wr = (const bf16_t*)(F.ws + WS_WR) + (size_t)layer * 256 * 1024;
#pragma unroll
      for (int nb = 0; nb < 2; ++nb)
#pragma unroll
          for (int s = 0; s < 8; ++s) wb[nb][s] = *(const bf16x8*)(wr + (size_t)(32 * nb + r32) * 1024 + 128 * w + 16 * s + 8 * hi); }
    for (int blk = F.bid; blk < NTOK / 128; blk += F.G) {
        if (F.tid < 32) lcnt[F.tid] = 0;
        __syncthreads();
#pragma unroll 1
        for (int sg = 0; sg < 4; ++sg) {
            const int tok0 = blk * 128 + sg * 32;
            { f32x4 v[4][4];
#pragma unroll
              for (int q = 0; q < 4; ++q) { const bf16_t* xrow = (const bf16_t*)(F.ws + WS_X) + (size_t)(tok0 + 4 * w + q) * DM;
#pragma unroll
                  for (int h = 0; h < 2; ++h) { const u32x4 t = *(const u32x4*)(xrow + 8 * l + 512 * h); bf8_to_f32(t, v[q][2 * h], v[q][2 * h + 1]); } }
              const int b = tok0 >> 12;
              const float* g = F.in[I_N2G] + layer * DM; const float* sh = mod + (size_t)b * 6144 + 3 * 1024; const float* sc = mod + (size_t)b * 6144 + 4 * 1024;
#pragma unroll
              for (int q = 0; q < 4; ++q) { const int rl = 4 * w + q, r = tok0 + rl; float ssq = 0.f;
#pragma unroll
                  for (int j = 0; j < 4; ++j) ssq += (v[q][j].x * v[q][j].x + v[q][j].y * v[q][j].y) + (v[q][j].z * v[q][j].z + v[q][j].w * v[q][j].w);
                  const float rstd = 1.0f / sqrtf(wave_sum(ssq) * (1.0f / 1024.0f) + EPS);
                  unsigned char* orow = F.ws + WS_BUF0 + (size_t)r * DM;
#pragma unroll
                  for (int h = 0; h < 2; ++h) { const int c = 8 * l + 512 * h;
                      const f32x4 y0 = v[q][2 * h] * rstd * *(const f32x4*)(g + c) * (*(const f32x4*)(sc + c) + 1.0f) + *(const f32x4*)(sh + c);
                      const f32x4 y1 = v[q][2 * h + 1] * rstd * *(const f32x4*)(g + c + 4) * (*(const f32x4*)(sc + c + 4) + 1.0f) + *(const f32x4*)(sh + c + 4);
                      u32x4 pk; pk.x = cvt_pk_bf16(y0[0], y0[1]); pk.y = cvt_pk_bf16(y0[2], y0[3]); pk.z = cvt_pk_bf16(y1[0], y1[1]); pk.w = cvt_pk_bf16(y1[2], y1[3]);
                      *(LAS u32x4*)(lds + MF_TILE + rl * MF_PITCH + c * 2) = pk;
                      int p0 = 0, p1 = 0; p0 = __builtin_amdgcn_cvt_pk_fp8_f32(y0[0], y0[1], p0, false); p0 = __builtin_amdgcn_cvt_pk_fp8_f32(y0[2], y0[3], p0, true);
                      p1 = __builtin_amdgcn_cvt_pk_fp8_f32(y1[0], y1[1], p1, false); p1 = __builtin_amdgcn_cvt_pk_fp8_f32(y1[2], y1[3], p1, true);
                      *(u32x2*)(orow + c) = (u32x2){(unsigned)p0, (unsigned)p1}; } } }
            __syncthreads();
            { f32x16 d0, d1;
#pragma unroll
              for (int r = 0; r < 16; ++r) { d0[r] = 0.f; d1[r] = 0.f; }
#pragma unroll
              for (int s = 0; s < 8; ++s) { const bf16x8 a = *(const LAS bf16x8*)(lds + MF_TILE + r32 * MF_PITCH + (128 * w + 16 * s + 8 * hi) * 2);
                  d0 = __builtin_amdgcn_mfma_f32_32x32x16_bf16(a, wb[0][s], d0, 0, 0, 0); d1 = __builtin_amdgcn_mfma_f32_32x32x16_bf16(a, wb[1][s], d1, 0, 0, 0); }
#pragma unroll
              for (int r = 0; r < 16; ++r) { const int t = (r & 3) + 8 * (r >> 2) + 4 * hi; red[(w * 32 + t) * 65 + r32] = d0[r]; red[(w * 32 + t) * 65 + 32 + r32] = d1[r]; } }
            __syncthreads();
            if (F.tid < 32) { const int t = F.tid;
                int g = 0; float gm = -1e30f, gl[4];
#pragma unroll
                for (int i = 0; i < 4; ++i) { float sum = F.in[I_MBG][layer * 4 + i];
#pragma unroll
                    for (int ww = 0; ww < 8; ++ww) sum += red[(ww * 32 + t) * 65 + i];
                    gl[i] = sum; if (sum > gm) { gm = sum; g = i; } }
                float gs = 0.f;
#pragma unroll
                for (int i = 0; i < 4; ++i) gs += __expf(gl[i] - gm);
                const float gw = 1.0f / gs;
                float el[8];
#pragma unroll
                for (int i = 0; i < 8; ++i) { float sum = F.in[I_MBE][layer * 32 + 8 * g + i];
#pragma unroll
                    for (int ww = 0; ww < 8; ++ww) sum += red[(ww * 32 + t) * 65 + 4 + 8 * g + i];
                    el[i] = sum; }
                int i1 = 0; float m1 = -1e30f;
#pragma unroll
                for (int i = 0; i < 8; ++i) if (el[i] > m1) { m1 = el[i]; i1 = i; }
                int i2 = 0; float m2 = -1e30f;
#pragma unroll
                for (int i = 0; i < 8; ++i) if (i != i1 && el[i] > m2) { m2 = el[i]; i2 = i; }
                const float e2 = __expf(m2 - m1), w1 = gw / (1.0f + e2), w2 = gw * e2 / (1.0f + e2);
                const int x1 = g * 8 + i1, x2 = g * 8 + i2;
                const int p1 = __hip_atomic_fetch_add(&lcnt[x1], 1, __ATOMIC_RELAXED, __HIP_MEMORY_SCOPE_WORKGROUP), p2 = __hip_atomic_fetch_add(&lcnt[x2], 1, __ATOMIC_RELAXED, __HIP_MEMORY_SCOPE_WORKGROUP);
                LAS int* sel = (LAS int*)(lds + MF_SEL) + (sg * 32 + t) * 8;
                sel[0] = x1; sel[1] = p1; sel[2] = x2; sel[3] = p2; sel[4] = __float_as_int(w1); sel[5] = __float_as_int(w2); }
            __syncthreads();
        }
        if (F.tid < 32) lbase[F.tid] = (int)__hip_atomic_fetch_add(gcnt + F.tid * 64, (unsigned)lcnt[F.tid], RLX_AGENT);
        __syncthreads();
        if (F.tid < 128) { const LAS int* sel = (const LAS int*)(lds + MF_SEL) + F.tid * 8; const int tok = blk * 128 + F.tid;
            const int x1 = sel[0], x2 = sel[2], q1 = lbase[x1] + sel[1], q2 = lbase[x2] + sel[3];
            list[x1 * 32768 + q1] = 2 * tok; list[x2 * 32768 + q2] = 2 * tok + 1;
            *(int4*)(tinfo + 4 * (size_t)tok) = make_int4(x1, q1, x2, q2);
            *(float2*)(tw + 2 * (size_t)tok) = make_float2(__int_as_float(sel[4]), __int_as_float(sel[5])); }
        __syncthreads();
    }
}

__device__ __forceinline__ void moe_prefix(Frame& F, int layer, LAS int* pref) {
    const unsigned* gcnt = (const unsigned*)(F.ws + WS_CTL) + CW_CNT + layer * 32 * 64;
    if (F.tid < 64) {
        const int e = F.tid & 31; const int c = (int)gcnt[e * 64]; const int tiles = (c + 255) >> 8;
        int s = tiles;
#pragma unroll
        for (int o = 1; o < 32; o <<= 1) { const int t = __shfl_up(s, o); if (e >= o) s += t; }
        if (F.tid < 32) { pref[e] = s - tiles; pref[40 + e] = c; if (e == 31) pref[32] = s; }
    }
    __syncthreads();
}

template <int MODE> __device__ __forceinline__ void moe_combine(Frame& F, int layer) {
    const int gw = F.bid * NWAVES + F.wave, NGW = F.G * NWAVES;
    const float* mod = (const float*)(F.ws + WS_MOD) + (size_t)layer * 9 * 6144;
    const float* modn = (const float*)(F.ws + WS_MOD) + (size_t)1 * 9 * 6144;
    const float* tw = (const float*)(F.ws + WS_TOK + 512 * 1024);
    const bf16_t* Y0 = (const bf16_t*)(F.ws + WS_Y0); const bf16_t* Y1 = (const bf16_t*)(F.ws + WS_Y1);
    bf16_t* X = (bf16_t*)(F.ws + WS_X);
#pragma unroll 1
    for (int r0 = gw; r0 < NTOK; r0 += 4 * NGW) {
        f32x4 v[4][4];
#pragma unroll
        for (int q = 0; q < 4; ++q) { const int r = r0 + q * NGW; const int b = r >> 12;
            float2 ww = *(const float2*)(tw + 2 * (size_t)r); ww.x *= 0.0625f; ww.y *= 0.0625f;
            const float* g2 = mod + (size_t)b * 6144 + 5 * 1024;
#pragma unroll
            for (int h = 0; h < 2; ++h) { const int c = 8 * F.lane + 512 * h;
                const u32x4 xr = *(const u32x4*)(X + (size_t)r * DM + c); const u32x2 ar = *(const u32x2*)((const unsigned char*)Y0 + (size_t)r * DM + c), br = *(const u32x2*)((const unsigned char*)Y1 + (size_t)r * DM + c);
                f32x4 x0, x1, a0, a1, b0, b1; bf8_to_f32(xr, x0, x1); fp8x8_to_f32(ar, a0, a1); fp8x8_to_f32(br, b0, b1);
                v[q][2 * h] = x0 + *(const f32x4*)(g2 + c) * (a0 * ww.x + b0 * ww.y); v[q][2 * h + 1] = x1 + *(const f32x4*)(g2 + c + 4) * (a1 * ww.x + b1 * ww.y); } }
#pragma unroll
        for (int q = 0; q < 4; ++q) { const int r = r0 + q * NGW; const int b = r >> 12;
            float ssq = 0.f;
#pragma unroll
            for (int j = 0; j < 4; ++j) ssq += (v[q][j].x * v[q][j].x + v[q][j].y * v[q][j].y) + (v[q][j].z * v[q][j].z + v[q][j].w * v[q][j].w);
            const float rstd = 1.0f / sqrtf(wave_sum(ssq) * (1.0f / 1024.0f) + EPS);
            const float* g = (MODE == 0) ? F.in[I_N1G] + DM : F.in[I_FING];
#pragma unroll
            for (int h = 0; h < 2; ++h) { const int c = 8 * F.lane + 512 * h;
                if (MODE == 0) { u32x4 pk; pk.x = cvt_pk_bf16(v[q][2 * h][0], v[q][2 * h][1]); pk.y = cvt_pk_bf16(v[q][2 * h][2], v[q][2 * h][3]); pk.z = cvt_pk_bf16(v[q][2 * h + 1][0], v[q][2 * h + 1][1]); pk.w = cvt_pk_bf16(v[q][2 * h + 1][2], v[q][2 * h + 1][3]);
                    *(u32x4*)(X + (size_t)r * DM + c) = pk; }
                f32x4 y0 = v[q][2 * h] * rstd * *(const f32x4*)(g + c), y1 = v[q][2 * h + 1] * rstd * *(const f32x4*)(g + c + 4);
                if (MODE == 0) { const float* sh = modn + (size_t)b * 6144; const float* sc = sh + 1024;
                    y0 = y0 * (*(const f32x4*)(sc + c) + 1.0f) + *(const f32x4*)(sh + c); y1 = y1 * (*(const f32x4*)(sc + c + 4) + 1.0f) + *(const f32x4*)(sh + c + 4);
                    if (CONF_FP8) { int p0 = 0, p1 = 0; p0 = __builtin_amdgcn_cvt_pk_fp8_f32(y0[0], y0[1], p0, false); p0 = __builtin_amdgcn_cvt_pk_fp8_f32(y0[2], y0[3], p0, true);
                        p1 = __builtin_amdgcn_cvt_pk_fp8_f32(y1[0], y1[1], p1, false); p1 = __builtin_amdgcn_cvt_pk_fp8_f32(y1[2], y1[3], p1, true);
                        *(u32x2*)(F.ws + WS_BUF0 + (size_t)r * DM + c) = (u32x2){(unsigned)p0, (unsigned)p1}; }
                    else { u32x4 pk; pk.x = cvt_pk_bf16(y0[0], y0[1]); pk.y = cvt_pk_bf16(y0[2], y0[3]); pk.z = cvt_pk_bf16(y1[0], y1[1]); pk.w = cvt_pk_bf16(y1[2], y1[3]);
                        *(u32x4*)((bf16_t*)(F.ws + WS_BUF0) + (size_t)r * DM + c) = pk; } }
                else { *(f32x4*)(F.out + (size_t)r * DM + c) = y0; *(f32x4*)(F.out + (size_t)r * DM + c + 4) = y1; } } }
    }
}

__device__ __forceinline__ void transpose_ob(Frame& F) {
    LAS bf16_t* scr = (LAS bf16_t*)(F.lds + F.wave * 16384);
    const int gw = F.bid * NWAVES + F.wave, NGW = F.G * NWAVES;
    const bf16_t* src = (const bf16_t*)(F.ws + WS_OBT); bf16_t* dst = (bf16_t*)(F.ws + WS_BUF0);
    const int r8 = F.lane >> 3, c8 = F.lane & 7;
    for (int it = gw; it < 8 * 512; it += NGW) {
        const int cb = it & 7, tb = it >> 3; const int c0 = cb * 64, t0 = tb * 64;
        u32x4 v[8];
#pragma unroll
        for (int i = 0; i < 8; ++i) v[i] = *(const u32x4*)(src + (size_t)(c0 + r8 + 8 * i) * NTOK + t0 + 8 * c8);
#pragma unroll
        for (int i = 0; i < 8; ++i) *(LAS u32x4*)(scr + (r8 + 8 * i) * 72 + 8 * c8) = v[i];
        LDS_WAIT(); asm volatile("" ::: "memory");
#pragma unroll
        for (int i = 0; i < 8; ++i) { const int t = r8 + 8 * i; unsigned short e[8];
#pragma unroll
            for (int k = 0; k < 8; ++k) e[k] = scr[(8 * c8 + k) * 72 + t];
            if (OUT_FP8) { float f[8];
#pragma unroll
                for (int k = 0; k < 8; ++k) f[k] = __builtin_amdgcn_fmed3f(__uint_as_float((unsigned)e[k] << 16) * 16.0f, -448.0f, 448.0f);
                int p0 = 0, p1 = 0; p0 = __builtin_amdgcn_cvt_pk_fp8_f32(f[0], f[1], p0, false); p0 = __builtin_amdgcn_cvt_pk_fp8_f32(f[2], f[3], p0, true);
                p1 = __builtin_amdgcn_cvt_pk_fp8_f32(f[4], f[5], p1, false); p1 = __builtin_amdgcn_cvt_pk_fp8_f32(f[6], f[7], p1, true);
                *(u32x2*)((unsigned char*)dst + (size_t)(t0 + t) * DM + 512 + c0 + 8 * c8) = (u32x2){(unsigned)p0, (unsigned)p1}; }
            else { u32x4 o; o.x = e[0] | ((unsigned)e[1] << 16); o.y = e[2] | ((unsigned)e[3] << 16); o.z = e[4] | ((unsigned)e[5] << 16); o.w = e[6] | ((unsigned)e[7] << 16);
                *(u32x4*)(dst + (size_t)(t0 + t) * DM + 512 + c0 + 8 * c8) = o; } }
        LDS_WAIT(); asm volatile("" ::: "memory");
    }
}

template <int SS> __device__ __forceinline__ void conv_step(f32x2 (&acc)[32], const f32x2 (&w)[31], const f32x2 bias, const unsigned rawv) {
    const f32x2 xin = (f32x2){bflo(rawv), bfhi(rawv)};
    acc[SS] = bias;
#pragma unroll
    for (int k = 0; k < 31; ++k) acc[(SS - k) & 31] += w[k] * xin;
}
constexpr int CV_TILE = 65536;
__device__ __forceinline__ void conv_ln_rows(Frame& F, const LAS bf16_t* tile, bf16_t* Obase  ) {
#pragma unroll 1
    for (int q = 0; q < 4; ++q) { const int rr = F.wave * 4 + q;
        f32x4 v[4]; float sm = 0.f;
#pragma unroll
        for (int h = 0; h < 2; ++h) { const u32x4 t = *(const LAS u32x4*)(tile + rr * 1024 + 8 * F.lane + 512 * h); bf8_to_f32(t, v[2 * h], v[2 * h + 1]); }
#pragma unroll
        for (int j = 0; j < 4; ++j) sm += (v[j].x + v[j].y) + (v[j].z + v[j].w);
        const float mean = wave_sum(sm) * (1.0f / 1024.0f); float s2 = 0.f;
#pragma unroll
        for (int j = 0; j < 4; ++j) { v[j] = v[j] - mean; s2 += (v[j].x * v[j].x + v[j].y * v[j].y) + (v[j].z * v[j].z + v[j].w * v[j].w); }
        const float rstd = 1.0f / sqrtf(wave_sum(s2) * (1.0f / 1024.0f) + EPS);
        bf16_t* orow = Obase + (size_t)rr * (CONF_FP8 ? DM / 2 : DM);
#pragma unroll
        for (int h = 0; h < 2; ++h) { const int c = 8 * F.lane + 512 * h;
            f32x4 y0 = v[2 * h] * rstd * *(const f32x4*)(F.in[I_CVLNG] + c) + *(const f32x4*)(F.in[I_CVLNB] + c), y1 = v[2 * h + 1] * rstd * *(const f32x4*)(F.in[I_CVLNG] + c + 4) + *(const f32x4*)(F.in[I_CVLNB] + c + 4);
#pragma unroll
            for (int e = 0; e < 4; ++e) { y0[e] = silu_f(y0[e]); y1[e] = silu_f(y1[e]); }
            if (CONF_FP8) { int p0 = 0, p1 = 0; p0 = __builtin_amdgcn_cvt_pk_fp8_f32(y0[0], y0[1], p0, false); p0 = __builtin_amdgcn_cvt_pk_fp8_f32(y0[2], y0[3], p0, true);
                p1 = __builtin_amdgcn_cvt_pk_fp8_f32(y1[0], y1[1], p1, false); p1 = __builtin_amdgcn_cvt_pk_fp8_f32(y1[2], y1[3], p1, true); *(u32x2*)((unsigned char*)orow + c) = (u32x2){(unsigned)p0, (unsigned)p1}; }
            else { u32x4 pk; pk.x = cvt_pk_bf16(y0[0], y0[1]); pk.y = cvt_pk_bf16(y0[2], y0[3]); pk.z = cvt_pk_bf16(y1[0], y1[1]); pk.w = cvt_pk_bf16(y1[2], y1[3]); *(u32x4*)(orow + c) = pk; } } }
}
__device__ __forceinline__ void conv_half_issue(Frame& F, const bf16_t* Abatch, int t0, int s1, LAS unsigned char* dst) {
    const char* zrow = (const char*)(F.ws + WS_CTL + 512 * 1024);
#pragma unroll
    for (int i = 0; i < 4; ++i) { const int p = F.tid + 512 * i, row = p >> 7, chn = p & 127; const int t = t0 - 15 + s1 + row;
        const char* src = (t >= 0 && t < SEQ) ? (const char*)(Abatch + (size_t)t * DM) + 16 * chn : zrow + 16 * chn;
        __builtin_amdgcn_global_load_lds((const unsigned*)src, (LAS unsigned*)(dst + i * 8192 + F.wave * 1024), 16, 0, 0); }
}
__device__ __forceinline__ void conv_ln_phase(Frame& F) {
    LAS unsigned char* stA = F.lds; LAS unsigned char* stB = F.lds + 32768; LAS bf16_t* tile = (LAS bf16_t*)(F.lds + CV_TILE);
    const bf16_t* A = (const bf16_t*)(F.ws + WS_GLU); bf16_t* O = (bf16_t*)(F.ws + WS_BUF0);
    const int ch = 2 * F.tid;
    f32x2 w[31];
#pragma unroll
    for (int k = 0; k < 31; ++k) w[k] = *(const f32x2*)(F.in[I_CVDWW] + k * 1024 + ch);
    const f32x2 bias = *(const f32x2*)(F.in[I_CVDWB] + ch);
    for (int blk = F.bid; blk < 256; blk += F.G) {
        const int b = blk >> 5, t0 = (blk & 31) * 128;
        const bf16_t* Ab = A + (size_t)b * SEQ * DM;
        f32x2 acc[32];
#pragma unroll
        for (int i = 0; i < 32; ++i) acc[i] = (f32x2){0.f, 0.f};
        __syncthreads();
        conv_half_issue(F, Ab, t0, 0, stA); conv_half_issue(F, Ab, t0, 16, stB);
#pragma unroll 1
        for (int s0 = 0; s0 < 160; s0 += 32) {
#define CV_STEP(SS) { conv_step<SS>(acc, w, bias, *(const LAS unsigned*)((SS < 16 ? stA : stB) + (SS & 15) * 2048 + 2 * ch)); const int o = s0 + SS - 30; \
                if (o >= 0 && o < 128) { const f32x2 r_ = acc[(SS + 2) & 31]; *(LAS unsigned*)(tile + ((SS + 2) & 31) * 1024 + ch) = cvt_pk_bf16(r_.x, r_.y); } \
                if (SS == 29 && o >= 0 && o < 128) { __syncthreads(); conv_ln_rows(F, tile, O + ((size_t)b * SEQ + t0 + (o - 31)) * (CONF_FP8 ? DM / 2 : DM)); __syncthreads(); } }
            VM_WAIT(); __syncthreads();
            CV_STEP(0) CV_STEP(1) CV_STEP(2) CV_STEP(3) CV_STEP(4) CV_STEP(5) CV_STEP(6) CV_STEP(7) CV_STEP(8) CV_STEP(9) CV_STEP(10) CV_STEP(11) CV_STEP(12) CV_STEP(13) CV_STEP(14) CV_STEP(15)
            __syncthreads();
            if (s0 + 32 < 160) conv_half_issue(F, Ab, t0, s0 + 32, stA);
            CV_STEP(16) CV_STEP(17) CV_STEP(18) CV_STEP(19) CV_STEP(20) CV_STEP(21) CV_STEP(22) CV_STEP(23) CV_STEP(24) CV_STEP(25) CV_STEP(26) CV_STEP(27) CV_STEP(28) CV_STEP(29) CV_STEP(30) CV_STEP(31)
            __syncthreads();
            if (s0 + 32 < 160) conv_half_issue(F, Ab, t0, s0 + 48, stB);
#undef CV_STEP
        }
    }
}
namespace att {
constexpr int KT = 64, NTILE = LKV / KT, ST_BYTES = 24576;
typedef short v4i16_t __attribute__((ext_vector_type(4)));

__device__ __forceinline__ f32x16 mfma32(bf16x8 a, bf16x8 b, f32x16 c) { return __builtin_amdgcn_mfma_f32_32x32x16_bf16(a, b, c, 0, 0, 0); }

__device__ __forceinline__ void attn_phase(Frame& F) {
    LAS unsigned char* lds = F.lds;
    const int l = F.lane, w = F.wave, tid = F.tid, r32 = l & 31, hi = l >> 5;
    const bf16_t* Qb = (const bf16_t*)(F.ws + WS_Q); const bf16_t* Kb = (const bf16_t*)(F.ws + WS_K); const bf16_t* Vb = (const bf16_t*)(F.ws + WS_V);
    bf16_t* Ob = (bf16_t*)(F.ws + WS_BUF0);
    const float lam = ((const float*)(F.ws + WS_TAB))[TB_LAM];
    LAS float* subl = (LAS float*)(lds + 2 * ST_BYTES);
    if (tid < 128) subl[tid] = F.in[I_SUBLN][tid];
    __syncthreads();
    const unsigned kbase_ = (unsigned)(r32 * 128), kx_ = (unsigned)((r32 >> 1) & 7);
    unsigned vbase_, vq4_;
    { const int g = l >> 4, i = l & 15, q4 = i >> 2, p4 = i & 3; const int row = 4 * (g >> 1) + q4;
      const int lowch = (2 * (g & 1) + (p4 >> 1)) ^ ((row >> 2) & 3);
      vbase_ = (unsigned)(8192 + row * 256 + (lowch << 4) + 8 * (p4 & 1)); vq4_ = (unsigned)q4; }
#define ATT_ISSUE(st, kv0) do { const size_t _ro = (size_t)(kv0) * 1024; int t_ = tid; asm volatile("" : "+v"(t_)); \
        const int krow = t_ >> 3; const unsigned ksrc = (unsigned)(krow * 1024 + (((t_ & 7) ^ ((krow >> 1) & 7)) << 4)); unsigned vsrc[2]; \
        _Pragma("unroll") for (int i_ = 0; i_ < 2; ++i_) { const int p = t_ + 512 * i_, vrow = p >> 4; vsrc[i_] = (unsigned)(vrow * 1024 + (((p & 15) ^ (((vrow & 3) << 2) | ((vrow >> 2) & 3))) << 4)); } \
        __builtin_amdgcn_global_load_lds((const unsigned*)(Kg + _ro + ksrc), (LAS unsigned*)(lds + (st) * ST_BYTES + w * 1024), 16, 0, 0); \
        __builtin_amdgcn_global_load_lds((const unsigned*)(Vg + _ro + vsrc[0]), (LAS unsigned*)(lds + (st) * ST_BYTES + 8192 + w * 1024), 16, 0, 0); \
        __builtin_amdgcn_global_load_lds((const unsigned*)(Vg + _ro + vsrc[1]), (LAS unsigned*)(lds + (st) * ST_BYTES + 16384 + w * 1024), 16, 0, 0); } while (0)

    for (int it = 0;; ++it) {
        int grp, qb;
        if (F.G == 256) { const int x = F.bid & 7, j = F.bid >> 3; if (it >= 2) break; grp = x * 4 + it * 2 + (j >> 4); qb = j & 15; }
        else { const int un = it * F.G + F.bid; if (un >= 512) break; grp = un >> 4; qb = un & 15; }
        const int b = grp >> 2, hp = grp & 3;
        const bf16_t* Qg = Qb + ((size_t)b * SEQ + qb * 256 + w * 32 + r32) * 512;
        const char* Vg = (const char*)(Vb + (size_t)b * LKV * 512 + hp * 128);
        f32x16 o1[4];
#pragma unroll 1
        for (int s = 0; s < 2; ++s) {
            const char* Kg = (const char*)(Kb + (size_t)b * LKV * 512 + (2 * hp + s) * 64);
            bf16x8 qf[4];
#pragma unroll
            for (int ds = 0; ds < 4; ++ds) qf[ds] = *(const bf16x8*)(Qg + (2 * hp + s) * 64 + ds * 16 + hi * 8);
            f32x16 O[4];
            float m, lsum;
            int exact = 0;
            LAS int* oflag = (LAS int*)(lds + 2 * ST_BYTES + 1024);
#pragma unroll 1
            for (;;) {
#pragma unroll
            for (int d = 0; d < 4; ++d)
#pragma unroll
                for (int r = 0; r < 16; ++r) O[d][r] = 0.f;
            m = 0.f; lsum = 0.f;
            if (tid == 0) *oflag = 0;
            __syncthreads();
            ATT_ISSUE(0, 0);
#pragma unroll 1
            for (int j = 0; j < NTILE; ++j) {
                VM_WAIT(); __syncthreads();
                if (j + 1 < NTILE) ATT_ISSUE((j + 1) & 1, (j + 1) * KT);
                const LAS unsigned char* Ks = lds + (j & 1) * ST_BYTES;
                unsigned kbase = kbase_, kx = kx_, vbase = vbase_, vq4 = vq4_; asm volatile("" : "+v"(kbase), "+v"(kx), "+v"(vbase), "+v"(vq4));
                f32x16 p0, p1;
#pragma unroll
                for (int r = 0; r < 16; ++r) { p0[r] = 0.f; p1[r] = 0.f; }
                bf16x8 kf0[4], kf1[4];
#pragma unroll
                for (int ds = 0; ds < 4; ++ds) { const unsigned ka = (unsigned)(size_t)Ks + kbase + ((((unsigned)(2 * ds + hi)) ^ kx) << 4);
                    asm volatile("ds_read_b128 %0, %2\n\tds_read_b128 %1, %2 offset:4096" : "=&v"(kf0[ds]), "=&v"(kf1[ds]) : "v"(ka)); }
                asm volatile("s_waitcnt lgkmcnt(6)" : "+v"(kf0[0]), "+v"(kf1[0]));
                p0 = mfma32(kf0[0], qf[0], p0); p1 = mfma32(kf1[0], qf[0], p1);
                asm volatile("s_waitcnt lgkmcnt(4)" : "+v"(kf0[1]), "+v"(kf1[1]));
                p0 = mfma32(kf0[1], qf[1], p0); p1 = mfma32(kf1[1], qf[1], p1);
                asm volatile("s_waitcnt lgkmcnt(2)" : "+v"(kf0[2]), "+v"(kf1[2]));
                p0 = mfma32(kf0[2], qf[2], p0); p1 = mfma32(kf1[2], qf[2], p1);
                asm volatile("s_waitcnt lgkmcnt(0)" : "+v"(kf0[3]), "+v"(kf1[3]));
                p0 = mfma32(kf0[3], qf[3], p0); p1 = mfma32(kf1[3], qf[3], p1);
                if (j == 0) { float mx0 = fmaxf(p0[0], p1[0]);
#pragma unroll
                    for (int r = 1; r < 16; ++r) mx0 = fmaxf(mx0, fmaxf(p0[r], p1[r]));
                    m = fmaxf(mx0, __shfl_xor(mx0, 32)); }
                f32x2 e0[8], e1[8];
                { const f32x2 mm = (f32x2){m, m};
#pragma unroll
                  for (int r = 0; r < 8; ++r) { e0[r] = (f32x2){p0[2 * r], p0[2 * r + 1]} - mm; e1[r] = (f32x2){p1[2 * r], p1[2 * r + 1]} - mm; } }
                if (exact) {
                float mx = fmaxf(fmaxf(e0[0].x, e0[0].y), fmaxf(e1[0].x, e1[0].y));
#pragma unroll
                for (int r = 1; r < 8; ++r) { mx = fmaxf(fmaxf(mx, e0[r].x), e0[r].y); mx = fmaxf(fmaxf(mx, e1[r].x), e1[r].y); }
                if (!__all(mx <= 8.0f)) { mx = fmaxf(mx, __shfl_xor(mx, 32)); const float dl = fmaxf(mx, 0.f), alpha = __builtin_amdgcn_exp2f(-dl);
#pragma unroll
                    for (int d = 0; d < 4; ++d) O[d] = O[d] * alpha;
                    lsum *= alpha; m += dl; const f32x2 dd = (f32x2){dl, dl};
#pragma unroll
                    for (int r = 0; r < 8; ++r) { e0[r] -= dd; e1[r] -= dd; } }
                }
                { f32x2 acc = (f32x2){0.f, 0.f};
#pragma unroll
                  for (int r = 0; r < 8; ++r) { e0[r] = (f32x2){__builtin_amdgcn_exp2f(e0[r].x), __builtin_amdgcn_exp2f(e0[r].y)}; e1[r] = (f32x2){__builtin_amdgcn_exp2f(e1[r].x), __builtin_amdgcn_exp2f(e1[r].y)};
                      acc += e0[r] + e1[r]; }
                  lsum += acc.x + acc.y; }
                bf16x8 pb[4];
#pragma unroll
                for (int q = 0; q < 2; ++q) { u32x4 a, c;
                    a.x = cvt_pk_bf16(e0[4 * q + 0].x, e0[4 * q + 0].y); a.y = cvt_pk_bf16(e0[4 * q + 1].x, e0[4 * q + 1].y); a.z = cvt_pk_bf16(e0[4 * q + 2].x, e0[4 * q + 2].y); a.w = cvt_pk_bf16(e0[4 * q + 3].x, e0[4 * q + 3].y);
                    c.x = cvt_pk_bf16(e1[4 * q + 0].x, e1[4 * q + 0].y); c.y = cvt_pk_bf16(e1[4 * q + 1].x, e1[4 * q + 1].y); c.z = cvt_pk_bf16(e1[4 * q + 2].x, e1[4 * q + 2].y); c.w = cvt_pk_bf16(e1[4 * q + 3].x, e1[4 * q + 3].y);
                    pb[q] = __builtin_bit_cast(bf16x8, a); pb[2 + q] = __builtin_bit_cast(bf16x8, c); }
#pragma unroll
                for (int d = 0; d < 4; ++d) {
                    const unsigned va0 = vbase + ((((unsigned)d) ^ vq4) << 6), va1 = (va0 ^ 32u) + 2048u;
#pragma unroll
                    for (int kv = 0; kv < 4; ++kv) {
                        const v4i16_t lo = __builtin_amdgcn_ds_read_tr16_b64_v4i16((LAS v4i16_t*)(Ks + va0 + kv * 4096));
                        const v4i16_t hh = __builtin_amdgcn_ds_read_tr16_b64_v4i16((LAS v4i16_t*)(Ks + va1 + kv * 4096));
                        const bf16x8 vf = (bf16x8){lo[0], lo[1], lo[2], lo[3], hh[0], hh[1], hh[2], hh[3]};
                        O[d] = mfma32(vf, pb[kv], O[d]); } }
            }
            if (exact) break;
            { float osum = 0.f;
#pragma unroll
              for (int d = 0; d < 4; ++d)
#pragma unroll
                  for (int r = 0; r < 16; ++r) osum += fabsf(O[d][r]);
              const bool okl = (lsum < 0x1p100f) && (osum < 0x1p120f);
              if (!okl) *oflag = 1;
              __syncthreads();
              exact = __builtin_amdgcn_readfirstlane(*(volatile LAS int*)oflag);
              __syncthreads();
              if (!exact) break; }
            }
            const float lt = lsum + __shfl_xor(lsum, 32);
            if (s == 0) { const float inv = 1.0f / lt;
#pragma unroll
                for (int d = 0; d < 4; ++d) o1[d] = O[d] * inv; }
            else { const float inv = lam / lt; float ss = 0.f;
#pragma unroll
                for (int d = 0; d < 4; ++d) { o1[d] = o1[d] - O[d] * inv;
#pragma unroll
                    for (int r = 0; r < 16; ++r) ss += o1[d][r] * o1[d][r]; }
                ss += __shfl_xor(ss, 32);
                const float rn = (OUT_FP8 ? 12.8f : 0.8f) / sqrtf(ss * (1.0f / 128.0f) + EPS);
                bf16_t* orow = Ob + ((size_t)b * SEQ + qb * 256 + w * 32 + r32) * DM + hp * 128 + 4 * hi;
                unsigned char* orow8 = (unsigned char*)Ob + ((size_t)b * SEQ + qb * 256 + w * 32 + r32) * DM + hp * 128 + 4 * hi;
#pragma unroll
                for (int d = 0; d < 4; ++d)
#pragma unroll
                    for (int q = 0; q < 4; ++q) { const f32x4 g4 = *(const LAS f32x4*)(subl + 32 * d + 8 * q + 4 * hi);
                        if (OUT_FP8) { int p = 0; p = __builtin_amdgcn_cvt_pk_fp8_f32(o1[d][4 * q] * rn * g4[0], o1[d][4 * q + 1] * rn * g4[1], p, false);
                            p = __builtin_amdgcn_cvt_pk_fp8_f32(o1[d][4 * q + 2] * rn * g4[2], o1[d][4 * q + 3] * rn * g4[3], p, true); *(unsigned*)(orow8 + 32 * d + 8 * q) = (unsigned)p; }
                        else { u32x2 pk; pk.x = cvt_pk_bf16(o1[d][4 * q] * rn * g4[0], o1[d][4 * q + 1] * rn * g4[1]); pk.y = cvt_pk_bf16(o1[d][4 * q + 2] * rn * g4[2], o1[d][4 * q + 3] * rn * g4[3]);
                            *(u32x2*)(orow + 32 * d + 8 * q) = pk; } }
            }
        }
    }
#undef ATT_ISSUE
}
}
namespace hy {
constexpr int FBUF = 4352 * 8;
constexpr int KOFF = 2 * FBUF;
constexpr int KLEN = 2192;
constexpr int RED_OFF = KOFF + 4 * KLEN * 8;
__device__ __forceinline__ int pad(int i) { return i + (i >> 4); }
__device__ __forceinline__ float sgpr_f(float v) { return __int_as_float(__builtin_amdgcn_readfirstlane(__float_as_int(v))); }
typedef f32x2 cx;
#ifndef HY_ASM
#define HY_ASM 3
#endif
#if HY_ASM & 1
__device__ __forceinline__ void c_mul_ip(cx& x, cx w) { cx t;
    asm("v_pk_mul_f32 %1, %0, %2 op_sel_hi:[0,1]\n\tv_pk_fma_f32 %0, %0, %2, %1 op_sel:[1,1,0] op_sel_hi:[1,0,1] neg_lo:[1,0,0]" : "+v"(x), "=&v"(t) : "v"(w)); }
__device__ __forceinline__ cx c_mul(cx x, cx w) { cx y;
    asm("v_pk_mul_f32 %0, %1, %2 op_sel_hi:[0,1]\n\tv_pk_fma_f32 %0, %1, %2, %0 op_sel:[1,1,0] op_sel_hi:[1,0,1] neg_lo:[1,0,0]" : "=&v"(y) : "v"(x), "v"(w)); return y; }
__device__ __forceinline__ void c_mul_sw_ip(cx& x, cx w) { cx t;
    asm("v_pk_mul_f32 %1, %0, %2 op_sel:[0,1] op_sel_hi:[0,0]\n\tv_pk_fma_f32 %0, %0, %2, %1 op_sel:[1,0,0] op_sel_hi:[1,1,1] neg_hi:[1,0,0]" : "+v"(x), "=&v"(t) : "v"(w)); }
__device__ __forceinline__ void c_mul_swc_ip(cx& x, cx w) { cx t;
    asm("v_pk_mul_f32 %1, %0, %2 op_sel:[0,1] op_sel_hi:[0,0]\n\tv_pk_fma_f32 %0, %0, %2, %1 op_sel:[1,0,0] op_sel_hi:[1,1,1] neg_lo:[0,0,1]" : "+v"(x), "=&v"(t) : "v"(w)); }
__device__ __forceinline__ void c_mul_k_ip(cx& x, cx w) { cx t;
    asm("v_pk_mul_f32 %1, %0, %2 op_sel_hi:[0,1]\n\tv_pk_fma_f32 %0, %0, %2, %1 op_sel:[1,1,0] op_sel_hi:[1,0,1] neg_lo:[1,0,0]" : "+v"(x), "=&v"(t) : "s"(w)); }
#else
__device__ __forceinline__ cx c_mul(cx x, cx w) { return (cx){x.x, x.x} * w + (cx){-x.y, x.y} * (cx){w.y, w.x}; }
__device__ __forceinline__ void c_mul_ip(cx& x, cx w) { x = c_mul(x, w); }
__device__ __forceinline__ void c_mul_k_ip(cx& x, cx w) { x = c_mul(x, w); }
__device__ __forceinline__ void c_mul_sw_ip(cx& x, cx w) { x = (cx){x.x, x.x} * (cx){w.y, w.x} + (cx){x.y, -x.y} * w; }
__device__ __forceinline__ void c_mul_swc_ip(cx& x, cx w) { c_mul_sw_ip(x, (cx){w.x, -w.y}); }
#endif
#if HY_ASM & 2
__device__ __forceinline__ cx c_mi(cx a, cx b) { cx d; asm("v_pk_add_f32 %0, %1, %2 op_sel:[0,1] op_sel_hi:[1,0] neg_hi:[0,1]" : "=v"(d) : "v"(a), "v"(b)); return d; }
__device__ __forceinline__ cx c_pi(cx a, cx b) { cx d; asm("v_pk_add_f32 %0, %1, %2 op_sel:[0,1] op_sel_hi:[1,0] neg_lo:[0,1]" : "=v"(d) : "v"(a), "v"(b)); return d; }
#else
__device__ __forceinline__ cx c_mi(cx a, cx b) { return a + (cx){b.y, -b.x}; }
__device__ __forceinline__ cx c_pi(cx a, cx b) { return a + (cx){-b.y, b.x}; }
#endif

__device__ __forceinline__ void dft4(cx& a, cx& b, cx& c, cx& d) {
    const cx s0 = a + c, d0 = a - c, s1 = b + d, d1 = b - d;
    a = s0 + s1; c = s0 - s1; b = c_mi(d0, d1); d = c_pi(d0, d1);
}
__device__ __forceinline__ void dft4_rc(cx& a, cx& b, cx& c, cx& d) {
    const cx s0 = c_mi(a, c), d0 = c_pi(a, c), s1 = b + d, d1 = b - d;
    a = s0 + s1; c = s0 - s1; b = c_mi(d0, d1); d = c_pi(d0, d1);
}
__device__ __forceinline__ void dft16(cx (&x)[16]) {
    constexpr float C1 = 0.9238795325112867f, S1 = 0.3826834323650898f, R = 0.7071067811865476f;
#pragma unroll
    for (int b = 0; b < 4; ++b) dft4(x[b], x[4 + b], x[8 + b], x[12 + b]);
    c_mul_k_ip(x[5], (cx){C1, -S1}); c_mul_k_ip(x[6], (cx){R, -R}); c_mul_k_ip(x[7], (cx){S1, -C1});
    c_mul_k_ip(x[9], (cx){R, -R});   c_mul_k_ip(x[11], (cx){-R, -R});
    c_mul_k_ip(x[13], (cx){S1, -C1}); c_mul_k_ip(x[14], (cx){-R, -R}); c_mul_k_ip(x[15], (cx){-C1, S1});
#pragma unroll
    for (int c = 0; c < 4; ++c) { if (c == 2) dft4_rc(x[8], x[9], x[10], x[11]); else dft4(x[4 * c], x[4 * c + 1], x[4 * c + 2], x[4 * c + 3]); }
    cx y[16];
#pragma unroll
    for (int k = 0; k < 16; ++k) y[k] = x[4 * (k & 3) + (k >> 2)];
#pragma unroll
    for (int k = 0; k < 16; ++k) x[k] = y[k];
}
__device__ __forceinline__ void twiddle_pow(cx (&x)[16], cx w) {
    cx p[16]; p[1] = w;
#pragma unroll
    for (int n = 2; n < 16; ++n) { const int a = n >> 1, b = n - a; p[n] = c_mul(p[a], p[b]); }
#pragma unroll
    for (int n = 1; n < 16; ++n) c_mul_ip(x[n], p[n]);
}
__device__ __forceinline__ void fft4096(cx (&x)[16], LAS f32x2* buf, int uw, int u, const cx w2, const cx w3) {
    dft16(x);
    { LAS f32x2* p = buf + pad(uw);
#pragma unroll
      for (int k = 0; k < 16; ++k) p[272 * k] = x[k]; }
    __syncthreads();
    { LAS f32x2* p = buf + 272 * (u >> 4) + (u & 15);
#pragma unroll
      for (int n = 0; n < 16; ++n) x[n] = *(const volatile LAS f32x2*)(p + 17 * n);
      twiddle_pow(x, w2);
      dft16(x);
#pragma unroll
      for (int k = 0; k < 16; ++k) p[17 * k] = x[k]; }
    __syncthreads();
    { const LAS f32x2* p = buf + 272 * (u >> 4) + 17 * (u & 15);
#pragma unroll
      for (int n = 0; n < 16; ++n) x[n] = *(const volatile LAS f32x2*)(p + n);
      twiddle_pow(x, w3);
      dft16(x); }
}
__device__ __forceinline__ void twiddle_w8192(cx (&x)[16], cx base, bool conj) {
    constexpr float C = 0.9807852804032304f, S = 0.1950903220161283f;
    cx w = conj ? (cx){base.x, -base.y} : base; const cx st = (cx){C, conj ? S : -S};
#pragma unroll
    for (int n = 0; n < 16; ++n) { c_mul_ip(x[n], w); c_mul_ip(w, st); }
}
struct SRow { u32x4 raw; bf16_t l, r; };
__device__ __forceinline__ void sconv_load(const bf16_t* row, int t0, SRow& R) {
    R.raw = *(const u32x4*)(row + t0); R.l = row[t0 > 0 ? t0 - 1 : 0]; R.r = row[t0 + 8 < SEQ ? t0 + 8 : SEQ - 1];
}
__device__ __forceinline__ void sconv_apply(const SRow& R, int t0, const f32x4 wb  , float (&out)[8]) {
    float x[10]; x[0] = t0 > 0 ? bf2f(R.l) : 0.f; x[9] = t0 + 8 < SEQ ? bf2f(R.r) : 0.f;
    x[1] = bflo(R.raw.x); x[2] = bfhi(R.raw.x); x[3] = bflo(R.raw.y); x[4] = bfhi(R.raw.y); x[5] = bflo(R.raw.z); x[6] = bfhi(R.raw.z); x[7] = bflo(R.raw.w); x[8] = bfhi(R.raw.w);
#pragma unroll
    for (int i = 0; i < 8; ++i) out[i] = wb[3] + wb[0] * x[i] + wb[1] * x[i + 1] + wb[2] * x[i + 2];
}

__device__ __forceinline__ void hyena_phase(Frame& F) {
    LAS f32x2* FB0 = (LAS f32x2*)F.lds; LAS f32x2* FB1 = (LAS f32x2*)(F.lds + FBUF);
    LAS f32x2* KH = (LAS f32x2*)(F.lds + KOFF);
    LAS float* red = (LAS float*)(F.lds + RED_OFF);
    const int tid = F.tid, half = tid >> 8, u_ = tid & 255, u1_ = (u_ >> 4) + 16 * (u_ & 15);
    LAS f32x2* myF = half ? FB1 : FB0;
    const float* tab = (const float*)(F.ws + WS_TAB);
    const f32x2* T4096 = (const f32x2*)(tab + TB_T4096); const f32x2* T8A = (const f32x2*)(tab + TB_T8A); const f32x2* T8B = (const f32x2*)(tab + TB_T8B);
#define HY_W8192(dst, idx) f32x2 dst; { const f32x2 a_ = T8A[(idx) & 63], b_ = T8B[(idx) >> 6]; dst = (f32x2){a_.x * b_.x - a_.y * b_.y, a_.x * b_.y + a_.y * b_.x}; }
    const cx tw2 = T4096[16 * (u_ >> 4)], tw3 = T4096[(u_ >> 4) + 16 * (u_ & 15)];
    HY_W8192(twu, u_); HY_W8192(twu1, u1_);
    const float* kraw = (const float*)(F.ws + WS_KRAW);
    const bf16_t* UT = (const bf16_t*)(F.ws + WS_UT); bf16_t* OBT = (bf16_t*)(F.ws + WS_OBT);
    const int j0 = 8 * tid, jp = 8 * tid + (tid >> 1);
    for (int c = F.bid; c < 512; c += F.G) {
        f32x4 wS[3]; float bias0, bias1;
        { const int k = F.lane < 14 ? F.lane : 0;
          const float* pk = (k < 9) ? F.in[I_HYSW] + 512 * (k / 3) + c + 1536 * (k % 3) : (k < 12) ? F.in[I_HYSB] + 512 * (k - 9) + c : F.in[I_HYBIAS] + 512 * (k - 12) + c;
          const int sv = __float_as_int(*pk);
#define HY_RL(i) __int_as_float(__builtin_amdgcn_readlane(sv, (i)))
          wS[0] = (f32x4){HY_RL(0), HY_RL(1), HY_RL(2), HY_RL(9)}; wS[1] = (f32x4){HY_RL(3), HY_RL(4), HY_RL(5), HY_RL(10)}; wS[2] = (f32x4){HY_RL(6), HY_RL(7), HY_RL(8), HY_RL(11)};
          bias0 = HY_RL(12); bias1 = HY_RL(13);
#undef HY_RL
        }
        __syncthreads();
        { float an[2];
#pragma unroll
          for (int o = 0; o < 2; ++o) { const float* fw = kraw + (size_t)(1024 * o + c) * 4096; const float* bw = kraw + (size_t)(1024 * o + 512 + c) * 4096;
              float f[8], g[8];
              { const f32x4 fa = *(const f32x4*)(fw + j0), fb = *(const f32x4*)(fw + j0 + 4);
                const f32x4 ga = *(const f32x4*)(bw + 4088 - j0), gb = *(const f32x4*)(bw + 4092 - j0);
                const float g0 = tid > 0 ? bw[4096 - j0] : 0.f;
                f[0] = fa[0]; f[1] = fa[1]; f[2] = fa[2]; f[3] = fa[3]; f[4] = fb[0]; f[5] = fb[1]; f[6] = fb[2]; f[7] = fb[3];
                g[0] = g0; g[1] = gb[3]; g[2] = gb[2]; g[3] = gb[1]; g[4] = gb[0]; g[5] = ga[3]; g[6] = ga[2]; g[7] = ga[1]; }
              float a = 0.f;
#pragma unroll
              for (int i = 0; i < 8; ++i) { a += fabsf(f[i]) + fabsf(g[i]);
                  ((LAS float*)(FB0 + jp + i))[o] = f[i] + g[i]; ((LAS float*)(FB1 + jp + i))[o] = f[i] - g[i]; }
              an[o] = wave_sum(a);
              asm volatile("" ::: "memory"); }
          if (F.lane == 0) { red[F.wave] = an[0]; red[8 + F.wave] = an[1]; } }
        __syncthreads();
        float nrm0 = 0.f, nrm1 = 0.f;
#pragma unroll
        for (int i = 0; i < 8; ++i) { nrm0 += red[i]; nrm1 += red[8 + i]; }
        const float sc0 = 1.0f / (nrm0 * 8192.0f), sc1 = 1.0f / (nrm1 * 8192.0f);
        cx x[16];
        { int u = u_, u1 = u1_; asm volatile("" : "+v"(u), "+v"(u1));
#pragma unroll
        for (int n = 0; n < 16; ++n) x[n] = (myF + pad(u))[272 * n];
        __syncthreads();
        if (half) twiddle_w8192(x, twu, false);
        fft4096(x, myF, u, u, tw2, tw3);
        __syncthreads();
#pragma unroll
        for (int k = 0; k < 16; ++k) (myF + pad(u1))[272 * k] = x[k]; }
        __syncthreads();
        for (int kk = tid; kk < 2049; kk += 512) {
            { const f32x2 A = FB0[pad(kk)]; f32x2 B = FB0[pad((4096 - kk) & 4095)]; B.y = -B.y;
              KH[0 * KLEN + pad(kk)] = (f32x2){(A.x + B.x) * 0.5f * sc0, (A.y + B.y) * 0.5f * sc0};
              KH[2 * KLEN + pad(kk)] = (f32x2){(A.y - B.y) * 0.5f * sc1, -(A.x - B.x) * 0.5f * sc1}; }
            if (kk < 2048) { const f32x2 A = FB1[pad(kk)]; f32x2 B = FB1[pad(4095 - kk)]; B.y = -B.y;
              KH[1 * KLEN + pad(kk)] = (f32x2){(A.x + B.x) * 0.5f * sc0, (A.y + B.y) * 0.5f * sc0};
              KH[3 * KLEN + pad(kk)] = (f32x2){(A.y - B.y) * 0.5f * sc1, -(A.x - B.x) * 0.5f * sc1}; }
        }
        __syncthreads();
        SRow pv0, pv1, pa0, pa1;
        { const bf16_t* vr = UT + (size_t)c * NTOK; sconv_load(vr, j0, pv0); sconv_load(vr + SEQ, j0, pv1); }
#pragma unroll 1
        for (int bp = 0; bp < 4; ++bp) {
            const size_t rb = (size_t)(2 * bp) * SEQ;
            float zr[8], zi[8], vre[8], vim[8];
            sconv_apply(pv0, j0, wS[0], vre); sconv_apply(pv1, j0, wS[0], vim);
#pragma unroll
            for (int i = 0; i < 8; ++i) (FB0 + jp)[i] = (f32x2){vre[i], vim[i]};
            { const bf16_t* x1r = UT + (size_t)(512 + c) * NTOK + rb; sconv_load(x1r, j0, pa0); sconv_load(x1r + SEQ, j0, pa1); }
            __syncthreads();
#pragma unroll 1
            for (int ord = 0; ord < 2; ++ord) {
                int u = u_, u1 = u1_; asm volatile("" : "+v"(u), "+v"(u1));
#pragma unroll
                for (int n = 0; n < 16; ++n) x[n] = (FB0 + pad(u))[272 * n];
                __syncthreads();
                if (half) twiddle_w8192(x, twu, false);
                fft4096(x, myF, u, u, tw2, tw3);
                { const LAS f32x2* Kp = KH + (2 * ord + half) * KLEN;
                  const LAS f32x2* pf = Kp + pad(u1); const LAS f32x2* pm = Kp + pad((half ? 4095 : 4096) - u1);
#pragma unroll
                  for (int n = 0; n < 8; ++n) c_mul_sw_ip(x[n], pf[272 * n]);
                  { const bool mir = half || u1 > 0; f32x2 kv = *(mir ? pm - 272 * 8 : pf + 272 * 8); if (mir) kv.y = -kv.y; c_mul_sw_ip(x[8], kv); }
#pragma unroll
                  for (int n = 9; n < 16; ++n) c_mul_swc_ip(x[n], *(pm - 272 * n)); }
                __syncthreads();
                fft4096(x, myF, u1, u, tw2, tw3);
                if (half) twiddle_w8192(x, twu1, false);
                __syncthreads();
#pragma unroll
                for (int k = 0; k < 16; ++k) (myF + pad(u1))[272 * k] = x[k];
                __syncthreads();
                if (ord == 0) {
                    { float a0[8];
                      sconv_apply(pa0, j0, wS[1], a0);
#pragma unroll
                      for (int i = 0; i < 8; ++i) { const f32x2 e = (FB0 + jp)[i], o = (FB1 + jp)[i]; zr[i] = a0[i] * (e.y + o.y + bias0 * vre[i]); zi[i] = e.x + o.x + bias0 * vim[i]; } }
                    { float a1[8];
                      sconv_apply(pa1, j0, wS[1], a1);
#pragma unroll
                      for (int i = 0; i < 8; ++i) zi[i] *= a1[i]; }
                    { const bf16_t* x2r = UT + (size_t)(1024 + c) * NTOK + rb; sconv_load(x2r, j0, pa0); sconv_load(x2r + SEQ, j0, pa1);
                      const bf16_t* vn = UT + (size_t)c * NTOK + (size_t)(2 * (bp < 3 ? bp + 1 : 3)) * SEQ; sconv_load(vn, j0, pv0); sconv_load(vn + SEQ, j0, pv1); }
                    __syncthreads();
#pragma unroll
                    for (int i = 0; i < 8; ++i) (FB0 + jp)[i] = (f32x2){zr[i], zi[i]};
                    __syncthreads();
                } else {
                    float a0[8], a1[8], r0[8], r1[8];
                    sconv_apply(pa0, j0, wS[2], a0); sconv_apply(pa1, j0, wS[2], a1);
#pragma unroll
                    for (int i = 0; i < 8; ++i) { const f32x2 e = (FB0 + jp)[i], o = (FB1 + jp)[i];
                        r0[i] = a0[i] * (e.y + o.y + bias1 * zr[i]); r1[i] = a1[i] * (e.x + o.x + bias1 * zi[i]); }
                    u32x4 p0, p1;
                    p0.x = cvt_pk_bf16(r0[0], r0[1]); p0.y = cvt_pk_bf16(r0[2], r0[3]); p0.z = cvt_pk_bf16(r0[4], r0[5]); p0.w = cvt_pk_bf16(r0[6], r0[7]);
                    p1.x = cvt_pk_bf16(r1[0], r1[1]); p1.y = cvt_pk_bf16(r1[2], r1[3]); p1.z = cvt_pk_bf16(r1[4], r1[5]); p1.w = cvt_pk_bf16(r1[6], r1[7]);
                    *(u32x4*)(OBT + (size_t)c * NTOK + rb + j0) = p0; *(u32x4*)(OBT + (size_t)c * NTOK + rb + SEQ + j0) = p1;
                    __syncthreads();
                }
            }
        }
    }
}
#undef HY_W8192
}
template <bool GATH, bool HK = false> struct MoeOrder {
    static constexpr bool GATHER = GATH; static constexpr bool HOOK = HK;
    const unsigned* rtc; unsigned need;
    __device__ __forceinline__ unsigned a_peek(const pg8::Unit& u, int wid, int lane) const { unsigned v = need; if (wid == 0 && lane == 0) v = __hip_atomic_load(rtc + u.pm, RLX_AGENT); return v; }
    __device__ __forceinline__ void a_wait(const pg8::Unit& u, unsigned seen, int wid, int lane) const {
        if (wid == 0) { if (lane == 0 && seen < need) { unsigned sp = 0; while (__hip_atomic_load(rtc + u.pm, RLX_AGENT) < need) { __builtin_amdgcn_s_sleep(2); if (++sp > (1u << 22)) break; } }
            asm volatile("" ::: "memory"); }
        __builtin_amdgcn_s_barrier(); asm volatile("" ::: "memory");
    }
    const LAS int* pref;
    int total, G, c, ncol, K;
    const char* A; const char* W; size_t wtile; const int* list;
    __device__ bool next(int i, pg8::Unit& u) const {
        const long L = (long)i * G + c; if (L >= total) return false;
        int id = (int)L; { const int q = total / 8, r = total % 8, xcd = id % 8, off = id / 8; id = (xcd < r ? xcd * (q + 1) : r * (q + 1) + (xcd - r) * q) + off; }
        const int rt = id / ncol, pn = id % ncol;
        int e = 0;
#pragma unroll
        for (int k = 1; k < 32; ++k) e += (pref[k] <= rt) ? 1 : 0;
        u.pm = rt; u.pn = pn; u.aux = e;
        u.a = GATH ? A : A + (size_t)rt * 256 * K * 2; u.b = W + (size_t)e * 3 * MiB + (size_t)pn * wtile;
        return true;
    }
    __device__ __forceinline__ void gather(const pg8::Unit& u, int R0, int R1, unsigned (&v)[2][2]) const {
        const int e = u.aux, j = u.pm - pref[e], cnt = pref[40 + e];
#pragma unroll
        for (int h = 0; h < 2; ++h)
#pragma unroll
            for (int i = 0; i < 2; ++i) { int r = j * 256 + h * 128 + (i ? R1 : R0); r = r < cnt ? r : 0; v[h][i] = (unsigned)(list[e * 32768 + r] >> 1) * (unsigned)(K * 2); }
    }
};

#ifndef MK_PER_PHASE
#define MK_PER_PHASE 0
#endif
constexpr int N_PHASES = 17;

__global__ void __launch_bounds__(NTHREADS, 2) fwd_kernel(Args args) {
    extern __shared__ __attribute__((aligned(16))) unsigned char lds_[];
    const int wave0_ = __builtin_amdgcn_readfirstlane((int)threadIdx.x >> 6);
#define MKFRAME(F) Frame F; { int t_ = wave0_ * 64 + (int)__builtin_amdgcn_mbcnt_hi(~0u, __builtin_amdgcn_mbcnt_lo(~0u, 0u)); asm volatile("" : "+v"(t_)); F.lds = (LAS unsigned char*)lds_; F.tid = t_; F.lane = t_ & 63; F.wave = __builtin_amdgcn_readfirstlane(t_ >> 6); \
        F.G = gridDim.x; F.bid = blockIdx.x; F.in = args.in; F.out = args.out; F.ws = args.ws; }
    volatile LAS unsigned* MISC = (volatile LAS unsigned*)((LAS unsigned char*)lds_ + MISC_OFF);
    if (threadIdx.x < 128) MISC[threadIdx.x] = 0u;
    __syncthreads();
    unsigned* ctl = (unsigned*)(args.ws + WS_CTL);
#define lo (args.ph_lo)
#define hi (args.ph_hi)
    if (hi - lo > 1) (void)xcd_barrier_post(ctl + CW_BAR, MISC, threadIdx.x == 0);
#ifndef PH_MASK
#define PH_MASK 0xFFFFFFFFu
#endif
#define IN(k) (lo <= (k) && (k) < hi)
#ifndef DUP_PHASE
#define DUP_PHASE -1
#endif
#define REP(k) _Pragma("unroll") for (int rep_ = 0; rep_ < ((DUP_PHASE) == (k) ? 2 : 1); ++rep_)
#ifdef TPROBE
    const unsigned long long t_start_ = __builtin_amdgcn_s_memrealtime(); unsigned long long t_mark_ = 0ull;
#define TMARK(k) do { if ((k) == (TPROBE)) t_mark_ = __builtin_amdgcn_s_memrealtime() - t_start_; } while (0)
#else
#define TMARK(k) do { } while (0)
#endif
#define SEAM(k) do { if (IN(k) && IN((k) + 1)) { XcdBarrier bar_; bar_.bar = (unsigned*)(args.ws + WS_CTL) + CW_BAR; bar_.x = xb_xcc_id(); bar_.st = (volatile LAS unsigned*)((LAS unsigned char*)lds_ + MISC_OFF); \
        xcd_barrier(bar_, wave0_ == 0 && __builtin_amdgcn_mbcnt_hi(~0u, __builtin_amdgcn_mbcnt_lo(~0u, 0u)) == 0u); } TMARK(k); } while (0)
#define WSP (args.ws)
#define mod0 ((const float*)(args.ws + WS_MOD))
#define mod1 (mod0 + 9 * 6144)
#define tab ((const float*)(args.ws + WS_TAB))

    if (IN(0)) { MKFRAME(F); p0_prologue(F, (unsigned*)(args.ws + WS_CTL) + CW_Q0, (volatile LAS unsigned*)((LAS unsigned char*)lds_ + MISC_OFF) + 4); }
    SEAM(0);
    if (IN(1)) REP(1) { MKFRAME(F); p1_norm_in(F); }
    SEAM(1);
    if (IN(2)) REP(2) { MKFRAME(F);
        { pg8::StaticOrder S; S.init(WSP + WS_BUF0, WSP + WS_WQKVH, NTOK, 1024, 1024, F.G, F.bid);
          pg8::EpiQKV E{(bf16_t*)(WSP + WS_Q), (bf16_t*)(WSP + WS_K), (bf16_t*)(WSP + WS_V), tab + TB_ROPE_C, tab + TB_ROPE_S, 0};
          pg8::gemm_phase(F.lds, F.tid, 1024, S, E); }
        { pg8::StaticOrder S; S.init(WSP + WS_Y1, WSP + WS_WQKVH + 5 * MiB, NTOK, 512, 512, F.G, F.bid);
          pg8::EpiQKV E{(bf16_t*)(WSP + WS_Q), (bf16_t*)(WSP + WS_K), (bf16_t*)(WSP + WS_V), tab + TB_ROPE_C, tab + TB_ROPE_S, 4};
          pg8::gemm_phase<pg8::EpiQKV, pg8::StaticOrder, true, 127, 122>(F.lds, F.tid, 512, S, E); }
        { pg8::StaticOrder S; S.init(WSP + WS_WQKVH + 3 * MiB, WSP + WS_Y1, 1536, NTOK, 512, F.G, F.bid);
          pg8::EpiBf16 E{(bf16_t*)(WSP + WS_UT), (size_t)NTOK};
          pg8::gemm_phase<pg8::EpiBf16, pg8::StaticOrder, true, 122, 127>(F.lds, F.tid, 512, S, E); }
        { pg8::StaticOrder S; S.init(WSP + WS_Y1 + (size_t)NTOK * DM, WSP + WS_WQKVH + 4 * MiB + 512 * 1024, NB * CTXL, 1024, 512, F.G, F.bid);
          pg8::EpiCtxKV E{(bf16_t*)(WSP + WS_K), (bf16_t*)(WSP + WS_V)};
          pg8::gemm_phase<pg8::EpiCtxKV, pg8::StaticOrder, true, 127, 122>(F.lds, F.tid, 512, S, E); }
    }
    SEAM(2);
    if (IN(3)) {
#ifndef NO_ATTN
        { MKFRAME(F); att::attn_phase(F); } __syncthreads();
#ifdef DUP_ATTN
        { MKFRAME(F); att::attn_phase(F); } __syncthreads();
#endif
#else
        { MKFRAME(F); bf16_t* o = (bf16_t*)(F.ws + WS_BUF0); for (size_t i = (size_t)F.bid * NTHREADS + F.tid; i < (size_t)NTOK * 64; i += (size_t)F.G * NTHREADS) { const size_t r = i >> 6, c8 = i & 63; *(u32x4*)(o + r * DM + c8 * 8) = (u32x4){0u, 0u, 0u, 0u}; } }
#endif
#ifndef NO_HYENA
        { MKFRAME(F); hy::hyena_phase(F); }
#ifdef DUP_HYENA
        __syncthreads(); { MKFRAME(F); hy::hyena_phase(F); }
#endif
#else
        { MKFRAME(F); bf16_t* o = (bf16_t*)(F.ws + WS_OBT); for (size_t i = (size_t)F.bid * NTHREADS + F.tid; i < (size_t)512 * NTOK / 8; i += (size_t)F.G * NTHREADS) *(u32x4*)(o + i * 8) = (u32x4){0u, 0u, 0u, 0u}; }
#endif
    }
    SEAM(3);
    if (IN(4)) REP(4) { MKFRAME(F); transpose_ob(F); }
    SEAM(4);
    if (IN(5)) REP(5) { MKFRAME(F);
        pg8::StaticOrder S; S.init(WSP + WS_BUF0, WSP + WS_WO, NTOK, 1024, OUT_FP8 ? 512 : 1024, F.G, F.bid);
        pg8::EpiResid<true> E{F.in[I_X], (bf16_t*)(WSP + WS_X), mod0 + 2 * 1024, nullptr};
        pg8::gemm_phase<pg8::EpiResid<true>, pg8::StaticOrder, OUT_FP8 != 0, OUT_FP8 ? 123 : 127, OUT_FP8 ? 122 : 127>(F.lds, F.tid, OUT_FP8 ? 512 : 1024, S, E);
    }
    SEAM(5);
        if (IN(6 + 0)) { MKFRAME(F); moe_front(F, 0); }
        SEAM(6 + 0);
        if (IN(6 + 1)) REP(9) { MKFRAME(F);
            moe_prefix(F, 0, (LAS int*)((LAS unsigned char*)lds_ + MISC_OFF + 64));
            MoeOrder<true> S; LAS int* pref = (LAS int*)((LAS unsigned char*)lds_ + MISC_OFF + 64); S.pref = pref; S.total = pref[32] * 4; S.G = F.G; S.c = F.bid; S.ncol = 4; S.K = 512;
            S.A = (const char*)(WSP + WS_BUF0); S.W = (const char*)(WSP + WS_WMOE + (size_t)0 * 32 * 3 * MiB); S.wtile = (size_t)256 * 512 * 2; S.list = (const int*)(WSP + WS_LIST);
            pg8::EpiGatedPub E{(unsigned char*)(WSP + WS_H), (size_t)512, (unsigned*)(WSP + WS_CTL) + CW_RT + 0 * 512};
            pg8::gemm_phase<pg8::EpiGatedPub, MoeOrder<true>, true, 127, 122>(F.lds, F.tid, 512, S, E);
        }
        if (IN(6 + 2)) REP(10) { MKFRAME(F);
            moe_prefix(F, 0, (LAS int*)((LAS unsigned char*)lds_ + MISC_OFF + 64));
            MoeOrder<false, true> S; LAS int* pref = (LAS int*)((LAS unsigned char*)lds_ + MISC_OFF + 64); S.pref = pref; S.total = pref[32] * 4; S.G = F.G; S.ncol = 4; S.K = 256;
            { const int rot = ((S.total % F.G) + 7) & ~7; S.c = (F.bid - rot + 2 * F.G) % F.G; }
            S.rtc = (const unsigned*)(WSP + WS_CTL) + CW_RT + 0 * 512; S.need = 32u;
            S.A = (const char*)(WSP + WS_H); S.W = (const char*)(WSP + WS_WMOE + (size_t)0 * 32 * 3 * MiB + 2 * MiB); S.wtile = (size_t)256 * 256 * 2; S.list = nullptr;
            pg8::EpiScatter E{(bf16_t*)(WSP + WS_Y0), (bf16_t*)(WSP + WS_Y1), (const int*)(WSP + WS_LIST), pref};
            pg8::gemm_phase<pg8::EpiScatter, MoeOrder<false, true>, true, 127, 122>(F.lds, F.tid, 256, S, E);
        }
        SEAM(6 + 2);
        if (IN(6 + 3)) {
            MKFRAME(F); moe_combine<0>(F, 0);
        }
        SEAM(6 + 3);

            if (IN(10)) REP(12) { MKFRAME(F);
                pg8::StaticOrder S; S.init(WSP + WS_BUF0, WSP + WS_WC1, NTOK, 2048, CONF_FP8 ? 512 : 1024, F.G, F.bid);
                pg8::EpiGated<1> E{(bf16_t*)(WSP + WS_GLU), (size_t)1024, F.in[I_CVB1], F.in[I_CVB1] + 1024};
                pg8::gemm_phase<pg8::EpiGated<1>, pg8::StaticOrder, CONF_FP8 != 0, 127, CONF_FP8 ? 122 : 127>(F.lds, F.tid, CONF_FP8 ? 512 : 1024, S, E);
            }
            SEAM(10);
            if (IN(11)) REP(13) { MKFRAME(F); conv_ln_phase(F); }
            SEAM(11);
            if (IN(12)) { MKFRAME(F);
                pg8::StaticOrder S; S.init(WSP + WS_BUF0, WSP + WS_WC2, NTOK, 1024, CONF_FP8 ? 512 : 1024, F.G, F.bid);
                pg8::EpiResid<false> E{WSP + WS_X, (bf16_t*)(WSP + WS_X), mod1 + 2 * 1024, F.in[I_CVB2]};
                pg8::gemm_phase<pg8::EpiResid<false>, pg8::StaticOrder, CONF_FP8 != 0, 127, CONF_FP8 ? 122 : 127>(F.lds, F.tid, CONF_FP8 ? 512 : 1024, S, E);
            }
            SEAM(12);
        if (IN(13 + 0)) { MKFRAME(F); moe_front(F, 1); }
        SEAM(13 + 0);
        if (IN(13 + 1)) REP(9) { MKFRAME(F);
            moe_prefix(F, 1, (LAS int*)((LAS unsigned char*)lds_ + MISC_OFF + 64));
            MoeOrder<true> S; LAS int* pref = (LAS int*)((LAS unsigned char*)lds_ + MISC_OFF + 64); S.pref = pref; S.total = pref[32] * 4; S.G = F.G; S.c = F.bid; S.ncol = 4; S.K = 512;
            S.A = (const char*)(WSP + WS_BUF0); S.W = (const char*)(WSP + WS_WMOE + (size_t)1 * 32 * 3 * MiB); S.wtile = (size_t)256 * 512 * 2; S.list = (const int*)(WSP + WS_LIST);
            pg8::EpiGatedPub E{(unsigned char*)(WSP + WS_H), (size_t)512, (unsigned*)(WSP + WS_CTL) + CW_RT + 1 * 512};
            pg8::gemm_phase<pg8::EpiGatedPub, MoeOrder<true>, true, 127, 122>(F.lds, F.tid, 512, S, E);
        }
        if (IN(13 + 2)) REP(10) { MKFRAME(F);
            moe_prefix(F, 1, (LAS int*)((LAS unsigned char*)lds_ + MISC_OFF + 64));
            MoeOrder<false, true> S; LAS int* pref = (LAS int*)((LAS unsigned char*)lds_ + MISC_OFF + 64); S.pref = pref; S.total = pref[32] * 4; S.G = F.G; S.ncol = 4; S.K = 256;
            { const int rot = ((S.total % F.G) + 7) & ~7; S.c = (F.bid - rot + 2 * F.G) % F.G; }
            S.rtc = (const unsigned*)(WSP + WS_CTL) + CW_RT + 1 * 512; S.need = 32u;
            S.A = (const char*)(WSP + WS_H); S.W = (const char*)(WSP + WS_WMOE + (size_t)1 * 32 * 3 * MiB + 2 * MiB); S.wtile = (size_t)256 * 256 * 2; S.list = nullptr;
            pg8::EpiScatter E{(bf16_t*)(WSP + WS_Y0), (bf16_t*)(WSP + WS_Y1), (const int*)(WSP + WS_LIST), pref};
            pg8::gemm_phase<pg8::EpiScatter, MoeOrder<false, true>, true, 127, 122>(F.lds, F.tid, 256, S, E);
        }
        SEAM(13 + 2);
        if (IN(13 + 3)) {
            MKFRAME(F); moe_combine<1>(F, 1);
        }

#ifdef TPROBE
    if (blockIdx.x == 0 && threadIdx.x == 0) { const unsigned long long t1 = __builtin_amdgcn_s_memrealtime(); while (__builtin_amdgcn_s_memrealtime() - t1 < 4ull * t_mark_) __builtin_amdgcn_s_sleep(8); }
#endif
#undef IN
#undef SEAM
#undef lo
#undef hi
#undef WSP
#undef mod0
#undef mod1
#undef tab
#undef MKFRAME
}

extern "C" void kernel_launch(void* const* d_in, const int* in_sizes, int n_in, void* d_out, int out_size, void* d_ws, size_t ws_size, hipStream_t stream) {
    static int grid = 0;
    if (grid == 0) {
        if (n_in != N_IN || out_size != NTOK * DM || ws_size < WS_END) { grid = -1; return; }
        int dev = 0, cus = 0, per_cu = 0;
        if (hipGetDevice(&dev) != hipSuccess || hipDeviceGetAttribute(&cus, hipDeviceAttributeMultiprocessorCount, dev) != hipSuccess) { grid = -1; return; }
        if (hipFuncSetAttribute((const void*)fwd_kernel, hipFuncAttributeMaxDynamicSharedMemorySize, LDS_BYTES) != hipSuccess) { grid = -1; return; }
        (void)hipOccupancyMaxActiveBlocksPerMultiprocessor(&per_cu, (const void*)fwd_kernel, NTHREADS, LDS_BYTES);
        (void)hipGetLastError();
        grid = cus;
    }
    if (grid < 0) return;
    (void)hipMemsetAsync((char*)d_ws + WS_CTL, 0, CTL_ZERO_BYTES, stream);
    Args a{};
    for (int i = 0; i < N_IN; ++i) a.in[i] = (const float*)d_in[i];
    a.out = (float*)d_out; a.ws = (unsigned char*)d_ws;
#if MK_PER_PHASE
    for (int p = 0; p < N_PHASES; ++p) { a.ph_lo = p; a.ph_hi = p + 1; hipLaunchKernelGGL(fwd_kernel, dim3(grid), dim3(NTHREADS), LDS_BYTES, stream, a); }
#else
    a.ph_lo = 0; a.ph_hi = N_PHASES;
    hipLaunchKernelGGL(fwd_kernel, dim3(grid), dim3(NTHREADS), LDS_BYTES, stream, a);
#endif
}
```
